# Optimizing an MI355X kernel written in HIP

```python
import jax, jax.numpy as jnp
from jax import lax
import numpy as np

D_MODEL = 1024
BATCH = 8
SEQ = 4096
DEPTH = 1

CHUNK = 64
RET_HEADS = 4
RET_DK = 128
RET_DV = 128
GDN_HEADS = 4
GDN_DK = 128
GDN_DV = 128
CONV_WIDTH = 4
D_FF = 4 * D_MODEL
ROPE_BASE = 10000.0
NORM_EPS = 1e-6
RET_QK_W = RET_HEADS * RET_DK
RET_W = RET_HEADS * RET_DV
GDN_QK_W = GDN_HEADS * GDN_DK
GDN_W = GDN_HEADS * GDN_DV
MIX_W = RET_W + GDN_W
CONV_CH = 2 * GDN_QK_W + GDN_W
D_IN = 2 * RET_QK_W + 2 * RET_W + 2 * GDN_QK_W + 2 * GDN_W + 2 * GDN_HEADS
N_MOD = 6

kernel_name = "hybrid_retention_gdn_adaln_block"


def rmsnorm(x, w):
    xf = x.astype(jnp.float32)
    y = xf * lax.rsqrt(jnp.mean(xf * xf, axis=-1, keepdims=True) + NORM_EPS)
    return (y * w.astype(jnp.float32)).astype(x.dtype)


def modulate(h, shift, scale):
    return h * (1.0 + scale[:, None, :]) + shift[:, None, :]


def l2norm(x):
    return x * lax.rsqrt(jnp.sum(x * x, axis=-1, keepdims=True) + NORM_EPS)


def rotary(x, positions):
    d = x.shape[-1]
    inv = ROPE_BASE ** (-jnp.arange(0, d, 2, dtype=jnp.float32) / d)
    ang = positions[:, None] * inv[None, :]
    cos = jnp.cos(ang)[None, :, None, :]
    sin = jnp.sin(ang)[None, :, None, :]
    x1, x2 = jnp.split(x, 2, axis=-1)
    return jnp.concatenate([x1 * cos - x2 * sin, x1 * sin + x2 * cos], axis=-1)


def causal_depthwise_conv(x, w):
    ch = x.shape[-1]
    return lax.conv_general_dilated(
        x, w[:, None, :], window_strides=(1,), padding=[(CONV_WIDTH - 1, 0)],
        dimension_numbers=("NWC", "WIO", "NWC"), feature_group_count=ch)


def to_chunks(x):
    b, t, h, d = x.shape
    return x.reshape(b, t // CHUNK, CHUNK, h, d).transpose(0, 3, 1, 2, 4)


def from_chunks(x):
    b, h, n, c, d = x.shape
    return x.transpose(0, 2, 3, 1, 4).reshape(b, n * c, h, d)


def retention_chunkwise(q, k, v):
    n_heads = q.shape[1]
    log_gamma = jnp.log(1.0 - 2.0 ** (-5.0 - jnp.arange(n_heads, dtype=jnp.float32)))
    j = jnp.arange(CHUNK, dtype=jnp.float32)
    intra_decay = jnp.exp(log_gamma[:, None, None] * jnp.abs(j[:, None] - j[None, :]))
    scores = jnp.einsum("bhncd,bhnsd->bhncs", q, k) * intra_decay[None, :, None]
    o_intra = jnp.einsum("bhncs,bhnsv->bhncv", scores, v)
    q_dec = q * jnp.exp(log_gamma[:, None] * (j + 1.0)[None, :])[None, :, None, :, None]
    k_dec = k * jnp.exp(log_gamma[:, None] * (CHUNK - 1.0 - j)[None, :])[None, :, None, :, None]
    chunk_decay = jnp.exp(log_gamma * CHUNK)[None, :, None, None]

    def step(state, xs):
        qd, kd, vc = xs
        o = jnp.einsum("bhcd,bhdv->bhcv", qd, state)
        state = state * chunk_decay + jnp.einsum("bhcd,bhcv->bhdv", kd, vc)
        return state, o

    b, h, _, _, dk = q.shape
    s0 = jnp.zeros((b, h, dk, v.shape[-1]), jnp.float32)
    xs = (jnp.moveaxis(q_dec, 2, 0), jnp.moveaxis(k_dec, 2, 0), jnp.moveaxis(v, 2, 0))
    _, o_cross = lax.scan(step, s0, xs)
    return o_intra + jnp.moveaxis(o_cross, 0, 2)


def gated_delta_rule_chunked(q, k, v, g, beta):
    gc = jnp.cumsum(g, axis=-1)
    idx = jnp.arange(CHUNK)
    tril = idx[:, None] >= idx[None, :]
    strict = idx[:, None] > idx[None, :]
    diff = gc[..., :, None] - gc[..., None, :]
    decay = jnp.exp(jnp.where(tril, diff, -jnp.inf))
    kk = jnp.einsum("bhncd,bhnsd->bhncs", k, k)
    lower = jnp.where(strict, beta[..., :, None] * kk * decay, 0.0)
    eye = jnp.eye(CHUNK, dtype=jnp.float32)
    rhs = jnp.concatenate([beta[..., None] * v, beta[..., None] * k * jnp.exp(gc)[..., None]], axis=-1)
    a_mat = jnp.broadcast_to(eye, lower.shape) + lower
    sol = lax.linalg.triangular_solve(a_mat, rhs, left_side=True, lower=True, unit_diagonal=True)
    dv = v.shape[-1]
    u, w = sol[..., :dv], sol[..., dv:]
    attn = jnp.einsum("bhncd,bhnsd->bhncs", q, k) * decay
    q_g = q * jnp.exp(gc)[..., None]
    g_last = gc[..., -1]
    k_dec = k * jnp.exp(g_last[..., None] - gc)[..., None]

    def step(state, xs):
        qg, at, uc, wc, kd, gl = xs
        v_new = uc - jnp.einsum("bhcd,bhdv->bhcv", wc, state)
        o = jnp.einsum("bhcd,bhdv->bhcv", qg, state) + jnp.einsum("bhcs,bhsv->bhcv", at, v_new)
        state = state * jnp.exp(gl)[:, :, None, None] + jnp.einsum("bhcd,bhcv->bhdv", kd, v_new)
        return state, o

    b, h, _, _, dk = q.shape
    s0 = jnp.zeros((b, h, dk, dv), jnp.float32)
    xs = tuple(jnp.moveaxis(t, 2, 0) for t in (q_g, attn, u, w, k_dec, g_last))
    _, o = lax.scan(step, s0, xs)
    return jnp.moveaxis(o, 0, 2)


def token_mix(proj, positions, conv_w, a_log, dt_bias, ret_norm_w, gdn_norm_w):
    b, t, _ = proj.shape
    sizes = (RET_QK_W, RET_QK_W, RET_W, RET_W, GDN_QK_W, GDN_QK_W, GDN_W, GDN_W, GDN_HEADS, GDN_HEADS)
    cuts = np.cumsum(sizes)[:-1].tolist()
    rq, rk, rv, rg, gq, gk, gv, gz, ga, gb = jnp.split(proj, cuts, axis=-1)

    rq = rotary(rq.reshape(b, t, RET_HEADS, RET_DK), positions)
    rk = rotary(rk.reshape(b, t, RET_HEADS, RET_DK), positions) * (RET_DK ** -0.5)
    rv = rv.reshape(b, t, RET_HEADS, RET_DV)
    ro = from_chunks(retention_chunkwise(to_chunks(rq), to_chunks(rk), to_chunks(rv)))
    mu = jnp.mean(ro, axis=-1, keepdims=True)
    var = jnp.mean(jnp.square(ro - mu), axis=-1, keepdims=True)
    ro = ((ro - mu) * lax.rsqrt(var + NORM_EPS)).reshape(b, t, RET_W) * ret_norm_w
    ret_out = ro * jax.nn.silu(rg)

    qkv = jax.nn.silu(causal_depthwise_conv(jnp.concatenate([gq, gk, gv], axis=-1), conv_w))
    gq, gk, gv = jnp.split(qkv, [GDN_QK_W, 2 * GDN_QK_W], axis=-1)
    gq = l2norm(gq.reshape(b, t, GDN_HEADS, GDN_DK)) * (GDN_DK ** -0.5)
    gk = l2norm(gk.reshape(b, t, GDN_HEADS, GDN_DK))
    gv = gv.reshape(b, t, GDN_HEADS, GDN_DV)
    beta = jax.nn.sigmoid(gb)
    g = -jnp.exp(a_log) * jax.nn.softplus(ga + dt_bias)
    n = t // CHUNK
    g_c = g.reshape(b, n, CHUNK, GDN_HEADS).transpose(0, 3, 1, 2)
    beta_c = beta.reshape(b, n, CHUNK, GDN_HEADS).transpose(0, 3, 1, 2)
    go = from_chunks(gated_delta_rule_chunked(to_chunks(gq), to_chunks(gk), to_chunks(gv), g_c, beta_c))
    go = go * lax.rsqrt(jnp.mean(go * go, axis=-1, keepdims=True) + NORM_EPS) * gdn_norm_w
    gdn_out = go.reshape(b, t, GDN_W) * jax.nn.silu(gz)

    return jnp.concatenate([ret_out, gdn_out], axis=-1)


def setup_inputs(seed: int = 0) -> dict:
    key = jax.random.key(seed)
    ks = jax.random.split(key, 20)
    f32 = jnp.float32
    nrm = lambda k, shape, s: jax.random.normal(k, shape, f32) * s
    dt = jnp.exp(jax.random.uniform(ks[7], (DEPTH, GDN_HEADS), f32, np.log(1e-3), np.log(1e-1)))
    return {
        "x": nrm(ks[0], (BATCH, SEQ, D_MODEL), 1.0),
        "c": nrm(ks[1], (BATCH, D_MODEL), 1.0),
        "ada_w": nrm(ks[2], (DEPTH, D_MODEL, N_MOD * D_MODEL), 0.5 * D_MODEL ** -0.5),
        "ada_b": nrm(ks[3], (DEPTH, N_MOD * D_MODEL), 0.02),
        "norm_mix_w": 1.0 + nrm(ks[4], (DEPTH, D_MODEL), 0.02),
        "w_in": nrm(ks[5], (DEPTH, D_MODEL, D_IN), D_MODEL ** -0.5),
        "conv_w": nrm(ks[6], (DEPTH, CONV_WIDTH, CONV_CH), CONV_WIDTH ** -0.5),
        "a_log": jnp.log(jax.random.uniform(ks[8], (DEPTH, GDN_HEADS), f32, 1.0, 16.0)),
        "dt_bias": dt + jnp.log(-jnp.expm1(-dt)),
        "ret_norm_w": 1.0 + nrm(ks[9], (DEPTH, RET_W), 0.02),
        "gdn_norm_w": 1.0 + nrm(ks[10], (DEPTH, GDN_DV), 0.02),
        "w_out": nrm(ks[11], (DEPTH, MIX_W, D_MODEL), MIX_W ** -0.5),
        "norm_mlp_w": 1.0 + nrm(ks[12], (DEPTH, D_MODEL), 0.02),
        "w_ff1": nrm(ks[13], (DEPTH, D_MODEL, D_FF), D_MODEL ** -0.5),
        "w_ff2": nrm(ks[14], (DEPTH, D_FF, D_MODEL), D_FF ** -0.5),
        "norm_final_w": 1.0 + nrm(ks[15], (D_MODEL,), 0.02),
    }


def reference(x, c, ada_w, ada_b, norm_mix_w, w_in, conv_w, a_log, dt_bias, ret_norm_w,
              gdn_norm_w, w_out, norm_mlp_w, w_ff1, w_ff2, norm_final_w):
    t = x.shape[1]
    positions = jnp.arange(t, dtype=jnp.float32)
    f32 = jnp.float32
    for l in range(DEPTH):
        mod = jax.nn.silu(c) @ ada_w[l] + ada_b[l]
        shift_a, scale_a, gate_a, shift_m, scale_m, gate_m = jnp.split(mod, N_MOD, axis=-1)
        h = modulate(rmsnorm(x, norm_mix_w[l]), shift_a, scale_a)
        proj = (h @ w_in[l]).astype(f32)
        mixed = token_mix(proj, positions, conv_w[l].astype(f32), a_log[l].astype(f32),
                          dt_bias[l].astype(f32), ret_norm_w[l].astype(f32),
                          gdn_norm_w[l].astype(f32)).astype(x.dtype)
        x = x + gate_a[:, None, :] * (mixed @ w_out[l])
        h = modulate(rmsnorm(x, norm_mlp_w[l]), shift_m, scale_m)
        x = x + gate_m[:, None, :] * (jnp.square(jax.nn.relu(h @ w_ff1[l])) @ w_ff2[l])
    return rmsnorm(x, norm_final_w)
```

```cpp
#include <hip/hip_runtime.h>
#include <hip/hip_cooperative_groups.h>
#include <cstdio>
#include <cstdint>
namespace cg = cooperative_groups;

#ifndef MK_N_LAUNCHES
#define MK_N_LAUNCHES 1
#endif

#define LAS __attribute__((address_space(3)))
typedef unsigned short bf16_t;
typedef short bf16x8 __attribute__((ext_vector_type(8)));
typedef float f32x4 __attribute__((ext_vector_type(4)));
typedef float f32x16 __attribute__((ext_vector_type(16)));
typedef unsigned u32x4 __attribute__((ext_vector_type(4)));
typedef unsigned u32x2 __attribute__((ext_vector_type(2)));
typedef float f32x2_t __attribute__((ext_vector_type(2)));
typedef __bf16 bf16x2_t __attribute__((ext_vector_type(2)));

#define DI __device__ __forceinline__

DI unsigned pk2(float lo, float hi) { f32x2_t v = {lo, hi}; bf16x2_t b = __builtin_convertvector(v, bf16x2_t); return __builtin_bit_cast(unsigned, b); }
DI unsigned short f2bf(float x) { return (unsigned short)(pk2(x, 0.f) & 0xffffu); }
DI float bf2f(unsigned short u) { return __builtin_bit_cast(float, ((unsigned)u) << 16); }
DI float bflo(unsigned u) { return __builtin_bit_cast(float, u << 16); }
DI float bfhi(unsigned u) { return __builtin_bit_cast(float, u & 0xffff0000u); }
DI float wave_sum(float v) {
#pragma unroll
    for (int o = 1; o < 64; o <<= 1) v += __shfl_xor(v, o);
    return v;
}
DI float silu_f(float v) { return v / (1.f + __expf(-v)); }
DI int lane_id() { return (int)__builtin_amdgcn_mbcnt_hi(~0u, __builtin_amdgcn_mbcnt_lo(~0u, 0u)); }

constexpr int BATCH = 8, SEQ = 4096, DM = 1024, MROWS = BATCH * SEQ, DFF = 4096, NPROJ = 4096, DIN = 4104, NMOD = 6144;
constexpr float EPS = 1e-6f;
constexpr size_t MiB = 1u << 20;
constexpr size_t WS_WIN = 0, WS_WOUT = 8 * MiB, WS_WFF1 = 10 * MiB, WS_WFF2 = 18 * MiB, WS_MOD = 26 * MiB, WS_GLAST = 26 * MiB + 256 * 1024, WS_CVEC = 26 * MiB + 512 * 1024, WS_SUMSQ = 26 * MiB + 768 * 1024, WS_GAB = 27 * MiB,
                 WS_ACT = 28 * MiB, WS_PROJ = 92 * MiB, WS_GREC = 348 * MiB, WS_BAR = 492 * MiB, WS_END = 493 * MiB;
constexpr size_t WS_X1 = WS_GREC + 64 * MiB;
constexpr size_t WS_ACT2 = WS_GREC;
constexpr int GREC = 73728, RREC = 57344;
constexpr int LDS_BYTES = 147456;

struct Args {
    const float* x; const float* c; const float* ada_w; const float* ada_b; const float* norm_mix_w; const float* w_in;
    const float* conv_w; const float* a_log; const float* dt_bias; const float* ret_norm_w; const float* gdn_norm_w;
    const float* w_out; const float* norm_mlp_w; const float* w_ff1; const float* w_ff2; const float* norm_final_w;
    float* out; unsigned char* ws; int ph_lo, ph_hi;
};

namespace pg8 {
constexpr int BM = 256, BK = 64, HALF = 128, HTB = HALF * BK * 2, STAGE_BYTES = 8 * HTB, NXCD = 8, WGM = 8;
__host__ __device__ __forceinline__ int lds_byte(int r, int c) { const int st = (r >> 4) * 2 + (c >> 5), rr = r & 15, cc = c & 31, ob = rr * 64 + cc * 2; return st * 1024 + (ob ^ (((ob >> 9) & 1) << 5)); }
__host__ __device__ __forceinline__ void stage_rc(int b, int& R, int& C) { const int st = b / 1024, sb = b % 1024, swz = sb ^ (((sb >> 9) & 1) << 5); R = (st >> 1) * 16 + swz / 64; C = (st & 1) * 32 + (swz % 64) / 2; }
__host__ __device__ __forceinline__ int perm32(int rho) { const int n = rho >> 4, i = rho & 15; return 8 * (i >> 2) + 4 * n + (i & 3); }

struct Unit { int pm, pn; };
struct Gemm { const bf16_t* A; const bf16_t* Bt; int M, N, K; };

struct StaticOrder {
    int nM, nN, nwg, G, c;
    __host__ __device__ void init(int M, int N, int G_, int c_) { nM = M / BM; nN = N / BM; nwg = nM * nN; G = G_; c = c_; }
    __host__ __device__ bool next(int i, Unit& u) const {
        const long L = (long)i * G + c; if (L >= nwg) return false;
        int wgid = (int)L; { const int q = nwg / NXCD, r = nwg % NXCD, xcd = wgid % NXCD, off = wgid / NXCD; wgid = (xcd < r ? xcd * (q + 1) : r * (q + 1) + (xcd - r) * q) + off; }
        const int nig = WGM * nN, gid = wgid / nig, fm = gid * WGM, gsz = (nM - fm) < WGM ? (nM - fm) : WGM;
        u.pm = fm + ((wgid % nig) % gsz); u.pn = (wgid % nig) / gsz; return true;
    }
    __device__ __forceinline__ void a_ready(const Unit&) const {}
    __device__ __forceinline__ void done(const Unit&) const {}
};

template <int ACT  > struct EpiBf16 {
    static constexpr bool PERM = true, AFTER_DRAIN = false;
    bf16_t* O; int ldc;
    __device__ __forceinline__ void operator()(const f32x4 (&acc)[2][2][4][2], const Unit& u, int wr, int wc, int fr, int fq) const {
        const int row0 = u.pm * BM + wr * 64 + fr; const int col0 = u.pn * BM + wc * 32 + 8 * fq;
#pragma unroll
        for (int ai = 0; ai < 2; ++ai)
#pragma unroll
            for (int m = 0; m < 4; ++m) { bf16_t* rowp = O + (size_t)(row0 + ai * HALF + m * 16) * ldc + col0;
#pragma unroll
                for (int bj = 0; bj < 2; ++bj) { f32x4 v0 = acc[ai][bj][m][0], v1 = acc[ai][bj][m][1];
                    if (ACT == 1) {
#pragma unroll
                        for (int e = 0; e < 4; ++e) { float a0 = fmaxf(v0[e], 0.f), a1 = fmaxf(v1[e], 0.f); v0[e] = a0 * a0; v1[e] = a1 * a1; } }
                    u32x4 w; w.x = pk2(v0[0], v0[1]); w.y = pk2(v0[2], v0[3]); w.z = pk2(v1[0], v1[1]); w.w = pk2(v1[2], v1[3]);
                    *(u32x4*)(rowp + bj * HALF) = w; } }
    }
};
struct EpiResGate {
    static constexpr bool PERM = true, AFTER_DRAIN = false;
    const float* res; float* out; const float* gate;
    __device__ __forceinline__ void operator()(const f32x4 (&acc)[2][2][4][2], const Unit& u, int wr, int wc, int fr, int fq) const {
        const int row0 = u.pm * BM + wr * 64 + fr; const int col0 = u.pn * BM + wc * 32 + 8 * fq;
        const float* g = gate + (size_t)(u.pm >> 4) * NMOD + col0;
        f32x4 gv[2][2];
#pragma unroll
        for (int bj = 0; bj < 2; ++bj) { gv[bj][0] = *(const f32x4*)(g + bj * HALF); gv[bj][1] = *(const f32x4*)(g + bj * HALF + 4); }
#pragma unroll
        for (int ai = 0; ai < 2; ++ai)
#pragma unroll
            for (int m = 0; m < 4; ++m) { const size_t p = (size_t)(row0 + ai * HALF + m * 16) * DM + col0;
#pragma unroll
                for (int bj = 0; bj < 2; ++bj) {
                    const f32x4 r0 = *(const f32x4*)(res + p + bj * HALF), r1 = *(const f32x4*)(res + p + bj * HALF + 4);
                    *(f32x4*)(out + p + bj * HALF) = r0 + gv[bj][0] * acc[ai][bj][m][0];
                    *(f32x4*)(out + p + bj * HALF + 4) = r1 + gv[bj][1] * acc[ai][bj][m][1]; } }
    }
};

struct EpiResGateNorm {
    static constexpr bool PERM = true, AFTER_DRAIN = false;
    const float* res; bf16_t* out; const float* gate; const float* nw; const float* scale; bf16_t* A2; float* sumsq;
    __device__ __forceinline__ void operator()(const f32x4 (&acc)[2][2][4][2], const Unit& u, int wr, int wc, int fr, int fq) const {
        const int row0 = u.pm * BM + wr * 64 + fr; const int col0 = u.pn * BM + wc * 32 + 8 * fq;
        const float* g = gate + (size_t)(u.pm >> 4) * NMOD + col0; const float* sc = scale + (size_t)(u.pm >> 4) * NMOD + col0;
        f32x4 gv[2][2], gm[2][2];
#pragma unroll
        for (int bj = 0; bj < 2; ++bj)
#pragma unroll
            for (int q = 0; q < 2; ++q) { gv[bj][q] = *(const f32x4*)(g + bj * HALF + 4 * q);
                gm[bj][q] = *(const f32x4*)(nw + col0 + bj * HALF + 4 * q) * (*(const f32x4*)(sc + bj * HALF + 4 * q) + 1.0f); }
#pragma unroll
        for (int ai = 0; ai < 2; ++ai)
#pragma unroll
            for (int m = 0; m < 4; ++m) { const int row = row0 + ai * HALF + m * 16; const size_t p = (size_t)row * DM + col0; float ss = 0.f;
#pragma unroll
                for (int bj = 0; bj < 2; ++bj) {
                    const f32x4 x0 = *(const f32x4*)(res + p + bj * HALF) + gv[bj][0] * acc[ai][bj][m][0], x1 = *(const f32x4*)(res + p + bj * HALF + 4) + gv[bj][1] * acc[ai][bj][m][1];
                    { u32x4 xw; xw.x = pk2(x0.x, x0.y); xw.y = pk2(x0.z, x0.w); xw.z = pk2(x1.x, x1.y); xw.w = pk2(x1.z, x1.w); *(u32x4*)(out + p + bj * HALF) = xw; }
                    ss += (x0.x * x0.x + x0.y * x0.y) + (x0.z * x0.z + x0.w * x0.w) + (x1.x * x1.x + x1.y * x1.y) + (x1.z * x1.z + x1.w * x1.w);
                    const f32x4 a0 = x0 * gm[bj][0], a1 = x1 * gm[bj][1];
                    u32x4 w; w.x = pk2(a0.x, a0.y); w.y = pk2(a0.z, a0.w); w.z = pk2(a1.x, a1.y); w.w = pk2(a1.z, a1.w);
                    *(u32x4*)(A2 + p + bj * HALF) = w; }
                ss += __shfl_xor(ss, 16); ss += __shfl_xor(ss, 32);
                if (fq == 0) unsafeAtomicAdd(sumsq + row, ss); }
    }
};
struct EpiResGateBf {
    static constexpr bool PERM = true, AFTER_DRAIN = false;
    bf16_t* X; const float* gate;
    __device__ __forceinline__ void operator()(const f32x4 (&acc)[2][2][4][2], const Unit& u, int wr, int wc, int fr, int fq) const {
        const int row0 = u.pm * BM + wr * 64 + fr; const int col0 = u.pn * BM + wc * 32 + 8 * fq;
        const float* g = gate + (size_t)(u.pm >> 4) * NMOD + col0;
        f32x4 gv[2][2];
#pragma unroll
        for (int bj = 0; bj < 2; ++bj) { gv[bj][0] = *(const f32x4*)(g + bj * HALF); gv[bj][1] = *(const f32x4*)(g + bj * HALF + 4); }
#pragma unroll
        for (int ai = 0; ai < 2; ++ai)
#pragma unroll
            for (int m = 0; m < 4; ++m) { bf16_t* rp = X + (size_t)(row0 + ai * HALF + m * 16) * DM + col0;
#pragma unroll
                for (int bj = 0; bj < 2; ++bj) {
                    const u32x4 xr = *(const u32x4*)(rp + bj * HALF);
                    const f32x4 r0 = (f32x4){bflo(xr.x), bfhi(xr.x), bflo(xr.y), bfhi(xr.y)}, r1 = (f32x4){bflo(xr.z), bfhi(xr.z), bflo(xr.w), bfhi(xr.w)};
                    const f32x4 y0 = r0 + gv[bj][0] * acc[ai][bj][m][0], y1 = r1 + gv[bj][1] * acc[ai][bj][m][1];
                    u32x4 w; w.x = pk2(y0.x, y0.y); w.y = pk2(y0.z, y0.w); w.z = pk2(y1.x, y1.y); w.w = pk2(y1.z, y1.w);
                    *(u32x4*)(rp + bj * HALF) = w; } }
    }
};
struct EpiFf1 {
    static constexpr bool PERM = true, AFTER_DRAIN = false;
    bf16_t* O; int ldc; const float* sumsq; const float* cvec;
    __device__ __forceinline__ void operator()(const f32x4 (&acc)[2][2][4][2], const Unit& u, int wr, int wc, int fr, int fq) const {
        const int row0 = u.pm * BM + wr * 64 + fr; const int col0 = u.pn * BM + wc * 32 + 8 * fq;
        const float* cv = cvec + (size_t)(u.pm >> 4) * DFF + col0;
        f32x4 cq[2][2];
#pragma unroll
        for (int bj = 0; bj < 2; ++bj)
#pragma unroll
            for (int q = 0; q < 2; ++q) cq[bj][q] = *(const f32x4*)(cv + bj * HALF + 4 * q);
#pragma unroll
        for (int ai = 0; ai < 2; ++ai)
#pragma unroll
            for (int m = 0; m < 4; ++m) { const int row = row0 + ai * HALF + m * 16; bf16_t* rowp = O + (size_t)row * ldc + col0;
                const float rstd = 1.0f / sqrtf(sumsq[row] * (1.f / DM) + EPS);
#pragma unroll
                for (int bj = 0; bj < 2; ++bj) { f32x4 v0 = acc[ai][bj][m][0] * rstd + cq[bj][0], v1 = acc[ai][bj][m][1] * rstd + cq[bj][1];
#pragma unroll
                    for (int e = 0; e < 4; ++e) { const float a0 = fmaxf(v0[e], 0.f), a1 = fmaxf(v1[e], 0.f); v0[e] = a0 * a0; v1[e] = a1 * a1; }
                    u32x4 w; w.x = pk2(v0[0], v0[1]); w.y = pk2(v0[2], v0[3]); w.z = pk2(v1[0], v1[1]); w.w = pk2(v1[2], v1[3]);
                    *(u32x4*)(rowp + bj * HALF) = w; } }
    }
};

template <class Epi, class Sched, bool ALIGN_EPI = false, bool SP2 = false>
__device__ __forceinline__ void gemm_phase(LAS unsigned char* lds, const Gemm g, const Sched& S, const Epi& E, int wv) {
    const int wid = wv, lane = lane_id(), tid = wv * 64 + lane, wr = wid >> 2, wc = wid & 3, fr = lane & 15, fq = lane >> 4;
    const int K = g.K, nt = K / BK;
    unsigned voffA[2], voffB[2];
#pragma unroll
    for (int i = 0; i < 2; ++i) { int R, C; stage_rc(tid * 16 + i * 8192, R, C); const int Rb = Epi::PERM ? ((R & ~31) + perm32(R & 31)) : R;
        voffA[i] = (unsigned)(R * K + C) * 2u; voffB[i] = (unsigned)(Rb * K + C) * 2u; }
    const size_t kstep = (size_t)(BK * 2);
    const size_t hstep = (size_t)HALF * K * 2;
    const size_t tstep = 2 * hstep;
    const unsigned ldsw = (unsigned)wid * 1024u;
    const int aoff = lds_byte(wr * 64 + fr, fq * 8), boff = lds_byte(wc * 32 + fr, fq * 8);
#define PG8_SA(b, h) (((b) * 2 + (h)) * HTB)
#define PG8_SB(b, h) ((4 + (b) * 2 + (h)) * HTB)
#define PG8_STAGE(bufoff, gbase, voff) do { _Pragma("unroll") for (int _i = 0; _i < 2; ++_i) \
        __builtin_amdgcn_global_load_lds((const unsigned*)((const char*)(gbase) + (voff)[_i]), (LAS unsigned*)(lds + (bufoff) + ldsw + _i * 8192), 16, 0, 0); } while (0)
#define PG8_LDA(dst, b, h) do { _Pragma("unroll") for (int m = 0; m < 4; ++m) _Pragma("unroll") for (int k = 0; k < 2; ++k) dst[m][k] = *(const LAS bf16x8*)(lds + PG8_SA(b, h) + aoff + m * 2048 + k * 1024); } while (0)
#define PG8_LDB(dst, b, h) do { _Pragma("unroll") for (int n = 0; n < 2; ++n) _Pragma("unroll") for (int k = 0; k < 2; ++k) dst[n][k] = *(const LAS bf16x8*)(lds + PG8_SB(b, h) + boff + n * 2048 + k * 1024); } while (0)
#define PG8_MMA(ai, bj, At, Bt) do { __builtin_amdgcn_s_setprio(1); _Pragma("unroll") for (int m = 0; m < 4; ++m) _Pragma("unroll") for (int n = 0; n < 2; ++n) _Pragma("unroll") for (int k = 0; k < 2; ++k) \
        acc[ai][bj][m][n] = __builtin_amdgcn_mfma_f32_16x16x32_bf16(Bt[n][k], At[m][k], acc[ai][bj][m][n], 0, 0, 0); __builtin_amdgcn_s_setprio(0); } while (0)
#define PG8_WAIT_V(n) asm volatile("s_waitcnt vmcnt(" #n ")" ::: "memory")
#define PG8_WAIT_L(n) asm volatile("s_waitcnt lgkmcnt(" #n ")" ::: "memory")
#define PG8_BAR __builtin_amdgcn_s_barrier()
#define PG8_SCHED __builtin_amdgcn_sched_barrier(0)
    Unit cur, nxt; int ui = 0;
    if (!S.next(0, cur)) return;
    f32x4 acc[2][2][4][2];
#pragma unroll
    for (int a = 0; a < 2; ++a)
#pragma unroll
        for (int b = 0; b < 2; ++b)
#pragma unroll
            for (int m = 0; m < 4; ++m)
#pragma unroll
                for (int n = 0; n < 2; ++n) acc[a][b][m][n] = (f32x4){0.f, 0.f, 0.f, 0.f};
    bf16x8 At[4][2], B0[2][2], B1[2][2];
    const char* cA = (const char*)g.A + (size_t)cur.pm * tstep; const char* cB = (const char*)g.Bt + (size_t)cur.pn * tstep;
    S.a_ready(cur);
    if constexpr (SP2) {
        PG8_STAGE(PG8_SB(0, 0), cB, voffB); PG8_STAGE(PG8_SB(0, 1), cB + hstep, voffB); PG8_STAGE(PG8_SA(0, 0), cA, voffA); PG8_STAGE(PG8_SA(0, 1), cA + hstep, voffA);
        if (wr == 1) PG8_BAR;
        PG8_WAIT_V(2); PG8_BAR;
        PG8_STAGE(PG8_SB(1, 0), cB + kstep, voffB); PG8_STAGE(PG8_SA(1, 0), cA + kstep, voffA); PG8_STAGE(PG8_SB(1, 1), cB + hstep + kstep, voffB);
        PG8_WAIT_V(6); PG8_BAR;
    } else {
        PG8_STAGE(PG8_SB(0, 0), cB, voffB); PG8_STAGE(PG8_SA(0, 0), cA, voffA); PG8_STAGE(PG8_SB(0, 1), cB + hstep, voffB); PG8_STAGE(PG8_SA(0, 1), cA + hstep, voffA);
        if (wr == 1) PG8_BAR;
        PG8_WAIT_V(4); PG8_BAR;
        PG8_STAGE(PG8_SB(1, 0), cB + kstep, voffB); PG8_STAGE(PG8_SA(1, 0), cA + kstep, voffA); PG8_STAGE(PG8_SB(1, 1), cB + hstep + kstep, voffB);
        PG8_WAIT_V(6); PG8_BAR;
    }
    for (;;) {
        const bool has_next = S.next(ui + 1, nxt);
        const char* nA = has_next ? (const char*)g.A + (size_t)nxt.pm * tstep : cA; const char* nB = has_next ? (const char*)g.Bt + (size_t)nxt.pn * tstep : cB;
        for (int t = 0; t < nt; t += 2) {
            const bool last = (t == nt - 2);
            const char* a1 = cA + (size_t)(t + 1) * kstep;
            const char* a2 = last ? nA : cA + (size_t)(t + 2) * kstep; const char* b2 = last ? nB : cB + (size_t)(t + 2) * kstep;
            const char* a3 = a2 + kstep; const char* b3 = b2 + kstep;
            if (last && has_next) S.a_ready(nxt);
            if constexpr (SP2) {
            PG8_LDB(B0, 0, 0); PG8_LDB(B1, 0, 1); PG8_SCHED; PG8_LDA(At, 0, 0); PG8_STAGE(PG8_SA(1, 1), a1 + hstep, voffA);
            PG8_WAIT_V(8); PG8_WAIT_L(0); PG8_BAR; PG8_MMA(0, 0, At, B0); PG8_MMA(0, 1, At, B1); PG8_BAR; PG8_SCHED;
            PG8_LDA(At, 0, 1); PG8_STAGE(PG8_SB(0, 0), b2, voffB); PG8_STAGE(PG8_SB(0, 1), b2 + hstep, voffB); PG8_STAGE(PG8_SA(0, 0), a2, voffA);
            PG8_WAIT_V(8); PG8_WAIT_L(0); PG8_BAR; PG8_MMA(1, 0, At, B0); PG8_MMA(1, 1, At, B1); PG8_BAR; PG8_SCHED;
            PG8_LDB(B0, 1, 0); PG8_LDB(B1, 1, 1); PG8_SCHED; PG8_LDA(At, 1, 0); PG8_STAGE(PG8_SA(0, 1), a2 + hstep, voffA);
            PG8_WAIT_V(8); PG8_WAIT_L(0); PG8_BAR; PG8_MMA(0, 0, At, B0); PG8_MMA(0, 1, At, B1); PG8_BAR; PG8_SCHED;
            PG8_LDA(At, 1, 1); PG8_STAGE(PG8_SB(1, 0), b3, voffB); PG8_STAGE(PG8_SB(1, 1), b3 + hstep, voffB); PG8_STAGE(PG8_SA(1, 0), a3, voffA);
            PG8_WAIT_V(8); PG8_WAIT_L(0); PG8_BAR; PG8_MMA(1, 0, At, B0); PG8_MMA(1, 1, At, B1); PG8_BAR; PG8_SCHED;
            } else {
            PG8_LDB(B0, 0, 0); PG8_SCHED; PG8_LDA(At, 0, 0); PG8_STAGE(PG8_SA(1, 1), a1 + hstep, voffA);
            PG8_WAIT_L(8); PG8_BAR; PG8_WAIT_L(0); PG8_MMA(0, 0, At, B0); PG8_BAR; PG8_SCHED;
            PG8_LDB(B1, 0, 1); PG8_STAGE(PG8_SB(0, 0), b2, voffB);
            PG8_BAR; PG8_WAIT_L(0); PG8_MMA(0, 1, At, B1); PG8_BAR;
            PG8_LDA(At, 0, 1); PG8_STAGE(PG8_SA(0, 0), a2, voffA);
            PG8_BAR; PG8_WAIT_L(0); PG8_MMA(1, 0, At, B0); PG8_BAR; PG8_SCHED;
            PG8_STAGE(PG8_SB(0, 1), b2 + hstep, voffB);
            PG8_WAIT_V(6); PG8_BAR; PG8_MMA(1, 1, At, B1); PG8_BAR;
            PG8_LDB(B0, 1, 0); PG8_SCHED; PG8_LDA(At, 1, 0); PG8_STAGE(PG8_SA(0, 1), a2 + hstep, voffA);
            PG8_WAIT_L(8); PG8_BAR; PG8_WAIT_L(0); PG8_MMA(0, 0, At, B0); PG8_BAR; PG8_SCHED;
            PG8_LDB(B1, 1, 1); PG8_STAGE(PG8_SB(1, 0), b3, voffB);
            PG8_BAR; PG8_WAIT_L(0); PG8_MMA(0, 1, At, B1); PG8_BAR;
            PG8_LDA(At, 1, 1); PG8_STAGE(PG8_SA(1, 0), a3, voffA);
            PG8_BAR; PG8_WAIT_L(0); PG8_MMA(1, 0, At, B0); PG8_BAR; PG8_SCHED;
            PG8_STAGE(PG8_SB(1, 1), b3 + hstep, voffB);
            PG8_WAIT_V(6); PG8_BAR; PG8_MMA(1, 1, At, B1); PG8_BAR;
            }
        }
        if constexpr (ALIGN_EPI) { if (wr == 0) PG8_BAR; }
        if constexpr (!Epi::AFTER_DRAIN) { E(acc, cur, wr, wc, fr, fq); S.done(cur); }
        if (!has_next) break;
#pragma unroll
        for (int a = 0; a < 2; ++a)
#pragma unroll
            for (int b = 0; b < 2; ++b)
#pragma unroll
                for (int m = 0; m < 4; ++m)
#pragma unroll
                    for (int n = 0; n < 2; ++n) acc[a][b][m][n] = (f32x4){0.f, 0.f, 0.f, 0.f};
        cur = nxt; cA = nA; cB = nB; ++ui;
        if constexpr (ALIGN_EPI) { if (wr == 1) PG8_BAR; }
    }
    PG8_WAIT_V(0);
    if constexpr (!ALIGN_EPI) { if (wr == 0) PG8_BAR; }
    PG8_BAR;
#undef PG8_SA
#undef PG8_SB
#undef PG8_STAGE
#undef PG8_LDA
#undef PG8_LDB
#undef PG8_MMA
#undef PG8_WAIT_V
#undef PG8_WAIT_L
#undef PG8_BAR
#undef PG8_SCHED
}
}

DI void p0_transpose_job(const float* W, int ldn, int K, bf16_t* WT, int kb, int nb, LAS unsigned char* lds, int wv) {
    LAS float* tile = (LAS float*)lds;
    const int tid = wv * 64 + lane_id(), k0 = kb * 64, n0 = nb * 256;
    f32x4 v[8];
#pragma unroll
    for (int i = 0; i < 8; ++i) v[i] = *(const f32x4*)(W + (size_t)(k0 + (tid >> 6) + 8 * i) * ldn + n0 + (tid & 63) * 4);
#pragma unroll
    for (int i = 0; i < 8; ++i) { LAS float* t = tile + ((tid >> 6) + 8 * i) * 257 + (tid & 63) * 4; t[0] = v[i].x; t[1] = v[i].y; t[2] = v[i].z; t[3] = v[i].w; }
    __syncthreads();
#pragma unroll
    for (int j = 0; j < 4; ++j) { const int n = (tid >> 3) + 64 * j, k8 = (tid & 7) * 8; const LAS float* s = tile + k8 * 257 + n;
      u32x4 o; o.x = pk2(s[0], s[257]); o.y = pk2(s[2 * 257], s[3 * 257]); o.z = pk2(s[4 * 257], s[5 * 257]); o.w = pk2(s[6 * 257], s[7 * 257]);
      *(u32x4*)(WT + (size_t)(n0 + n) * K + k0 + k8) = o; }
    __syncthreads();
}
DI void p0_phase(const Args& a, LAS unsigned char* lds, int wv) {
    const int tid = wv * 64 + lane_id(), G = gridDim.x, blk = blockIdx.x;
    for (int i = blk * 512 + tid; i < MROWS; i += G * 512) ((float*)(a.ws + WS_SUMSQ))[i] = 0.f;
    for (int cg_ = blk; cg_ < NMOD / 32; cg_ += G) {
        LAS float* sc = (LAS float*)lds;
        LAS float* red = (LAS float*)(lds + 32768);
        for (int i = tid; i < 8192; i += 512) sc[i] = silu_f(a.c[i]);
        __syncthreads();
        const int ks = tid >> 5, col = tid & 31, j0 = cg_ * 32;
        float acc[8];
#pragma unroll
        for (int b = 0; b < 8; ++b) acc[b] = 0.f;
#pragma unroll 16
        for (int kk = 0; kk < 64; ++kk) { const int k = ks * 64 + kk; const float w = a.ada_w[(size_t)k * NMOD + j0 + col];
#pragma unroll
            for (int b = 0; b < 8; ++b) acc[b] += sc[b * 1024 + k] * w; }
#pragma unroll
        for (int b = 0; b < 8; ++b) red[(ks * 8 + b) * 32 + col] = acc[b];
        __syncthreads();
        if (tid < 256) { const int b = tid >> 5, cc = tid & 31; float s = a.ada_b[j0 + cc];
#pragma unroll
            for (int q = 0; q < 16; ++q) s += red[(q * 8 + b) * 32 + cc];
            ((float*)(a.ws + WS_MOD))[b * NMOD + j0 + cc] = s; }
        __syncthreads();
    }
    constexpr int J_IN = 16 * 16, J_OUT = 16 * 4, J_F1 = 16 * 16, J_F2 = 64 * 4, NJ = J_IN + J_OUT + J_F1 + J_F2;
    for (int j = (blk + 64) % G; j < NJ; j += G) {
        int r = j;
        if (r < J_IN) { p0_transpose_job(a.w_in, DIN, 1024, (bf16_t*)(a.ws + WS_WIN), r / 16, r % 16, lds, wv); continue; } r -= J_IN;
        if (r < J_OUT) { p0_transpose_job(a.w_out, 1024, 1024, (bf16_t*)(a.ws + WS_WOUT), r / 4, r % 4, lds, wv); continue; } r -= J_OUT;
        if (r < J_F1) { p0_transpose_job(a.w_ff1, 4096, 1024, (bf16_t*)(a.ws + WS_WFF1), r / 16, r % 16, lds, wv); continue; } r -= J_F1;
        p0_transpose_job(a.w_ff2, 1024, 4096, (bf16_t*)(a.ws + WS_WFF2), r / 4, r % 4, lds, wv);
    }
}

template <bool GAB>
DI void norm_mod_phase(const float* src, const float* nw, const float* mod, int shift_off, int scale_off, bf16_t* dst, const float* w_in, float* gab, LAS unsigned char* lds, int wv) {
    const int lane = lane_id(), wave = wv, tid = wv * 64 + lane;
    LAS float* W8 = (LAS float*)lds;
    if (GAB) { for (int i = tid; i < 8192; i += 512) { const int k = i >> 3, j = i & 7; W8[j * 1024 + k] = w_in[(size_t)k * DIN + 4096 + j]; } __syncthreads(); }
    const int gw = blockIdx.x * 8 + wave, NGW = gridDim.x * 8, c0 = lane * 8;
    f32x4 nwv[2][2];
#pragma unroll
    for (int i = 0; i < 2; ++i)
#pragma unroll
        for (int q = 0; q < 2; ++q) nwv[i][q] = *(const f32x4*)(nw + c0 + 512 * i + 4 * q);
    for (int m = gw; m < MROWS; m += NGW) {
        const float* xr = src + (size_t)m * DM;
        f32x4 v[2][2]; float ss = 0.f;
#pragma unroll
        for (int i = 0; i < 2; ++i)
#pragma unroll
            for (int q = 0; q < 2; ++q) { v[i][q] = *(const f32x4*)(xr + c0 + 512 * i + 4 * q); ss += (v[i][q].x * v[i][q].x + v[i][q].y * v[i][q].y) + (v[i][q].z * v[i][q].z + v[i][q].w * v[i][q].w); }
        ss = wave_sum(ss);
        const float rstd = 1.0f / sqrtf(ss * (1.f / DM) + EPS);
        const float* sh = mod + (size_t)(m >> 12) * NMOD + shift_off; const float* sc = mod + (size_t)(m >> 12) * NMOD + scale_off;
        float p[8];
#pragma unroll
        for (int j = 0; j < 8; ++j) p[j] = 0.f;
#pragma unroll
        for (int i = 0; i < 2; ++i) {
            f32x4 hq[2];
#pragma unroll
            for (int q = 0; q < 2; ++q) { const f32x4 shv = *(const f32x4*)(sh + c0 + 512 * i + 4 * q), scv = *(const f32x4*)(sc + c0 + 512 * i + 4 * q);
                hq[q] = v[i][q] * rstd * nwv[i][q] * (scv + 1.0f) + shv; }
            u32x4 w; w.x = pk2(hq[0].x, hq[0].y); w.y = pk2(hq[0].z, hq[0].w); w.z = pk2(hq[1].x, hq[1].y); w.w = pk2(hq[1].z, hq[1].w);
            *(u32x4*)(dst + (size_t)m * DM + c0 + 512 * i) = w;
            if (GAB) {
#pragma unroll
                for (int q = 0; q < 2; ++q)
#pragma unroll
                    for (int j = 0; j < 8; ++j) { const f32x4 wv = *(const LAS f32x4*)(W8 + j * 1024 + c0 + 512 * i + 4 * q);
                        p[j] += (hq[q].x * wv.x + hq[q].y * wv.y) + (hq[q].z * wv.z + hq[q].w * wv.w); } }
        }
        if (GAB) {
#pragma unroll
            for (int j = 0; j < 8; ++j) p[j] = wave_sum(p[j]);
            if (lane == 0) { *(f32x4*)(gab + (size_t)m * 8) = (f32x4){p[0], p[1], p[2], p[3]}; *(f32x4*)(gab + (size_t)m * 8 + 4) = (f32x4){p[4], p[5], p[6], p[7]}; }
        }
    }
    if (GAB) __syncthreads();
}

DI int pinv16(int d) { return ((d >> 2) & 1) * 8 + (d >> 3) * 4 + (d & 3); }
constexpr int P3_Q = 0, P3_K = 17408, P3_V = 34816, P3_L = 52224, P3_GC = 69632, P3_BETA = 69888, P3_BE = 70144;
DI u32x4 pack16lo(const float* v) { u32x4 o; o.x = pk2(v[0], v[1]); o.y = pk2(v[2], v[3]); o.z = pk2(v[8], v[9]); o.w = pk2(v[10], v[11]); return o; }
DI u32x4 pack16hi(const float* v) { u32x4 o; o.x = pk2(v[4], v[5]); o.y = pk2(v[6], v[7]); o.z = pk2(v[12], v[13]); o.w = pk2(v[14], v[15]); return o; }

constexpr int P3_CW = 126976;
DI void conv_silu16(const bf16_t* proj, const LAS float* cwl, int b, int tpos, int colbase, int chl, float* val) {
#pragma unroll
    for (int e = 0; e < 16; ++e) val[e] = 0.f;
#pragma unroll
    for (int w = 0; w < 4; ++w) {
        const int tt = tpos - 3 + w;
        if (tt >= 0) {
            const bf16_t* src = proj + (size_t)(b * SEQ + tt) * NPROJ + colbase;
            const u32x4 x0 = *(const u32x4*)src, x1 = *(const u32x4*)(src + 8);
            const LAS float* cw = cwl + w * 128 + chl;
            const f32x4 c0 = *(const LAS f32x4*)cw, c1 = *(const LAS f32x4*)(cw + 4), c2 = *(const LAS f32x4*)(cw + 8), c3 = *(const LAS f32x4*)(cw + 12);
            val[0] += c0.x * bflo(x0.x); val[1] += c0.y * bfhi(x0.x); val[2] += c0.z * bflo(x0.y); val[3] += c0.w * bfhi(x0.y);
            val[4] += c1.x * bflo(x0.z); val[5] += c1.y * bfhi(x0.z); val[6] += c1.z * bflo(x0.w); val[7] += c1.w * bfhi(x0.w);
            val[8] += c2.x * bflo(x1.x); val[9] += c2.y * bfhi(x1.x); val[10] += c2.z * bflo(x1.y); val[11] += c2.w * bfhi(x1.y);
            val[12] += c3.x * bflo(x1.z); val[13] += c3.y * bfhi(x1.z); val[14] += c3.z * bflo(x1.w); val[15] += c3.w * bfhi(x1.w);
        }
    }
#pragma unroll
    for (int e = 0; e < 16; ++e) val[e] = silu_f(val[e]);
}
DI void st16_lds(LAS unsigned char* p, const float* v) {
    u32x4 o0, o1; o0.x = pk2(v[0], v[1]); o0.y = pk2(v[2], v[3]); o0.z = pk2(v[4], v[5]); o0.w = pk2(v[6], v[7]);
    o1.x = pk2(v[8], v[9]); o1.y = pk2(v[10], v[11]); o1.z = pk2(v[12], v[13]); o1.w = pk2(v[14], v[15]);
    *(LAS u32x4*)p = o0; *(LAS u32x4*)(p + 16) = o1;
}
DI float red8(float v) { v += __shfl_xor(v, 1); v += __shfl_xor(v, 2); v += __shfl_xor(v, 4); return v; }

DI void p3_ret_half(const Args& a, LAS unsigned char* lds, int b, int n, int h, int t2in);
DI void p3_pair_item(const Args& a, LAS unsigned char* lds, int b, int n, int h, int rb, int rn, int rh, int wv) {
    int tid_ = wv * 64 + lane_id(); asm volatile("" : "+v"(tid_));
    const int tid = tid_, lane = tid & 63, wave = tid >> 6;
    const bf16_t* proj = (const bf16_t*)(a.ws + WS_PROJ);
    const float* gab = (const float*)(a.ws + WS_GAB);
    const int bh = b * 4 + h;
    unsigned char* rec = a.ws + WS_GREC + (size_t)(bh * 64 + n) * GREC;
    bf16_t* uT = (bf16_t*)rec; bf16_t* wG = (bf16_t*)(rec + 16384); bf16_t* qgG = (bf16_t*)(rec + 32768); bf16_t* kdT = (bf16_t*)(rec + 49152); bf16_t* atG = (bf16_t*)(rec + 65536);
    LAS float* gcs = (LAS float*)(lds + P3_GC); LAS float* betas = (LAS float*)(lds + P3_BETA); LAS float* bes = (LAS float*)(lds + P3_BE); LAS float* Ls = (LAS float*)(lds + P3_L);
    if (wave == 0) {
        const size_t m = (size_t)b * SEQ + n * 64 + lane;
        const float ga = gab[m * 8 + h], gb = gab[m * 8 + 4 + h];
        const float beta = 1.f / (1.f + __expf(-gb));
        const float xx = ga + a.dt_bias[h];
        const float sp = fmaxf(xx, 0.f) + log1pf(__expf(-fabsf(xx)));
        float g = -__expf(a.a_log[h]) * sp;
#pragma unroll
        for (int o = 1; o < 64; o <<= 1) { const float t = __shfl_up(g, o); if (lane >= o) g += t; }
        gcs[lane] = g; betas[lane] = beta; bes[lane] = beta * __expf(g);
    }
    const int r = tid >> 3, cb = tid & 7, c0 = cb * 16, tpos = n * 64 + r;
    float qv[16];
    {
        conv_silu16(proj, (const LAS float*)(lds + P3_CW), b, tpos, 2048 + h * 128 + c0, c0, qv);
        float ss = 0.f;
#pragma unroll
        for (int e = 0; e < 16; ++e) ss += qv[e] * qv[e];
        ss = red8(ss); const float rn = (1.0f / sqrtf(ss + EPS)) * 0.08838834764831845f;
#pragma unroll
        for (int e = 0; e < 16; ++e) qv[e] *= rn;
        st16_lds(lds + P3_Q + r * 272 + c0 * 2, qv);
    }
    {
        float kv[16];
        conv_silu16(proj, (const LAS float*)(lds + P3_CW) + 512, b, tpos, 2560 + h * 128 + c0, c0, kv);
        float ss = 0.f;
#pragma unroll
        for (int e = 0; e < 16; ++e) ss += kv[e] * kv[e];
        ss = red8(ss); const float rn = 1.0f / sqrtf(ss + EPS);
#pragma unroll
        for (int e = 0; e < 16; ++e) kv[e] *= rn;
        st16_lds(lds + P3_K + r * 272 + c0 * 2, kv);
    }
    {
        float vv[16];
        conv_silu16(proj, (const LAS float*)(lds + P3_CW) + 1024, b, tpos, 3072 + h * 128 + c0, c0, vv);
        st16_lds(lds + P3_V + r * 272 + c0 * 2, vv);
    }
    __syncthreads();
    {
        const float eg = __expf(gcs[r]);
#pragma unroll
        for (int e = 0; e < 16; ++e) qv[e] *= eg;
        *(u32x4*)(qgG + r * 128 + c0) = pack16lo(qv); *(u32x4*)(qgG + r * 128 + c0 + 8) = pack16hi(qv);
    }
#pragma unroll
    for (int i = 0; i < 4; ++i) {
        const int ti = wave * 4 + i, mat = ti >> 4, mt = (ti >> 2) & 3, nt = ti & 3;
        const LAS unsigned char* Ab = lds + (mat ? P3_Q : P3_K) + (16 * mt + (lane & 15)) * 272 + (lane >> 4) * 16;
        const LAS unsigned char* Bb = lds + P3_K + (16 * nt + (lane & 15)) * 272 + (lane >> 4) * 16;
        f32x4 acc = {0.f, 0.f, 0.f, 0.f};
#pragma unroll
        for (int s = 0; s < 4; ++s) acc = __builtin_amdgcn_mfma_f32_16x16x32_bf16(*(const LAS bf16x8*)(Ab + s * 64), *(const LAS bf16x8*)(Bb + s * 64), acc, 0, 0, 0);
        const int jj = 16 * nt + (lane & 15); const float gj = gcs[jj];
#pragma unroll
        for (int j = 0; j < 4; ++j) {
            const int ii = 16 * mt + (lane >> 4) * 4 + j; const float gi = gcs[ii];
            if (mat == 0) { Ls[ii * 68 + jj] = (ii > jj) ? betas[ii] * acc[j] * __expf(gi - gj) : 0.f; }
            else { const float v = (ii >= jj) ? acc[j] * __expf(gi - gj) : 0.f; atG[ii * 64 + (jj & ~15) + pinv16(jj & 15)] = f2bf(v); }
        }
    }
    __syncthreads();
    if (tid < 256) {
        const int col = tid; const bool isu = col < 128;
        int xoff = (isu ? P3_V : P3_K) + 2 * (isu ? col : col - 128), coff = isu ? P3_BETA : P3_BE;
        asm volatile("" : "+v"(xoff), "+v"(coff));
        const LAS unsigned short* Xp = (const LAS unsigned short*)(lds + xoff);
        const LAS float* cf = (const LAS float*)(lds + coff);
        float xs[64];
#pragma unroll
        for (int i = 0; i < 64; ++i) xs[i] = cf[i] * bf2f(Xp[i * 136]);
        f32x4 LB0[12], LB1[12];
        int zlane; asm volatile("v_mov_b32 %0, 0" : "=v"(zlane));
        const LAS float* Lv = Ls + zlane;
#define SOL_L(b, k, off) LB##b[k] = *(const LAS f32x4*)(Lv + (off))
#define SOL_F(i, j, b, k, c) xs[i] = fmaf(-LB##b[k].c, xs[j], xs[i])
        SOL_L(0, 0, 68); SOL_L(0, 1, 136); SOL_L(0, 2, 204); SOL_L(0, 3, 272); SOL_L(0, 4, 340); SOL_L(0, 5, 344); SOL_L(0, 6, 408); SOL_L(0, 7, 412); SOL_L(0, 8, 476); SOL_L(0, 9, 480); SOL_L(0, 10, 544); SOL_L(0, 11, 548);
        SOL_L(1, 0, 612); SOL_L(1, 1, 616); SOL_L(1, 2, 620); SOL_L(1, 3, 680); SOL_L(1, 4, 684); SOL_L(1, 5, 688); SOL_L(1, 6, 748); SOL_L(1, 7, 752); SOL_L(1, 8, 756); SOL_L(1, 9, 816); SOL_L(1, 10, 820); SOL_L(1, 11, 824);
        __builtin_amdgcn_sched_barrier(0);
        SOL_F(1, 0, 0, 0, x);
        SOL_F(2, 0, 0, 1, x); SOL_F(2, 1, 0, 1, y);
        SOL_F(3, 0, 0, 2, x); SOL_F(3, 1, 0, 2, y); SOL_F(3, 2, 0, 2, z);
        SOL_F(4, 0, 0, 3, x); SOL_F(4, 1, 0, 3, y); SOL_F(4, 2, 0, 3, z); SOL_F(4, 3, 0, 3, w);
        SOL_F(5, 0, 0, 4, x); SOL_F(5, 1, 0, 4, y); SOL_F(5, 2, 0, 4, z); SOL_F(5, 3, 0, 4, w);
        SOL_F(5, 4, 0, 5, x);
        SOL_F(6, 0, 0, 6, x); SOL_F(6, 1, 0, 6, y); SOL_F(6, 2, 0, 6, z); SOL_F(6, 3, 0, 6, w);
        SOL_F(6, 4, 0, 7, x); SOL_F(6, 5, 0, 7, y);
        SOL_F(7, 0, 0, 8, x); SOL_F(7, 1, 0, 8, y); SOL_F(7, 2, 0, 8, z); SOL_F(7, 3, 0, 8, w);
        SOL_F(7, 4, 0, 9, x); SOL_F(7, 5, 0, 9, y); SOL_F(7, 6, 0, 9, z);
        SOL_F(8, 0, 0, 10, x); SOL_F(8, 1, 0, 10, y); SOL_F(8, 2, 0, 10, z); SOL_F(8, 3, 0, 10, w);
        SOL_F(8, 4, 0, 11, x); SOL_F(8, 5, 0, 11, y); SOL_F(8, 6, 0, 11, z); SOL_F(8, 7, 0, 11, w);
        __builtin_amdgcn_sched_barrier(0);
        SOL_L(0, 0, 884); SOL_L(0, 1, 888); SOL_L(0, 2, 892); SOL_L(0, 3, 896); SOL_L(0, 4, 952); SOL_L(0, 5, 956); SOL_L(0, 6, 960); SOL_L(0, 7, 964); SOL_L(0, 8, 1020); SOL_L(0, 9, 1024); SOL_L(0, 10, 1028); SOL_L(0, 11, 1032);
        __builtin_amdgcn_sched_barrier(0);
        SOL_F(9, 0, 1, 0, x); SOL_F(9, 1, 1, 0, y); SOL_F(9, 2, 1, 0, z); SOL_F(9, 3, 1, 0, w);
        SOL_F(9, 4, 1, 1, x); SOL_F(9, 5, 1, 1, y); SOL_F(9, 6, 1, 1, z); SOL_F(9, 7, 1, 1, w);
        SOL_F(9, 8, 1, 2, x);
        SOL_F(10, 0, 1, 3, x); SOL_F(10, 1, 1, 3, y); SOL_F(10, 2, 1, 3, z); SOL_F(10, 3, 1, 3, w);
        SOL_F(10, 4, 1, 4, x); SOL_F(10, 5, 1, 4, y); SOL_F(10, 6, 1, 4, z); SOL_F(10, 7, 1, 4, w);
        SOL_F(10, 8, 1, 5, x); SOL_F(10, 9, 1, 5, y);
        SOL_F(11, 0, 1, 6, x); SOL_F(11, 1, 1, 6, y); SOL_F(11, 2, 1, 6, z); SOL_F(11, 3, 1, 6, w);
        SOL_F(11, 4, 1, 7, x); SOL_F(11, 5, 1, 7, y); SOL_F(11, 6, 1, 7, z); SOL_F(11, 7, 1, 7, w);
        SOL_F(11, 8, 1, 8, x); SOL_F(11, 9, 1, 8, y); SOL_F(11, 10, 1, 8, z);
        SOL_F(12, 0, 1, 9, x); SOL_F(12, 1, 1, 9, y); SOL_F(12, 2, 1, 9, z); SOL_F(12, 3, 1, 9, w);
        SOL_F(12, 4, 1, 10, x); SOL_F(12, 5, 1, 10, y); SOL_F(12, 6, 1, 10, z); SOL_F(12, 7, 1, 10, w);
        SOL_F(12, 8, 1, 11, x); SOL_F(12, 9, 1, 11, y); SOL_F(12, 10, 1, 11, z); SOL_F(12, 11, 1, 11, w);
        __builtin_amdgcn_sched_barrier(0);
        SOL_L(1, 0, 1088); SOL_L(1, 1, 1092); SOL_L(1, 2, 1096); SOL_L(1, 3, 1100); SOL_L(1, 4, 1156); SOL_L(1, 5, 1160); SOL_L(1, 6, 1164); SOL_L(1, 7, 1168); SOL_L(1, 8, 1172); SOL_L(1, 9, 1224); SOL_L(1, 10, 1228); SOL_L(1, 11, 1232);
        __builtin_amdgcn_sched_barrier(0);
        SOL_F(13, 0, 0, 0, x); SOL_F(13, 1, 0, 0, y); SOL_F(13, 2, 0, 0, z); SOL_F(13, 3, 0, 0, w);
        SOL_F(13, 4, 0, 1, x); SOL_F(13, 5, 0, 1, y); SOL_F(13, 6, 0, 1, z); SOL_F(13, 7, 0, 1, w);
        SOL_F(13, 8, 0, 2, x); SOL_F(13, 9, 0, 2, y); SOL_F(13, 10, 0, 2, z); SOL_F(13, 11, 0, 2, w);
        SOL_F(13, 12, 0, 3, x);
        SOL_F(14, 0, 0, 4, x); SOL_F(14, 1, 0, 4, y); SOL_F(14, 2, 0, 4, z); SOL_F(14, 3, 0, 4, w);
        SOL_F(14, 4, 0, 5, x); SOL_F(14, 5, 0, 5, y); SOL_F(14, 6, 0, 5, z); SOL_F(14, 7, 0, 5, w);
        SOL_F(14, 8, 0, 6, x); SOL_F(14, 9, 0, 6, y); SOL_F(14, 10, 0, 6, z); SOL_F(14, 11, 0, 6, w);
        SOL_F(14, 12, 0, 7, x); SOL_F(14, 13, 0, 7, y);
        SOL_F(15, 0, 0, 8, x); SOL_F(15, 1, 0, 8, y); SOL_F(15, 2, 0, 8, z); SOL_F(15, 3, 0, 8, w);
        SOL_F(15, 4, 0, 9, x); SOL_F(15, 5, 0, 9, y); SOL_F(15, 6, 0, 9, z); SOL_F(15, 7, 0, 9, w);
        SOL_F(15, 8, 0, 10, x); SOL_F(15, 9, 0, 10, y); SOL_F(15, 10, 0, 10, z); SOL_F(15, 11, 0, 10, w);
        SOL_F(15, 12, 0, 11, x); SOL_F(15, 13, 0, 11, y); SOL_F(15, 14, 0, 11, z);
        __builtin_amdgcn_sched_barrier(0);
        SOL_L(0, 0, 1236); SOL_L(0, 1, 1240); SOL_L(0, 2, 1292); SOL_L(0, 3, 1296); SOL_L(0, 4, 1300); SOL_L(0, 5, 1304); SOL_L(0, 6, 1308); SOL_L(0, 7, 1360); SOL_L(0, 8, 1364); SOL_L(0, 9, 1368); SOL_L(0, 10, 1372); SOL_L(0, 11, 1376);
        __builtin_amdgcn_sched_barrier(0);
        SOL_F(16, 0, 1, 0, x); SOL_F(16, 1, 1, 0, y); SOL_F(16, 2, 1, 0, z); SOL_F(16, 3, 1, 0, w);
        SOL_F(16, 4, 1, 1, x); SOL_F(16, 5, 1, 1, y); SOL_F(16, 6, 1, 1, z); SOL_F(16, 7, 1, 1, w);
        SOL_F(16, 8, 1, 2, x); SOL_F(16, 9, 1, 2, y); SOL_F(16, 10, 1, 2, z); SOL_F(16, 11, 1, 2, w);
        SOL_F(16, 12, 1, 3, x); SOL_F(16, 13, 1, 3, y); SOL_F(16, 14, 1, 3, z); SOL_F(16, 15, 1, 3, w);
        SOL_F(17, 0, 1, 4, x); SOL_F(17, 1, 1, 4, y); SOL_F(17, 2, 1, 4, z); SOL_F(17, 3, 1, 4, w);
        SOL_F(17, 4, 1, 5, x); SOL_F(17, 5, 1, 5, y); SOL_F(17, 6, 1, 5, z); SOL_F(17, 7, 1, 5, w);
        SOL_F(17, 8, 1, 6, x); SOL_F(17, 9, 1, 6, y); SOL_F(17, 10, 1, 6, z); SOL_F(17, 11, 1, 6, w);
        SOL_F(17, 12, 1, 7, x); SOL_F(17, 13, 1, 7, y); SOL_F(17, 14, 1, 7, z); SOL_F(17, 15, 1, 7, w);
        SOL_F(17, 16, 1, 8, x);
        SOL_F(18, 0, 1, 9, x); SOL_F(18, 1, 1, 9, y); SOL_F(18, 2, 1, 9, z); SOL_F(18, 3, 1, 9, w);
        SOL_F(18, 4, 1, 10, x); SOL_F(18, 5, 1, 10, y); SOL_F(18, 6, 1, 10, z); SOL_F(18, 7, 1, 10, w);
        SOL_F(18, 8, 1, 11, x); SOL_F(18, 9, 1, 11, y); SOL_F(18, 10, 1, 11, z); SOL_F(18, 11, 1, 11, w);
        __builtin_amdgcn_sched_barrier(0);
        SOL_L(1, 0, 1428); SOL_L(1, 1, 1432); SOL_L(1, 2, 1436); SOL_L(1, 3, 1440); SOL_L(1, 4, 1444); SOL_L(1, 5, 1448); SOL_L(1, 6, 1496); SOL_L(1, 7, 1500); SOL_L(1, 8, 1504); SOL_L(1, 9, 1508); SOL_L(1, 10, 1512); SOL_L(1, 11, 1516);
        __builtin_amdgcn_sched_barrier(0);
        SOL_F(18, 12, 0, 0, x); SOL_F(18, 13, 0, 0, y); SOL_F(18, 14, 0, 0, z); SOL_F(18, 15, 0, 0, w);
        SOL_F(18, 16, 0, 1, x); SOL_F(18, 17, 0, 1, y);
        SOL_F(19, 0, 0, 2, x); SOL_F(19, 1, 0, 2, y); SOL_F(19, 2, 0, 2, z); SOL_F(19, 3, 0, 2, w);
        SOL_F(19, 4, 0, 3, x); SOL_F(19, 5, 0, 3, y); SOL_F(19, 6, 0, 3, z); SOL_F(19, 7, 0, 3, w);
        SOL_F(19, 8, 0, 4, x); SOL_F(19, 9, 0, 4, y); SOL_F(19, 10, 0, 4, z); SOL_F(19, 11, 0, 4, w);
        SOL_F(19, 12, 0, 5, x); SOL_F(19, 13, 0, 5, y); SOL_F(19, 14, 0, 5, z); SOL_F(19, 15, 0, 5, w);
        SOL_F(19, 16, 0, 6, x); SOL_F(19, 17, 0, 6, y); SOL_F(19, 18, 0, 6, z);
        SOL_F(20, 0, 0, 7, x); SOL_F(20, 1, 0, 7, y); SOL_F(20, 2, 0, 7, z); SOL_F(20, 3, 0, 7, w);
        SOL_F(20, 4, 0, 8, x); SOL_F(20, 5, 0, 8, y); SOL_F(20, 6, 0, 8, z); SOL_F(20, 7, 0, 8, w);
        SOL_F(20, 8, 0, 9, x); SOL_F(20, 9, 0, 9, y); SOL_F(20, 10, 0, 9, z); SOL_F(20, 11, 0, 9, w);
        SOL_F(20, 12, 0, 10, x); SOL_F(20, 13, 0, 10, y); SOL_F(20, 14, 0, 10, z); SOL_F(20, 15, 0, 10, w);
        SOL_F(20, 16, 0, 11, x); SOL_F(20, 17, 0, 11, y); SOL_F(20, 18, 0, 11, z); SOL_F(20, 19, 0, 11, w);
        __builtin_amdgcn_sched_barrier(0);
        SOL_L(0, 0, 1564); SOL_L(0, 1, 1568); SOL_L(0, 2, 1572); SOL_L(0, 3, 1576); SOL_L(0, 4, 1580); SOL_L(0, 5, 1584); SOL_L(0, 6, 1632); SOL_L(0, 7, 1636); SOL_L(0, 8, 1640); SOL_L(0, 9, 1644); SOL_L(0, 10, 1648); SOL_L(0, 11, 1652);
        __builtin_amdgcn_sched_barrier(0);
        SOL_F(21, 0, 1, 0, x); SOL_F(21, 1, 1, 0, y); SOL_F(21, 2, 1, 0, z); SOL_F(21, 3, 1, 0, w);
        SOL_F(21, 4, 1, 1, x); SOL_F(21, 5, 1, 1, y); SOL_F(21, 6, 1, 1, z); SOL_F(21, 7, 1, 1, w);
        SOL_F(21, 8, 1, 2, x); SOL_F(21, 9, 1, 2, y); SOL_F(21, 10, 1, 2, z); SOL_F(21, 11, 1, 2, w);
        SOL_F(21, 12, 1, 3, x); SOL_F(21, 13, 1, 3, y); SOL_F(21, 14, 1, 3, z); SOL_F(21, 15, 1, 3, w);
        SOL_F(21, 16, 1, 4, x); SOL_F(21, 17, 1, 4, y); SOL_F(21, 18, 1, 4, z); SOL_F(21, 19, 1, 4, w);
        SOL_F(21, 20, 1, 5, x);
        SOL_F(22, 0, 1, 6, x); SOL_F(22, 1, 1, 6, y); SOL_F(22, 2, 1, 6, z); SOL_F(22, 3, 1, 6, w);
        SOL_F(22, 4, 1, 7, x); SOL_F(22, 5, 1, 7, y); SOL_F(22, 6, 1, 7, z); SOL_F(22, 7, 1, 7, w);
        SOL_F(22, 8, 1, 8, x); SOL_F(22, 9, 1, 8, y); SOL_F(22, 10, 1, 8, z); SOL_F(22, 11, 1, 8, w);
        SOL_F(22, 12, 1, 9, x); SOL_F(22, 13, 1, 9, y); SOL_F(22, 14, 1, 9, z); SOL_F(22, 15, 1, 9, w);
        SOL_F(22, 16, 1, 10, x); SOL_F(22, 17, 1, 10, y); SOL_F(22, 18, 1, 10, z); SOL_F(22, 19, 1, 10, w);
        SOL_F(22, 20, 1, 11, x); SOL_F(22, 21, 1, 11, y);
        __builtin_amdgcn_sched_barrier(0);
        SOL_L(1, 0, 1700); SOL_L(1, 1, 1704); SOL_L(1, 2, 1708); SOL_L(1, 3, 1712); SOL_L(1, 4, 1716); SOL_L(1, 5, 1720); SOL_L(1, 6, 1724); SOL_L(1, 7, 1768); SOL_L(1, 8, 1772); SOL_L(1, 9, 1776); SOL_L(1, 10, 1780); SOL_L(1, 11, 1784);
        __builtin_amdgcn_sched_barrier(0);
        SOL_F(23, 0, 0, 0, x); SOL_F(23, 1, 0, 0, y); SOL_F(23, 2, 0, 0, z); SOL_F(23, 3, 0, 0, w);
        SOL_F(23, 4, 0, 1, x); SOL_F(23, 5, 0, 1, y); SOL_F(23, 6, 0, 1, z); SOL_F(23, 7, 0, 1, w);
        SOL_F(23, 8, 0, 2, x); SOL_F(23, 9, 0, 2, y); SOL_F(23, 10, 0, 2, z); SOL_F(23, 11, 0, 2, w);
        SOL_F(23, 12, 0, 3, x); SOL_F(23, 13, 0, 3, y); SOL_F(23, 14, 0, 3, z); SOL_F(23, 15, 0, 3, w);
        SOL_F(23, 16, 0, 4, x); SOL_F(23, 17, 0, 4, y); SOL_F(23, 18, 0, 4, z); SOL_F(23, 19, 0, 4, w);
        SOL_F(23, 20, 0, 5, x); SOL_F(23, 21, 0, 5, y); SOL_F(23, 22, 0, 5, z);
        SOL_F(24, 0, 0, 6, x); SOL_F(24, 1, 0, 6, y); SOL_F(24, 2, 0, 6, z); SOL_F(24, 3, 0, 6, w);
        SOL_F(24, 4, 0, 7, x); SOL_F(24, 5, 0, 7, y); SOL_F(24, 6, 0, 7, z); SOL_F(24, 7, 0, 7, w);
        SOL_F(24, 8, 0, 8, x); SOL_F(24, 9, 0, 8, y); SOL_F(24, 10, 0, 8, z); SOL_F(24, 11, 0, 8, w);
        SOL_F(24, 12, 0, 9, x); SOL_F(24, 13, 0, 9, y); SOL_F(24, 14, 0, 9, z); SOL_F(24, 15, 0, 9, w);
        SOL_F(24, 16, 0, 10, x); SOL_F(24, 17, 0, 10, y); SOL_F(24, 18, 0, 10, z); SOL_F(24, 19, 0, 10, w);
        SOL_F(24, 20, 0, 11, x); SOL_F(24, 21, 0, 11, y); SOL_F(24, 22, 0, 11, z); SOL_F(24, 23, 0, 11, w);
        __builtin_amdgcn_sched_barrier(0);
        SOL_L(0, 0, 1788); SOL_L(0, 1, 1792); SOL_L(0, 2, 1836); SOL_L(0, 3, 1840); SOL_L(0, 4, 1844); SOL_L(0, 5, 1848); SOL_L(0, 6, 1852); SOL_L(0, 7, 1856); SOL_L(0, 8, 1860); SOL_L(0, 9, 1904); SOL_L(0, 10, 1908); SOL_L(0, 11, 1912);
        __builtin_amdgcn_sched_barrier(0);
        SOL_F(25, 0, 1, 0, x); SOL_F(25, 1, 1, 0, y); SOL_F(25, 2, 1, 0, z); SOL_F(25, 3, 1, 0, w);
        SOL_F(25, 4, 1, 1, x); SOL_F(25, 5, 1, 1, y); SOL_F(25, 6, 1, 1, z); SOL_F(25, 7, 1, 1, w);
        SOL_F(25, 8, 1, 2, x); SOL_F(25, 9, 1, 2, y); SOL_F(25, 10, 1, 2, z); SOL_F(25, 11, 1, 2, w);
        SOL_F(25, 12, 1, 3, x); SOL_F(25, 13, 1, 3, y); SOL_F(25, 14, 1, 3, z); SOL_F(25, 15, 1, 3, w);
        SOL_F(25, 16, 1, 4, x); SOL_F(25, 17, 1, 4, y); SOL_F(25, 18, 1, 4, z); SOL_F(25, 19, 1, 4, w);
        SOL_F(25, 20, 1, 5, x); SOL_F(25, 21, 1, 5, y); SOL_F(25, 22, 1, 5, z); SOL_F(25, 23, 1, 5, w);
        SOL_F(25, 24, 1, 6, x);
        SOL_F(26, 0, 1, 7, x); SOL_F(26, 1, 1, 7, y); SOL_F(26, 2, 1, 7, z); SOL_F(26, 3, 1, 7, w);
        SOL_F(26, 4, 1, 8, x); SOL_F(26, 5, 1, 8, y); SOL_F(26, 6, 1, 8, z); SOL_F(26, 7, 1, 8, w);
        SOL_F(26, 8, 1, 9, x); SOL_F(26, 9, 1, 9, y); SOL_F(26, 10, 1, 9, z); SOL_F(26, 11, 1, 9, w);
        SOL_F(26, 12, 1, 10, x); SOL_F(26, 13, 1, 10, y); SOL_F(26, 14, 1, 10, z); SOL_F(26, 15, 1, 10, w);
        SOL_F(26, 16, 1, 11, x); SOL_F(26, 17, 1, 11, y); SOL_F(26, 18, 1, 11, z); SOL_F(26, 19, 1, 11, w);
        __builtin_amdgcn_sched_barrier(0);
        SOL_L(1, 0, 1916); SOL_L(1, 1, 1920); SOL_L(1, 2, 1924); SOL_L(1, 3, 1928); SOL_L(1, 4, 1972); SOL_L(1, 5, 1976); SOL_L(1, 6, 1980); SOL_L(1, 7, 1984); SOL_L(1, 8, 1988); SOL_L(1, 9, 1992); SOL_L(1, 10, 1996); SOL_L(1, 11, 2000);
        __builtin_amdgcn_sched_barrier(0);
        SOL_F(26, 20, 0, 0, x); SOL_F(26, 21, 0, 0, y); SOL_F(26, 22, 0, 0, z); SOL_F(26, 23, 0, 0, w);
        SOL_F(26, 24, 0, 1, x); SOL_F(26, 25, 0, 1, y);
        SOL_F(27, 0, 0, 2, x); SOL_F(27, 1, 0, 2, y); SOL_F(27, 2, 0, 2, z); SOL_F(27, 3, 0, 2, w);
        SOL_F(27, 4, 0, 3, x); SOL_F(27, 5, 0, 3, y); SOL_F(27, 6, 0, 3, z); SOL_F(27, 7, 0, 3, w);
        SOL_F(27, 8, 0, 4, x); SOL_F(27, 9, 0, 4, y); SOL_F(27, 10, 0, 4, z); SOL_F(27, 11, 0, 4, w);
        SOL_F(27, 12, 0, 5, x); SOL_F(27, 13, 0, 5, y); SOL_F(27, 14, 0, 5, z); SOL_F(27, 15, 0, 5, w);
        SOL_F(27, 16, 0, 6, x); SOL_F(27, 17, 0, 6, y); SOL_F(27, 18, 0, 6, z); SOL_F(27, 19, 0, 6, w);
        SOL_F(27, 20, 0, 7, x); SOL_F(27, 21, 0, 7, y); SOL_F(27, 22, 0, 7, z); SOL_F(27, 23, 0, 7, w);
        SOL_F(27, 24, 0, 8, x); SOL_F(27, 25, 0, 8, y); SOL_F(27, 26, 0, 8, z);
        SOL_F(28, 0, 0, 9, x); SOL_F(28, 1, 0, 9, y); SOL_F(28, 2, 0, 9, z); SOL_F(28, 3, 0, 9, w);
        SOL_F(28, 4, 0, 10, x); SOL_F(28, 5, 0, 10, y); SOL_F(28, 6, 0, 10, z); SOL_F(28, 7, 0, 10, w);
        SOL_F(28, 8, 0, 11, x); SOL_F(28, 9, 0, 11, y); SOL_F(28, 10, 0, 11, z); SOL_F(28, 11, 0, 11, w);
        __builtin_amdgcn_sched_barrier(0);
        SOL_L(0, 0, 2040); SOL_L(0, 1, 2044); SOL_L(0, 2, 2048); SOL_L(0, 3, 2052); SOL_L(0, 4, 2056); SOL_L(0, 5, 2060); SOL_L(0, 6, 2064); SOL_L(0, 7, 2068); SOL_L(0, 8, 2108); SOL_L(0, 9, 2112); SOL_L(0, 10, 2116); SOL_L(0, 11, 2120);
        __builtin_amdgcn_sched_barrier(0);
        SOL_F(28, 12, 1, 0, x); SOL_F(28, 13, 1, 0, y); SOL_F(28, 14, 1, 0, z); SOL_F(28, 15, 1, 0, w);
        SOL_F(28, 16, 1, 1, x); SOL_F(28, 17, 1, 1, y); SOL_F(28, 18, 1, 1, z); SOL_F(28, 19, 1, 1, w);
        SOL_F(28, 20, 1, 2, x); SOL_F(28, 21, 1, 2, y); SOL_F(28, 22, 1, 2, z); SOL_F(28, 23, 1, 2, w);
        SOL_F(28, 24, 1, 3, x); SOL_F(28, 25, 1, 3, y); SOL_F(28, 26, 1, 3, z); SOL_F(28, 27, 1, 3, w);
        SOL_F(29, 0, 1, 4, x); SOL_F(29, 1, 1, 4, y); SOL_F(29, 2, 1, 4, z); SOL_F(29, 3, 1, 4, w);
        SOL_F(29, 4, 1, 5, x); SOL_F(29, 5, 1, 5, y); SOL_F(29, 6, 1, 5, z); SOL_F(29, 7, 1, 5, w);
        SOL_F(29, 8, 1, 6, x); SOL_F(29, 9, 1, 6, y); SOL_F(29, 10, 1, 6, z); SOL_F(29, 11, 1, 6, w);
        SOL_F(29, 12, 1, 7, x); SOL_F(29, 13, 1, 7, y); SOL_F(29, 14, 1, 7, z); SOL_F(29, 15, 1, 7, w);
        SOL_F(29, 16, 1, 8, x); SOL_F(29, 17, 1, 8, y); SOL_F(29, 18, 1, 8, z); SOL_F(29, 19, 1, 8, w);
        SOL_F(29, 20, 1, 9, x); SOL_F(29, 21, 1, 9, y); SOL_F(29, 22, 1, 9, z); SOL_F(29, 23, 1, 9, w);
        SOL_F(29, 24, 1, 10, x); SOL_F(29, 25, 1, 10, y); SOL_F(29, 26, 1, 10, z); SOL_F(29, 27, 1, 10, w);
        SOL_F(29, 28, 1, 11, x);
        __builtin_amdgcn_sched_barrier(0);
        SOL_L(1, 0, 2124); SOL_L(1, 1, 2128); SOL_L(1, 2, 2132); SOL_L(1, 3, 2136); SOL_L(1, 4, 2176); SOL_L(1, 5, 2180); SOL_L(1, 6, 2184); SOL_L(1, 7, 2188); SOL_L(1, 8, 2192); SOL_L(1, 9, 2196); SOL_L(1, 10, 2200); SOL_L(1, 11, 2204);
        __builtin_amdgcn_sched_barrier(0);
        SOL_F(30, 0, 0, 0, x); SOL_F(30, 1, 0, 0, y); SOL_F(30, 2, 0, 0, z); SOL_F(30, 3, 0, 0, w);
        SOL_F(30, 4, 0, 1, x); SOL_F(30, 5, 0, 1, y); SOL_F(30, 6, 0, 1, z); SOL_F(30, 7, 0, 1, w);
        SOL_F(30, 8, 0, 2, x); SOL_F(30, 9, 0, 2, y); SOL_F(30, 10, 0, 2, z); SOL_F(30, 11, 0, 2, w);
        SOL_F(30, 12, 0, 3, x); SOL_F(30, 13, 0, 3, y); SOL_F(30, 14, 0, 3, z); SOL_F(30, 15, 0, 3, w);
        SOL_F(30, 16, 0, 4, x); SOL_F(30, 17, 0, 4, y); SOL_F(30, 18, 0, 4, z); SOL_F(30, 19, 0, 4, w);
        SOL_F(30, 20, 0, 5, x); SOL_F(30, 21, 0, 5, y); SOL_F(30, 22, 0, 5, z); SOL_F(30, 23, 0, 5, w);
        SOL_F(30, 24, 0, 6, x); SOL_F(30, 25, 0, 6, y); SOL_F(30, 26, 0, 6, z); SOL_F(30, 27, 0, 6, w);
        SOL_F(30, 28, 0, 7, x); SOL_F(30, 29, 0, 7, y);
        SOL_F(31, 0, 0, 8, x); SOL_F(31, 1, 0, 8, y); SOL_F(31, 2, 0, 8, z); SOL_F(31, 3, 0, 8, w);
        SOL_F(31, 4, 0, 9, x); SOL_F(31, 5, 0, 9, y); SOL_F(31, 6, 0, 9, z); SOL_F(31, 7, 0, 9, w);
        SOL_F(31, 8, 0, 10, x); SOL_F(31, 9, 0, 10, y); SOL_F(31, 10, 0, 10, z); SOL_F(31, 11, 0, 10, w);
        SOL_F(31, 12, 0, 11, x); SOL_F(31, 13, 0, 11, y); SOL_F(31, 14, 0, 11, z); SOL_F(31, 15, 0, 11, w);
        __builtin_amdgcn_sched_barrier(0);
        SOL_L(0, 0, 2244); SOL_L(0, 1, 2248); SOL_L(0, 2, 2252); SOL_L(0, 3, 2256); SOL_L(0, 4, 2260); SOL_L(0, 5, 2264); SOL_L(0, 6, 2268); SOL_L(0, 7, 2272); SOL_L(0, 8, 2276); SOL_L(0, 9, 2312); SOL_L(0, 10, 2316); SOL_L(0, 11, 2320);
        __builtin_amdgcn_sched_barrier(0);
        SOL_F(31, 16, 1, 0, x); SOL_F(31, 17, 1, 0, y); SOL_F(31, 18, 1, 0, z); SOL_F(31, 19, 1, 0, w);
        SOL_F(31, 20, 1, 1, x); SOL_F(31, 21, 1, 1, y); SOL_F(31, 22, 1, 1, z); SOL_F(31, 23, 1, 1, w);
        SOL_F(31, 24, 1, 2, x); SOL_F(31, 25, 1, 2, y); SOL_F(31, 26, 1, 2, z); SOL_F(31, 27, 1, 2, w);
        SOL_F(31, 28, 1, 3, x); SOL_F(31, 29, 1, 3, y); SOL_F(31, 30, 1, 3, z);
        SOL_F(32, 0, 1, 4, x); SOL_F(32, 1, 1, 4, y); SOL_F(32, 2, 1, 4, z); SOL_F(32, 3, 1, 4, w);
        SOL_F(32, 4, 1, 5, x); SOL_F(32, 5, 1, 5, y); SOL_F(32, 6, 1, 5, z); SOL_F(32, 7, 1, 5, w);
        SOL_F(32, 8, 1, 6, x); SOL_F(32, 9, 1, 6, y); SOL_F(32, 10, 1, 6, z); SOL_F(32, 11, 1, 6, w);
        SOL_F(32, 12, 1, 7, x); SOL_F(32, 13, 1, 7, y); SOL_F(32, 14, 1, 7, z); SOL_F(32, 15, 1, 7, w);
        SOL_F(32, 16, 1, 8, x); SOL_F(32, 17, 1, 8, y); SOL_F(32, 18, 1, 8, z); SOL_F(32, 19, 1, 8, w);
        SOL_F(32, 20, 1, 9, x); SOL_F(32, 21, 1, 9, y); SOL_F(32, 22, 1, 9, z); SOL_F(32, 23, 1, 9, w);
        SOL_F(32, 24, 1, 10, x); SOL_F(32, 25, 1, 10, y); SOL_F(32, 26, 1, 10, z); SOL_F(32, 27, 1, 10, w);
        SOL_F(32, 28, 1, 11, x); SOL_F(32, 29, 1, 11, y); SOL_F(32, 30, 1, 11, z); SOL_F(32, 31, 1, 11, w);
        __builtin_amdgcn_sched_barrier(0);
        __syncthreads();
        SOL_L(1, 0, 2324); SOL_L(1, 1, 2328); SOL_L(1, 2, 2332); SOL_L(1, 3, 2336); SOL_L(1, 4, 2340); SOL_L(1, 5, 2344); SOL_L(1, 6, 2380); SOL_L(1, 7, 2384); SOL_L(1, 8, 2388); SOL_L(1, 9, 2392); SOL_L(1, 10, 2396); SOL_L(1, 11, 2400);
        __builtin_amdgcn_sched_barrier(0);
        SOL_F(33, 0, 0, 0, x); SOL_F(33, 1, 0, 0, y); SOL_F(33, 2, 0, 0, z); SOL_F(33, 3, 0, 0, w);
        SOL_F(33, 4, 0, 1, x); SOL_F(33, 5, 0, 1, y); SOL_F(33, 6, 0, 1, z); SOL_F(33, 7, 0, 1, w);
        SOL_F(33, 8, 0, 2, x); SOL_F(33, 9, 0, 2, y); SOL_F(33, 10, 0, 2, z); SOL_F(33, 11, 0, 2, w);
        SOL_F(33, 12, 0, 3, x); SOL_F(33, 13, 0, 3, y); SOL_F(33, 14, 0, 3, z); SOL_F(33, 15, 0, 3, w);
        SOL_F(33, 16, 0, 4, x); SOL_F(33, 17, 0, 4, y); SOL_F(33, 18, 0, 4, z); SOL_F(33, 19, 0, 4, w);
        SOL_F(33, 20, 0, 5, x); SOL_F(33, 21, 0, 5, y); SOL_F(33, 22, 0, 5, z); SOL_F(33, 23, 0, 5, w);
        SOL_F(33, 24, 0, 6, x); SOL_F(33, 25, 0, 6, y); SOL_F(33, 26, 0, 6, z); SOL_F(33, 27, 0, 6, w);
        SOL_F(33, 28, 0, 7, x); SOL_F(33, 29, 0, 7, y); SOL_F(33, 30, 0, 7, z); SOL_F(33, 31, 0, 7, w);
        SOL_F(33, 32, 0, 8, x);
        SOL_F(34, 0, 0, 9, x); SOL_F(34, 1, 0, 9, y); SOL_F(34, 2, 0, 9, z); SOL_F(34, 3, 0, 9, w);
        SOL_F(34, 4, 0, 10, x); SOL_F(34, 5, 0, 10, y); SOL_F(34, 6, 0, 10, z); SOL_F(34, 7, 0, 10, w);
        SOL_F(34, 8, 0, 11, x); SOL_F(34, 9, 0, 11, y); SOL_F(34, 10, 0, 11, z); SOL_F(34, 11, 0, 11, w);
        __builtin_amdgcn_sched_barrier(0);
        SOL_L(0, 0, 2404); SOL_L(0, 1, 2408); SOL_L(0, 2, 2412); SOL_L(0, 3, 2448); SOL_L(0, 4, 2452); SOL_L(0, 5, 2456); SOL_L(0, 6, 2460); SOL_L(0, 7, 2464); SOL_L(0, 8, 2468); SOL_L(0, 9, 2472); SOL_L(0, 10, 2476); SOL_L(0, 11, 2480);
        __builtin_amdgcn_sched_barrier(0);
        SOL_F(34, 12, 1, 0, x); SOL_F(34, 13, 1, 0, y); SOL_F(34, 14, 1, 0, z); SOL_F(34, 15, 1, 0, w);
        SOL_F(34, 16, 1, 1, x); SOL_F(34, 17, 1, 1, y); SOL_F(34, 18, 1, 1, z); SOL_F(34, 19, 1, 1, w);
        SOL_F(34, 20, 1, 2, x); SOL_F(34, 21, 1, 2, y); SOL_F(34, 22, 1, 2, z); SOL_F(34, 23, 1, 2, w);
        SOL_F(34, 24, 1, 3, x); SOL_F(34, 25, 1, 3, y); SOL_F(34, 26, 1, 3, z); SOL_F(34, 27, 1, 3, w);
        SOL_F(34, 28, 1, 4, x); SOL_F(34, 29, 1, 4, y); SOL_F(34, 30, 1, 4, z); SOL_F(34, 31, 1, 4, w);
        SOL_F(34, 32, 1, 5, x); SOL_F(34, 33, 1, 5, y);
        SOL_F(35, 0, 1, 6, x); SOL_F(35, 1, 1, 6, y); SOL_F(35, 2, 1, 6, z); SOL_F(35, 3, 1, 6, w);
        SOL_F(35, 4, 1, 7, x); SOL_F(35, 5, 1, 7, y); SOL_F(35, 6, 1, 7, z); SOL_F(35, 7, 1, 7, w);
        SOL_F(35, 8, 1, 8, x); SOL_F(35, 9, 1, 8, y); SOL_F(35, 10, 1, 8, z); SOL_F(35, 11, 1, 8, w);
        SOL_F(35, 12, 1, 9, x); SOL_F(35, 13, 1, 9, y); SOL_F(35, 14, 1, 9, z); SOL_F(35, 15, 1, 9, w);
        SOL_F(35, 16, 1, 10, x); SOL_F(35, 17, 1, 10, y); SOL_F(35, 18, 1, 10, z); SOL_F(35, 19, 1, 10, w);
        SOL_F(35, 20, 1, 11, x); SOL_F(35, 21, 1, 11, y); SOL_F(35, 22, 1, 11, z); SOL_F(35, 23, 1, 11, w);
        __builtin_amdgcn_sched_barrier(0);
        SOL_L(1, 0, 2516); SOL_L(1, 1, 2520); SOL_L(1, 2, 2524); SOL_L(1, 3, 2528); SOL_L(1, 4, 2532); SOL_L(1, 5, 2536); SOL_L(1, 6, 2540); SOL_L(1, 7, 2544); SOL_L(1, 8, 2548); SOL_L(1, 9, 2552); SOL_L(1, 10, 2584); SOL_L(1, 11, 2588);
        __builtin_amdgcn_sched_barrier(0);
        SOL_F(35, 24, 0, 0, x); SOL_F(35, 25, 0, 0, y); SOL_F(35, 26, 0, 0, z); SOL_F(35, 27, 0, 0, w);
        SOL_F(35, 28, 0, 1, x); SOL_F(35, 29, 0, 1, y); SOL_F(35, 30, 0, 1, z); SOL_F(35, 31, 0, 1, w);
        SOL_F(35, 32, 0, 2, x); SOL_F(35, 33, 0, 2, y); SOL_F(35, 34, 0, 2, z);
        SOL_F(36, 0, 0, 3, x); SOL_F(36, 1, 0, 3, y); SOL_F(36, 2, 0, 3, z); SOL_F(36, 3, 0, 3, w);
        SOL_F(36, 4, 0, 4, x); SOL_F(36, 5, 0, 4, y); SOL_F(36, 6, 0, 4, z); SOL_F(36, 7, 0, 4, w);
        SOL_F(36, 8, 0, 5, x); SOL_F(36, 9, 0, 5, y); SOL_F(36, 10, 0, 5, z); SOL_F(36, 11, 0, 5, w);
        SOL_F(36, 12, 0, 6, x); SOL_F(36, 13, 0, 6, y); SOL_F(36, 14, 0, 6, z); SOL_F(36, 15, 0, 6, w);
        SOL_F(36, 16, 0, 7, x); SOL_F(36, 17, 0, 7, y); SOL_F(36, 18, 0, 7, z); SOL_F(36, 19, 0, 7, w);
        SOL_F(36, 20, 0, 8, x); SOL_F(36, 21, 0, 8, y); SOL_F(36, 22, 0, 8, z); SOL_F(36, 23, 0, 8, w);
        SOL_F(36, 24, 0, 9, x); SOL_F(36, 25, 0, 9, y); SOL_F(36, 26, 0, 9, z); SOL_F(36, 27, 0, 9, w);
        SOL_F(36, 28, 0, 10, x); SOL_F(36, 29, 0, 10, y); SOL_F(36, 30, 0, 10, z); SOL_F(36, 31, 0, 10, w);
        SOL_F(36, 32, 0, 11, x); SOL_F(36, 33, 0, 11, y); SOL_F(36, 34, 0, 11, z); SOL_F(36, 35, 0, 11, w);
        __builtin_amdgcn_sched_barrier(0);
        SOL_L(0, 0, 2592); SOL_L(0, 1, 2596); SOL_L(0, 2, 2600); SOL_L(0, 3, 2604); SOL_L(0, 4, 2608); SOL_L(0, 5, 2612); SOL_L(0, 6, 2616); SOL_L(0, 7, 2620); SOL_L(0, 8, 2652); SOL_L(0, 9, 2656); SOL_L(0, 10, 2660); SOL_L(0, 11, 2664);
        __builtin_amdgcn_sched_barrier(0);
        SOL_F(37, 0, 1, 0, x); SOL_F(37, 1, 1, 0, y); SOL_F(37, 2, 1, 0, z); SOL_F(37, 3, 1, 0, w);
        SOL_F(37, 4, 1, 1, x); SOL_F(37, 5, 1, 1, y); SOL_F(37, 6, 1, 1, z); SOL_F(37, 7, 1, 1, w);
        SOL_F(37, 8, 1, 2, x); SOL_F(37, 9, 1, 2, y); SOL_F(37, 10, 1, 2, z); SOL_F(37, 11, 1, 2, w);
        SOL_F(37, 12, 1, 3, x); SOL_F(37, 13, 1, 3, y); SOL_F(37, 14, 1, 3, z); SOL_F(37, 15, 1, 3, w);
        SOL_F(37, 16, 1, 4, x); SOL_F(37, 17, 1, 4, y); SOL_F(37, 18, 1, 4, z); SOL_F(37, 19, 1, 4, w);
        SOL_F(37, 20, 1, 5, x); SOL_F(37, 21, 1, 5, y); SOL_F(37, 22, 1, 5, z); SOL_F(37, 23, 1, 5, w);
        SOL_F(37, 24, 1, 6, x); SOL_F(37, 25, 1, 6, y); SOL_F(37, 26, 1, 6, z); SOL_F(37, 27, 1, 6, w);
        SOL_F(37, 28, 1, 7, x); SOL_F(37, 29, 1, 7, y); SOL_F(37, 30, 1, 7, z); SOL_F(37, 31, 1, 7, w);
        SOL_F(37, 32, 1, 8, x); SOL_F(37, 33, 1, 8, y); SOL_F(37, 34, 1, 8, z); SOL_F(37, 35, 1, 8, w);
        SOL_F(37, 36, 1, 9, x);
        SOL_F(38, 0, 1, 10, x); SOL_F(38, 1, 1, 10, y); SOL_F(38, 2, 1, 10, z); SOL_F(38, 3, 1, 10, w);
        SOL_F(38, 4, 1, 11, x); SOL_F(38, 5, 1, 11, y); SOL_F(38, 6, 1, 11, z); SOL_F(38, 7, 1, 11, w);
        __builtin_amdgcn_sched_barrier(0);
        SOL_L(1, 0, 2668); SOL_L(1, 1, 2672); SOL_L(1, 2, 2676); SOL_L(1, 3, 2680); SOL_L(1, 4, 2684); SOL_L(1, 5, 2688); SOL_L(1, 6, 2720); SOL_L(1, 7, 2724); SOL_L(1, 8, 2728); SOL_L(1, 9, 2732); SOL_L(1, 10, 2736); SOL_L(1, 11, 2740);
        __builtin_amdgcn_sched_barrier(0);
        SOL_F(38, 8, 0, 0, x); SOL_F(38, 9, 0, 0, y); SOL_F(38, 10, 0, 0, z); SOL_F(38, 11, 0, 0, w);
        SOL_F(38, 12, 0, 1, x); SOL_F(38, 13, 0, 1, y); SOL_F(38, 14, 0, 1, z); SOL_F(38, 15, 0, 1, w);
        SOL_F(38, 16, 0, 2, x); SOL_F(38, 17, 0, 2, y); SOL_F(38, 18, 0, 2, z); SOL_F(38, 19, 0, 2, w);
        SOL_F(38, 20, 0, 3, x); SOL_F(38, 21, 0, 3, y); SOL_F(38, 22, 0, 3, z); SOL_F(38, 23, 0, 3, w);
        SOL_F(38, 24, 0, 4, x); SOL_F(38, 25, 0, 4, y); SOL_F(38, 26, 0, 4, z); SOL_F(38, 27, 0, 4, w);
        SOL_F(38, 28, 0, 5, x); SOL_F(38, 29, 0, 5, y); SOL_F(38, 30, 0, 5, z); SOL_F(38, 31, 0, 5, w);
        SOL_F(38, 32, 0, 6, x); SOL_F(38, 33, 0, 6, y); SOL_F(38, 34, 0, 6, z); SOL_F(38, 35, 0, 6, w);
        SOL_F(38, 36, 0, 7, x); SOL_F(38, 37, 0, 7, y);
        SOL_F(39, 0, 0, 8, x); SOL_F(39, 1, 0, 8, y); SOL_F(39, 2, 0, 8, z); SOL_F(39, 3, 0, 8, w);
        SOL_F(39, 4, 0, 9, x); SOL_F(39, 5, 0, 9, y); SOL_F(39, 6, 0, 9, z); SOL_F(39, 7, 0, 9, w);
        SOL_F(39, 8, 0, 10, x); SOL_F(39, 9, 0, 10, y); SOL_F(39, 10, 0, 10, z); SOL_F(39, 11, 0, 10, w);
        SOL_F(39, 12, 0, 11, x); SOL_F(39, 13, 0, 11, y); SOL_F(39, 14, 0, 11, z); SOL_F(39, 15, 0, 11, w);
        __builtin_amdgcn_sched_barrier(0);
        SOL_L(0, 0, 2744); SOL_L(0, 1, 2748); SOL_L(0, 2, 2752); SOL_L(0, 3, 2756); SOL_L(0, 4, 2788); SOL_L(0, 5, 2792); SOL_L(0, 6, 2796); SOL_L(0, 7, 2800); SOL_L(0, 8, 2804); SOL_L(0, 9, 2808); SOL_L(0, 10, 2812); SOL_L(0, 11, 2816);
        __builtin_amdgcn_sched_barrier(0);
        SOL_F(39, 16, 1, 0, x); SOL_F(39, 17, 1, 0, y); SOL_F(39, 18, 1, 0, z); SOL_F(39, 19, 1, 0, w);
        SOL_F(39, 20, 1, 1, x); SOL_F(39, 21, 1, 1, y); SOL_F(39, 22, 1, 1, z); SOL_F(39, 23, 1, 1, w);
        SOL_F(39, 24, 1, 2, x); SOL_F(39, 25, 1, 2, y); SOL_F(39, 26, 1, 2, z); SOL_F(39, 27, 1, 2, w);
        SOL_F(39, 28, 1, 3, x); SOL_F(39, 29, 1, 3, y); SOL_F(39, 30, 1, 3, z); SOL_F(39, 31, 1, 3, w);
        SOL_F(39, 32, 1, 4, x); SOL_F(39, 33, 1, 4, y); SOL_F(39, 34, 1, 4, z); SOL_F(39, 35, 1, 4, w);
        SOL_F(39, 36, 1, 5, x); SOL_F(39, 37, 1, 5, y); SOL_F(39, 38, 1, 5, z);
        SOL_F(40, 0, 1, 6, x); SOL_F(40, 1, 1, 6, y); SOL_F(40, 2, 1, 6, z); SOL_F(40, 3, 1, 6, w);
        SOL_F(40, 4, 1, 7, x); SOL_F(40, 5, 1, 7, y); SOL_F(40, 6, 1, 7, z); SOL_F(40, 7, 1, 7, w);
        SOL_F(40, 8, 1, 8, x); SOL_F(40, 9, 1, 8, y); SOL_F(40, 10, 1, 8, z); SOL_F(40, 11, 1, 8, w);
        SOL_F(40, 12, 1, 9, x); SOL_F(40, 13, 1, 9, y); SOL_F(40, 14, 1, 9, z); SOL_F(40, 15, 1, 9, w);
        SOL_F(40, 16, 1, 10, x); SOL_F(40, 17, 1, 10, y); SOL_F(40, 18, 1, 10, z); SOL_F(40, 19, 1, 10, w);
        SOL_F(40, 20, 1, 11, x); SOL_F(40, 21, 1, 11, y); SOL_F(40, 22, 1, 11, z); SOL_F(40, 23, 1, 11, w);
        __builtin_amdgcn_sched_barrier(0);
        SOL_L(1, 0, 2820); SOL_L(1, 1, 2824); SOL_L(1, 2, 2828); SOL_L(1, 3, 2856); SOL_L(1, 4, 2860); SOL_L(1, 5, 2864); SOL_L(1, 6, 2868); SOL_L(1, 7, 2872); SOL_L(1, 8, 2876); SOL_L(1, 9, 2880); SOL_L(1, 10, 2884); SOL_L(1, 11, 2888);
        __builtin_amdgcn_sched_barrier(0);
        SOL_F(40, 24, 0, 0, x); SOL_F(40, 25, 0, 0, y); SOL_F(40, 26, 0, 0, z); SOL_F(40, 27, 0, 0, w);
        SOL_F(40, 28, 0, 1, x); SOL_F(40, 29, 0, 1, y); SOL_F(40, 30, 0, 1, z); SOL_F(40, 31, 0, 1, w);
        SOL_F(40, 32, 0, 2, x); SOL_F(40, 33, 0, 2, y); SOL_F(40, 34, 0, 2, z); SOL_F(40, 35, 0, 2, w);
        SOL_F(40, 36, 0, 3, x); SOL_F(40, 37, 0, 3, y); SOL_F(40, 38, 0, 3, z); SOL_F(40, 39, 0, 3, w);
        SOL_F(41, 0, 0, 4, x); SOL_F(41, 1, 0, 4, y); SOL_F(41, 2, 0, 4, z); SOL_F(41, 3, 0, 4, w);
        SOL_F(41, 4, 0, 5, x); SOL_F(41, 5, 0, 5, y); SOL_F(41, 6, 0, 5, z); SOL_F(41, 7, 0, 5, w);
        SOL_F(41, 8, 0, 6, x); SOL_F(41, 9, 0, 6, y); SOL_F(41, 10, 0, 6, z); SOL_F(41, 11, 0, 6, w);
        SOL_F(41, 12, 0, 7, x); SOL_F(41, 13, 0, 7, y); SOL_F(41, 14, 0, 7, z); SOL_F(41, 15, 0, 7, w);
        SOL_F(41, 16, 0, 8, x); SOL_F(41, 17, 0, 8, y); SOL_F(41, 18, 0, 8, z); SOL_F(41, 19, 0, 8, w);
        SOL_F(41, 20, 0, 9, x); SOL_F(41, 21, 0, 9, y); SOL_F(41, 22, 0, 9, z); SOL_F(41, 23, 0, 9, w);
        SOL_F(41, 24, 0, 10, x); SOL_F(41, 25, 0, 10, y); SOL_F(41, 26, 0, 10, z); SOL_F(41, 27, 0, 10, w);
        SOL_F(41, 28, 0, 11, x); SOL_F(41, 29, 0, 11, y); SOL_F(41, 30, 0, 11, z); SOL_F(41, 31, 0, 11, w);
        __builtin_amdgcn_sched_barrier(0);
        SOL_L(0, 0, 2892); SOL_L(0, 1, 2896); SOL_L(0, 2, 2924); SOL_L(0, 3, 2928); SOL_L(0, 4, 2932); SOL_L(0, 5, 2936); SOL_L(0, 6, 2940); SOL_L(0, 7, 2944); SOL_L(0, 8, 2948); SOL_L(0, 9, 2952); SOL_L(0, 10, 2956); SOL_L(0, 11, 2960);
        __builtin_amdgcn_sched_barrier(0);
        SOL_F(41, 32, 1, 0, x); SOL_F(41, 33, 1, 0, y); SOL_F(41, 34, 1, 0, z); SOL_F(41, 35, 1, 0, w);
        SOL_F(41, 36, 1, 1, x); SOL_F(41, 37, 1, 1, y); SOL_F(41, 38, 1, 1, z); SOL_F(41, 39, 1, 1, w);
        SOL_F(41, 40, 1, 2, x);
        SOL_F(42, 0, 1, 3, x); SOL_F(42, 1, 1, 3, y); SOL_F(42, 2, 1, 3, z); SOL_F(42, 3, 1, 3, w);
        SOL_F(42, 4, 1, 4, x); SOL_F(42, 5, 1, 4, y); SOL_F(42, 6, 1, 4, z); SOL_F(42, 7, 1, 4, w);
        SOL_F(42, 8, 1, 5, x); SOL_F(42, 9, 1, 5, y); SOL_F(42, 10, 1, 5, z); SOL_F(42, 11, 1, 5, w);
        SOL_F(42, 12, 1, 6, x); SOL_F(42, 13, 1, 6, y); SOL_F(42, 14, 1, 6, z); SOL_F(42, 15, 1, 6, w);
        SOL_F(42, 16, 1, 7, x); SOL_F(42, 17, 1, 7, y); SOL_F(42, 18, 1, 7, z); SOL_F(42, 19, 1, 7, w);
        SOL_F(42, 20, 1, 8, x); SOL_F(42, 21, 1, 8, y); SOL_F(42, 22, 1, 8, z); SOL_F(42, 23, 1, 8, w);
        SOL_F(42, 24, 1, 9, x); SOL_F(42, 25, 1, 9, y); SOL_F(42, 26, 1, 9, z); SOL_F(42, 27, 1, 9, w);
        SOL_F(42, 28, 1, 10, x); SOL_F(42, 29, 1, 10, y); SOL_F(42, 30, 1, 10, z); SOL_F(42, 31, 1, 10, w);
        SOL_F(42, 32, 1, 11, x); SOL_F(42, 33, 1, 11, y); SOL_F(42, 34, 1, 11, z); SOL_F(42, 35, 1, 11, w);
        __builtin_amdgcn_sched_barrier(0);
        SOL_L(1, 0, 2964); SOL_L(1, 1, 2992); SOL_L(1, 2, 2996); SOL_L(1, 3, 3000); SOL_L(1, 4, 3004); SOL_L(1, 5, 3008); SOL_L(1, 6, 3012); SOL_L(1, 7, 3016); SOL_L(1, 8, 3020); SOL_L(1, 9, 3024); SOL_L(1, 10, 3028); SOL_L(1, 11, 3032);
        __builtin_amdgcn_sched_barrier(0);
        SOL_F(42, 36, 0, 0, x); SOL_F(42, 37, 0, 0, y); SOL_F(42, 38, 0, 0, z); SOL_F(42, 39, 0, 0, w);
        SOL_F(42, 40, 0, 1, x); SOL_F(42, 41, 0, 1, y);
        SOL_F(43, 0, 0, 2, x); SOL_F(43, 1, 0, 2, y); SOL_F(43, 2, 0, 2, z); SOL_F(43, 3, 0, 2, w);
        SOL_F(43, 4, 0, 3, x); SOL_F(43, 5, 0, 3, y); SOL_F(43, 6, 0, 3, z); SOL_F(43, 7, 0, 3, w);
        SOL_F(43, 8, 0, 4, x); SOL_F(43, 9, 0, 4, y); SOL_F(43, 10, 0, 4, z); SOL_F(43, 11, 0, 4, w);
        SOL_F(43, 12, 0, 5, x); SOL_F(43, 13, 0, 5, y); SOL_F(43, 14, 0, 5, z); SOL_F(43, 15, 0, 5, w);
        SOL_F(43, 16, 0, 6, x); SOL_F(43, 17, 0, 6, y); SOL_F(43, 18, 0, 6, z); SOL_F(43, 19, 0, 6, w);
        SOL_F(43, 20, 0, 7, x); SOL_F(43, 21, 0, 7, y); SOL_F(43, 22, 0, 7, z); SOL_F(43, 23, 0, 7, w);
        SOL_F(43, 24, 0, 8, x); SOL_F(43, 25, 0, 8, y); SOL_F(43, 26, 0, 8, z); SOL_F(43, 27, 0, 8, w);
        SOL_F(43, 28, 0, 9, x); SOL_F(43, 29, 0, 9, y); SOL_F(43, 30, 0, 9, z); SOL_F(43, 31, 0, 9, w);
        SOL_F(43, 32, 0, 10, x); SOL_F(43, 33, 0, 10, y); SOL_F(43, 34, 0, 10, z); SOL_F(43, 35, 0, 10, w);
        SOL_F(43, 36, 0, 11, x); SOL_F(43, 37, 0, 11, y); SOL_F(43, 38, 0, 11, z); SOL_F(43, 39, 0, 11, w);
        __builtin_amdgcn_sched_barrier(0);
        SOL_L(0, 0, 3060); SOL_L(0, 1, 3064); SOL_L(0, 2, 3068); SOL_L(0, 3, 3072); SOL_L(0, 4, 3076); SOL_L(0, 5, 3080); SOL_L(0, 6, 3084); SOL_L(0, 7, 3088); SOL_L(0, 8, 3092); SOL_L(0, 9, 3096); SOL_L(0, 10, 3100); SOL_L(0, 11, 3104);
        __builtin_amdgcn_sched_barrier(0);
        SOL_F(43, 40, 1, 0, x); SOL_F(43, 41, 1, 0, y); SOL_F(43, 42, 1, 0, z);
        SOL_F(44, 0, 1, 1, x); SOL_F(44, 1, 1, 1, y); SOL_F(44, 2, 1, 1, z); SOL_F(44, 3, 1, 1, w);
        SOL_F(44, 4, 1, 2, x); SOL_F(44, 5, 1, 2, y); SOL_F(44, 6, 1, 2, z); SOL_F(44, 7, 1, 2, w);
        SOL_F(44, 8, 1, 3, x); SOL_F(44, 9, 1, 3, y); SOL_F(44, 10, 1, 3, z); SOL_F(44, 11, 1, 3, w);
        SOL_F(44, 12, 1, 4, x); SOL_F(44, 13, 1, 4, y); SOL_F(44, 14, 1, 4, z); SOL_F(44, 15, 1, 4, w);
        SOL_F(44, 16, 1, 5, x); SOL_F(44, 17, 1, 5, y); SOL_F(44, 18, 1, 5, z); SOL_F(44, 19, 1, 5, w);
        SOL_F(44, 20, 1, 6, x); SOL_F(44, 21, 1, 6, y); SOL_F(44, 22, 1, 6, z); SOL_F(44, 23, 1, 6, w);
        SOL_F(44, 24, 1, 7, x); SOL_F(44, 25, 1, 7, y); SOL_F(44, 26, 1, 7, z); SOL_F(44, 27, 1, 7, w);
        SOL_F(44, 28, 1, 8, x); SOL_F(44, 29, 1, 8, y); SOL_F(44, 30, 1, 8, z); SOL_F(44, 31, 1, 8, w);
        SOL_F(44, 32, 1, 9, x); SOL_F(44, 33, 1, 9, y); SOL_F(44, 34, 1, 9, z); SOL_F(44, 35, 1, 9, w);
        SOL_F(44, 36, 1, 10, x); SOL_F(44, 37, 1, 10, y); SOL_F(44, 38, 1, 10, z); SOL_F(44, 39, 1, 10, w);
        SOL_F(44, 40, 1, 11, x); SOL_F(44, 41, 1, 11, y); SOL_F(44, 42, 1, 11, z); SOL_F(44, 43, 1, 11, w);
        __builtin_amdgcn_sched_barrier(0);
        SOL_L(1, 0, 3128); SOL_L(1, 1, 3132); SOL_L(1, 2, 3136); SOL_L(1, 3, 3140); SOL_L(1, 4, 3144); SOL_L(1, 5, 3148); SOL_L(1, 6, 3152); SOL_L(1, 7, 3156); SOL_L(1, 8, 3160); SOL_L(1, 9, 3164); SOL_L(1, 10, 3168); SOL_L(1, 11, 3172);
        __builtin_amdgcn_sched_barrier(0);
        SOL_F(45, 0, 0, 0, x); SOL_F(45, 1, 0, 0, y); SOL_F(45, 2, 0, 0, z); SOL_F(45, 3, 0, 0, w);
        SOL_F(45, 4, 0, 1, x); SOL_F(45, 5, 0, 1, y); SOL_F(45, 6, 0, 1, z); SOL_F(45, 7, 0, 1, w);
        SOL_F(45, 8, 0, 2, x); SOL_F(45, 9, 0, 2, y); SOL_F(45, 10, 0, 2, z); SOL_F(45, 11, 0, 2, w);
        SOL_F(45, 12, 0, 3, x); SOL_F(45, 13, 0, 3, y); SOL_F(45, 14, 0, 3, z); SOL_F(45, 15, 0, 3, w);
        SOL_F(45, 16, 0, 4, x); SOL_F(45, 17, 0, 4, y); SOL_F(45, 18, 0, 4, z); SOL_F(45, 19, 0, 4, w);
        SOL_F(45, 20, 0, 5, x); SOL_F(45, 21, 0, 5, y); SOL_F(45, 22, 0, 5, z); SOL_F(45, 23, 0, 5, w);
        SOL_F(45, 24, 0, 6, x); SOL_F(45, 25, 0, 6, y); SOL_F(45, 26, 0, 6, z); SOL_F(45, 27, 0, 6, w);
        SOL_F(45, 28, 0, 7, x); SOL_F(45, 29, 0, 7, y); SOL_F(45, 30, 0, 7, z); SOL_F(45, 31, 0, 7, w);
        SOL_F(45, 32, 0, 8, x); SOL_F(45, 33, 0, 8, y); SOL_F(45, 34, 0, 8, z); SOL_F(45, 35, 0, 8, w);
        SOL_F(45, 36, 0, 9, x); SOL_F(45, 37, 0, 9, y); SOL_F(45, 38, 0, 9, z); SOL_F(45, 39, 0, 9, w);
        SOL_F(45, 40, 0, 10, x); SOL_F(45, 41, 0, 10, y); SOL_F(45, 42, 0, 10, z); SOL_F(45, 43, 0, 10, w);
        SOL_F(45, 44, 0, 11, x);
        __builtin_amdgcn_sched_barrier(0);
        SOL_L(0, 0, 3196); SOL_L(0, 1, 3200); SOL_L(0, 2, 3204); SOL_L(0, 3, 3208); SOL_L(0, 4, 3212); SOL_L(0, 5, 3216); SOL_L(0, 6, 3220); SOL_L(0, 7, 3224); SOL_L(0, 8, 3228); SOL_L(0, 9, 3232); SOL_L(0, 10, 3236); SOL_L(0, 11, 3240);
        __builtin_amdgcn_sched_barrier(0);
        SOL_F(46, 0, 1, 0, x); SOL_F(46, 1, 1, 0, y); SOL_F(46, 2, 1, 0, z); SOL_F(46, 3, 1, 0, w);
        SOL_F(46, 4, 1, 1, x); SOL_F(46, 5, 1, 1, y); SOL_F(46, 6, 1, 1, z); SOL_F(46, 7, 1, 1, w);
        SOL_F(46, 8, 1, 2, x); SOL_F(46, 9, 1, 2, y); SOL_F(46, 10, 1, 2, z); SOL_F(46, 11, 1, 2, w);
        SOL_F(46, 12, 1, 3, x); SOL_F(46, 13, 1, 3, y); SOL_F(46, 14, 1, 3, z); SOL_F(46, 15, 1, 3, w);
        SOL_F(46, 16, 1, 4, x); SOL_F(46, 17, 1, 4, y); SOL_F(46, 18, 1, 4, z); SOL_F(46, 19, 1, 4, w);
        SOL_F(46, 20, 1, 5, x); SOL_F(46, 21, 1, 5, y); SOL_F(46, 22, 1, 5, z); SOL_F(46, 23, 1, 5, w);
        SOL_F(46, 24, 1, 6, x); SOL_F(46, 25, 1, 6, y); SOL_F(46, 26, 1, 6, z); SOL_F(46, 27, 1, 6, w);
        SOL_F(46, 28, 1, 7, x); SOL_F(46, 29, 1, 7, y); SOL_F(46, 30, 1, 7, z); SOL_F(46, 31, 1, 7, w);
        SOL_F(46, 32, 1, 8, x); SOL_F(46, 33, 1, 8, y); SOL_F(46, 34, 1, 8, z); SOL_F(46, 35, 1, 8, w);
        SOL_F(46, 36, 1, 9, x); SOL_F(46, 37, 1, 9, y); SOL_F(46, 38, 1, 9, z); SOL_F(46, 39, 1, 9, w);
        SOL_F(46, 40, 1, 10, x); SOL_F(46, 41, 1, 10, y); SOL_F(46, 42, 1, 10, z); SOL_F(46, 43, 1, 10, w);
        SOL_F(46, 44, 1, 11, x); SOL_F(46, 45, 1, 11, y);
        __builtin_amdgcn_sched_barrier(0);
        SOL_L(1, 0, 3264); SOL_L(1, 1, 3268); SOL_L(1, 2, 3272); SOL_L(1, 3, 3276); SOL_L(1, 4, 3280); SOL_L(1, 5, 3284); SOL_L(1, 6, 3288); SOL_L(1, 7, 3292); SOL_L(1, 8, 3296); SOL_L(1, 9, 3300); SOL_L(1, 10, 3304); SOL_L(1, 11, 3308);
        __builtin_amdgcn_sched_barrier(0);
        SOL_F(47, 0, 0, 0, x); SOL_F(47, 1, 0, 0, y); SOL_F(47, 2, 0, 0, z); SOL_F(47, 3, 0, 0, w);
        SOL_F(47, 4, 0, 1, x); SOL_F(47, 5, 0, 1, y); SOL_F(47, 6, 0, 1, z); SOL_F(47, 7, 0, 1, w);
        SOL_F(47, 8, 0, 2, x); SOL_F(47, 9, 0, 2, y); SOL_F(47, 10, 0, 2, z); SOL_F(47, 11, 0, 2, w);
        SOL_F(47, 12, 0, 3, x); SOL_F(47, 13, 0, 3, y); SOL_F(47, 14, 0, 3, z); SOL_F(47, 15, 0, 3, w);
        SOL_F(47, 16, 0, 4, x); SOL_F(47, 17, 0, 4, y); SOL_F(47, 18, 0, 4, z); SOL_F(47, 19, 0, 4, w);
        SOL_F(47, 20, 0, 5, x); SOL_F(47, 21, 0, 5, y); SOL_F(47, 22, 0, 5, z); SOL_F(47, 23, 0, 5, w);
        SOL_F(47, 24, 0, 6, x); SOL_F(47, 25, 0, 6, y); SOL_F(47, 26, 0, 6, z); SOL_F(47, 27, 0, 6, w);
        SOL_F(47, 28, 0, 7, x); SOL_F(47, 29, 0, 7, y); SOL_F(47, 30, 0, 7, z); SOL_F(47, 31, 0, 7, w);
        SOL_F(47, 32, 0, 8, x); SOL_F(47, 33, 0, 8, y); SOL_F(47, 34, 0, 8, z); SOL_F(47, 35, 0, 8, w);
        SOL_F(47, 36, 0, 9, x); SOL_F(47, 37, 0, 9, y); SOL_F(47, 38, 0, 9, z); SOL_F(47, 39, 0, 9, w);
        SOL_F(47, 40, 0, 10, x); SOL_F(47, 41, 0, 10, y); SOL_F(47, 42, 0, 10, z); SOL_F(47, 43, 0, 10, w);
        SOL_F(47, 44, 0, 11, x); SOL_F(47, 45, 0, 11, y); SOL_F(47, 46, 0, 11, z);
        __builtin_amdgcn_sched_barrier(0);
        SOL_L(0, 0, 3332); SOL_L(0, 1, 3336); SOL_L(0, 2, 3340); SOL_L(0, 3, 3344); SOL_L(0, 4, 3348); SOL_L(0, 5, 3352); SOL_L(0, 6, 3356); SOL_L(0, 7, 3360); SOL_L(0, 8, 3364); SOL_L(0, 9, 3368); SOL_L(0, 10, 3372); SOL_L(0, 11, 3376);
        __builtin_amdgcn_sched_barrier(0);
        SOL_F(48, 0, 1, 0, x); SOL_F(48, 1, 1, 0, y); SOL_F(48, 2, 1, 0, z); SOL_F(48, 3, 1, 0, w);
        SOL_F(48, 4, 1, 1, x); SOL_F(48, 5, 1, 1, y); SOL_F(48, 6, 1, 1, z); SOL_F(48, 7, 1, 1, w);
        SOL_F(48, 8, 1, 2, x); SOL_F(48, 9, 1, 2, y); SOL_F(48, 10, 1, 2, z); SOL_F(48, 11, 1, 2, w);
        SOL_F(48, 12, 1, 3, x); SOL_F(48, 13, 1, 3, y); SOL_F(48, 14, 1, 3, z); SOL_F(48, 15, 1, 3, w);
        SOL_F(48, 16, 1, 4, x); SOL_F(48, 17, 1, 4, y); SOL_F(48, 18, 1, 4, z); SOL_F(48, 19, 1, 4, w);
        SOL_F(48, 20, 1, 5, x); SOL_F(48, 21, 1, 5, y); SOL_F(48, 22, 1, 5, z); SOL_F(48, 23, 1, 5, w);
        SOL_F(48, 24, 1, 6, x); SOL_F(48, 25, 1, 6, y); SOL_F(48, 26, 1, 6, z); SOL_F(48, 27, 1, 6, w);
        SOL_F(48, 28, 1, 7, x); SOL_F(48, 29, 1, 7, y); SOL_F(48, 30, 1, 7, z); SOL_F(48, 31, 1, 7, w);
        SOL_F(48, 32, 1, 8, x); SOL_F(48, 33, 1, 8, y); SOL_F(48, 34, 1, 8, z); SOL_F(48, 35, 1, 8, w);
        SOL_F(48, 36, 1, 9, x); SOL_F(48, 37, 1, 9, y); SOL_F(48, 38, 1, 9, z); SOL_F(48, 39, 1, 9, w);
        SOL_F(48, 40, 1, 10, x); SOL_F(48, 41, 1, 10, y); SOL_F(48, 42, 1, 10, z); SOL_F(48, 43, 1, 10, w);
        SOL_F(48, 44, 1, 11, x); SOL_F(48, 45, 1, 11, y); SOL_F(48, 46, 1, 11, z); SOL_F(48, 47, 1, 11, w);
        __builtin_amdgcn_sched_barrier(0);
        SOL_L(1, 0, 3380); SOL_L(1, 1, 3400); SOL_L(1, 2, 3404); SOL_L(1, 3, 3408); SOL_L(1, 4, 3412); SOL_L(1, 5, 3416); SOL_L(1, 6, 3420); SOL_L(1, 7, 3424); SOL_L(1, 8, 3428); SOL_L(1, 9, 3432); SOL_L(1, 10, 3436); SOL_L(1, 11, 3440);
        __builtin_amdgcn_sched_barrier(0);
        SOL_F(49, 0, 0, 0, x); SOL_F(49, 1, 0, 0, y); SOL_F(49, 2, 0, 0, z); SOL_F(49, 3, 0, 0, w);
        SOL_F(49, 4, 0, 1, x); SOL_F(49, 5, 0, 1, y); SOL_F(49, 6, 0, 1, z); SOL_F(49, 7, 0, 1, w);
        SOL_F(49, 8, 0, 2, x); SOL_F(49, 9, 0, 2, y); SOL_F(49, 10, 0, 2, z); SOL_F(49, 11, 0, 2, w);
        SOL_F(49, 12, 0, 3, x); SOL_F(49, 13, 0, 3, y); SOL_F(49, 14, 0, 3, z); SOL_F(49, 15, 0, 3, w);
        SOL_F(49, 16, 0, 4, x); SOL_F(49, 17, 0, 4, y); SOL_F(49, 18, 0, 4, z); SOL_F(49, 19, 0, 4, w);
        SOL_F(49, 20, 0, 5, x); SOL_F(49, 21, 0, 5, y); SOL_F(49, 22, 0, 5, z); SOL_F(49, 23, 0, 5, w);
        SOL_F(49, 24, 0, 6, x); SOL_F(49, 25, 0, 6, y); SOL_F(49, 26, 0, 6, z); SOL_F(49, 27, 0, 6, w);
        SOL_F(49, 28, 0, 7, x); SOL_F(49, 29, 0, 7, y); SOL_F(49, 30, 0, 7, z); SOL_F(49, 31, 0, 7, w);
        SOL_F(49, 32, 0, 8, x); SOL_F(49, 33, 0, 8, y); SOL_F(49, 34, 0, 8, z); SOL_F(49, 35, 0, 8, w);
        SOL_F(49, 36, 0, 9, x); SOL_F(49, 37, 0, 9, y); SOL_F(49, 38, 0, 9, z); SOL_F(49, 39, 0, 9, w);
        SOL_F(49, 40, 0, 10, x); SOL_F(49, 41, 0, 10, y); SOL_F(49, 42, 0, 10, z); SOL_F(49, 43, 0, 10, w);
        SOL_F(49, 44, 0, 11, x); SOL_F(49, 45, 0, 11, y); SOL_F(49, 46, 0, 11, z); SOL_F(49, 47, 0, 11, w);
        __builtin_amdgcn_sched_barrier(0);
        SOL_L(0, 0, 3444); SOL_L(0, 1, 3448); SOL_L(0, 2, 3468); SOL_L(0, 3, 3472); SOL_L(0, 4, 3476); SOL_L(0, 5, 3480); SOL_L(0, 6, 3484); SOL_L(0, 7, 3488); SOL_L(0, 8, 3492); SOL_L(0, 9, 3496); SOL_L(0, 10, 3500); SOL_L(0, 11, 3504);
        __builtin_amdgcn_sched_barrier(0);
        SOL_F(49, 48, 1, 0, x);
        SOL_F(50, 0, 1, 1, x); SOL_F(50, 1, 1, 1, y); SOL_F(50, 2, 1, 1, z); SOL_F(50, 3, 1, 1, w);
        SOL_F(50, 4, 1, 2, x); SOL_F(50, 5, 1, 2, y); SOL_F(50, 6, 1, 2, z); SOL_F(50, 7, 1, 2, w);
        SOL_F(50, 8, 1, 3, x); SOL_F(50, 9, 1, 3, y); SOL_F(50, 10, 1, 3, z); SOL_F(50, 11, 1, 3, w);
        SOL_F(50, 12, 1, 4, x); SOL_F(50, 13, 1, 4, y); SOL_F(50, 14, 1, 4, z); SOL_F(50, 15, 1, 4, w);
        SOL_F(50, 16, 1, 5, x); SOL_F(50, 17, 1, 5, y); SOL_F(50, 18, 1, 5, z); SOL_F(50, 19, 1, 5, w);
        SOL_F(50, 20, 1, 6, x); SOL_F(50, 21, 1, 6, y); SOL_F(50, 22, 1, 6, z); SOL_F(50, 23, 1, 6, w);
        SOL_F(50, 24, 1, 7, x); SOL_F(50, 25, 1, 7, y); SOL_F(50, 26, 1, 7, z); SOL_F(50, 27, 1, 7, w);
        SOL_F(50, 28, 1, 8, x); SOL_F(50, 29, 1, 8, y); SOL_F(50, 30, 1, 8, z); SOL_F(50, 31, 1, 8, w);
        SOL_F(50, 32, 1, 9, x); SOL_F(50, 33, 1, 9, y); SOL_F(50, 34, 1, 9, z); SOL_F(50, 35, 1, 9, w);
        SOL_F(50, 36, 1, 10, x); SOL_F(50, 37, 1, 10, y); SOL_F(50, 38, 1, 10, z); SOL_F(50, 39, 1, 10, w);
        SOL_F(50, 40, 1, 11, x); SOL_F(50, 41, 1, 11, y); SOL_F(50, 42, 1, 11, z); SOL_F(50, 43, 1, 11, w);
        __builtin_amdgcn_sched_barrier(0);
        SOL_L(1, 0, 3508); SOL_L(1, 1, 3512); SOL_L(1, 2, 3516); SOL_L(1, 3, 3536); SOL_L(1, 4, 3540); SOL_L(1, 5, 3544); SOL_L(1, 6, 3548); SOL_L(1, 7, 3552); SOL_L(1, 8, 3556); SOL_L(1, 9, 3560); SOL_L(1, 10, 3564); SOL_L(1, 11, 3568);
        __builtin_amdgcn_sched_barrier(0);
        SOL_F(50, 44, 0, 0, x); SOL_F(50, 45, 0, 0, y); SOL_F(50, 46, 0, 0, z); SOL_F(50, 47, 0, 0, w);
        SOL_F(50, 48, 0, 1, x); SOL_F(50, 49, 0, 1, y);
        SOL_F(51, 0, 0, 2, x); SOL_F(51, 1, 0, 2, y); SOL_F(51, 2, 0, 2, z); SOL_F(51, 3, 0, 2, w);
        SOL_F(51, 4, 0, 3, x); SOL_F(51, 5, 0, 3, y); SOL_F(51, 6, 0, 3, z); SOL_F(51, 7, 0, 3, w);
        SOL_F(51, 8, 0, 4, x); SOL_F(51, 9, 0, 4, y); SOL_F(51, 10, 0, 4, z); SOL_F(51, 11, 0, 4, w);
        SOL_F(51, 12, 0, 5, x); SOL_F(51, 13, 0, 5, y); SOL_F(51, 14, 0, 5, z); SOL_F(51, 15, 0, 5, w);
        SOL_F(51, 16, 0, 6, x); SOL_F(51, 17, 0, 6, y); SOL_F(51, 18, 0, 6, z); SOL_F(51, 19, 0, 6, w);
        SOL_F(51, 20, 0, 7, x); SOL_F(51, 21, 0, 7, y); SOL_F(51, 22, 0, 7, z); SOL_F(51, 23, 0, 7, w);
        SOL_F(51, 24, 0, 8, x); SOL_F(51, 25, 0, 8, y); SOL_F(51, 26, 0, 8, z); SOL_F(51, 27, 0, 8, w);
        SOL_F(51, 28, 0, 9, x); SOL_F(51, 29, 0, 9, y); SOL_F(51, 30, 0, 9, z); SOL_F(51, 31, 0, 9, w);
        SOL_F(51, 32, 0, 10, x); SOL_F(51, 33, 0, 10, y); SOL_F(51, 34, 0, 10, z); SOL_F(51, 35, 0, 10, w);
        SOL_F(51, 36, 0, 11, x); SOL_F(51, 37, 0, 11, y); SOL_F(51, 38, 0, 11, z); SOL_F(51, 39, 0, 11, w);
        __builtin_amdgcn_sched_barrier(0);
        SOL_L(0, 0, 3572); SOL_L(0, 1, 3576); SOL_L(0, 2, 3580); SOL_L(0, 3, 3584); SOL_L(0, 4, 3604); SOL_L(0, 5, 3608); SOL_L(0, 6, 3612); SOL_L(0, 7, 3616); SOL_L(0, 8, 3620); SOL_L(0, 9, 3624); SOL_L(0, 10, 3628); SOL_L(0, 11, 3632);
        __builtin_amdgcn_sched_barrier(0);
        SOL_F(51, 40, 1, 0, x); SOL_F(51, 41, 1, 0, y); SOL_F(51, 42, 1, 0, z); SOL_F(51, 43, 1, 0, w);
        SOL_F(51, 44, 1, 1, x); SOL_F(51, 45, 1, 1, y); SOL_F(51, 46, 1, 1, z); SOL_F(51, 47, 1, 1, w);
        SOL_F(51, 48, 1, 2, x); SOL_F(51, 49, 1, 2, y); SOL_F(51, 50, 1, 2, z);
        SOL_F(52, 0, 1, 3, x); SOL_F(52, 1, 1, 3, y); SOL_F(52, 2, 1, 3, z); SOL_F(52, 3, 1, 3, w);
        SOL_F(52, 4, 1, 4, x); SOL_F(52, 5, 1, 4, y); SOL_F(52, 6, 1, 4, z); SOL_F(52, 7, 1, 4, w);
        SOL_F(52, 8, 1, 5, x); SOL_F(52, 9, 1, 5, y); SOL_F(52, 10, 1, 5, z); SOL_F(52, 11, 1, 5, w);
        SOL_F(52, 12, 1, 6, x); SOL_F(52, 13, 1, 6, y); SOL_F(52, 14, 1, 6, z); SOL_F(52, 15, 1, 6, w);
        SOL_F(52, 16, 1, 7, x); SOL_F(52, 17, 1, 7, y); SOL_F(52, 18, 1, 7, z); SOL_F(52, 19, 1, 7, w);
        SOL_F(52, 20, 1, 8, x); SOL_F(52, 21, 1, 8, y); SOL_F(52, 22, 1, 8, z); SOL_F(52, 23, 1, 8, w);
        SOL_F(52, 24, 1, 9, x); SOL_F(52, 25, 1, 9, y); SOL_F(52, 26, 1, 9, z); SOL_F(52, 27, 1, 9, w);
        SOL_F(52, 28, 1, 10, x); SOL_F(52, 29, 1, 10, y); SOL_F(52, 30, 1, 10, z); SOL_F(52, 31, 1, 10, w);
        SOL_F(52, 32, 1, 11, x); SOL_F(52, 33, 1, 11, y); SOL_F(52, 34, 1, 11, z); SOL_F(52, 35, 1, 11, w);
        __builtin_amdgcn_sched_barrier(0);
        SOL_L(1, 0, 3636); SOL_L(1, 1, 3640); SOL_L(1, 2, 3644); SOL_L(1, 3, 3648); SOL_L(1, 4, 3652); SOL_L(1, 5, 3656); SOL_L(1, 6, 3672); SOL_L(1, 7, 3676); SOL_L(1, 8, 3680); SOL_L(1, 9, 3684); SOL_L(1, 10, 3688); SOL_L(1, 11, 3692);
        __builtin_amdgcn_sched_barrier(0);
        SOL_F(52, 36, 0, 0, x); SOL_F(52, 37, 0, 0, y); SOL_F(52, 38, 0, 0, z); SOL_F(52, 39, 0, 0, w);
        SOL_F(52, 40, 0, 1, x); SOL_F(52, 41, 0, 1, y); SOL_F(52, 42, 0, 1, z); SOL_F(52, 43, 0, 1, w);
        SOL_F(52, 44, 0, 2, x); SOL_F(52, 45, 0, 2, y); SOL_F(52, 46, 0, 2, z); SOL_F(52, 47, 0, 2, w);
        SOL_F(52, 48, 0, 3, x); SOL_F(52, 49, 0, 3, y); SOL_F(52, 50, 0, 3, z); SOL_F(52, 51, 0, 3, w);
        SOL_F(53, 0, 0, 4, x); SOL_F(53, 1, 0, 4, y); SOL_F(53, 2, 0, 4, z); SOL_F(53, 3, 0, 4, w);
        SOL_F(53, 4, 0, 5, x); SOL_F(53, 5, 0, 5, y); SOL_F(53, 6, 0, 5, z); SOL_F(53, 7, 0, 5, w);
        SOL_F(53, 8, 0, 6, x); SOL_F(53, 9, 0, 6, y); SOL_F(53, 10, 0, 6, z); SOL_F(53, 11, 0, 6, w);
        SOL_F(53, 12, 0, 7, x); SOL_F(53, 13, 0, 7, y); SOL_F(53, 14, 0, 7, z); SOL_F(53, 15, 0, 7, w);
        SOL_F(53, 16, 0, 8, x); SOL_F(53, 17, 0, 8, y); SOL_F(53, 18, 0, 8, z); SOL_F(53, 19, 0, 8, w);
        SOL_F(53, 20, 0, 9, x); SOL_F(53, 21, 0, 9, y); SOL_F(53, 22, 0, 9, z); SOL_F(53, 23, 0, 9, w);
        SOL_F(53, 24, 0, 10, x); SOL_F(53, 25, 0, 10, y); SOL_F(53, 26, 0, 10, z); SOL_F(53, 27, 0, 10, w);
        SOL_F(53, 28, 0, 11, x); SOL_F(53, 29, 0, 11, y); SOL_F(53, 30, 0, 11, z); SOL_F(53, 31, 0, 11, w);
        __builtin_amdgcn_sched_barrier(0);
        SOL_L(0, 0, 3696); SOL_L(0, 1, 3700); SOL_L(0, 2, 3704); SOL_L(0, 3, 3708); SOL_L(0, 4, 3712); SOL_L(0, 5, 3716); SOL_L(0, 6, 3720); SOL_L(0, 7, 3724); SOL_L(0, 8, 3740); SOL_L(0, 9, 3744); SOL_L(0, 10, 3748); SOL_L(0, 11, 3752);
        __builtin_amdgcn_sched_barrier(0);
        SOL_F(53, 32, 1, 0, x); SOL_F(53, 33, 1, 0, y); SOL_F(53, 34, 1, 0, z); SOL_F(53, 35, 1, 0, w);
        SOL_F(53, 36, 1, 1, x); SOL_F(53, 37, 1, 1, y); SOL_F(53, 38, 1, 1, z); SOL_F(53, 39, 1, 1, w);
        SOL_F(53, 40, 1, 2, x); SOL_F(53, 41, 1, 2, y); SOL_F(53, 42, 1, 2, z); SOL_F(53, 43, 1, 2, w);
        SOL_F(53, 44, 1, 3, x); SOL_F(53, 45, 1, 3, y); SOL_F(53, 46, 1, 3, z); SOL_F(53, 47, 1, 3, w);
        SOL_F(53, 48, 1, 4, x); SOL_F(53, 49, 1, 4, y); SOL_F(53, 50, 1, 4, z); SOL_F(53, 51, 1, 4, w);
        SOL_F(53, 52, 1, 5, x);
        SOL_F(54, 0, 1, 6, x); SOL_F(54, 1, 1, 6, y); SOL_F(54, 2, 1, 6, z); SOL_F(54, 3, 1, 6, w);
        SOL_F(54, 4, 1, 7, x); SOL_F(54, 5, 1, 7, y); SOL_F(54, 6, 1, 7, z); SOL_F(54, 7, 1, 7, w);
        SOL_F(54, 8, 1, 8, x); SOL_F(54, 9, 1, 8, y); SOL_F(54, 10, 1, 8, z); SOL_F(54, 11, 1, 8, w);
        SOL_F(54, 12, 1, 9, x); SOL_F(54, 13, 1, 9, y); SOL_F(54, 14, 1, 9, z); SOL_F(54, 15, 1, 9, w);
        SOL_F(54, 16, 1, 10, x); SOL_F(54, 17, 1, 10, y); SOL_F(54, 18, 1, 10, z); SOL_F(54, 19, 1, 10, w);
        SOL_F(54, 20, 1, 11, x); SOL_F(54, 21, 1, 11, y); SOL_F(54, 22, 1, 11, z); SOL_F(54, 23, 1, 11, w);
        __builtin_amdgcn_sched_barrier(0);
        SOL_L(1, 0, 3756); SOL_L(1, 1, 3760); SOL_L(1, 2, 3764); SOL_L(1, 3, 3768); SOL_L(1, 4, 3772); SOL_L(1, 5, 3776); SOL_L(1, 6, 3780); SOL_L(1, 7, 3784); SOL_L(1, 8, 3788); SOL_L(1, 9, 3792); SOL_L(1, 10, 3808); SOL_L(1, 11, 3812);
        __builtin_amdgcn_sched_barrier(0);
        SOL_F(54, 24, 0, 0, x); SOL_F(54, 25, 0, 0, y); SOL_F(54, 26, 0, 0, z); SOL_F(54, 27, 0, 0, w);
        SOL_F(54, 28, 0, 1, x); SOL_F(54, 29, 0, 1, y); SOL_F(54, 30, 0, 1, z); SOL_F(54, 31, 0, 1, w);
        SOL_F(54, 32, 0, 2, x); SOL_F(54, 33, 0, 2, y); SOL_F(54, 34, 0, 2, z); SOL_F(54, 35, 0, 2, w);
        SOL_F(54, 36, 0, 3, x); SOL_F(54, 37, 0, 3, y); SOL_F(54, 38, 0, 3, z); SOL_F(54, 39, 0, 3, w);
        SOL_F(54, 40, 0, 4, x); SOL_F(54, 41, 0, 4, y); SOL_F(54, 42, 0, 4, z); SOL_F(54, 43, 0, 4, w);
        SOL_F(54, 44, 0, 5, x); SOL_F(54, 45, 0, 5, y); SOL_F(54, 46, 0, 5, z); SOL_F(54, 47, 0, 5, w);
        SOL_F(54, 48, 0, 6, x); SOL_F(54, 49, 0, 6, y); SOL_F(54, 50, 0, 6, z); SOL_F(54, 51, 0, 6, w);
        SOL_F(54, 52, 0, 7, x); SOL_F(54, 53, 0, 7, y);
        SOL_F(55, 0, 0, 8, x); SOL_F(55, 1, 0, 8, y); SOL_F(55, 2, 0, 8, z); SOL_F(55, 3, 0, 8, w);
        SOL_F(55, 4, 0, 9, x); SOL_F(55, 5, 0, 9, y); SOL_F(55, 6, 0, 9, z); SOL_F(55, 7, 0, 9, w);
        SOL_F(55, 8, 0, 10, x); SOL_F(55, 9, 0, 10, y); SOL_F(55, 10, 0, 10, z); SOL_F(55, 11, 0, 10, w);
        SOL_F(55, 12, 0, 11, x); SOL_F(55, 13, 0, 11, y); SOL_F(55, 14, 0, 11, z); SOL_F(55, 15, 0, 11, w);
        __builtin_amdgcn_sched_barrier(0);
        SOL_L(0, 0, 3816); SOL_L(0, 1, 3820); SOL_L(0, 2, 3824); SOL_L(0, 3, 3828); SOL_L(0, 4, 3832); SOL_L(0, 5, 3836); SOL_L(0, 6, 3840); SOL_L(0, 7, 3844); SOL_L(0, 8, 3848); SOL_L(0, 9, 3852); SOL_L(0, 10, 3856); SOL_L(0, 11, 3860);
        __builtin_amdgcn_sched_barrier(0);
        SOL_F(55, 16, 1, 0, x); SOL_F(55, 17, 1, 0, y); SOL_F(55, 18, 1, 0, z); SOL_F(55, 19, 1, 0, w);
        SOL_F(55, 20, 1, 1, x); SOL_F(55, 21, 1, 1, y); SOL_F(55, 22, 1, 1, z); SOL_F(55, 23, 1, 1, w);
        SOL_F(55, 24, 1, 2, x); SOL_F(55, 25, 1, 2, y); SOL_F(55, 26, 1, 2, z); SOL_F(55, 27, 1, 2, w);
        SOL_F(55, 28, 1, 3, x); SOL_F(55, 29, 1, 3, y); SOL_F(55, 30, 1, 3, z); SOL_F(55, 31, 1, 3, w);
        SOL_F(55, 32, 1, 4, x); SOL_F(55, 33, 1, 4, y); SOL_F(55, 34, 1, 4, z); SOL_F(55, 35, 1, 4, w);
        SOL_F(55, 36, 1, 5, x); SOL_F(55, 37, 1, 5, y); SOL_F(55, 38, 1, 5, z); SOL_F(55, 39, 1, 5, w);
        SOL_F(55, 40, 1, 6, x); SOL_F(55, 41, 1, 6, y); SOL_F(55, 42, 1, 6, z); SOL_F(55, 43, 1, 6, w);
        SOL_F(55, 44, 1, 7, x); SOL_F(55, 45, 1, 7, y); SOL_F(55, 46, 1, 7, z); SOL_F(55, 47, 1, 7, w);
        SOL_F(55, 48, 1, 8, x); SOL_F(55, 49, 1, 8, y); SOL_F(55, 50, 1, 8, z); SOL_F(55, 51, 1, 8, w);
        SOL_F(55, 52, 1, 9, x); SOL_F(55, 53, 1, 9, y); SOL_F(55, 54, 1, 9, z);
        SOL_F(56, 0, 1, 10, x); SOL_F(56, 1, 1, 10, y); SOL_F(56, 2, 1, 10, z); SOL_F(56, 3, 1, 10, w);
        SOL_F(56, 4, 1, 11, x); SOL_F(56, 5, 1, 11, y); SOL_F(56, 6, 1, 11, z); SOL_F(56, 7, 1, 11, w);
        __builtin_amdgcn_sched_barrier(0);
        SOL_L(1, 0, 3876); SOL_L(1, 1, 3880); SOL_L(1, 2, 3884); SOL_L(1, 3, 3888); SOL_L(1, 4, 3892); SOL_L(1, 5, 3896); SOL_L(1, 6, 3900); SOL_L(1, 7, 3904); SOL_L(1, 8, 3908); SOL_L(1, 9, 3912); SOL_L(1, 10, 3916); SOL_L(1, 11, 3920);
        __builtin_amdgcn_sched_barrier(0);
        SOL_F(56, 8, 0, 0, x); SOL_F(56, 9, 0, 0, y); SOL_F(56, 10, 0, 0, z); SOL_F(56, 11, 0, 0, w);
        SOL_F(56, 12, 0, 1, x); SOL_F(56, 13, 0, 1, y); SOL_F(56, 14, 0, 1, z); SOL_F(56, 15, 0, 1, w);
        SOL_F(56, 16, 0, 2, x); SOL_F(56, 17, 0, 2, y); SOL_F(56, 18, 0, 2, z); SOL_F(56, 19, 0, 2, w);
        SOL_F(56, 20, 0, 3, x); SOL_F(56, 21, 0, 3, y); SOL_F(56, 22, 0, 3, z); SOL_F(56, 23, 0, 3, w);
        SOL_F(56, 24, 0, 4, x); SOL_F(56, 25, 0, 4, y); SOL_F(56, 26, 0, 4, z); SOL_F(56, 27, 0, 4, w);
        SOL_F(56, 28, 0, 5, x); SOL_F(56, 29, 0, 5, y); SOL_F(56, 30, 0, 5, z); SOL_F(56, 31, 0, 5, w);
        SOL_F(56, 32, 0, 6, x); SOL_F(56, 33, 0, 6, y); SOL_F(56, 34, 0, 6, z); SOL_F(56, 35, 0, 6, w);
        SOL_F(56, 36, 0, 7, x); SOL_F(56, 37, 0, 7, y); SOL_F(56, 38, 0, 7, z); SOL_F(56, 39, 0, 7, w);
        SOL_F(56, 40, 0, 8, x); SOL_F(56, 41, 0, 8, y); SOL_F(56, 42, 0, 8, z); SOL_F(56, 43, 0, 8, w);
        SOL_F(56, 44, 0, 9, x); SOL_F(56, 45, 0, 9, y); SOL_F(56, 46, 0, 9, z); SOL_F(56, 47, 0, 9, w);
        SOL_F(56, 48, 0, 10, x); SOL_F(56, 49, 0, 10, y); SOL_F(56, 50, 0, 10, z); SOL_F(56, 51, 0, 10, w);
        SOL_F(56, 52, 0, 11, x); SOL_F(56, 53, 0, 11, y); SOL_F(56, 54, 0, 11, z); SOL_F(56, 55, 0, 11, w);
        __builtin_amdgcn_sched_barrier(0);
        SOL_L(0, 0, 3924); SOL_L(0, 1, 3928); SOL_L(0, 2, 3932); SOL_L(0, 3, 3944); SOL_L(0, 4, 3948); SOL_L(0, 5, 3952); SOL_L(0, 6, 3956); SOL_L(0, 7, 3960); SOL_L(0, 8, 3964); SOL_L(0, 9, 3968); SOL_L(0, 10, 3972); SOL_L(0, 11, 3976);
        __builtin_amdgcn_sched_barrier(0);
        SOL_F(57, 0, 1, 0, x); SOL_F(57, 1, 1, 0, y); SOL_F(57, 2, 1, 0, z); SOL_F(57, 3, 1, 0, w);
        SOL_F(57, 4, 1, 1, x); SOL_F(57, 5, 1, 1, y); SOL_F(57, 6, 1, 1, z); SOL_F(57, 7, 1, 1, w);
        SOL_F(57, 8, 1, 2, x); SOL_F(57, 9, 1, 2, y); SOL_F(57, 10, 1, 2, z); SOL_F(57, 11, 1, 2, w);
        SOL_F(57, 12, 1, 3, x); SOL_F(57, 13, 1, 3, y); SOL_F(57, 14, 1, 3, z); SOL_F(57, 15, 1, 3, w);
        SOL_F(57, 16, 1, 4, x); SOL_F(57, 17, 1, 4, y); SOL_F(57, 18, 1, 4, z); SOL_F(57, 19, 1, 4, w);
        SOL_F(57, 20, 1, 5, x); SOL_F(57, 21, 1, 5, y); SOL_F(57, 22, 1, 5, z); SOL_F(57, 23, 1, 5, w);
        SOL_F(57, 24, 1, 6, x); SOL_F(57, 25, 1, 6, y); SOL_F(57, 26, 1, 6, z); SOL_F(57, 27, 1, 6, w);
        SOL_F(57, 28, 1, 7, x); SOL_F(57, 29, 1, 7, y); SOL_F(57, 30, 1, 7, z); SOL_F(57, 31, 1, 7, w);
        SOL_F(57, 32, 1, 8, x); SOL_F(57, 33, 1, 8, y); SOL_F(57, 34, 1, 8, z); SOL_F(57, 35, 1, 8, w);
        SOL_F(57, 36, 1, 9, x); SOL_F(57, 37, 1, 9, y); SOL_F(57, 38, 1, 9, z); SOL_F(57, 39, 1, 9, w);
        SOL_F(57, 40, 1, 10, x); SOL_F(57, 41, 1, 10, y); SOL_F(57, 42, 1, 10, z); SOL_F(57, 43, 1, 10, w);
        SOL_F(57, 44, 1, 11, x); SOL_F(57, 45, 1, 11, y); SOL_F(57, 46, 1, 11, z); SOL_F(57, 47, 1, 11, w);
        __builtin_amdgcn_sched_barrier(0);
        SOL_L(1, 0, 3980); SOL_L(1, 1, 3984); SOL_L(1, 2, 3988); SOL_L(1, 3, 3992); SOL_L(1, 4, 3996); SOL_L(1, 5, 4000); SOL_L(1, 6, 4012); SOL_L(1, 7, 4016); SOL_L(1, 8, 4020); SOL_L(1, 9, 4024); SOL_L(1, 10, 4028); SOL_L(1, 11, 4032);
        __builtin_amdgcn_sched_barrier(0);
        SOL_F(57, 48, 0, 0, x); SOL_F(57, 49, 0, 0, y); SOL_F(57, 50, 0, 0, z); SOL_F(57, 51, 0, 0, w);
        SOL_F(57, 52, 0, 1, x); SOL_F(57, 53, 0, 1, y); SOL_F(57, 54, 0, 1, z); SOL_F(57, 55, 0, 1, w);
        SOL_F(57, 56, 0, 2, x);
        SOL_F(58, 0, 0, 3, x); SOL_F(58, 1, 0, 3, y); SOL_F(58, 2, 0, 3, z); SOL_F(58, 3, 0, 3, w);
        SOL_F(58, 4, 0, 4, x); SOL_F(58, 5, 0, 4, y); SOL_F(58, 6, 0, 4, z); SOL_F(58, 7, 0, 4, w);
        SOL_F(58, 8, 0, 5, x); SOL_F(58, 9, 0, 5, y); SOL_F(58, 10, 0, 5, z); SOL_F(58, 11, 0, 5, w);
        SOL_F(58, 12, 0, 6, x); SOL_F(58, 13, 0, 6, y); SOL_F(58, 14, 0, 6, z); SOL_F(58, 15, 0, 6, w);
        SOL_F(58, 16, 0, 7, x); SOL_F(58, 17, 0, 7, y); SOL_F(58, 18, 0, 7, z); SOL_F(58, 19, 0, 7, w);
        SOL_F(58, 20, 0, 8, x); SOL_F(58, 21, 0, 8, y); SOL_F(58, 22, 0, 8, z); SOL_F(58, 23, 0, 8, w);
        SOL_F(58, 24, 0, 9, x); SOL_F(58, 25, 0, 9, y); SOL_F(58, 26, 0, 9, z); SOL_F(58, 27, 0, 9, w);
        SOL_F(58, 28, 0, 10, x); SOL_F(58, 29, 0, 10, y); SOL_F(58, 30, 0, 10, z); SOL_F(58, 31, 0, 10, w);
        SOL_F(58, 32, 0, 11, x); SOL_F(58, 33, 0, 11, y); SOL_F(58, 34, 0, 11, z); SOL_F(58, 35, 0, 11, w);
        __builtin_amdgcn_sched_barrier(0);
        SOL_L(0, 0, 4036); SOL_L(0, 1, 4040); SOL_L(0, 2, 4044); SOL_L(0, 3, 4048); SOL_L(0, 4, 4052); SOL_L(0, 5, 4056); SOL_L(0, 6, 4060); SOL_L(0, 7, 4064); SOL_L(0, 8, 4068); SOL_L(0, 9, 4080); SOL_L(0, 10, 4084); SOL_L(0, 11, 4088);
        __builtin_amdgcn_sched_barrier(0);
        SOL_F(58, 36, 1, 0, x); SOL_F(58, 37, 1, 0, y); SOL_F(58, 38, 1, 0, z); SOL_F(58, 39, 1, 0, w);
        SOL_F(58, 40, 1, 1, x); SOL_F(58, 41, 1, 1, y); SOL_F(58, 42, 1, 1, z); SOL_F(58, 43, 1, 1, w);
        SOL_F(58, 44, 1, 2, x); SOL_F(58, 45, 1, 2, y); SOL_F(58, 46, 1, 2, z); SOL_F(58, 47, 1, 2, w);
        SOL_F(58, 48, 1, 3, x); SOL_F(58, 49, 1, 3, y); SOL_F(58, 50, 1, 3, z); SOL_F(58, 51, 1, 3, w);
        SOL_F(58, 52, 1, 4, x); SOL_F(58, 53, 1, 4, y); SOL_F(58, 54, 1, 4, z); SOL_F(58, 55, 1, 4, w);
        SOL_F(58, 56, 1, 5, x); SOL_F(58, 57, 1, 5, y);
        SOL_F(59, 0, 1, 6, x); SOL_F(59, 1, 1, 6, y); SOL_F(59, 2, 1, 6, z); SOL_F(59, 3, 1, 6, w);
        SOL_F(59, 4, 1, 7, x); SOL_F(59, 5, 1, 7, y); SOL_F(59, 6, 1, 7, z); SOL_F(59, 7, 1, 7, w);
        SOL_F(59, 8, 1, 8, x); SOL_F(59, 9, 1, 8, y); SOL_F(59, 10, 1, 8, z); SOL_F(59, 11, 1, 8, w);
        SOL_F(59, 12, 1, 9, x); SOL_F(59, 13, 1, 9, y); SOL_F(59, 14, 1, 9, z); SOL_F(59, 15, 1, 9, w);
        SOL_F(59, 16, 1, 10, x); SOL_F(59, 17, 1, 10, y); SOL_F(59, 18, 1, 10, z); SOL_F(59, 19, 1, 10, w);
        SOL_F(59, 20, 1, 11, x); SOL_F(59, 21, 1, 11, y); SOL_F(59, 22, 1, 11, z); SOL_F(59, 23, 1, 11, w);
        __builtin_amdgcn_sched_barrier(0);
        SOL_L(1, 0, 4092); SOL_L(1, 1, 4096); SOL_L(1, 2, 4100); SOL_L(1, 3, 4104); SOL_L(1, 4, 4108); SOL_L(1, 5, 4112); SOL_L(1, 6, 4116); SOL_L(1, 7, 4120); SOL_L(1, 8, 4124); SOL_L(1, 9, 4128); SOL_L(1, 10, 4132); SOL_L(1, 11, 4136);
        __builtin_amdgcn_sched_barrier(0);
        SOL_F(59, 24, 0, 0, x); SOL_F(59, 25, 0, 0, y); SOL_F(59, 26, 0, 0, z); SOL_F(59, 27, 0, 0, w);
        SOL_F(59, 28, 0, 1, x); SOL_F(59, 29, 0, 1, y); SOL_F(59, 30, 0, 1, z); SOL_F(59, 31, 0, 1, w);
        SOL_F(59, 32, 0, 2, x); SOL_F(59, 33, 0, 2, y); SOL_F(59, 34, 0, 2, z); SOL_F(59, 35, 0, 2, w);
        SOL_F(59, 36, 0, 3, x); SOL_F(59, 37, 0, 3, y); SOL_F(59, 38, 0, 3, z); SOL_F(59, 39, 0, 3, w);
        SOL_F(59, 40, 0, 4, x); SOL_F(59, 41, 0, 4, y); SOL_F(59, 42, 0, 4, z); SOL_F(59, 43, 0, 4, w);
        SOL_F(59, 44, 0, 5, x); SOL_F(59, 45, 0, 5, y); SOL_F(59, 46, 0, 5, z); SOL_F(59, 47, 0, 5, w);
        SOL_F(59, 48, 0, 6, x); SOL_F(59, 49, 0, 6, y); SOL_F(59, 50, 0, 6, z); SOL_F(59, 51, 0, 6, w);
        SOL_F(59, 52, 0, 7, x); SOL_F(59, 53, 0, 7, y); SOL_F(59, 54, 0, 7, z); SOL_F(59, 55, 0, 7, w);
        SOL_F(59, 56, 0, 8, x); SOL_F(59, 57, 0, 8, y); SOL_F(59, 58, 0, 8, z);
        SOL_F(60, 0, 0, 9, x); SOL_F(60, 1, 0, 9, y); SOL_F(60, 2, 0, 9, z); SOL_F(60, 3, 0, 9, w);
        SOL_F(60, 4, 0, 10, x); SOL_F(60, 5, 0, 10, y); SOL_F(60, 6, 0, 10, z); SOL_F(60, 7, 0, 10, w);
        SOL_F(60, 8, 0, 11, x); SOL_F(60, 9, 0, 11, y); SOL_F(60, 10, 0, 11, z); SOL_F(60, 11, 0, 11, w);
        __builtin_amdgcn_sched_barrier(0);
        SOL_L(0, 0, 4148); SOL_L(0, 1, 4152); SOL_L(0, 2, 4156); SOL_L(0, 3, 4160); SOL_L(0, 4, 4164); SOL_L(0, 5, 4168); SOL_L(0, 6, 4172); SOL_L(0, 7, 4176); SOL_L(0, 8, 4180); SOL_L(0, 9, 4184); SOL_L(0, 10, 4188); SOL_L(0, 11, 4192);
        __builtin_amdgcn_sched_barrier(0);
        SOL_F(60, 12, 1, 0, x); SOL_F(60, 13, 1, 0, y); SOL_F(60, 14, 1, 0, z); SOL_F(60, 15, 1, 0, w);
        SOL_F(60, 16, 1, 1, x); SOL_F(60, 17, 1, 1, y); SOL_F(60, 18, 1, 1, z); SOL_F(60, 19, 1, 1, w);
        SOL_F(60, 20, 1, 2, x); SOL_F(60, 21, 1, 2, y); SOL_F(60, 22, 1, 2, z); SOL_F(60, 23, 1, 2, w);
        SOL_F(60, 24, 1, 3, x); SOL_F(60, 25, 1, 3, y); SOL_F(60, 26, 1, 3, z); SOL_F(60, 27, 1, 3, w);
        SOL_F(60, 28, 1, 4, x); SOL_F(60, 29, 1, 4, y); SOL_F(60, 30, 1, 4, z); SOL_F(60, 31, 1, 4, w);
        SOL_F(60, 32, 1, 5, x); SOL_F(60, 33, 1, 5, y); SOL_F(60, 34, 1, 5, z); SOL_F(60, 35, 1, 5, w);
        SOL_F(60, 36, 1, 6, x); SOL_F(60, 37, 1, 6, y); SOL_F(60, 38, 1, 6, z); SOL_F(60, 39, 1, 6, w);
        SOL_F(60, 40, 1, 7, x); SOL_F(60, 41, 1, 7, y); SOL_F(60, 42, 1, 7, z); SOL_F(60, 43, 1, 7, w);
        SOL_F(60, 44, 1, 8, x); SOL_F(60, 45, 1, 8, y); SOL_F(60, 46, 1, 8, z); SOL_F(60, 47, 1, 8, w);
        SOL_F(60, 48, 1, 9, x); SOL_F(60, 49, 1, 9, y); SOL_F(60, 50, 1, 9, z); SOL_F(60, 51, 1, 9, w);
        SOL_F(60, 52, 1, 10, x); SOL_F(60, 53, 1, 10, y); SOL_F(60, 54, 1, 10, z); SOL_F(60, 55, 1, 10, w);
        SOL_F(60, 56, 1, 11, x); SOL_F(60, 57, 1, 11, y); SOL_F(60, 58, 1, 11, z); SOL_F(60, 59, 1, 11, w);
        __builtin_amdgcn_sched_barrier(0);
        SOL_L(1, 0, 4196); SOL_L(1, 1, 4200); SOL_L(1, 2, 4204); SOL_L(1, 3, 4208); SOL_L(1, 4, 4216); SOL_L(1, 5, 4220); SOL_L(1, 6, 4224); SOL_L(1, 7, 4228); SOL_L(1, 8, 4232); SOL_L(1, 9, 4236); SOL_L(1, 10, 4240); SOL_L(1, 11, 4244);
        __builtin_amdgcn_sched_barrier(0);
        SOL_F(61, 0, 0, 0, x); SOL_F(61, 1, 0, 0, y); SOL_F(61, 2, 0, 0, z); SOL_F(61, 3, 0, 0, w);
        SOL_F(61, 4, 0, 1, x); SOL_F(61, 5, 0, 1, y); SOL_F(61, 6, 0, 1, z); SOL_F(61, 7, 0, 1, w);
        SOL_F(61, 8, 0, 2, x); SOL_F(61, 9, 0, 2, y); SOL_F(61, 10, 0, 2, z); SOL_F(61, 11, 0, 2, w);
        SOL_F(61, 12, 0, 3, x); SOL_F(61, 13, 0, 3, y); SOL_F(61, 14, 0, 3, z); SOL_F(61, 15, 0, 3, w);
        SOL_F(61, 16, 0, 4, x); SOL_F(61, 17, 0, 4, y); SOL_F(61, 18, 0, 4, z); SOL_F(61, 19, 0, 4, w);
        SOL_F(61, 20, 0, 5, x); SOL_F(61, 21, 0, 5, y); SOL_F(61, 22, 0, 5, z); SOL_F(61, 23, 0, 5, w);
        SOL_F(61, 24, 0, 6, x); SOL_F(61, 25, 0, 6, y); SOL_F(61, 26, 0, 6, z); SOL_F(61, 27, 0, 6, w);
        SOL_F(61, 28, 0, 7, x); SOL_F(61, 29, 0, 7, y); SOL_F(61, 30, 0, 7, z); SOL_F(61, 31, 0, 7, w);
        SOL_F(61, 32, 0, 8, x); SOL_F(61, 33, 0, 8, y); SOL_F(61, 34, 0, 8, z); SOL_F(61, 35, 0, 8, w);
        SOL_F(61, 36, 0, 9, x); SOL_F(61, 37, 0, 9, y); SOL_F(61, 38, 0, 9, z); SOL_F(61, 39, 0, 9, w);
        SOL_F(61, 40, 0, 10, x); SOL_F(61, 41, 0, 10, y); SOL_F(61, 42, 0, 10, z); SOL_F(61, 43, 0, 10, w);
        SOL_F(61, 44, 0, 11, x); SOL_F(61, 45, 0, 11, y); SOL_F(61, 46, 0, 11, z); SOL_F(61, 47, 0, 11, w);
        __builtin_amdgcn_sched_barrier(0);
        SOL_L(0, 0, 4248); SOL_L(0, 1, 4252); SOL_L(0, 2, 4256); SOL_L(0, 3, 4260); SOL_L(0, 4, 4264); SOL_L(0, 5, 4268); SOL_L(0, 6, 4272); SOL_L(0, 7, 4276); SOL_L(0, 8, 4284); SOL_L(0, 9, 4288); SOL_L(0, 10, 4292); SOL_L(0, 11, 4296);
        __builtin_amdgcn_sched_barrier(0);
        SOL_F(61, 48, 1, 0, x); SOL_F(61, 49, 1, 0, y); SOL_F(61, 50, 1, 0, z); SOL_F(61, 51, 1, 0, w);
        SOL_F(61, 52, 1, 1, x); SOL_F(61, 53, 1, 1, y); SOL_F(61, 54, 1, 1, z); SOL_F(61, 55, 1, 1, w);
        SOL_F(61, 56, 1, 2, x); SOL_F(61, 57, 1, 2, y); SOL_F(61, 58, 1, 2, z); SOL_F(61, 59, 1, 2, w);
        SOL_F(61, 60, 1, 3, x);
        SOL_F(62, 0, 1, 4, x); SOL_F(62, 1, 1, 4, y); SOL_F(62, 2, 1, 4, z); SOL_F(62, 3, 1, 4, w);
        SOL_F(62, 4, 1, 5, x); SOL_F(62, 5, 1, 5, y); SOL_F(62, 6, 1, 5, z); SOL_F(62, 7, 1, 5, w);
        SOL_F(62, 8, 1, 6, x); SOL_F(62, 9, 1, 6, y); SOL_F(62, 10, 1, 6, z); SOL_F(62, 11, 1, 6, w);
        SOL_F(62, 12, 1, 7, x); SOL_F(62, 13, 1, 7, y); SOL_F(62, 14, 1, 7, z); SOL_F(62, 15, 1, 7, w);
        SOL_F(62, 16, 1, 8, x); SOL_F(62, 17, 1, 8, y); SOL_F(62, 18, 1, 8, z); SOL_F(62, 19, 1, 8, w);
        SOL_F(62, 20, 1, 9, x); SOL_F(62, 21, 1, 9, y); SOL_F(62, 22, 1, 9, z); SOL_F(62, 23, 1, 9, w);
        SOL_F(62, 24, 1, 10, x); SOL_F(62, 25, 1, 10, y); SOL_F(62, 26, 1, 10, z); SOL_F(62, 27, 1, 10, w);
        SOL_F(62, 28, 1, 11, x); SOL_F(62, 29, 1, 11, y); SOL_F(62, 30, 1, 11, z); SOL_F(62, 31, 1, 11, w);
        __builtin_amdgcn_sched_barrier(0);
        SOL_L(1, 0, 4300); SOL_L(1, 1, 4304); SOL_L(1, 2, 4308); SOL_L(1, 3, 4312); SOL_L(1, 4, 4316); SOL_L(1, 5, 4320); SOL_L(1, 6, 4324); SOL_L(1, 7, 4328); SOL_L(1, 8, 4332); SOL_L(1, 9, 4336); SOL_L(1, 10, 4340); SOL_L(1, 11, 4344);
        __builtin_amdgcn_sched_barrier(0);
        SOL_F(62, 32, 0, 0, x); SOL_F(62, 33, 0, 0, y); SOL_F(62, 34, 0, 0, z); SOL_F(62, 35, 0, 0, w);
        SOL_F(62, 36, 0, 1, x); SOL_F(62, 37, 0, 1, y); SOL_F(62, 38, 0, 1, z); SOL_F(62, 39, 0, 1, w);
        SOL_F(62, 40, 0, 2, x); SOL_F(62, 41, 0, 2, y); SOL_F(62, 42, 0, 2, z); SOL_F(62, 43, 0, 2, w);
        SOL_F(62, 44, 0, 3, x); SOL_F(62, 45, 0, 3, y); SOL_F(62, 46, 0, 3, z); SOL_F(62, 47, 0, 3, w);
        SOL_F(62, 48, 0, 4, x); SOL_F(62, 49, 0, 4, y); SOL_F(62, 50, 0, 4, z); SOL_F(62, 51, 0, 4, w);
        SOL_F(62, 52, 0, 5, x); SOL_F(62, 53, 0, 5, y); SOL_F(62, 54, 0, 5, z); SOL_F(62, 55, 0, 5, w);
        SOL_F(62, 56, 0, 6, x); SOL_F(62, 57, 0, 6, y); SOL_F(62, 58, 0, 6, z); SOL_F(62, 59, 0, 6, w);
        SOL_F(62, 60, 0, 7, x); SOL_F(62, 61, 0, 7, y);
        SOL_F(63, 0, 0, 8, x); SOL_F(63, 1, 0, 8, y); SOL_F(63, 2, 0, 8, z); SOL_F(63, 3, 0, 8, w);
        SOL_F(63, 4, 0, 9, x); SOL_F(63, 5, 0, 9, y); SOL_F(63, 6, 0, 9, z); SOL_F(63, 7, 0, 9, w);
        SOL_F(63, 8, 0, 10, x); SOL_F(63, 9, 0, 10, y); SOL_F(63, 10, 0, 10, z); SOL_F(63, 11, 0, 10, w);
        SOL_F(63, 12, 0, 11, x); SOL_F(63, 13, 0, 11, y); SOL_F(63, 14, 0, 11, z); SOL_F(63, 15, 0, 11, w);
        __builtin_amdgcn_sched_barrier(0);
        __builtin_amdgcn_sched_barrier(0);
        SOL_F(63, 16, 1, 0, x); SOL_F(63, 17, 1, 0, y); SOL_F(63, 18, 1, 0, z); SOL_F(63, 19, 1, 0, w);
        SOL_F(63, 20, 1, 1, x); SOL_F(63, 21, 1, 1, y); SOL_F(63, 22, 1, 1, z); SOL_F(63, 23, 1, 1, w);
        SOL_F(63, 24, 1, 2, x); SOL_F(63, 25, 1, 2, y); SOL_F(63, 26, 1, 2, z); SOL_F(63, 27, 1, 2, w);
        SOL_F(63, 28, 1, 3, x); SOL_F(63, 29, 1, 3, y); SOL_F(63, 30, 1, 3, z); SOL_F(63, 31, 1, 3, w);
        SOL_F(63, 32, 1, 4, x); SOL_F(63, 33, 1, 4, y); SOL_F(63, 34, 1, 4, z); SOL_F(63, 35, 1, 4, w);
        SOL_F(63, 36, 1, 5, x); SOL_F(63, 37, 1, 5, y); SOL_F(63, 38, 1, 5, z); SOL_F(63, 39, 1, 5, w);
        SOL_F(63, 40, 1, 6, x); SOL_F(63, 41, 1, 6, y); SOL_F(63, 42, 1, 6, z); SOL_F(63, 43, 1, 6, w);
        SOL_F(63, 44, 1, 7, x); SOL_F(63, 45, 1, 7, y); SOL_F(63, 46, 1, 7, z); SOL_F(63, 47, 1, 7, w);
        SOL_F(63, 48, 1, 8, x); SOL_F(63, 49, 1, 8, y); SOL_F(63, 50, 1, 8, z); SOL_F(63, 51, 1, 8, w);
        SOL_F(63, 52, 1, 9, x); SOL_F(63, 53, 1, 9, y); SOL_F(63, 54, 1, 9, z); SOL_F(63, 55, 1, 9, w);
        SOL_F(63, 56, 1, 10, x); SOL_F(63, 57, 1, 10, y); SOL_F(63, 58, 1, 10, z); SOL_F(63, 59, 1, 10, w);
        SOL_F(63, 60, 1, 11, x); SOL_F(63, 61, 1, 11, y); SOL_F(63, 62, 1, 11, z);
        __builtin_amdgcn_sched_barrier(0);
#undef SOL_L
#undef SOL_F
        if (isu) {
#pragma unroll
            for (int q = 0; q < 8; ++q) { u32x4 o; o.x = pk2(xs[8 * q], xs[8 * q + 1]); o.y = pk2(xs[8 * q + 2], xs[8 * q + 3]); o.z = pk2(xs[8 * q + 4], xs[8 * q + 5]); o.w = pk2(xs[8 * q + 6], xs[8 * q + 7]);
                bf16_t* up = uT + ((col >> 5) * 8 + q) * 256 + (col & 31) * 4;
                *(u32x2*)up = (u32x2){o.x, o.y}; *(u32x2*)(up + 128) = (u32x2){o.z, o.w}; }
        } else {
            const int dk = col - 128, pos = (dk & ~15) + pinv16(dk & 15);
            LAS unsigned short* Wp = (LAS unsigned short*)(lds + P3_Q) + pos;
#pragma unroll
            for (int i = 0; i < 64; ++i) Wp[i * 136] = f2bf(xs[i]);
        }
    } else {
        const int t2 = tid - 256; const float gl = gcs[63];
        const LAS unsigned short* Kb = (const LAS unsigned short*)(lds + P3_K);
#pragma unroll
        for (int i = 0; i < 4; ++i) {
            const int idx = t2 + 256 * i, dk = idx >> 3, ch = idx & 7, cb0 = (ch >> 1) * 16 + (ch & 1) * 4;
            float v[8];
#pragma unroll
            for (int e = 0; e < 8; ++e) { const int c = cb0 + (e & 3) + (e >> 2) * 8; v[e] = bf2f(Kb[c * 136 + dk]) * __expf(gl - gcs[c]); }
            u32x4 o; o.x = pk2(v[0], v[1]); o.y = pk2(v[2], v[3]); o.z = pk2(v[4], v[5]); o.w = pk2(v[6], v[7]);
            *(u32x4*)(kdT + dk * 64 + ch * 8) = o;
        }
        if (tid == 256) ((float*)(a.ws + WS_GLAST))[bh * 64 + n] = gl;
        p3_ret_half(a, lds + 73728, rb, rn, rh, t2);
    }
    __syncthreads();
#pragma unroll
    for (int i = 0; i < 2; ++i) { const int p = tid + 512 * i, row = p >> 4, pc = p & 15; *(u32x4*)(wG + row * 128 + pc * 8) = *(const LAS u32x4*)(lds + P3_Q + row * 272 + pc * 16); }
    __syncthreads();
}

DI void p3_ret_half(const Args& a, LAS unsigned char* lds, int b, int n, int h, int t2in) {
    int tid_ = t2in; asm volatile("" : "+v"(tid_));
    const int tid = tid_, lane = tid & 63, wave = tid >> 6;
    const bf16_t* proj = (const bf16_t*)(a.ws + WS_PROJ);
    const int bh = b * 4 + h;
    unsigned char* rec = (unsigned char*)a.out + (size_t)(bh * 64 + n) * RREC;
    bf16_t* vT = (bf16_t*)rec; bf16_t* qgG = (bf16_t*)(rec + 16384); bf16_t* kdT = (bf16_t*)(rec + 32768); bf16_t* atG = (bf16_t*)(rec + 49152);
    const float lg = log1pf(-exp2f(-5.f - (float)h));
#pragma unroll 1
    for (int ps = 0; ps < 2; ++ps) {
    const int r = (tid >> 3) + 32 * ps, cb = tid & 7;
    const bf16_t* prow = proj + (size_t)(b * SEQ + n * 64 + r) * NPROJ;
    {
        const u32x4 q1 = *(const u32x4*)(prow + h * 128 + cb * 8), q2 = *(const u32x4*)(prow + h * 128 + 64 + cb * 8);
        const u32x4 k1 = *(const u32x4*)(prow + 512 + h * 128 + cb * 8), k2 = *(const u32x4*)(prow + 512 + h * 128 + 64 + cb * 8);
        const u32x4 v0 = *(const u32x4*)(prow + 1024 + h * 128 + cb * 16), v1 = *(const u32x4*)(prow + 1024 + h * 128 + cb * 16 + 8);
        *(LAS u32x4*)(lds + P3_V + r * 272 + cb * 32) = v0; *(LAS u32x4*)(lds + P3_V + r * 272 + cb * 32 + 16) = v1;
        const float pos = (float)(n * 64 + r);
        float qa[8], qb[8], ka[8], kb[8];
        const unsigned qw1[4] = {q1.x, q1.y, q1.z, q1.w}, qw2[4] = {q2.x, q2.y, q2.z, q2.w}, kw1[4] = {k1.x, k1.y, k1.z, k1.w}, kw2[4] = {k2.x, k2.y, k2.z, k2.w};
#pragma unroll
        for (int e = 0; e < 8; ++e) {
            const int d = cb * 8 + e;
            const float inv = exp2f(-(float)d * (13.287712379549449f / 64.f));
            const float ang = pos * inv;
            const float kq = rintf(ang * 0.15915494309189535f);
            float rr = fmaf(-kq, 6.2831854820251465f, ang); rr = fmaf(-kq, -1.7484555e-7f, rr);
            const float cs = __cosf(rr), sn = __sinf(rr);
            const float x1 = (e & 1) ? bfhi(qw1[e >> 1]) : bflo(qw1[e >> 1]), x2 = (e & 1) ? bfhi(qw2[e >> 1]) : bflo(qw2[e >> 1]);
            const float y1 = (e & 1) ? bfhi(kw1[e >> 1]) : bflo(kw1[e >> 1]), y2 = (e & 1) ? bfhi(kw2[e >> 1]) : bflo(kw2[e >> 1]);
            qa[e] = x1 * cs - x2 * sn; qb[e] = x1 * sn + x2 * cs;
            ka[e] = (y1 * cs - y2 * sn) * 0.08838834764831845f; kb[e] = (y1 * sn + y2 * cs) * 0.08838834764831845f;
        }
        u32x4 o;
        o.x = pk2(qa[0], qa[1]); o.y = pk2(qa[2], qa[3]); o.z = pk2(qa[4], qa[5]); o.w = pk2(qa[6], qa[7]); *(LAS u32x4*)(lds + P3_Q + r * 272 + cb * 16) = o;
        o.x = pk2(qb[0], qb[1]); o.y = pk2(qb[2], qb[3]); o.z = pk2(qb[4], qb[5]); o.w = pk2(qb[6], qb[7]); *(LAS u32x4*)(lds + P3_Q + r * 272 + 128 + cb * 16) = o;
        o.x = pk2(ka[0], ka[1]); o.y = pk2(ka[2], ka[3]); o.z = pk2(ka[4], ka[5]); o.w = pk2(ka[6], ka[7]); *(LAS u32x4*)(lds + P3_K + r * 272 + cb * 16) = o;
        o.x = pk2(kb[0], kb[1]); o.y = pk2(kb[2], kb[3]); o.z = pk2(kb[4], kb[5]); o.w = pk2(kb[6], kb[7]); *(LAS u32x4*)(lds + P3_K + r * 272 + 128 + cb * 16) = o;
        const float qd = __expf(lg * (float)(r + 1));
        bf16_t* q0 = qgG + r * 128 + (cb >> 1) * 16 + 4 * (cb & 1);
        u32x2 w2;
        w2.x = pk2(qa[0] * qd, qa[1] * qd); w2.y = pk2(qa[2] * qd, qa[3] * qd); *(u32x2*)(q0) = w2;
        w2.x = pk2(qa[4] * qd, qa[5] * qd); w2.y = pk2(qa[6] * qd, qa[7] * qd); *(u32x2*)(q0 + 8) = w2;
        w2.x = pk2(qb[0] * qd, qb[1] * qd); w2.y = pk2(qb[2] * qd, qb[3] * qd); *(u32x2*)(q0 + 64) = w2;
        w2.x = pk2(qb[4] * qd, qb[5] * qd); w2.y = pk2(qb[6] * qd, qb[7] * qd); *(u32x2*)(q0 + 64 + 8) = w2;
    }
    }
    __syncthreads();
#pragma unroll
    for (int i = 0; i < 4; ++i) {
        const int ti = wave * 4 + i, mt = ti >> 2, nt = ti & 3;
        const LAS unsigned char* Ab = lds + P3_Q + (16 * mt + (lane & 15)) * 272 + (lane >> 4) * 16;
        const LAS unsigned char* Bb = lds + P3_K + (16 * nt + (lane & 15)) * 272 + (lane >> 4) * 16;
        f32x4 acc = {0.f, 0.f, 0.f, 0.f};
#pragma unroll
        for (int s = 0; s < 4; ++s) acc = __builtin_amdgcn_mfma_f32_16x16x32_bf16(*(const LAS bf16x8*)(Ab + s * 64), *(const LAS bf16x8*)(Bb + s * 64), acc, 0, 0, 0);
        const int jj = 16 * nt + (lane & 15);
#pragma unroll
        for (int j = 0; j < 4; ++j) { const int ii = 16 * mt + (lane >> 4) * 4 + j; const int dd = ii > jj ? ii - jj : jj - ii;
            atG[ii * 64 + (jj & ~15) + pinv16(jj & 15)] = f2bf(acc[j] * __expf(lg * (float)dd)); }
    }
    {
        const LAS unsigned short* Kb = (const LAS unsigned short*)(lds + P3_K);
#pragma unroll
        for (int i = 0; i < 4; ++i) {
            const int idx = tid + 256 * i, dk = idx >> 3, ch = idx & 7, cb0 = (ch >> 1) * 16 + (ch & 1) * 4;
            float v[8];
#pragma unroll
            for (int e = 0; e < 8; ++e) { const int c = cb0 + (e & 3) + (e >> 2) * 8; v[e] = bf2f(Kb[c * 136 + dk]) * __expf(lg * (float)(63 - c)); }
            u32x4 o; o.x = pk2(v[0], v[1]); o.y = pk2(v[2], v[3]); o.z = pk2(v[4], v[5]); o.w = pk2(v[6], v[7]);
            *(u32x4*)(kdT + dk * 64 + ch * 8) = o;
        }
    }
#pragma unroll 1
    for (int ps = 0; ps < 2; ++ps) {
        const int dk = tid & 127, cblk = (tid >> 7) + 2 * ps;
        const LAS unsigned short* Vp = (const LAS unsigned short*)(lds + P3_V) + dk;
        unsigned short vv[16];
#pragma unroll
        for (int d = 0; d < 16; ++d) vv[d] = Vp[(cblk * 16 + d) * 136];
        u32x4 o0, o1;
        o0.x = vv[0] | ((unsigned)vv[1] << 16); o0.y = vv[2] | ((unsigned)vv[3] << 16); o0.z = vv[4] | ((unsigned)vv[5] << 16); o0.w = vv[6] | ((unsigned)vv[7] << 16);
        o1.x = vv[8] | ((unsigned)vv[9] << 16); o1.y = vv[10] | ((unsigned)vv[11] << 16); o1.z = vv[12] | ((unsigned)vv[13] << 16); o1.w = vv[14] | ((unsigned)vv[15] << 16);
        { bf16_t* up = vT + ((dk >> 5) * 8 + cblk * 2) * 256 + (dk & 31) * 4;
          *(u32x2*)up = (u32x2){o0.x, o0.y}; *(u32x2*)(up + 128) = (u32x2){o0.z, o0.w}; *(u32x2*)(up + 256) = (u32x2){o1.x, o1.y}; *(u32x2*)(up + 256 + 128) = (u32x2){o1.z, o1.w}; }
    }
}

DI void p3_phase(const Args& a, LAS unsigned char* lds, int wv) {
    { const int hh = (blockIdx.x >> 1) & 3, tid = wv * 64 + lane_id();
      LAS float* cwl = (LAS float*)(lds + P3_CW);
      for (int i = tid; i < 1536; i += 512) { const int mtx = i >> 9, w = (i >> 7) & 3, ch = i & 127; cwl[i] = a.conv_w[(size_t)w * 1536 + mtx * 512 + hh * 128 + ch]; }
      __syncthreads(); }
    for (int it = blockIdx.x; it < 4096; it += 2 * gridDim.x) {
        const int it2 = it + gridDim.x;
        const int typeA = (it & 1) ^ ((it >> 8) & 1);
        const int itg = typeA ? it : it2, itr = typeA ? it2 : it;
        const int chg = itg >> 1, chr = itr >> 1;
        p3_pair_item(a, lds, chg >> 8, (chg >> 2) & 63, chg & 3, chr >> 8, (chr >> 2) & 63, chr & 3, wv);
    }
}

constexpr int ST_BYTES = 62464, ST_W = 0, ST_QG = 17408, ST_KD = 34816, ST_AT = 53248;
DI bf16x8 pack8(const f32x16& x, int base) {
    u32x4 p; p.x = pk2(x[base + 0], x[base + 1]); p.y = pk2(x[base + 2], x[base + 3]); p.z = pk2(x[base + 4], x[base + 5]); p.w = pk2(x[base + 6], x[base + 7]);
    return __builtin_bit_cast(bf16x8, p);
}
#define MFMA32(a, b, c) __builtin_amdgcn_mfma_f32_32x32x16_bf16((a), (b), (c), 0, 0, 0)
#define SCAN_BAR() do { asm volatile("s_waitcnt lgkmcnt(0)" ::: "memory"); __builtin_amdgcn_s_barrier(); asm volatile("" ::: "memory"); } while (0)
#define SBAR __builtin_amdgcn_sched_barrier(0)
template <int type>
DI void scan_compute(const Args& a, LAS unsigned char* lds, const unsigned char* rec0, size_t rstride, bf16_t* O, int wave, int bh, int b, int h) {
            int lane_ = lane_id(); asm volatile("" : "+v"(lane_));
            const int r = lane_ & 31, hh = lane_ >> 5;
            const float* glast = (const float*)(a.ws + WS_GLAST) + bh * 64;
            const float rdec = __expf(64.f * log1pf(-exp2f(-5.f - (float)h)));
            const float edec = type ? __expf(glast[lane_]) : 1.f;
            const int ncol = 32 * wave + r;
            const int colbase = (type == 0 ? 0 : 512) + h * 128;
            u32x2 uc[2][4];
            f32x16 S[4];
#pragma unroll
            for (int mt = 0; mt < 4; ++mt)
#pragma unroll
                for (int i = 0; i < 16; ++i) S[mt][i] = 0.f;
#define SCAN_ULOAD(nn) do { const bf16_t* up = (const bf16_t*)(rec0 + (size_t)(nn) * rstride) + wave * 2048 + hh * 128 + r * 4;        \
                _Pragma("unroll") for (int mt = 0; mt < 2; ++mt) _Pragma("unroll") for (int g = 0; g < 4; ++g) uc[mt][g] = *(const u32x2*)(up + (mt * 4 + g) * 256); } while (0)
            SCAN_ULOAD(0);
            SCAN_BAR();
#define FR(p) (*(const LAS bf16x8*)(p))
#define LOAD_W(F, s)  do { F[0] = FR(pW + (s) * 32); F[1] = FR(pW + 32 * 272 + (s) * 32); F[2] = FR(pW + ((s) + 1) * 32); F[3] = FR(pW + 32 * 272 + ((s) + 1) * 32); } while (0)
#define LOAD_Q(F, s)  do { F[0] = FR(pQ + (s) * 32); F[1] = FR(pQ + 32 * 272 + (s) * 32); F[2] = FR(pQ + ((s) + 1) * 32); F[3] = FR(pQ + 32 * 272 + ((s) + 1) * 32); } while (0)
#define LOAD_T(F, s)  do { F[0] = FR(pT + (s) * 32); F[1] = FR(pT + 32 * 144 + (s) * 32); F[2] = FR(pT + ((s) + 1) * 32); F[3] = FR(pT + 32 * 144 + ((s) + 1) * 32); } while (0)
#define LOAD_K(F, s)  do { F[0] = FR(pK + (s) * 32); F[1] = FR(pK + 32 * 144 + (s) * 32); F[2] = FR(pK + 64 * 144 + (s) * 32); F[3] = FR(pK + 96 * 144 + (s) * 32); } while (0)
#define COMP_W(F, s)  do { acc0 = MFMA32(F[0], Sb[s], acc0); acc1 = MFMA32(F[1], Sb[s], acc1); acc0 = MFMA32(F[2], Sb[(s) + 1], acc0); acc1 = MFMA32(F[3], Sb[(s) + 1], acc1); } while (0)
#define COMP_Q(F, s)  do { o0 = MFMA32(F[0], Sb[s], o0); o1 = MFMA32(F[1], Sb[s], o1); o0 = MFMA32(F[2], Sb[(s) + 1], o0); o1 = MFMA32(F[3], Sb[(s) + 1], o1); } while (0)
#define COMP_T(F, s)  do { o0 = MFMA32(F[0], vb[s], o0); o1 = MFMA32(F[1], vb[s], o1); o0 = MFMA32(F[2], vb[(s) + 1], o0); o1 = MFMA32(F[3], vb[(s) + 1], o1); } while (0)
#define COMP_K(F, s)  do { S[0] = MFMA32(F[0], vb[s], S[0]); S[1] = MFMA32(F[1], vb[s], S[1]); S[2] = MFMA32(F[2], vb[s], S[2]); S[3] = MFMA32(F[3], vb[s], S[3]); } while (0)
#pragma unroll 1
            for (int n = 0; n < 64; ++n) {
                const LAS unsigned char* sb = lds + (n & 1) * ST_BYTES;
                const LAS unsigned char* pW = sb + ST_W + r * 272 + hh * 16;
                const LAS unsigned char* pQ = sb + ST_QG + r * 272 + hh * 16;
                const LAS unsigned char* pT = sb + ST_AT + r * 144 + hh * 16;
                const LAS unsigned char* pK = sb + ST_KD + r * 144 + hh * 16;
                const float dec = type ? __builtin_bit_cast(float, __builtin_amdgcn_readlane(__builtin_bit_cast(int, edec), n)) : rdec;
                bf16x8 vb[4], fa[4], fb[4];
                f32x16 acc0, acc1, o0, o1;
#pragma unroll
                for (int i = 0; i < 16; ++i) { acc0[i] = 0.f; acc1[i] = 0.f; o0[i] = 0.f; o1[i] = 0.f; }
#define SBF(s) pack8(S[(s) >> 1], ((s) & 1) * 8)
#define LOAD_WQ(F, s) do { if constexpr (type != 0) { F[0] = FR(pW + (s) * 32); F[1] = FR(pW + 32 * 272 + (s) * 32); } F[2] = FR(pQ + (s) * 32); F[3] = FR(pQ + 32 * 272 + (s) * 32); } while (0)
#define COMP_WQ(F, s) do { const bf16x8 sbs = SBF(s); if constexpr (type != 0) { acc0 = MFMA32(F[0], sbs, acc0); acc1 = MFMA32(F[1], sbs, acc1); } o0 = MFMA32(F[2], sbs, o0); o1 = MFMA32(F[3], sbs, o1); } while (0)
                LOAD_WQ(fa, 0);
                LOAD_WQ(fb, 1); SBAR; COMP_WQ(fa, 0); SBAR;
                LOAD_WQ(fa, 2); SBAR; COMP_WQ(fb, 1); SBAR;
                LOAD_WQ(fb, 3); SBAR; COMP_WQ(fa, 2); SBAR;
                LOAD_WQ(fa, 4); SBAR; COMP_WQ(fb, 3); SBAR;
                LOAD_WQ(fb, 5); SBAR; COMP_WQ(fa, 4); SBAR;
                LOAD_WQ(fa, 6); SBAR; COMP_WQ(fb, 5); SBAR;
                LOAD_WQ(fb, 7); SBAR; COMP_WQ(fa, 6); SBAR;
                LOAD_T(fa, 0); SBAR; COMP_WQ(fb, 7); SBAR;
                {
#pragma unroll
                    for (int g = 0; g < 4; ++g) {
                        acc0[4 * g + 0] = bflo(uc[0][g].x) - acc0[4 * g + 0]; acc0[4 * g + 1] = bfhi(uc[0][g].x) - acc0[4 * g + 1];
                        acc0[4 * g + 2] = bflo(uc[0][g].y) - acc0[4 * g + 2]; acc0[4 * g + 3] = bfhi(uc[0][g].y) - acc0[4 * g + 3];
                        acc1[4 * g + 0] = bflo(uc[1][g].x) - acc1[4 * g + 0]; acc1[4 * g + 1] = bfhi(uc[1][g].x) - acc1[4 * g + 1];
                        acc1[4 * g + 2] = bflo(uc[1][g].y) - acc1[4 * g + 2]; acc1[4 * g + 3] = bfhi(uc[1][g].y) - acc1[4 * g + 3]; }
                    vb[0] = pack8(acc0, 0); vb[1] = pack8(acc0, 8); vb[2] = pack8(acc1, 0); vb[3] = pack8(acc1, 8);
                }
                SBAR;
                SCAN_ULOAD(n + 1 < 64 ? n + 1 : 63);
                LOAD_T(fb, 2); SBAR; COMP_T(fa, 0); S[0] = S[0] * dec; S[1] = S[1] * dec; SBAR;
                LOAD_K(fa, 0); SBAR; COMP_T(fb, 2); S[2] = S[2] * dec; S[3] = S[3] * dec; SBAR;
                LOAD_K(fb, 1); SBAR; COMP_K(fa, 0); SBAR;
                LOAD_K(fa, 2); SBAR; COMP_K(fb, 1); SBAR;
                LOAD_K(fb, 3); SBAR; COMP_K(fa, 2); SBAR;
                COMP_K(fb, 3);
                SBAR;
                {
                    LAS unsigned char* og = lds + 2 * ST_BYTES + wave * 5120;
                    LAS unsigned short* ow = (LAS unsigned short*)(og + (4 * hh) * 80) + r;
                    unsigned pk[16];
#pragma unroll
                    for (int i = 0; i < 8; ++i) { pk[i] = pk2(o0[2 * i], o0[2 * i + 1]); pk[8 + i] = pk2(o1[2 * i], o1[2 * i + 1]); }
                    SBAR;
#pragma unroll
                    for (int i = 0; i < 8; ++i) {
                        ow[(((2 * i) & 3) + 8 * ((2 * i) >> 2)) * 40] = (unsigned short)(pk[i] & 0xffffu); ow[(((2 * i + 1) & 3) + 8 * ((2 * i + 1) >> 2)) * 40] = (unsigned short)(pk[i] >> 16);
                        ow[(32 + ((2 * i) & 3) + 8 * ((2 * i) >> 2)) * 40] = (unsigned short)(pk[8 + i] & 0xffffu); ow[(32 + ((2 * i + 1) & 3) + 8 * ((2 * i + 1) >> 2)) * 40] = (unsigned short)(pk[8 + i] >> 16); }
                    asm volatile("" ::: "memory");
                    char* ob = (char*)O + (size_t)(((b * SEQ + n * 64) * DM + colbase + 32 * wave) * 2);
                    const int lrow = (r >> 2) + 8 * hh, lpart = r & 3;
                    const unsigned lo = (unsigned)(lrow * (DM * 2) + lpart * 16);
                    const LAS unsigned char* orp = og + lrow * 80 + lpart * 16;
#pragma unroll
                    for (int k = 0; k < 4; ++k) *(u32x4*)(ob + (lo + (unsigned)(k * 16 * DM * 2))) = *(const LAS u32x4*)(orp + 16 * k * 80);
                }
                SCAN_BAR();
            }
#undef SCAN_ULOAD
#undef FR
#undef LOAD_W
#undef LOAD_Q
#undef LOAD_T
#undef LOAD_K
#undef COMP_W
#undef SBF
#undef LOAD_WQ
#undef COMP_WQ
#undef COMP_Q
#undef COMP_T
#undef COMP_K
}
DI u32x4 ld_async(const unsigned char* p) { u32x4 v; asm volatile("global_load_dwordx4 %0, %1, off" : "=v"(v) : "v"(p) : "memory"); return v; }
template <int type>
DI void scan_loader(LAS unsigned char* lds, const unsigned char* rec0, size_t rstride, int o_w, int o_qg, int o_kd, int o_at, int wv) {
    int t2_ = wv * 64 + lane_id() - 256; asm volatile("" : "+v"(t2_));
    const int t2 = t2_;
    u32x4 sgA[14], sgB[14];
#define LD_LOAD(dst, nn) do { const unsigned char* rec = rec0 + (size_t)((nn) < 64 ? (nn) : 63) * rstride; \
        _Pragma("unroll") for (int i = 0; i < 4; ++i) { if constexpr (type != 0) dst[i] = ld_async(rec + o_w + (t2 + 256 * i) * 16); \
            dst[4 + i] = ld_async(rec + o_qg + (t2 + 256 * i) * 16); dst[8 + i] = ld_async(rec + o_kd + (t2 + 256 * i) * 16); } \
        dst[12] = ld_async(rec + o_at + t2 * 16); dst[13] = ld_async(rec + o_at + (t2 + 256) * 16); } while (0)
#define LD_STORE(src, st) do { LAS unsigned char* sb = lds + (st) * ST_BYTES; \
        _Pragma("unroll") for (int i = 0; i < 4; ++i) { const int p = t2 + 256 * i; \
            if constexpr (type != 0) *(LAS u32x4*)(sb + ST_W + (p >> 4) * 272 + (p & 15) * 16) = src[i]; \
            *(LAS u32x4*)(sb + ST_QG + (p >> 4) * 272 + (p & 15) * 16) = src[4 + i]; \
            *(LAS u32x4*)(sb + ST_KD + (p >> 3) * 144 + (p & 7) * 16) = src[8 + i]; } \
        *(LAS u32x4*)(sb + ST_AT + (t2 >> 3) * 144 + (t2 & 7) * 16) = src[12]; \
        *(LAS u32x4*)(sb + ST_AT + ((t2 + 256) >> 3) * 144 + (t2 & 7) * 16) = src[13]; } while (0)
#define LD_WAIT_OLDER() do { if constexpr (type != 0) asm volatile("s_waitcnt vmcnt(14)" ::: "memory"); else asm volatile("s_waitcnt vmcnt(10)" ::: "memory"); } while (0)
    LD_LOAD(sgA, 0); asm volatile("s_waitcnt vmcnt(0)" ::: "memory"); LD_STORE(sgA, 0); LD_LOAD(sgB, 1); LD_LOAD(sgA, 2);
    SCAN_BAR();
#define LD_ITER(nn, BUF) do { LD_WAIT_OLDER(); if ((nn) + 1 < 64) LD_STORE(BUF, ((nn) + 1) & 1); LD_LOAD(BUF, (nn) + 3); SCAN_BAR(); } while (0)
#pragma unroll 1
    for (int n = 0; n < 64; n += 2) { LD_ITER(n, sgB); LD_ITER(n + 1, sgA); }
    asm volatile("s_waitcnt vmcnt(0)" ::: "memory");
#undef LD_ITER
#undef LD_WAIT_OLDER
#undef LD_LOAD
#undef LD_STORE
}
DI void p_cvec(const Args& a, LAS unsigned char* lds, int wv, int part) {
    const int tid = wv * 64 + lane_id(), j = part * 512 + tid;
    LAS float* sh = (LAS float*)lds;
    const float* mod = (const float*)(a.ws + WS_MOD);
    for (int i = tid; i < 8192; i += 512) sh[i] = mod[(size_t)(i >> 10) * NMOD + 3072 + (i & 1023)];
    __syncthreads();
    float acc[8];
#pragma unroll
    for (int b = 0; b < 8; ++b) acc[b] = 0.f;
#pragma unroll 16
    for (int k = 0; k < 1024; ++k) { const float w = a.w_ff1[(size_t)k * DFF + j];
#pragma unroll
        for (int b = 0; b < 8; ++b) acc[b] += sh[b * 1024 + k] * w; }
#pragma unroll
    for (int b = 0; b < 8; ++b) ((float*)(a.ws + WS_CVEC))[b * DFF + j] = acc[b];
}
DI void scan_phase(const Args& a, LAS unsigned char* lds, int wv) {
    const int wave = wv;
    bf16_t* O = (bf16_t*)(a.ws + WS_ACT);
    const int item = blockIdx.x;
    if (item < 64) {
        const int type = item & 1, bh = item >> 1, b = bh >> 2, h = bh & 3;
        const unsigned char* rec0; size_t rstride; int o_w, o_qg, o_kd, o_at;
        if (type == 0) { rec0 = (const unsigned char*)a.out + (size_t)bh * 64 * RREC; rstride = RREC; o_w = 0; o_qg = 16384; o_kd = 32768; o_at = 49152; }
        else { rec0 = a.ws + WS_GREC + (size_t)bh * 64 * GREC; rstride = GREC; o_w = 16384; o_qg = 32768; o_kd = 49152; o_at = 65536; }
        if (wave >= 4) {
            if (type) scan_loader<1>(lds, rec0, rstride, o_w, o_qg, o_kd, o_at, wv); else scan_loader<0>(lds, rec0, rstride, o_w, o_qg, o_kd, o_at, wv);
        } else {
            __builtin_amdgcn_s_setprio(3);
            if (type) scan_compute<1>(a, lds, rec0, rstride, O, wave, bh, b, h); else scan_compute<0>(a, lds, rec0, rstride, O, wave, bh, b, h);
            __builtin_amdgcn_s_setprio(0);
        }
    } else if (item < 72) {
        p_cvec(a, lds, wv, item - 64);
    }
#undef SCAN_BAR
#undef SBAR
}

DI void p5_phase(const Args& a, int wv) {
    const int lane = lane_id(), wave = wv;
    bf16_t* O = (bf16_t*)(a.ws + WS_ACT); const bf16_t* proj = (const bf16_t*)(a.ws + WS_PROJ);
    const int gw = blockIdx.x * 8 + wave, NGW = gridDim.x * 8, col = lane * 16; const bool isret = lane < 32;
    const float* nwp = isret ? a.ret_norm_w + col : a.gdn_norm_w + (col & 127);
    float nw[16];
#pragma unroll
    for (int q = 0; q < 4; ++q) { const f32x4 t = *(const f32x4*)(nwp + 4 * q); nw[4 * q] = t.x; nw[4 * q + 1] = t.y; nw[4 * q + 2] = t.z; nw[4 * q + 3] = t.w; }
    const int gcol = isret ? 1536 + col : 3072 + col;
    for (int m = gw; m < MROWS; m += NGW) {
        bf16_t* op = O + (size_t)m * DM + col;
        const u32x4 o0 = *(const u32x4*)op, o1 = *(const u32x4*)(op + 8);
        const u32x4 g0 = *(const u32x4*)(proj + (size_t)m * NPROJ + gcol), g1 = *(const u32x4*)(proj + (size_t)m * NPROJ + gcol + 8);
        float v[16], g[16];
        v[0] = bflo(o0.x); v[1] = bfhi(o0.x); v[2] = bflo(o0.y); v[3] = bfhi(o0.y); v[4] = bflo(o0.z); v[5] = bfhi(o0.z); v[6] = bflo(o0.w); v[7] = bfhi(o0.w);
        v[8] = bflo(o1.x); v[9] = bfhi(o1.x); v[10] = bflo(o1.y); v[11] = bfhi(o1.y); v[12] = bflo(o1.z); v[13] = bfhi(o1.z); v[14] = bflo(o1.w); v[15] = bfhi(o1.w);
        g[0] = bflo(g0.x); g[1] = bfhi(g0.x); g[2] = bflo(g0.y); g[3] = bfhi(g0.y); g[4] = bflo(g0.z); g[5] = bfhi(g0.z); g[6] = bflo(g0.w); g[7] = bfhi(g0.w);
        g[8] = bflo(g1.x); g[9] = bfhi(g1.x); g[10] = bflo(g1.y); g[11] = bfhi(g1.y); g[12] = bflo(g1.z); g[13] = bfhi(g1.z); g[14] = bflo(g1.w); g[15] = bfhi(g1.w);
        float s = 0.f;
#pragma unroll
        for (int e = 0; e < 16; ++e) s += v[e];
        s = red8(s);
        const float mu = isret ? s * (1.f / 128.f) : 0.f;
        float ss = 0.f;
#pragma unroll
        for (int e = 0; e < 16; ++e) { v[e] -= mu; ss += v[e] * v[e]; }
        ss = red8(ss);
        const float rstd = 1.0f / sqrtf(ss * (1.f / 128.f) + EPS);
        float y[16];
#pragma unroll
        for (int e = 0; e < 16; ++e) y[e] = v[e] * rstd * nw[e] * silu_f(g[e]);
        u32x4 w0, w1; w0.x = pk2(y[0], y[1]); w0.y = pk2(y[2], y[3]); w0.z = pk2(y[4], y[5]); w0.w = pk2(y[6], y[7]);
        w1.x = pk2(y[8], y[9]); w1.y = pk2(y[10], y[11]); w1.z = pk2(y[12], y[13]); w1.w = pk2(y[14], y[15]);
        *(u32x4*)op = w0; *(u32x4*)(op + 8) = w1;
    }
}

DI void final_norm_phase(const Args& a, int wv) {
    const int lane = lane_id(), wave = wv;
    const int gw = blockIdx.x * 8 + wave, NGW = gridDim.x * 8, c0 = lane * 16;
    const bf16_t* X = (const bf16_t*)(a.ws + WS_X1);
    f32x4 nwv[4];
#pragma unroll
    for (int q = 0; q < 4; ++q) nwv[q] = *(const f32x4*)(a.norm_final_w + c0 + 4 * q);
    for (int m0 = gw; m0 < MROWS; m0 += 2 * NGW) {
        u32x4 raw[2][2];
#pragma unroll
        for (int rr = 0; rr < 2; ++rr) { const int m = m0 + rr * NGW < MROWS ? m0 + rr * NGW : m0;
            raw[rr][0] = *(const u32x4*)(X + (size_t)m * DM + c0); raw[rr][1] = *(const u32x4*)(X + (size_t)m * DM + c0 + 8); }
#pragma unroll
        for (int rr = 0; rr < 2; ++rr) {
            const int m = m0 + rr * NGW;
            if (m < MROWS) {
                f32x4 v[4];
                v[0] = (f32x4){bflo(raw[rr][0].x), bfhi(raw[rr][0].x), bflo(raw[rr][0].y), bfhi(raw[rr][0].y)};
                v[1] = (f32x4){bflo(raw[rr][0].z), bfhi(raw[rr][0].z), bflo(raw[rr][0].w), bfhi(raw[rr][0].w)};
                v[2] = (f32x4){bflo(raw[rr][1].x), bfhi(raw[rr][1].x), bflo(raw[rr][1].y), bfhi(raw[rr][1].y)};
                v[3] = (f32x4){bflo(raw[rr][1].z), bfhi(raw[rr][1].z), bflo(raw[rr][1].w), bfhi(raw[rr][1].w)};
                float ss = 0.f;
#pragma unroll
                for (int q = 0; q < 4; ++q) ss += (v[q].x * v[q].x + v[q].y * v[q].y) + (v[q].z * v[q].z + v[q].w * v[q].w);
                ss = wave_sum(ss);
                const float rstd = 1.0f / sqrtf(ss * (1.f / DM) + EPS);
                float* xr = a.out + (size_t)m * DM + c0;
#pragma unroll
                for (int q = 0; q < 4; ++q) *(f32x4*)(xr + 4 * q) = v[q] * rstd * nwv[q];
            }
        }
    }
}

#define XB_TMO      128
#define XB_XCNT(j)  (256  + 64 * (j))
#define XB_XSUB(j)  (1280 + 64 * (j))
#define XB_XGEN(j)  (2304 + 64 * (j))
#define XB_TOP      3328
#define XB_TOPGEN   3392
#define XCD_BAR_WORDS 3456
#define XB_SPIN_CAP (1u << 18)
DI unsigned xb_ld(unsigned* p)              { return __hip_atomic_load(p, __ATOMIC_RELAXED, __HIP_MEMORY_SCOPE_AGENT); }
DI unsigned xb_add(unsigned* p, unsigned v) { return __hip_atomic_fetch_add(p, v, __ATOMIC_RELAXED, __HIP_MEMORY_SCOPE_AGENT); }
DI unsigned xb_xcc_id() { return (unsigned)__builtin_amdgcn_s_getreg((3 << 11) | 20) & 0xFu; }
#define XB_SPIN(cond, bar) do { unsigned _sp = 0; while (cond) { __builtin_amdgcn_s_sleep(1); \
    if ((++_sp & 255u) == 0u) { if (xb_ld(&(bar)[XB_TMO])) break; if (_sp > XB_SPIN_CAP) { atomicAdd(&(bar)[XB_TMO], 1u); break; } } } } while (0)
struct XcdBarrier { unsigned* bar; unsigned x; volatile LAS unsigned* st; };
DI XcdBarrier xcd_barrier_post(unsigned* bar, volatile LAS unsigned* st, int wv) {
    XcdBarrier b; b.bar = bar; b.x = xb_xcc_id(); b.st = st;
    if (wv == 0 && lane_id() == 0) (void)xb_add(&bar[XB_XCNT(b.x)], 1u);
    return b;
}
DI void xcd_barrier_complete(unsigned* bar, unsigned x, unsigned& nloc, unsigned& nx) {
    const unsigned G = gridDim.x * gridDim.y * gridDim.z;
    unsigned sum, cnt, mine, sp = 0u;
    for (;;) {
        sum = 0u; cnt = 0u; mine = 0u;
#pragma unroll
        for (unsigned j = 0; j < 16; ++j) { const unsigned c = xb_ld(&bar[XB_XCNT(j)]); sum += c; cnt += (c > 0u) ? 1u : 0u; mine = (j == x) ? c : mine; }
        if (sum == G) break;
        __builtin_amdgcn_s_sleep(1);
        if ((++sp & 255u) == 0u) { if (xb_ld(&bar[XB_TMO])) break; if (sp > XB_SPIN_CAP) { atomicAdd(&bar[XB_TMO], 1u); break; } }
    }
    nloc = mine > 0u ? mine : 1u; nx = cnt > 0u ? cnt : 1u;
}
DI void xcd_barrier(const XcdBarrier& b, int wv) {
    asm volatile("s_waitcnt vmcnt(0)" ::: "memory");
    __syncthreads();
    if (wv == 0 && lane_id() == 0) {
        unsigned* bar = b.bar;
        __builtin_amdgcn_s_waitcnt(0);
        unsigned nloc = b.st[0], nx = b.st[1];
        if (nloc == 0u) { xcd_barrier_complete(bar, b.x, nloc, nx); b.st[0] = nloc; b.st[1] = nx; }
        const unsigned old = xb_add(&bar[XB_XSUB(b.x)], 1u);
        const unsigned gen = old / nloc;
        if (old + 1u == (gen + 1u) * nloc) {
            __builtin_amdgcn_fence(__ATOMIC_RELEASE, "agent");
            asm volatile("s_waitcnt vmcnt(0)" ::: "memory");
            const unsigned og = xb_add(&bar[XB_TOP], 1u);
            const unsigned tg = og / nx;
            if (og + 1u == (tg + 1u) * nx) xb_add(&bar[XB_TOPGEN], 1u);
            else XB_SPIN(xb_ld(&bar[XB_TOPGEN]) == tg, bar);
            __builtin_amdgcn_fence(__ATOMIC_ACQUIRE, "agent");
            xb_add(&bar[XB_XGEN(b.x)], 1u);
            asm volatile("s_waitcnt vmcnt(0)" ::: "memory");
        } else {
            XB_SPIN(xb_ld(&bar[XB_XGEN(b.x)]) == gen, bar);
            __builtin_amdgcn_fence(__ATOMIC_ACQUIRE, "agent");
            asm volatile("s_waitcnt vmcnt(0)" ::: "memory");
        }
    }
    __syncthreads();
}

constexpr int N_PHASES = 11;
__global__ void __launch_bounds__(512, 2) fwd_megakernel(Args a) {
    extern __shared__ __attribute__((aligned(16))) unsigned char lds_raw[];
    LAS unsigned char* lds = (LAS unsigned char*)lds_raw;
    cg::grid_group grid = cg::this_grid();
    volatile LAS unsigned* bst = (volatile LAS unsigned*)(lds + 147200);
    const int wv = __builtin_amdgcn_readfirstlane(threadIdx.x >> 6);
    if (wv == 0 && lane_id() < 2) bst[lane_id()] = 0u;
    __syncthreads();
    const XcdBarrier bar = xcd_barrier_post((unsigned*)(a.ws + WS_BAR), bst, wv);
    if (a.ph_lo < 0) grid.sync();
    const float* mod = (const float*)(a.ws + WS_MOD);
    bf16_t* act = (bf16_t*)(a.ws + WS_ACT);
    bf16_t* proj = (bf16_t*)(a.ws + WS_PROJ);
    const int G = gridDim.x;
#define IN(k) (a.ph_lo <= (k) && (k) < a.ph_hi)
#define SEAM(k) do { if (IN(k) && IN((k) + 1)) xcd_barrier(bar, wv); } while (0)
    if (IN(0)) { p0_phase(a, lds, wv); } SEAM(0);
    if (IN(1)) { norm_mod_phase<true>(a.x, a.norm_mix_w, mod, 0, 1024, act, a.w_in, (float*)(a.ws + WS_GAB), lds, wv); } SEAM(1);
    if (IN(2)) { pg8::Gemm g{act, (const bf16_t*)(a.ws + WS_WIN), MROWS, NPROJ, DM}; pg8::StaticOrder S; S.init(MROWS, NPROJ, G, (int)blockIdx.x);
        pg8::EpiBf16<0> E{proj, NPROJ}; pg8::gemm_phase<pg8::EpiBf16<0>, pg8::StaticOrder, true, true>(lds, g, S, E, wv); } SEAM(2);
    if (IN(3)) { p3_phase(a, lds, wv); } SEAM(3);
    if (IN(4)) { scan_phase(a, lds, wv); } SEAM(4);
    if (IN(5)) { p5_phase(a, wv); } SEAM(5);
    if (IN(6)) { pg8::Gemm g{act, (const bf16_t*)(a.ws + WS_WOUT), MROWS, DM, DM}; pg8::StaticOrder S; S.init(MROWS, DM, G, (int)blockIdx.x);
        pg8::EpiResGateNorm E{a.x, (bf16_t*)(a.ws + WS_X1), mod + 2048, a.norm_mlp_w, mod + 4096, (bf16_t*)(a.ws + WS_ACT2), (float*)(a.ws + WS_SUMSQ)}; pg8::gemm_phase<pg8::EpiResGateNorm, pg8::StaticOrder, true, true>(lds, g, S, E, wv); } SEAM(6);
    if (IN(8)) { pg8::Gemm g{(const bf16_t*)(a.ws + WS_ACT2), (const bf16_t*)(a.ws + WS_WFF1), MROWS, DFF, DM}; pg8::StaticOrder S; S.init(MROWS, DFF, G, (int)blockIdx.x);
        pg8::EpiFf1 E{proj, DFF, (const float*)(a.ws + WS_SUMSQ), (const float*)(a.ws + WS_CVEC)}; pg8::gemm_phase<pg8::EpiFf1, pg8::StaticOrder, true, true>(lds, g, S, E, wv); } SEAM(8);
    if (IN(9)) { pg8::Gemm g{proj, (const bf16_t*)(a.ws + WS_WFF2), MROWS, DM, DFF}; pg8::StaticOrder S; S.init(MROWS, DM, G, (int)blockIdx.x);
        pg8::EpiResGateBf E{(bf16_t*)(a.ws + WS_X1), mod + 5120}; pg8::gemm_phase<pg8::EpiResGateBf, pg8::StaticOrder, true, true>(lds, g, S, E, wv); } SEAM(9);
    if (IN(10)) { final_norm_phase(a, wv); }
#undef IN
#undef SEAM
}

extern "C" void kernel_launch(void* const* d_in, const int* in_sizes, int n_in, void* d_out, int out_size, void* d_ws, size_t ws_size, hipStream_t stream) {
    static int grid = 0;
    if (grid == 0) {
        if (n_in != 16 || out_size != MROWS * DM || ws_size < WS_END) { fprintf(stderr, "kernel_launch: unexpected shapes (n_in %d out %d ws %zu)\n", n_in, out_size, ws_size); grid = -1; return; }
        int dev = 0, cus = 0, per_cu = 0;
        hipGetDevice(&dev); hipDeviceGetAttribute(&cus, hipDeviceAttributeMultiprocessorCount, dev);
        if (hipFuncSetAttribute((const void*)fwd_megakernel, hipFuncAttributeMaxDynamicSharedMemorySize, LDS_BYTES) != hipSuccess) { fprintf(stderr, "kernel_launch: hipFuncSetAttribute failed\n"); grid = -1; return; }
        if (hipOccupancyMaxActiveBlocksPerMultiprocessor(&per_cu, (const void*)fwd_megakernel, 512, LDS_BYTES) != hipSuccess || per_cu < 1) { fprintf(stderr, "kernel_launch: occupancy query says %d\n", per_cu); per_cu = 1; }
        (void)hipGetLastError();
        grid = cus * per_cu;
        if (grid > 256) grid = 256;
        if (grid != 256) { fprintf(stderr, "kernel_launch: this build needs a 256-workgroup grid, got %d\n", grid); grid = -1; return; }
    }
    if (grid < 0) return;
    Args a{};
    a.x = (const float*)d_in[0]; a.c = (const float*)d_in[1]; a.ada_w = (const float*)d_in[2]; a.ada_b = (const float*)d_in[3]; a.norm_mix_w = (const float*)d_in[4]; a.w_in = (const float*)d_in[5];
    a.conv_w = (const float*)d_in[6]; a.a_log = (const float*)d_in[7]; a.dt_bias = (const float*)d_in[8]; a.ret_norm_w = (const float*)d_in[9]; a.gdn_norm_w = (const float*)d_in[10];
    a.w_out = (const float*)d_in[11]; a.norm_mlp_w = (const float*)d_in[12]; a.w_ff1 = (const float*)d_in[13]; a.w_ff2 = (const float*)d_in[14]; a.norm_final_w = (const float*)d_in[15];
    a.out = (float*)d_out; a.ws = (unsigned char*)d_ws;
    if (hipMemsetAsync((char*)d_ws + WS_BAR, 0, XCD_BAR_WORDS * 4, stream) != hipSuccess) { fprintf(stderr, "kernel_launch: memset of barrier words failed\n"); return; }
#if MK_N_LAUNCHES == 1
    a.ph_lo = 0; a.ph_hi = N_PHASES;
    void* args[] = {&a};
    hipError_t e = hipLaunchCooperativeKernel((const void*)fwd_megakernel, dim3(grid), dim3(512), args, LDS_BYTES, stream);
    if (e != hipSuccess) fprintf(stderr, "cooperative launch failed: %s (grid %d)\n", hipGetErrorString(e), grid);
#else
    for (int p = 0; p < N_PHASES; ++p) { a.ph_lo = p; a.ph_hi = p + 1; hipLaunchKernelGGL(fwd_megakernel, dim3(grid), dim3(512), LDS_BYTES, stream, a); }
#endif
}
```

```cpp
#include <hip/hip_runtime.h>
#include <hip/hip_cooperative_groups.h>
#include <cstdio>
#include <cstdint>
namespace cg = cooperative_groups;

#ifndef MK_N_LAUNCHES
#define MK_N_LAUNCHES 1
#endif

#define LAS __attribute__((address_space(3)))
typedef unsigned short bf16_t;
typedef short bf16x8 __attribute__((ext_vector_type(8)));
typedef float f32x4 __attribute__((ext_vector_type(4)));
typedef float f32x16 __attribute__((ext_vector_type(16)));
typedef unsigned u32x4 __attribute__((ext_vector_type(4)));
typedef unsigned u32x2 __attribute__((ext_vector_type(2)));
typedef float f32x2_t __attribute__((ext_vector_type(2)));
typedef __bf16 bf16x2_t __attribute__((ext_vector_type(2)));

#define DI __device__ __forceinline__

DI unsigned pk2(float lo, float hi) { f32x2_t v = {lo, hi}; bf16x2_t b = __builtin_convertvector(v, bf16x2_t); return __builtin_bit_cast(unsigned, b); }
DI unsigned short f2bf(float x) { return (unsigned short)(pk2(x, 0.f) & 0xffffu); }
DI float bf2f(unsigned short u) { return __builtin_bit_cast(float, ((unsigned)u) << 16); }
DI float bflo(unsigned u) { return __builtin_bit_cast(float, u << 16); }
DI float bfhi(unsigned u) { return __builtin_bit_cast(float, u & 0xffff0000u); }
DI float wave_sum(float v) {
#pragma unroll
    for (int o = 1; o < 64; o <<= 1) v += __shfl_xor(v, o);
    return v;
}
DI float silu_f(float v) { return v / (1.f + __expf(-v)); }
DI int lane_id() { return (int)__builtin_amdgcn_mbcnt_hi(~0u, __builtin_amdgcn_mbcnt_lo(~0u, 0u)); }

constexpr int BATCH = 8, SEQ = 4096, DM = 1024, MROWS = BATCH * SEQ, DFF = 4096, NPROJ = 4096, DIN = 4104, NMOD = 6144;
constexpr float EPS = 1e-6f;
constexpr size_t MiB = 1u << 20;
constexpr size_t WS_WIN = 0, WS_WOUT = 8 * MiB, WS_WFF1 = 10 * MiB, WS_WFF2 = 18 * MiB, WS_MOD = 26 * MiB, WS_GLAST = 26 * MiB + 256 * 1024, WS_CVEC = 26 * MiB + 512 * 1024, WS_SUMSQ = 26 * MiB + 768 * 1024, WS_GAB = 27 * MiB,
                 WS_ACT = 28 * MiB, WS_PROJ = 92 * MiB, WS_GREC = 348 * MiB, WS_BAR = 492 * MiB, WS_END = 493 * MiB;
constexpr size_t WS_X1 = WS_GREC + 64 * MiB;
constexpr size_t WS_ACT2 = WS_GREC;
constexpr int GREC = 73728, RREC = 57344;
constexpr int LDS_BYTES = 147456;

struct Args {
    const float* x; const float* c; const float* ada_w; const float* ada_b; const float* norm_mix_w; const float* w_in;
    const float* conv_w; const float* a_log; const float* dt_bias; const float* ret_norm_w; const float* gdn_norm_w;
    const float* w_out; const float* norm_mlp_w; const float* w_ff1; const float* w_ff2; const float* norm_final_w;
    float* out; unsigned char* ws; int ph_lo, ph_hi;
};

namespace pg8 {
constexpr int BM = 256, BK = 64, HALF = 128, HTB = HALF * BK * 2, STAGE_BYTES = 8 * HTB, NXCD = 8, WGM = 8;
__host__ __device__ __forceinline__ int lds_byte(int r, int c) { const int st = (r >> 4) * 2 + (c >> 5), rr = r & 15, cc = c & 31, ob = rr * 64 + cc * 2; return st * 1024 + (ob ^ (((ob >> 9) & 1) << 5)); }
__host__ __device__ __forceinline__ void stage_rc(int b, int& R, int& C) { const int st = b / 1024, sb = b % 1024, swz = sb ^ (((sb >> 9) & 1) << 5); R = (st >> 1) * 16 + swz / 64; C = (st & 1) * 32 + (swz % 64) / 2; }
__host__ __device__ __forceinline__ int perm32(int rho) { const int n = rho >> 4, i = rho & 15; return 8 * (i >> 2) + 4 * n + (i & 3); }

struct Unit { int pm, pn; };
struct Gemm { const bf16_t* A; const bf16_t* Bt; int M, N, K; };

struct StaticOrder {
    int nM, nN, nwg, G, c;
    __host__ __device__ void init(int M, int N, int G_, int c_) { nM = M / BM; nN = N / BM; nwg = nM * nN; G = G_; c = c_; }
    __host__ __device__ bool next(int i, Unit& u) const {
        const long L = (long)i * G + c; if (L >= nwg) return false;
        int wgid = (int)L; { const int q = nwg / NXCD, r = nwg % NXCD, xcd = wgid % NXCD, off = wgid / NXCD; wgid = (xcd < r ? xcd * (q + 1) : r * (q + 1) + (xcd - r) * q) + off; }
        const int nig = WGM * nN, gid = wgid / nig, fm = gid * WGM, gsz = (nM - fm) < WGM ? (nM - fm) : WGM;
        u.pm = fm + ((wgid % nig) % gsz); u.pn = (wgid % nig) / gsz; return true;
    }
    __device__ __forceinline__ void a_ready(const Unit&) const {}
    __device__ __forceinline__ void done(const Unit&) const {}
};

template <int ACT  > struct EpiBf16 {
    static constexpr bool PERM = true, AFTER_DRAIN = false;
    bf16_t* O; int ldc;
    __device__ __forceinline__ void operator()(const f32x4 (&acc)[2][2][4][2], const Unit& u, int wr, int wc, int fr, int fq) const {
        const int row0 = u.pm * BM + wr * 64 + fr; const int col0 = u.pn * BM + wc * 32 + 8 * fq;
#pragma unroll
        for (int ai = 0; ai < 2; ++ai)
#pragma unroll
            for (int m = 0; m < 4; ++m) { bf16_t* rowp = O + (size_t)(row0 + ai * HALF + m * 16) * ldc + col0;
#pragma unroll
                for (int bj = 0; bj < 2; ++bj) { f32x4 v0 = acc[ai][bj][m][0], v1 = acc[ai][bj][m][1];
                    if (ACT == 1) {
#pragma unroll
                        for (int e = 0; e < 4; ++e) { float a0 = fmaxf(v0[e], 0.f), a1 = fmaxf(v1[e], 0.f); v0[e] = a0 * a0; v1[e] = a1 * a1; } }
                    u32x4 w; w.x = pk2(v0[0], v0[1]); w.y = pk2(v0[2], v0[3]); w.z = pk2(v1[0], v1[1]); w.w = pk2(v1[2], v1[3]);
                    *(u32x4*)(rowp + bj * HALF) = w; } }
    }
};
struct EpiResGate {
    static constexpr bool PERM = true, AFTER_DRAIN = false;
    const float* res; float* out; const float* gate;
    __device__ __forceinline__ void operator()(const f32x4 (&acc)[2][2][4][2], const Unit& u, int wr, int wc, int fr, int fq) const {
        const int row0 = u.pm * BM + wr * 64 + fr; const int col0 = u.pn * BM + wc * 32 + 8 * fq;
        const float* g = gate + (size_t)(u.pm >> 4) * NMOD + col0;
        f32x4 gv[2][2];
#pragma unroll
        for (int bj = 0; bj < 2; ++bj) { gv[bj][0] = *(const f32x4*)(g + bj * HALF); gv[bj][1] = *(const f32x4*)(g + bj * HALF + 4); }
#pragma unroll
        for (int ai = 0; ai < 2; ++ai)
#pragma unroll
            for (int m = 0; m < 4; ++m) { const size_t p = (size_t)(row0 + ai * HALF + m * 16) * DM + col0;
#pragma unroll
                for (int bj = 0; bj < 2; ++bj) {
                    const f32x4 r0 = *(const f32x4*)(res + p + bj * HALF), r1 = *(const f32x4*)(res + p + bj * HALF + 4);
                    *(f32x4*)(out + p + bj * HALF) = r0 + gv[bj][0] * acc[ai][bj][m][0];
                    *(f32x4*)(out + p + bj * HALF + 4) = r1 + gv[bj][1] * acc[ai][bj][m][1]; } }
    }
};

struct EpiResGateNorm {
    static constexpr bool PERM = true, AFTER_DRAIN = false;
    const float* res; bf16_t* out; const float* gate; const float* nw; const float* scale; bf16_t* A2; float* sumsq;
    __device__ __forceinline__ void operator()(const f32x4 (&acc)[2][2][4][2], const Unit& u, int wr, int wc, int fr, int fq) const {
        const int row0 = u.pm * BM + wr * 64 + fr; const int col0 = u.pn * BM + wc * 32 + 8 * fq;
        const float* g = gate + (size_t)(u.pm >> 4) * NMOD + col0; const float* sc = scale + (size_t)(u.pm >> 4) * NMOD + col0;
        f32x4 gv[2][2], gm[2][2];
#pragma unroll
        for (int bj = 0; bj < 2; ++bj)
#pragma unroll
            for (int q = 0; q < 2; ++q) { gv[bj][q] = *(const f32x4*)(g + bj * HALF + 4 * q);
                gm[bj][q] = *(const f32x4*)(nw + col0 + bj * HALF + 4 * q) * (*(const f32x4*)(sc + bj * HALF + 4 * q) + 1.0f); }
#pragma unroll
        for (int ai = 0; ai < 2; ++ai)
#pragma unroll
            for (int m = 0; m < 4; ++m) { const int row = row0 + ai * HALF + m * 16; const size_t p = (size_t)row * DM + col0; float ss = 0.f;
#pragma unroll
                for (int bj = 0; bj < 2; ++bj) {
                    const f32x4 x0 = *(const f32x4*)(res + p + bj * HALF) + gv[bj][0] * acc[ai][bj][m][0], x1 = *(const f32x4*)(res + p + bj * HALF + 4) + gv[bj][1] * acc[ai][bj][m][1];
                    { u32x4 xw; xw.x = pk2(x0.x, x0.y); xw.y = pk2(x0.z, x0.w); xw.z = pk2(x1.x, x1.y); xw.w = pk2(x1.z, x1.w); *(u32x4*)(out + p + bj * HALF) = xw; }
                    ss += (x0.x * x0.x + x0.y * x0.y) + (x0.z * x0.z + x0.w * x0.w) + (x1.x * x1.x + x1.y * x1.y) + (x1.z * x1.z + x1.w * x1.w);
                    const f32x4 a0 = x0 * gm[bj][0], a1 = x1 * gm[bj][1];
                    u32x4 w; w.x = pk2(a0.x, a0.y); w.y = pk2(a0.z, a0.w); w.z = pk2(a1.x, a1.y); w.w = pk2(a1.z, a1.w);
                    *(u32x4*)(A2 + p + bj * HALF) = w; }
                ss += __shfl_xor(ss, 16); ss += __shfl_xor(ss, 32);
                if (fq == 0) unsafeAtomicAdd(sumsq + row, ss); }
    }
};
struct EpiResGateBf {
    static constexpr bool PERM = true, AFTER_DRAIN = false;
    bf16_t* X; const float* gate;
    __device__ __forceinline__ void operator()(const f32x4 (&acc)[2][2][4][2], const Unit& u, int wr, int wc, int fr, int fq) const {
        const int row0 = u.pm * BM + wr * 64 + fr; const int col0 = u.pn * BM + wc * 32 + 8 * fq;
        const float* g = gate + (size_t)(u.pm >> 4) * NMOD + col0;
        f32x4 gv[2][2];
#pragma unroll
        for (int bj = 0; bj < 2; ++bj) { gv[bj][0] = *(const f32x4*)(g + bj * HALF); gv[bj][1] = *(const f32x4*)(g + bj * HALF + 4); }
#pragma unroll
        for (int ai = 0; ai < 2; ++ai)
#pragma unroll
            for (int m = 0; m < 4; ++m) { bf16_t* rp = X + (size_t)(row0 + ai * HALF + m * 16) * DM + col0;
#pragma unroll
                for (int bj = 0; bj < 2; ++bj) {
                    const u32x4 xr = *(const u32x4*)(rp + bj * HALF);
                    const f32x4 r0 = (f32x4){bflo(xr.x), bfhi(xr.x), bflo(xr.y), bfhi(xr.y)}, r1 = (f32x4){bflo(xr.z), bfhi(xr.z), bflo(xr.w), bfhi(xr.w)};
                    const f32x4 y0 = r0 + gv[bj][0] * acc[ai][bj][m][0], y1 = r1 + gv[bj][1] * acc[ai][bj][m][1];
                    u32x4 w; w.x = pk2(y0.x, y0.y); w.y = pk2(y0.z, y0.w); w.z = pk2(y1.x, y1.y); w.w = pk2(y1.z, y1.w);
                    *(u32x4*)(rp + bj * HALF) = w; } }
    }
};
struct EpiFf1 {
    static constexpr bool PERM = true, AFTER_DRAIN = false;
    bf16_t* O; int ldc; const float* sumsq; const float* cvec;
    __device__ __forceinline__ void operator()(const f32x4 (&acc)[2][2][4][2], const Unit& u, int wr, int wc, int fr, int fq) const {
        const int row0 = u.pm * BM + wr * 64 + fr; const int col0 = u.pn * BM + wc * 32 + 8 * fq;
        const float* cv = cvec + (size_t)(u.pm >> 4) * DFF + col0;
        f32x4 cq[2][2];
#pragma unroll
        for (int bj = 0; bj < 2; ++bj)
#pragma unroll
            for (int q = 0; q < 2; ++q) cq[bj][q] = *(const f32x4*)(cv + bj * HALF + 4 * q);
#pragma unroll
        for (int ai = 0; ai < 2; ++ai)
#pragma unroll
            for (int m = 0; m < 4; ++m) { const int row = row0 + ai * HALF + m * 16; bf16_t* rowp = O + (size_t)row * ldc + col0;
                const float rstd = 1.0f / sqrtf(sumsq[row] * (1.f / DM) + EPS);
#pragma unroll
                for (int bj = 0; bj < 2; ++bj) { f32x4 v0 = acc[ai][bj][m][0] * rstd + cq[bj][0], v1 = acc[ai][bj][m][1] * rstd + cq[bj][1];
#pragma unroll
                    for (int e = 0; e < 4; ++e) { const float a0 = fmaxf(v0[e], 0.f), a1 = fmaxf(v1[e], 0.f); v0[e] = a0 * a0; v1[e] = a1 * a1; }
                    u32x4 w; w.x = pk2(v0[0], v0[1]); w.y = pk2(v0[2], v0[3]); w.z = pk2(v1[0], v1[1]); w.w = pk2(v1[2], v1[3]);
                    *(u32x4*)(rowp + bj * HALF) = w; } }
    }
};

template <class Epi, class Sched, bool ALIGN_EPI = false, bool SP2 = false>
__device__ __forceinline__ void gemm_phase(LAS unsigned char* lds, const Gemm g, const Sched& S, const Epi& E, int wv) {
    const int wid = wv, lane = lane_id(), tid = wv * 64 + lane, wr = wid >> 2, wc = wid & 3, fr = lane & 15, fq = lane >> 4;
    const int K = g.K, nt = K / BK;
    unsigned voffA[2], voffB[2];
#pragma unroll
    for (int i = 0; i < 2; ++i) { int R, C; stage_rc(tid * 16 + i * 8192, R, C); const int Rb = Epi::PERM ? ((R & ~31) + perm32(R & 31)) : R;
        voffA[i] = (unsigned)(R * K + C) * 2u; voffB[i] = (unsigned)(Rb * K + C) * 2u; }
    const size_t kstep = (size_t)(BK * 2);
    const size_t hstep = (size_t)HALF * K * 2;
    const size_t tstep = 2 * hstep;
    const unsigned ldsw = (unsigned)wid * 1024u;
    const int aoff = lds_byte(wr * 64 + fr, fq * 8), boff = lds_byte(wc * 32 + fr, fq * 8);
#define PG8_SA(b, h) (((b) * 2 + (h)) * HTB)
#define PG8_SB(b, h) ((4 + (b) * 2 + (h)) * HTB)
#define PG8_STAGE(bufoff, gbase, voff) do { _Pragma("unroll") for (int _i = 0; _i < 2; ++_i) \
        __builtin_amdgcn_global_load_lds((const unsigned*)((const char*)(gbase) + (voff)[_i]), (LAS unsigned*)(lds + (bufoff) + ldsw + _i * 8192), 16, 0, 0); } while (0)
#define PG8_LDA(dst, b, h) do { _Pragma("unroll") for (int m = 0; m < 4; ++m) _Pragma("unroll") for (int k = 0; k < 2; ++k) dst[m][k] = *(const LAS bf16x8*)(lds + PG8_SA(b, h) + aoff + m * 2048 + k * 1024); } while (0)
#define PG8_LDB(dst, b, h) do { _Pragma("unroll") for (int n = 0; n < 2; ++n) _Pragma("unroll") for (int k = 0; k < 2; ++k) dst[n][k] = *(const LAS bf16x8*)(lds + PG8_SB(b, h) + boff + n * 2048 + k * 1024); } while (0)
#define PG8_MMA(ai, bj, At, Bt) do { __builtin_amdgcn_s_setprio(1); _Pragma("unroll") for (int m = 0; m < 4; ++m) _Pragma("unroll") for (int n = 0; n < 2; ++n) _Pragma("unroll") for (int k = 0; k < 2; ++k) \
        acc[ai][bj][m][n] = __builtin_amdgcn_mfma_f32_16x16x32_bf16(Bt[n][k], At[m][k], acc[ai][bj][m][n], 0, 0, 0); __builtin_amdgcn_s_setprio(0); } while (0)
#define PG8_WAIT_V(n) asm volatile("s_waitcnt vmcnt(" #n ")" ::: "memory")
#define PG8_WAIT_L(n) asm volatile("s_waitcnt lgkmcnt(" #n ")" ::: "memory")
#define PG8_BAR __builtin_amdgcn_s_barrier()
#define PG8_SCHED __builtin_amdgcn_sched_barrier(0)
    Unit cur, nxt; int ui = 0;
    if (!S.next(0, cur)) return;
    f32x4 acc[2][2][4][2];
#pragma unroll
    for (int a = 0; a < 2; ++a)
#pragma unroll
        for (int b = 0; b < 2; ++b)
#pragma unroll
            for (int m = 0; m < 4; ++m)
#pragma unroll
                for (int n = 0; n < 2; ++n) acc[a][b][m][n] = (f32x4){0.f, 0.f, 0.f, 0.f};
    bf16x8 At[4][2], B0[2][2], B1[2][2];
    const char* cA = (const char*)g.A + (size_t)cur.pm * tstep; const char* cB = (const char*)g.Bt + (size_t)cur.pn * tstep;
    S.a_ready(cur);
    if constexpr (SP2) {
        PG8_STAGE(PG8_SB(0, 0), cB, voffB); PG8_STAGE(PG8_SB(0, 1), cB + hstep, voffB); PG8_STAGE(PG8_SA(0, 0), cA, voffA); PG8_STAGE(PG8_SA(0, 1), cA + hstep, voffA);
        if (wr == 1) PG8_BAR;
        PG8_WAIT_V(2); PG8_BAR;
        PG8_STAGE(PG8_SB(1, 0), cB + kstep, voffB); PG8_STAGE(PG8_SA(1, 0), cA + kstep, voffA); PG8_STAGE(PG8_SB(1, 1), cB + hstep + kstep, voffB);
        PG8_WAIT_V(6); PG8_BAR;
    } else {
        PG8_STAGE(PG8_SB(0, 0), cB, voffB); PG8_STAGE(PG8_SA(0, 0), cA, voffA); PG8_STAGE(PG8_SB(0, 1), cB + hstep, voffB); PG8_STAGE(PG8_SA(0, 1), cA + hstep, voffA);
        if (wr == 1) PG8_BAR;
        PG8_WAIT_V(4); PG8_BAR;
        PG8_STAGE(PG8_SB(1, 0), cB + kstep, voffB); PG8_STAGE(PG8_SA(1, 0), cA + kstep, voffA); PG8_STAGE(PG8_SB(1, 1), cB + hstep + kstep, voffB);
        PG8_WAIT_V(6); PG8_BAR;
    }
    for (;;) {
        const bool has_next = S.next(ui + 1, nxt);
        const char* nA = has_next ? (const char*)g.A + (size_t)nxt.pm * tstep : cA; const char* nB = has_next ? (const char*)g.Bt + (size_t)nxt.pn * tstep : cB;
        for (int t = 0; t < nt; t += 2) {
            const bool last = (t == nt - 2);
            const char* a1 = cA + (size_t)(t + 1) * kstep;
            const char* a2 = last ? nA : cA + (size_t)(t + 2) * kstep; const char* b2 = last ? nB : cB + (size_t)(t + 2) * kstep;
            const char* a3 = a2 + kstep; const char* b3 = b2 + kstep;
            if (last && has_next) S.a_ready(nxt);
            if constexpr (SP2) {
            PG8_LDB(B0, 0, 0); PG8_LDB(B1, 0, 1); PG8_SCHED; PG8_LDA(At, 0, 0); PG8_STAGE(PG8_SA(1, 1), a1 + hstep, voffA);
            PG8_WAIT_V(8); PG8_WAIT_L(0); PG8_BAR; PG8_MMA(0, 0, At, B0); PG8_MMA(0, 1, At, B1); PG8_BAR; PG8_SCHED;
            PG8_LDA(At, 0, 1); PG8_STAGE(PG8_SB(0, 0), b2, voffB); PG8_STAGE(PG8_SB(0, 1), b2 + hstep, voffB); PG8_STAGE(PG8_SA(0, 0), a2, voffA);
            PG8_WAIT_V(8); PG8_WAIT_L(0); PG8_BAR; PG8_MMA(1, 0, At, B0); PG8_MMA(1, 1, At, B1); PG8_BAR; PG8_SCHED;
            PG8_LDB(B0, 1, 0); PG8_LDB(B1, 1, 1); PG8_SCHED; PG8_LDA(At, 1, 0); PG8_STAGE(PG8_SA(0, 1), a2 + hstep, voffA);
            PG8_WAIT_V(8); PG8_WAIT_L(0); PG8_BAR; PG8_MMA(0, 0, At, B0); PG8_MMA(0, 1, At, B1); PG8_BAR; PG8_SCHED;
            PG8_LDA(At, 1, 1); PG8_STAGE(PG8_SB(1, 0), b3, voffB); PG8_STAGE(PG8_SB(1, 1), b3 + hstep, voffB); PG8_STAGE(PG8_SA(1, 0), a3, voffA);
            PG8_WAIT_V(8); PG8_WAIT_L(0); PG8_BAR; PG8_MMA(1, 0, At, B0); PG8_MMA(1, 1, At, B1); PG8_BAR; PG8_SCHED;
            } else {
            PG8_LDB(B0, 0, 0); PG8_SCHED; PG8_LDA(At, 0, 0); PG8_STAGE(PG8_SA(1, 1), a1 + hstep, voffA);
            PG8_WAIT_L(8); PG8_BAR; PG8_WAIT_L(0); PG8_MMA(0, 0, At, B0); PG8_BAR; PG8_SCHED;
            PG8_LDB(B1, 0, 1); PG8_STAGE(PG8_SB(0, 0), b2, voffB);
            PG8_BAR; PG8_WAIT_L(0); PG8_MMA(0, 1, At, B1); PG8_BAR;
            PG8_LDA(At, 0, 1); PG8_STAGE(PG8_SA(0, 0), a2, voffA);
            PG8_BAR; PG8_WAIT_L(0); PG8_MMA(1, 0, At, B0); PG8_BAR; PG8_SCHED;
            PG8_STAGE(PG8_SB(0, 1), b2 + hstep, voffB);
            PG8_WAIT_V(6); PG8_BAR; PG8_MMA(1, 1, At, B1); PG8_BAR;
            PG8_LDB(B0, 1, 0); PG8_SCHED; PG8_LDA(At, 1, 0); PG8_STAGE(PG8_SA(0, 1), a2 + hstep, voffA);
            PG8_WAIT_L(8); PG8_BAR; PG8_WAIT_L(0); PG8_MMA(0, 0, At, B0); PG8_BAR; PG8_SCHED;
            PG8_LDB(B1, 1, 1); PG8_STAGE(PG8_SB(1, 0), b3, voffB);
            PG8_BAR; PG8_WAIT_L(0); PG8_MMA(0, 1, At, B1); PG8_BAR;
            PG8_LDA(At, 1, 1); PG8_STAGE(PG8_SA(1, 0), a3, voffA);
            PG8_BAR; PG8_WAIT_L(0); PG8_MMA(1, 0, At, B0); PG8_BAR; PG8_SCHED;
            PG8_STAGE(PG8_SB(1, 1), b3 + hstep, voffB);
            PG8_WAIT_V(6); PG8_BAR; PG8_MMA(1, 1, At, B1); PG8_BAR;
            }
        }
        if constexpr (ALIGN_EPI) { if (wr == 0) PG8_BAR; }
        if constexpr (!Epi::AFTER_DRAIN) { E(acc, cur, wr, wc, fr, fq); S.done(cur); }
        if (!has_next) break;
#pragma unroll
        for (int a = 0; a < 2; ++a)
#pragma unroll
            for (int b = 0; b < 2; ++b)
#pragma unroll
                for (int m = 0; m < 4; ++m)
#pragma unroll
                    for (int n = 0; n < 2; ++n) acc[a][b][m][n] = (f32x4){0.f, 0.f, 0.f, 0.f};
        cur = nxt; cA = nA; cB = nB; ++ui;
        if constexpr (ALIGN_EPI) { if (wr == 1) PG8_BAR; }
    }
    PG8_WAIT_V(0);
    if constexpr (!ALIGN_EPI) { if (wr == 0) PG8_BAR; }
    PG8_BAR;
#undef PG8_SA
#undef PG8_SB
#undef PG8_STAGE
#undef PG8_LDA
#undef PG8_LDB
#undef PG8_MMA
#undef PG8_WAIT_V
#undef PG8_WAIT_L
#undef PG8_BAR
#undef PG8_SCHED
}
}

DI void p0_transpose_job(const float* W, int ldn, int K, bf16_t* WT, int kb, int nb, LAS unsigned char* lds, int wv) {
    LAS float* tile = (LAS float*)lds;
    const int tid = wv * 64 + lane_id(), k0 = kb * 64, n0 = nb * 256;
    f32x4 v[8];
#pragma unroll
    for (int i = 0; i < 8; ++i) v[i] = *(const f32x4*)(W + (size_t)(k0 + (tid >> 6) + 8 * i) * ldn + n0 + (tid & 63) * 4);
#pragma unroll
    for (int i = 0; i < 8; ++i) { LAS float* t = tile + ((tid >> 6) + 8 * i) * 257 + (tid & 63) * 4; t[0] = v[i].x; t[1] = v[i].y; t[2] = v[i].z; t[3] = v[i].w; }
    __syncthreads();
#pragma unroll
    for (int j = 0; j < 4; ++j) { const int n = (tid >> 3) + 64 * j, k8 = (tid & 7) * 8; const LAS float* s = tile + k8 * 257 + n;
      u32x4 o; o.x = pk2(s[0], s[257]); o.y = pk2(s[2 * 257], s[3 * 257]); o.z = pk2(s[4 * 257], s[5 * 257]); o.w = pk2(s[6 * 257], s[7 * 257]);
      *(u32x4*)(WT + (size_t)(n0 + n) * K + k0 + k8) = o; }
    __syncthreads();
}
DI void p0_phase(const Args& a, LAS unsigned char* lds, int wv) {
    const int tid = wv * 64 + lane_id(), G = gridDim.x, blk = blockIdx.x;
    for (int i = blk * 512 + tid; i < MROWS; i += G * 512) ((float*)(a.ws + WS_SUMSQ))[i] = 0.f;
    for (int cg_ = blk; cg_ < NMOD / 32; cg_ += G) {
        LAS float* sc = (LAS float*)lds;
        LAS float* red = (LAS float*)(lds + 32768);
        for (int i = tid; i < 8192; i += 512) sc[i] = silu_f(a.c[i]);
        __syncthreads();
        const int ks = tid >> 5, col = tid & 31, j0 = cg_ * 32;
        float acc[8];
#pragma unroll
        for (int b = 0; b < 8; ++b) acc[b] = 0.f;
#pragma unroll 16
        for (int kk = 0; kk < 64; ++kk) { const int k = ks * 64 + kk; const float w = a.ada_w[(size_t)k * NMOD + j0 + col];
#pragma unroll
            for (int b = 0; b < 8; ++b) acc[b] += sc[b * 1024 + k] * w; }
#pragma unroll
        for (int b = 0; b < 8; ++b) red[(ks * 8 + b) * 32 + col] = acc[b];
        __syncthreads();
        if (tid < 256) { const int b = tid >> 5, cc = tid & 31; float s = a.ada_b[j0 + cc];
#pragma unroll
            for (int q = 0; q < 16; ++q) s += red[(q * 8 + b) * 32 + cc];
            ((float*)(a.ws + WS_MOD))[b * NMOD + j0 + cc] = s; }
        __syncthreads();
    }
    constexpr int J_IN = 16 * 16, J_OUT = 16 * 4, J_F1 = 16 * 16, J_F2 = 64 * 4, NJ = J_IN + J_OUT + J_F1 + J_F2;
    for (int j = (blk + 64) % G; j < NJ; j += G) {
        int r = j;
        if (r < J_IN) { p0_transpose_job(a.w_in, DIN, 1024, (bf16_t*)(a.ws + WS_WIN), r / 16, r % 16, lds, wv); continue; } r -= J_IN;
        if (r < J_OUT) { p0_transpose_job(a.w_out, 1024, 1024, (bf16_t*)(a.ws + WS_WOUT), r / 4, r % 4, lds, wv); continue; } r -= J_OUT;
        if (r < J_F1) { p0_transpose_job(a.w_ff1, 4096, 1024, (bf16_t*)(a.ws + WS_WFF1), r / 16, r % 16, lds, wv); continue; } r -= J_F1;
        p0_transpose_job(a.w_ff2, 1024, 4096, (bf16_t*)(a.ws + WS_WFF2), r / 4, r % 4, lds, wv);
    }
}

template <bool GAB>
DI void norm_mod_phase(const float* src, const float* nw, const float* mod, int shift_off, int scale_off, bf16_t* dst, const float* w_in, float* gab, LAS unsigned char* lds, int wv) {
    const int lane = lane_id(), wave = wv, tid = wv * 64 + lane;
    LAS float* W8 = (LAS float*)lds;
    if (GAB) { for (int i = tid; i < 8192; i += 512) { const int k = i >> 3, j = i & 7; W8[j * 1024 + k] = w_in[(size_t)k * DIN + 4096 + j]; } __syncthreads(); }
    const int gw = blockIdx.x * 8 + wave, NGW = gridDim.x * 8, c0 = lane * 8;
    f32x4 nwv[2][2];
#pragma unroll
    for (int i = 0; i < 2; ++i)
#pragma unroll
        for (int q = 0; q < 2; ++q) nwv[i][q] = *(const f32x4*)(nw + c0 + 512 * i + 4 * q);
    for (int m = gw; m < MROWS; m += NGW) {
        const float* xr = src + (size_t)m * DM;
        f32x4 v[2][2]; float ss = 0.f;
#pragma unroll
        for (int i = 0; i < 2; ++i)
#pragma unroll
            for (int q = 0; q < 2; ++q) { v[i][q] = *(const f32x4*)(xr + c0 + 512 * i + 4 * q); ss += (v[i][q].x * v[i][q].x + v[i][q].y * v[i][q].y) + (v[i][q].z * v[i][q].z + v[i][q].w * v[i][q].w); }
        ss = wave_sum(ss);
        const float rstd = 1.0f / sqrtf(ss * (1.f / DM) + EPS);
        const float* sh = mod + (size_t)(m >> 12) * NMOD + shift_off; const float* sc = mod + (size_t)(m >> 12) * NMOD + scale_off;
        float p[8];
#pragma unroll
        for (int j = 0; j < 8; ++j) p[j] = 0.f;
#pragma unroll
        for (int i = 0; i < 2; ++i) {
            f32x4 hq[2];
#pragma unroll
            for (int q = 0; q < 2; ++q) { const f32x4 shv = *(const f32x4*)(sh + c0 + 512 * i + 4 * q), scv = *(const f32x4*)(sc + c0 + 512 * i + 4 * q);
                hq[q] = v[i][q] * rstd * nwv[i][q] * (scv + 1.0f) + shv; }
            u32x4 w; w.x = pk2(hq[0].x, hq[0].y); w.y = pk2(hq[0].z, hq[0].w); w.z = pk2(hq[1].x, hq[1].y); w.w = pk2(hq[1].z, hq[1].w);
            *(u32x4*)(dst + (size_t)m * DM + c0 + 512 * i) = w;
            if (GAB) {
#pragma unroll
                for (int q = 0; q < 2; ++q)
#pragma unroll
                    for (int j = 0; j < 8; ++j) { const f32x4 wv = *(const LAS f32x4*)(W8 + j * 1024 + c0 + 512 * i + 4 * q);
                        p[j] += (hq[q].x * wv.x + hq[q].y * wv.y) + (hq[q].z * wv.z + hq[q].w * wv.w); } }
        }
        if (GAB) {
#pragma unroll
            for (int j = 0; j < 8; ++j) p[j] = wave_sum(p[j]);
            if (lane == 0) { *(f32x4*)(gab + (size_t)m * 8) = (f32x4){p[0], p[1], p[2], p[3]}; *(f32x4*)(gab + (size_t)m * 8 + 4) = (f32x4){p[4], p[5], p[6], p[7]}; }
        }
    }
    if (GAB) __syncthreads();
}

DI int pinv16(int d) { return ((d >> 2) & 1) * 8 + (d >> 3) * 4 + (d & 3); }
constexpr int P3_Q = 0, P3_K = 17408, P3_V = 34816, P3_L = 52224, P3_GC = 69632, P3_BETA = 69888, P3_BE = 70144;
DI u32x4 pack16lo(const float* v) { u32x4 o; o.x = pk2(v[0], v[1]); o.y = pk2(v[2], v[3]); o.z = pk2(v[8], v[9]); o.w = pk2(v[10], v[11]); return o; }
DI u32x4 pack16hi(const float* v) { u32x4 o; o.x = pk2(v[4], v[5]); o.y = pk2(v[6], v[7]); o.z = pk2(v[12], v[13]); o.w = pk2(v[14], v[15]); return o; }

constexpr int P3_CW = 126976;
DI void conv_silu16(const bf16_t* proj, const LAS float* cwl, int b, int tpos, int colbase, int chl, float* val) {
#pragma unroll
    for (int e = 0; e < 16; ++e) val[e] = 0.f;
#pragma unroll
    for (int w = 0; w < 4; ++w) {
        const int tt = tpos - 3 + w;
        if (tt >= 0) {
            const bf16_t* src = proj + (size_t)(b * SEQ + tt) * NPROJ + colbase;
            const u32x4 x0 = *(const u32x4*)src, x1 = *(const u32x4*)(src + 8);
            const LAS float* cw = cwl + w * 128 + chl;
            const f32x4 c0 = *(const LAS f32x4*)cw, c1 = *(const LAS f32x4*)(cw + 4), c2 = *(const LAS f32x4*)(cw + 8), c3 = *(const LAS f32x4*)(cw + 12);
            val[0] += c0.x * bflo(x0.x); val[1] += c0.y * bfhi(x0.x); val[2] += c0.z * bflo(x0.y); val[3] += c0.w * bfhi(x0.y);
            val[4] += c1.x * bflo(x0.z); val[5] += c1.y * bfhi(x0.z); val[6] += c1.z * bflo(x0.w); val[7] += c1.w * bfhi(x0.w);
            val[8] += c2.x * bflo(x1.x); val[9] += c2.y * bfhi(x1.x); val[10] += c2.z * bflo(x1.y); val[11] += c2.w * bfhi(x1.y);
            val[12] += c3.x * bflo(x1.z); val[13] += c3.y * bfhi(x1.z); val[14] += c3.z * bflo(x1.w); val[15] += c3.w * bfhi(x1.w);
        }
    }
#pragma unroll
    for (int e = 0; e < 16; ++e) val[e] = silu_f(val[e]);
}
DI void st16_lds(LAS unsigned char* p, const float* v) {
    u32x4 o0, o1; o0.x = pk2(v[0], v[1]); o0.y = pk2(v[2], v[3]); o0.z = pk2(v[4], v[5]); o0.w = pk2(v[6], v[7]);
    o1.x = pk2(v[8], v[9]); o1.y = pk2(v[10], v[11]); o1.z = pk2(v[12], v[13]); o1.w = pk2(v[14], v[15]);
    *(LAS u32x4*)p = o0; *(LAS u32x4*)(p + 16) = o1;
}
DI float red8(float v) { v += __shfl_xor(v, 1); v += __shfl_xor(v, 2); v += __shfl_xor(v, 4); return v; }

DI void p3_ret_half(const Args& a, LAS unsigned char* lds, int b, int n, int h, int t2in);
DI void p3_pair_item(const Args& a, LAS unsigned char* lds, int b, int n, int h, int rb, int rn, int rh, int wv) {
    int tid_ = wv * 64 + lane_id(); asm volatile("" : "+v"(tid_));
    const int tid = tid_, lane = tid & 63, wave = tid >> 6;
    const bf16_t* proj = (const bf16_t*)(a.ws + WS_PROJ);
    const float* gab = (const float*)(a.ws + WS_GAB);
    const int bh = b * 4 + h;
    unsigned char* rec = a.ws + WS_GREC + (size_t)(bh * 64 + n) * GREC;
    bf16_t* uT = (bf16_t*)rec; bf16_t* wG = (bf16_t*)(rec + 16384); bf16_t* qgG = (bf16_t*)(rec + 32768); bf16_t* kdT = (bf16_t*)(rec + 49152); bf16_t* atG = (bf16_t*)(rec + 65536);
    LAS float* gcs = (LAS float*)(lds + P3_GC); LAS float* betas = (LAS float*)(lds + P3_BETA); LAS float* bes = (LAS float*)(lds + P3_BE); LAS float* Ls = (LAS float*)(lds + P3_L);
    if (wave == 0) {
        const size_t m = (size_t)b * SEQ + n * 64 + lane;
        const float ga = gab[m * 8 + h], gb = gab[m * 8 + 4 + h];
        const float beta = 1.f / (1.f + __expf(-gb));
        const float xx = ga + a.dt_bias[h];
        const float sp = fmaxf(xx, 0.f) + log1pf(__expf(-fabsf(xx)));
        float g = -__expf(a.a_log[h]) * sp;
#pragma unroll
        for (int o = 1; o < 64; o <<= 1) { const float t = __shfl_up(g, o); if (lane >= o) g += t; }
        gcs[lane] = g; betas[lane] = beta; bes[lane] = beta * __expf(g);
    }
    const int r = tid >> 3, cb = tid & 7, c0 = cb * 16, tpos = n * 64 + r;
    float qv[16];
    {
        conv_silu16(proj, (const LAS float*)(lds + P3_CW), b, tpos, 2048 + h * 128 + c0, c0, qv);
        float ss = 0.f;
#pragma unroll
        for (int e = 0; e < 16; ++e) ss += qv[e] * qv[e];
        ss = red8(ss); const float rn = (1.0f / sqrtf(ss + EPS)) * 0.08838834764831845f;
#pragma unroll
        for (int e = 0; e < 16; ++e) qv[e] *= rn;
        st16_lds(lds + P3_Q + r * 272 + c0 * 2, qv);
    }
    {
        float kv[16];
        conv_silu16(proj, (const LAS float*)(lds + P3_CW) + 512, b, tpos, 2560 + h * 128 + c0, c0, kv);
        float ss = 0.f;
#pragma unroll
        for (int e = 0; e < 16; ++e) ss += kv[e] * kv[e];
        ss = red8(ss); const float rn = 1.0f / sqrtf(ss + EPS);
#pragma unroll
        for (int e = 0; e < 16; ++e) kv[e] *= rn;
        st16_lds(lds + P3_K + r * 272 + c0 * 2, kv);
    }
    {
        float vv[16];
        conv_silu16(proj, (const LAS float*)(lds + P3_CW) + 1024, b, tpos, 3072 + h * 128 + c0, c0, vv);
        st16_lds(lds + P3_V + r * 272 + c0 * 2, vv);
    }
    __syncthreads();
    {
        const float eg = __expf(gcs[r]);
#pragma unroll
        for (int e = 0; e < 16; ++e) qv[e] *= eg;
        *(u32x4*)(qgG + r * 128 + c0) = pack16lo(qv); *(u32x4*)(qgG + r * 128 + c0 + 8) = pack16hi(qv);
    }
#pragma unroll
    for (int i = 0; i < 4; ++i) {
        const int ti = wave * 4 + i, mat = ti >> 4, mt = (ti >> 2) & 3, nt = ti & 3;
        const LAS unsigned char* Ab = lds + (mat ? P3_Q : P3_K) + (16 * mt + (lane & 15)) * 272 + (lane >> 4) * 16;
        const LAS unsigned char* Bb = lds + P3_K + (16 * nt + (lane & 15)) * 272 + (lane >> 4) * 16;
        f32x4 acc = {0.f, 0.f, 0.f, 0.f};
#pragma unroll
        for (int s = 0; s < 4; ++s) acc = __builtin_amdgcn_mfma_f32_16x16x32_bf16(*(const LAS bf16x8*)(Ab + s * 64), *(const LAS bf16x8*)(Bb + s * 64), acc, 0, 0, 0);
        const int jj = 16 * nt + (lane & 15); const float gj = gcs[jj];
#pragma unroll
        for (int j = 0; j < 4; ++j) {
            const int ii = 16 * mt + (lane >> 4) * 4 + j; const float gi = gcs[ii];
            if (mat == 0) { Ls[ii * 68 + jj] = (ii > jj) ? betas[ii] * acc[j] * __expf(gi - gj) : 0.f; }
            else { const float v = (ii >= jj) ? acc[j] * __expf(gi - gj) : 0.f; atG[ii * 64 + (jj & ~15) + pinv16(jj & 15)] = f2bf(v); }
        }
    }
    __syncthreads();
    if (tid < 256) {
        const int col = tid; const bool isu = col < 128;
        int xoff = (isu ? P3_V : P3_K) + 2 * (isu ? col : col - 128), coff = isu ? P3_BETA : P3_BE;
        asm volatile("" : "+v"(xoff), "+v"(coff));
        const LAS unsigned short* Xp = (const LAS unsigned short*)(lds + xoff);
        const LAS float* cf = (const LAS float*)(lds + coff);
        float xs[64];
#pragma unroll
        for (int i = 0; i < 64; ++i) xs[i] = cf[i] * bf2f(Xp[i * 136]);
        f32x4 LB0[12], LB1[12];
        int zlane; asm volatile("v_mov_b32 %0, 0" : "=v"(zlane));
        const LAS float* Lv = Ls + zlane;
#define SOL_L(b, k, off) LB##b[k] = *(const LAS f32x4*)(Lv + (off))
#define SOL_F(i, j, b, k, c) xs[i] = fmaf(-LB##b[k].c, xs[j], xs[i])
        SOL_L(0, 0, 68); SOL_L(0, 1, 136); SOL_L(0, 2, 204); SOL_L(0, 3, 272); SOL_L(0, 4, 340); SOL_L(0, 5, 344); SOL_L(0, 6, 408); SOL_L(0, 7, 412); SOL_L(0, 8, 476); SOL_L(0, 9, 480); SOL_L(0, 10, 544); SOL_L(0, 11, 548);
        SOL_L(1, 0, 612); SOL_L(1, 1, 616); SOL_L(1, 2, 620); SOL_L(1, 3, 680); SOL_L(1, 4, 684); SOL_L(1, 5, 688); SOL_L(1, 6, 748); SOL_L(1, 7, 752); SOL_L(1, 8, 756); SOL_L(1, 9, 816); SOL_L(1, 10, 820); SOL_L(1, 11, 824);
        __builtin_amdgcn_sched_barrier(0);
        SOL_F(1, 0, 0, 0, x);
        SOL_F(2, 0, 0, 1, x); SOL_F(2, 1, 0, 1, y);
        SOL_F(3, 0, 0, 2, x); SOL_F(3, 1, 0, 2, y); SOL_F(3, 2, 0, 2, z);
        SOL_F(4, 0, 0, 3, x); SOL_F(4, 1, 0, 3, y); SOL_F(4, 2, 0, 3, z); SOL_F(4, 3, 0, 3, w);
        SOL_F(5, 0, 0, 4, x); SOL_F(5, 1, 0, 4, y); SOL_F(5, 2, 0, 4, z); SOL_F(5, 3, 0, 4, w);
        SOL_F(5, 4, 0, 5, x);
        SOL_F(6, 0, 0, 6, x); SOL_F(6, 1, 0, 6, y); SOL_F(6, 2, 0, 6, z); SOL_F(6, 3, 0, 6, w);
        SOL_F(6, 4, 0, 7, x); SOL_F(6, 5, 0, 7, y);
        SOL_F(7, 0, 0, 8, x); SOL_F(7, 1, 0, 8, y); SOL_F(7, 2, 0, 8, z); SOL_F(7, 3, 0, 8, w);
        SOL_F(7, 4, 0, 9, x); SOL_F(7, 5, 0, 9, y); SOL_F(7, 6, 0, 9, z);
        SOL_F(8, 0, 0, 10, x); SOL_F(8, 1, 0, 10, y); SOL_F(8, 2, 0, 10, z); SOL_F(8, 3, 0, 10, w);
        SOL_F(8, 4, 0, 11, x); SOL_F(8, 5, 0, 11, y); SOL_F(8, 6, 0, 11, z); SOL_F(8, 7, 0, 11, w);
        __builtin_amdgcn_sched_barrier(0);
        SOL_L(0, 0, 884); SOL_L(0, 1, 888); SOL_L(0, 2, 892); SOL_L(0, 3, 896); SOL_L(0, 4, 952); SOL_L(0, 5, 956); SOL_L(0, 6, 960); SOL_L(0, 7, 964); SOL_L(0, 8, 1020); SOL_L(0, 9, 1024); SOL_L(0, 10, 1028); SOL_L(0, 11, 1032);
        __builtin_amdgcn_sched_barrier(0);
        SOL_F(9, 0, 1, 0, x); SOL_F(9, 1, 1, 0, y); SOL_F(9, 2, 1, 0, z); SOL_F(9, 3, 1, 0, w);
        SOL_F(9, 4, 1, 1, x); SOL_F(9, 5, 1, 1, y); SOL_F(9, 6, 1, 1, z); SOL_F(9, 7, 1, 1, w);
        SOL_F(9, 8, 1, 2, x);
        SOL_F(10, 0, 1, 3, x); SOL_F(10, 1, 1, 3, y); SOL_F(10, 2, 1, 3, z); SOL_F(10, 3, 1, 3, w);
        SOL_F(10, 4, 1, 4, x); SOL_F(10, 5, 1, 4, y); SOL_F(10, 6, 1, 4, z); SOL_F(10, 7, 1, 4, w);
        SOL_F(10, 8, 1, 5, x); SOL_F(10, 9, 1, 5, y);
        SOL_F(11, 0, 1, 6, x); SOL_F(11, 1, 1, 6, y); SOL_F(11, 2, 1, 6, z); SOL_F(11, 3, 1, 6, w);
        SOL_F(11, 4, 1, 7, x); SOL_F(11, 5, 1, 7, y); SOL_F(11, 6, 1, 7, z); SOL_F(11, 7, 1, 7, w);
        SOL_F(11, 8, 1, 8, x); SOL_F(11, 9, 1, 8, y); SOL_F(11, 10, 1, 8, z);
        SOL_F(12, 0, 1, 9, x); SOL_F(12, 1, 1, 9, y); SOL_F(12, 2, 1, 9, z); SOL_F(12, 3, 1, 9, w);
        SOL_F(12, 4, 1, 10, x); SOL_F(12, 5, 1, 10, y); SOL_F(12, 6, 1, 10, z); SOL_F(12, 7, 1, 10, w);
        SOL_F(12, 8, 1, 11, x); SOL_F(12, 9, 1, 11, y); SOL_F(12, 10, 1, 11, z); SOL_F(12, 11, 1, 11, w);
        __builtin_amdgcn_sched_barrier(0);
        SOL_L(1, 0, 1088); SOL_L(1, 1, 1092); SOL_L(1, 2, 1096); SOL_L(1, 3, 1100); SOL_L(1, 4, 1156); SOL_L(1, 5, 1160); SOL_L(1, 6, 1164); SOL_L(1, 7, 1168); SOL_L(1, 8, 1172); SOL_L(1, 9, 1224); SOL_L(1, 10, 1228); SOL_L(1, 11, 1232);
        __builtin_amdgcn_sched_barrier(0);
        SOL_F(13, 0, 0, 0, x); SOL_F(13, 1, 0, 0, y); SOL_F(13, 2, 0, 0, z); SOL_F(13, 3, 0, 0, w);
        SOL_F(13, 4, 0, 1, x); SOL_F(13, 5, 0, 1, y); SOL_F(13, 6, 0, 1, z); SOL_F(13, 7, 0, 1, w);
        SOL_F(13, 8, 0, 2, x); SOL_F(13, 9, 0, 2, y); SOL_F(13, 10, 0, 2, z); SOL_F(13, 11, 0, 2, w);
        SOL_F(13, 12, 0, 3, x);
        SOL_F(14, 0, 0, 4, x); SOL_F(14, 1, 0, 4, y); SOL_F(14, 2, 0, 4, z); SOL_F(14, 3, 0, 4, w);
        SOL_F(14, 4, 0, 5, x); SOL_F(14, 5, 0, 5, y); SOL_F(14, 6, 0, 5, z); SOL_F(14, 7, 0, 5, w);
        SOL_F(14, 8, 0, 6, x); SOL_F(14, 9, 0, 6, y); SOL_F(14, 10, 0, 6, z); SOL_F(14, 11, 0, 6, w);
        SOL_F(14, 12, 0, 7, x); SOL_F(14, 13, 0, 7, y);
        SOL_F(15, 0, 0, 8, x); SOL_F(15, 1, 0, 8, y); SOL_F(15, 2, 0, 8, z); SOL_F(15, 3, 0, 8, w);
        SOL_F(15, 4, 0, 9, x); SOL_F(15, 5, 0, 9, y); SOL_F(15, 6, 0, 9, z); SOL_F(15, 7, 0, 9, w);
        SOL_F(15, 8, 0, 10, x); SOL_F(15, 9, 0, 10, y); SOL_F(15, 10, 0, 10, z); SOL_F(15, 11, 0, 10, w);
        SOL_F(15, 12, 0, 11, x); SOL_F(15, 13, 0, 11, y); SOL_F(15, 14, 0, 11, z);
        __builtin_amdgcn_sched_barrier(0);
        SOL_L(0, 0, 1236); SOL_L(0, 1, 1240); SOL_L(0, 2, 1292); SOL_L(0, 3, 1296); SOL_L(0, 4, 1300); SOL_L(0, 5, 1304); SOL_L(0, 6, 1308); SOL_L(0, 7, 1360); SOL_L(0, 8, 1364); SOL_L(0, 9, 1368); SOL_L(0, 10, 1372); SOL_L(0, 11, 1376);
        __builtin_amdgcn_sched_barrier(0);
        SOL_F(16, 0, 1, 0, x); SOL_F(16, 1, 1, 0, y); SOL_F(16, 2, 1, 0, z); SOL_F(16, 3, 1, 0, w);
        SOL_F(16, 4, 1, 1, x); SOL_F(16, 5, 1, 1, y); SOL_F(16, 6, 1, 1, z); SOL_F(16, 7, 1, 1, w);
        SOL_F(16, 8, 1, 2, x); SOL_F(16, 9, 1, 2, y); SOL_F(16, 10, 1, 2, z); SOL_F(16, 11, 1, 2, w);
        SOL_F(16, 12, 1, 3, x); SOL_F(16, 13, 1, 3, y); SOL_F(16, 14, 1, 3, z); SOL_F(16, 15, 1, 3, w);
        SOL_F(17, 0, 1, 4, x); SOL_F(17, 1, 1, 4, y); SOL_F(17, 2, 1, 4, z); SOL_F(17, 3, 1, 4, w);
        SOL_F(17, 4, 1, 5, x); SOL_F(17, 5, 1, 5, y); SOL_F(17, 6, 1, 5, z); SOL_F(17, 7, 1, 5, w);
        SOL_F(17, 8, 1, 6, x); SOL_F(17, 9, 1, 6, y); SOL_F(17, 10, 1, 6, z); SOL_F(17, 11, 1, 6, w);
        SOL_F(17, 12, 1, 7, x); SOL_F(17, 13, 1, 7, y); SOL_F(17, 14, 1, 7, z); SOL_F(17, 15, 1, 7, w);
        SOL_F(17, 16, 1, 8, x);
        SOL_F(18, 0, 1, 9, x); SOL_F(18, 1, 1, 9, y); SOL_F(18, 2, 1, 9, z); SOL_F(18, 3, 1, 9, w);
        SOL_F(18, 4, 1, 10, x); SOL_F(18, 5, 1, 10, y); SOL_F(18, 6, 1, 10, z); SOL_F(18, 7, 1, 10, w);
        SOL_F(18, 8, 1, 11, x); SOL_F(18, 9, 1, 11, y); SOL_F(18, 10, 1, 11, z); SOL_F(18, 11, 1, 11, w);
        __builtin_amdgcn_sched_barrier(0);
        SOL_L(1, 0, 1428); SOL_L(1, 1, 1432); SOL_L(1, 2, 1436); SOL_L(1, 3, 1440); SOL_L(1, 4, 1444); SOL_L(1, 5, 1448); SOL_L(1, 6, 1496); SOL_L(1, 7, 1500); SOL_L(1, 8, 1504); SOL_L(1, 9, 1508); SOL_L(1, 10, 1512); SOL_L(1, 11, 1516);
        __builtin_amdgcn_sched_barrier(0);
        SOL_F(18, 12, 0, 0, x); SOL_F(18, 13, 0, 0, y); SOL_F(18, 14, 0, 0, z); SOL_F(18, 15, 0, 0, w);
        SOL_F(18, 16, 0, 1, x); SOL_F(18, 17, 0, 1, y);
        SOL_F(19, 0, 0, 2, x); SOL_F(19, 1, 0, 2, y); SOL_F(19, 2, 0, 2, z); SOL_F(19, 3, 0, 2, w);
        SOL_F(19, 4, 0, 3, x); SOL_F(19, 5, 0, 3, y); SOL_F(19, 6, 0, 3, z); SOL_F(19, 7, 0, 3, w);
        SOL_F(19, 8, 0, 4, x); SOL_F(19, 9, 0, 4, y); SOL_F(19, 10, 0, 4, z); SOL_F(19, 11, 0, 4, w);
        SOL_F(19, 12, 0, 5, x); SOL_F(19, 13, 0, 5, y); SOL_F(19, 14, 0, 5, z); SOL_F(19, 15, 0, 5, w);
        SOL_F(19, 16, 0, 6, x); SOL_F(19, 17, 0, 6, y); SOL_F(19, 18, 0, 6, z);
        SOL_F(20, 0, 0, 7, x); SOL_F(20, 1, 0, 7, y); SOL_F(20, 2, 0, 7, z); SOL_F(20, 3, 0, 7, w);
        SOL_F(20, 4, 0, 8, x); SOL_F(20, 5, 0, 8, y); SOL_F(20, 6, 0, 8, z); SOL_F(20, 7, 0, 8, w);
        SOL_F(20, 8, 0, 9, x); SOL_F(20, 9, 0, 9, y); SOL_F(20, 10, 0, 9, z); SOL_F(20, 11, 0, 9, w);
        SOL_F(20, 12, 0, 10, x); SOL_F(20, 13, 0, 10, y); SOL_F(20, 14, 0, 10, z); SOL_F(20, 15, 0, 10, w);
        SOL_F(20, 16, 0, 11, x); SOL_F(20, 17, 0, 11, y); SOL_F(20, 18, 0, 11, z); SOL_F(20, 19, 0, 11, w);
        __builtin_amdgcn_sched_barrier(0);
        SOL_L(0, 0, 1564); SOL_L(0, 1, 1568); SOL_L(0, 2, 1572); SOL_L(0, 3, 1576); SOL_L(0, 4, 1580); SOL_L(0, 5, 1584); SOL_L(0, 6, 1632); SOL_L(0, 7, 1636); SOL_L(0, 8, 1640); SOL_L(0, 9, 1644); SOL_L(0, 10, 1648); SOL_L(0, 11, 1652);
        __builtin_amdgcn_sched_barrier(0);
        SOL_F(21, 0, 1, 0, x); SOL_F(21, 1, 1, 0, y); SOL_F(21, 2, 1, 0, z); SOL_F(21, 3, 1, 0, w);
        SOL_F(21, 4, 1, 1, x); SOL_F(21, 5, 1, 1, y); SOL_F(21, 6, 1, 1, z); SOL_F(21, 7, 1, 1, w);
        SOL_F(21, 8, 1, 2, x); SOL_F(21, 9, 1, 2, y); SOL_F(21, 10, 1, 2, z); SOL_F(21, 11, 1, 2, w);
        SOL_F(21, 12, 1, 3, x); SOL_F(21, 13, 1, 3, y); SOL_F(21, 14, 1, 3, z); SOL_F(21, 15, 1, 3, w);
        SOL_F(21, 16, 1, 4, x); SOL_F(21, 17, 1, 4, y); SOL_F(21, 18, 1, 4, z); SOL_F(21, 19, 1, 4, w);
        SOL_F(21, 20, 1, 5, x);
        SOL_F(22, 0, 1, 6, x); SOL_F(22, 1, 1, 6, y); SOL_F(22, 2, 1, 6, z); SOL_F(22, 3, 1, 6, w);
        SOL_F(22, 4, 1, 7, x); SOL_F(22, 5, 1, 7, y); SOL_F(22, 6, 1, 7, z); SOL_F(22, 7, 1, 7, w);
        SOL_F(22, 8, 1, 8, x); SOL_F(22, 9, 1, 8, y); SOL_F(22, 10, 1, 8, z); SOL_F(22, 11, 1, 8, w);
        SOL_F(22, 12, 1, 9, x); SOL_F(22, 13, 1, 9, y); SOL_F(22, 14, 1, 9, z); SOL_F(22, 15, 1, 9, w);
        SOL_F(22, 16, 1, 10, x); SOL_F(22, 17, 1, 10, y); SOL_F(22, 18, 1, 10, z); SOL_F(22, 19, 1, 10, w);
        SOL_F(22, 20, 1, 11, x); SOL_F(22, 21, 1, 11, y);
        __builtin_amdgcn_sched_barrier(0);
        SOL_L(1, 0, 1700); SOL_L(1, 1, 1704); SOL_L(1, 2, 1708); SOL_L(1, 3, 1712); SOL_L(1, 4, 1716); SOL_L(1, 5, 1720); SOL_L(1, 6, 1724); SOL_L(1, 7, 1768); SOL_L(1, 8, 1772); SOL_L(1, 9, 1776); SOL_L(1, 10, 1780); SOL_L(1, 11, 1784);
        __builtin_amdgcn_sched_barrier(0);
        SOL_F(23, 0, 0, 0, x); SOL_F(23, 1, 0, 0, y); SOL_F(23, 2, 0, 0, z); SOL_F(23, 3, 0, 0, w);
        SOL_F(23, 4, 0, 1, x); SOL_F(23, 5, 0, 1, y); SOL_F(23, 6, 0, 1, z); SOL_F(23, 7, 0, 1, w);
        SOL_F(23, 8, 0, 2, x); SOL_F(23, 9, 0, 2, y); SOL_F(23, 10, 0, 2, z); SOL_F(23, 11, 0, 2, w);
        SOL_F(23, 12, 0, 3, x); SOL_F(23, 13, 0, 3, y); SOL_F(23, 14, 0, 3, z); SOL_F(23, 15, 0, 3, w);
        SOL_F(23, 16, 0, 4, x); SOL_F(23, 17, 0, 4, y); SOL_F(23, 18, 0, 4, z); SOL_F(23, 19, 0, 4, w);
        SOL_F(23, 20, 0, 5, x); SOL_F(23, 21, 0, 5, y); SOL_F(23, 22, 0, 5, z);
        SOL_F(24, 0, 0, 6, x); SOL_F(24, 1, 0, 6, y); SOL_F(24, 2, 0, 6, z); SOL_F(24, 3, 0, 6, w);
        SOL_F(24, 4, 0, 7, x); SOL_F(24, 5, 0, 7, y); SOL_F(24, 6, 0, 7, z); SOL_F(24, 7, 0, 7, w);
        SOL_F(24, 8, 0, 8, x); SOL_F(24, 9, 0, 8, y); SOL_F(24, 10, 0, 8, z); SOL_F(24, 11, 0, 8, w);
        SOL_F(24, 12, 0, 9, x); SOL_F(24, 13, 0, 9, y); SOL_F(24, 14, 0, 9, z); SOL_F(24, 15, 0, 9, w);
        SOL_F(24, 16, 0, 10, x); SOL_F(24, 17, 0, 10, y); SOL_F(24, 18, 0, 10, z); SOL_F(24, 19, 0, 10, w);
        SOL_F(24, 20, 0, 11, x); SOL_F(24, 21, 0, 11, y); SOL_F(24, 22, 0, 11, z); SOL_F(24, 23, 0, 11, w);
        __builtin_amdgcn_sched_barrier(0);
        SOL_L(0, 0, 1788); SOL_L(0, 1, 1792); SOL_L(0, 2, 1836); SOL_L(0, 3, 1840); SOL_L(0, 4, 1844); SOL_L(0, 5, 1848); SOL_L(0, 6, 1852); SOL_L(0, 7, 1856); SOL_L(0, 8, 1860); SOL_L(0, 9, 1904); SOL_L(0, 10, 1908); SOL_L(0, 11, 1912);
        __builtin_amdgcn_sched_barrier(0);
        SOL_F(25, 0, 1, 0, x); SOL_F(25, 1, 1, 0, y); SOL_F(25, 2, 1, 0, z); SOL_F(25, 3, 1, 0, w);
        SOL_F(25, 4, 1, 1, x); SOL_F(25, 5, 1, 1, y); SOL_F(25, 6, 1, 1, z); SOL_F(25, 7, 1, 1, w);
        SOL_F(25, 8, 1, 2, x); SOL_F(25, 9, 1, 2, y); SOL_F(25, 10, 1, 2, z); SOL_F(25, 11, 1, 2, w);
        SOL_F(25, 12, 1, 3, x); SOL_F(25, 13, 1, 3, y); SOL_F(25, 14, 1, 3, z); SOL_F(25, 15, 1, 3, w);
        SOL_F(25, 16, 1, 4, x); SOL_F(25, 17, 1, 4, y); SOL_F(25, 18, 1, 4, z); SOL_F(25, 19, 1, 4, w);
        SOL_F(25, 20, 1, 5, x); SOL_F(25, 21, 1, 5, y); SOL_F(25, 22, 1, 5, z); SOL_F(25, 23, 1, 5, w);
        SOL_F(25, 24, 1, 6, x);
        SOL_F(26, 0, 1, 7, x); SOL_F(26, 1, 1, 7, y); SOL_F(26, 2, 1, 7, z); SOL_F(26, 3, 1, 7, w);
        SOL_F(26, 4, 1, 8, x); SOL_F(26, 5, 1, 8, y); SOL_F(26, 6, 1, 8, z); SOL_F(26, 7, 1, 8, w);
        SOL_F(26, 8, 1, 9, x); SOL_F(26, 9, 1, 9, y); SOL_F(26, 10, 1, 9, z); SOL_F(26, 11, 1, 9, w);
        SOL_F(26, 12, 1, 10, x); SOL_F(26, 13, 1, 10, y); SOL_F(26, 14, 1, 10, z); SOL_F(26, 15, 1, 10, w);
        SOL_F(26, 16, 1, 11, x); SOL_F(26, 17, 1, 11, y); SOL_F(26, 18, 1, 11, z); SOL_F(26, 19, 1, 11, w);
        __builtin_amdgcn_sched_barrier(0);
        SOL_L(1, 0, 1916); SOL_L(1, 1, 1920); SOL_L(1, 2, 1924); SOL_L(1, 3, 1928); SOL_L(1, 4, 1972); SOL_L(1, 5, 1976); SOL_L(1, 6, 1980); SOL_L(1, 7, 1984); SOL_L(1, 8, 1988); SOL_L(1, 9, 1992); SOL_L(1, 10, 1996); SOL_L(1, 11, 2000);
        __builtin_amdgcn_sched_barrier(0);
        SOL_F(26, 20, 0, 0, x); SOL_F(26, 21, 0, 0, y); SOL_F(26, 22, 0, 0, z); SOL_F(26, 23, 0, 0, w);
        SOL_F(26, 24, 0, 1, x); SOL_F(26, 25, 0, 1, y);
        SOL_F(27, 0, 0, 2, x); SOL_F(27, 1, 0, 2, y); SOL_F(27, 2, 0, 2, z); SOL_F(27, 3, 0, 2, w);
        SOL_F(27, 4, 0, 3, x); SOL_F(27, 5, 0, 3, y); SOL_F(27, 6, 0, 3, z); SOL_F(27, 7, 0, 3, w);
        SOL_F(27, 8, 0, 4, x); SOL_F(27, 9, 0, 4, y); SOL_F(27, 10, 0, 4, z); SOL_F(27, 11, 0, 4, w);
        SOL_F(27, 12, 0, 5, x); SOL_F(27, 13, 0, 5, y); SOL_F(27, 14, 0, 5, z); SOL_F(27, 15, 0, 5, w);
        SOL_F(27, 16, 0, 6, x); SOL_F(27, 17, 0, 6, y); SOL_F(27, 18, 0, 6, z); SOL_F(27, 19, 0, 6, w);
        SOL_F(27, 20, 0, 7, x); SOL_F(27, 21, 0, 7, y); SOL_F(27, 22, 0, 7, z); SOL_F(27, 23, 0, 7, w);
        SOL_F(27, 24, 0, 8, x); SOL_F(27, 25, 0, 8, y); SOL_F(27, 26, 0, 8, z);
        SOL_F(28, 0, 0, 9, x); SOL_F(28, 1, 0, 9, y); SOL_F(28, 2, 0, 9, z); SOL_F(28, 3, 0, 9, w);
        SOL_F(28, 4, 0, 10, x); SOL_F(28, 5, 0, 10, y); SOL_F(28, 6, 0, 10, z); SOL_F(28, 7, 0, 10, w);
        SOL_F(28, 8, 0, 11, x); SOL_F(28, 9, 0, 11, y); SOL_F(28, 10, 0, 11, z); SOL_F(28, 11, 0, 11, w);
        __builtin_amdgcn_sched_barrier(0);
        SOL_L(0, 0, 2040); SOL_L(0, 1, 2044); SOL_L(0, 2, 2048); SOL_L(0, 3, 2052); SOL_L(0, 4, 2056); SOL_L(0, 5, 2060); SOL_L(0, 6, 2064); SOL_L(0, 7, 2068); SOL_L(0, 8, 2108); SOL_L(0, 9, 2112); SOL_L(0, 10, 2116); SOL_L(0, 11, 2120);
        __builtin_amdgcn_sched_barrier(0);
        SOL_F(28, 12, 1, 0, x); SOL_F(28, 13, 1, 0, y); SOL_F(28, 14, 1, 0, z); SOL_F(28, 15, 1, 0, w);
        SOL_F(28, 16, 1, 1, x); SOL_F(28, 17, 1, 1, y); SOL_F(28, 18, 1, 1, z); SOL_F(28, 19, 1, 1, w);
        SOL_F(28, 20, 1, 2, x); SOL_F(28, 21, 1, 2, y); SOL_F(28, 22, 1, 2, z); SOL_F(28, 23, 1, 2, w);
        SOL_F(28, 24, 1, 3, x); SOL_F(28, 25, 1, 3, y); SOL_F(28, 26, 1, 3, z); SOL_F(28, 27, 1, 3, w);
        SOL_F(29, 0, 1, 4, x); SOL_F(29, 1, 1, 4, y); SOL_F(29, 2, 1, 4, z); SOL_F(29, 3, 1, 4, w);
        SOL_F(29, 4, 1, 5, x); SOL_F(29, 5, 1, 5, y); SOL_F(29, 6, 1, 5, z); SOL_F(29, 7, 1, 5, w);
        SOL_F(29, 8, 1, 6, x); SOL_F(29, 9, 1, 6, y); SOL_F(29, 10, 1, 6, z); SOL_F(29, 11, 1, 6, w);
        SOL_F(29, 12, 1, 7, x); SOL_F(29, 13, 1, 7, y); SOL_F(29, 14, 1, 7, z); SOL_F(29, 15, 1, 7, w);
        SOL_F(29, 16, 1, 8, x); SOL_F(29, 17, 1, 8, y); SOL_F(29, 18, 1, 8, z); SOL_F(29, 19, 1, 8, w);
        SOL_F(29, 20, 1, 9, x); SOL_F(29, 21, 1, 9, y); SOL_F(29, 22, 1, 9, z); SOL_F(29, 23, 1, 9, w);
        SOL_F(29, 24, 1, 10, x); SOL_F(29, 25, 1, 10, y); SOL_F(29, 26, 1, 10, z); SOL_F(29, 27, 1, 10, w);
        SOL_F(29, 28, 1, 11, x);
        __builtin_amdgcn_sched_barrier(0);
        SOL_L(1, 0, 2124); SOL_L(1, 1, 2128); SOL_L(1, 2, 2132); SOL_L(1, 3, 2136); SOL_L(1, 4, 2176); SOL_L(1, 5, 2180); SOL_L(1, 6, 2184); SOL_L(1, 7, 2188); SOL_L(1, 8, 2192); SOL_L(1, 9, 2196); SOL_L(1, 10, 2200); SOL_L(1, 11, 2204);
        __builtin_amdgcn_sched_barrier(0);
        SOL_F(30, 0, 0, 0, x); SOL_F(30, 1, 0, 0, y); SOL_F(30, 2, 0, 0, z); SOL_F(30, 3, 0, 0, w);
        SOL_F(30, 4, 0, 1, x); SOL_F(30, 5, 0, 1, y); SOL_F(30, 6, 0, 1, z); SOL_F(30, 7, 0, 1, w);
        SOL_F(30, 8, 0, 2, x); SOL_F(30, 9, 0, 2, y); SOL_F(30, 10, 0, 2, z); SOL_F(30, 11, 0, 2, w);
        SOL_F(30, 12, 0, 3, x); SOL_F(30, 13, 0, 3, y); SOL_F(30, 14, 0, 3, z); SOL_F(30, 15, 0, 3, w);
        SOL_F(30, 16, 0, 4, x); SOL_F(30, 17, 0, 4, y); SOL_F(30, 18, 0, 4, z); SOL_F(30, 19, 0, 4, w);
        SOL_F(30, 20, 0, 5, x); SOL_F(30, 21, 0, 5, y); SOL_F(30, 22, 0, 5, z); SOL_F(30, 23, 0, 5, w);
        SOL_F(30, 24, 0, 6, x); SOL_F(30, 25, 0, 6, y); SOL_F(30, 26, 0, 6, z); SOL_F(30, 27, 0, 6, w);
        SOL_F(30, 28, 0, 7, x); SOL_F(30, 29, 0, 7, y);
        SOL_F(31, 0, 0, 8, x); SOL_F(31, 1, 0, 8, y); SOL_F(31, 2, 0, 8, z); SOL_F(31, 3, 0, 8, w);
        SOL_F(31, 4, 0, 9, x); SOL_F(31, 5, 0, 9, y); SOL_F(31, 6, 0, 9, z); SOL_F(31, 7, 0, 9, w);
        SOL_F(31, 8, 0, 10, x); SOL_F(31, 9, 0, 10, y); SOL_F(31, 10, 0, 10, z); SOL_F(31, 11, 0, 10, w);
        SOL_F(31, 12, 0, 11, x); SOL_F(31, 13, 0, 11, y); SOL_F(31, 14, 0, 11, z); SOL_F(31, 15, 0, 11, w);
        __builtin_amdgcn_sched_barrier(0);
        SOL_L(0, 0, 2244); SOL_L(0, 1, 2248); SOL_L(0, 2, 2252); SOL_L(0, 3, 2256); SOL_L(0, 4, 2260); SOL_L(0, 5, 2264); SOL_L(0, 6, 2268); SOL_L(0, 7, 2272); SOL_L(0, 8, 2276); SOL_L(0, 9, 2312); SOL_L(0, 10, 2316); SOL_L(0, 11, 2320);
        __builtin_amdgcn_sched_barrier(0);
        SOL_F(31, 16, 1, 0, x); SOL_F(31, 17, 1, 0, y); SOL_F(31, 18, 1, 0, z); SOL_F(31, 19, 1, 0, w);
        SOL_F(31, 20, 1, 1, x); SOL_F(31, 21, 1, 1, y); SOL_F(31, 22, 1, 1, z); SOL_F(31, 23, 1, 1, w);
        SOL_F(31, 24, 1, 2, x); SOL_F(31, 25, 1, 2, y); SOL_F(31, 26, 1, 2, z); SOL_F(31, 27, 1, 2, w);
        SOL_F(31, 28, 1, 3, x); SOL_F(31, 29, 1, 3, y); SOL_F(31, 30, 1, 3, z);
        SOL_F(32, 0, 1, 4, x); SOL_F(32, 1, 1, 4, y); SOL_F(32, 2, 1, 4, z); SOL_F(32, 3, 1, 4, w);
        SOL_F(32, 4, 1, 5, x); SOL_F(32, 5, 1, 5, y); SOL_F(32, 6, 1, 5, z); SOL_F(32, 7, 1, 5, w);
        SOL_F(32, 8, 1, 6, x); SOL_F(32, 9, 1, 6, y); SOL_F(32, 10, 1, 6, z); SOL_F(32, 11, 1, 6, w);
        SOL_F(32, 12, 1, 7, x); SOL_F(32, 13, 1, 7, y); SOL_F(32, 14, 1, 7, z); SOL_F(32, 15, 1, 7, w);
        SOL_F(32, 16, 1, 8, x); SOL_F(32, 17, 1, 8, y); SOL_F(32, 18, 1, 8, z); SOL_F(32, 19, 1, 8, w);
        SOL_F(32, 20, 1, 9, x); SOL_F(32, 21, 1, 9, y); SOL_F(32, 22, 1, 9, z); SOL_F(32, 23, 1, 9, w);
        SOL_F(32, 24, 1, 10, x); SOL_F(32, 25, 1, 10, y); SOL_F(32, 26, 1, 10, z); SOL_F(32, 27, 1, 10, w);
        SOL_F(32, 28, 1, 11, x); SOL_F(32, 29, 1, 11, y); SOL_F(32, 30, 1, 11, z); SOL_F(32, 31, 1, 11, w);
        __builtin_amdgcn_sched_barrier(0);
        __syncthreads();
        SOL_L(1, 0, 2324); SOL_L(1, 1, 2328); SOL_L(1, 2, 2332); SOL_L(1, 3, 2336); SOL_L(1, 4, 2340); SOL_L(1, 5, 2344); SOL_L(1, 6, 2380); SOL_L(1, 7, 2384); SOL_L(1, 8, 2388); SOL_L(1, 9, 2392); SOL_L(1, 10, 2396); SOL_L(1, 11, 2400);
        __builtin_amdgcn_sched_barrier(0);
        SOL_F(33, 0, 0, 0, x); SOL_F(33, 1, 0, 0, y); SOL_F(33, 2, 0, 0, z); SOL_F(33, 3, 0, 0, w);
        SOL_F(33, 4, 0, 1, x); SOL_F(33, 5, 0, 1, y); SOL_F(33, 6, 0, 1, z); SOL_F(33, 7, 0, 1, w);
        SOL_F(33, 8, 0, 2, x); SOL_F(33, 9, 0, 2, y); SOL_F(33, 10, 0, 2, z); SOL_F(33, 11, 0, 2, w);
        SOL_F(33, 12, 0, 3, x); SOL_F(33, 13, 0, 3, y); SOL_F(33, 14, 0, 3, z); SOL_F(33, 15, 0, 3, w);
        SOL_F(33, 16, 0, 4, x); SOL_F(33, 17, 0, 4, y); SOL_F(33, 18, 0, 4, z); SOL_F(33, 19, 0, 4, w);
        SOL_F(33, 20, 0, 5, x); SOL_F(33, 21, 0, 5, y); SOL_F(33, 22, 0, 5, z); SOL_F(33, 23, 0, 5, w);
        SOL_F(33, 24, 0, 6, x); SOL_F(33, 25, 0, 6, y); SOL_F(33, 26, 0, 6, z); SOL_F(33, 27, 0, 6, w);
        SOL_F(33, 28, 0, 7, x); SOL_F(33, 29, 0, 7, y); SOL_F(33, 30, 0, 7, z); SOL_F(33, 31, 0, 7, w);
        SOL_F(33, 32, 0, 8, x);
        SOL_F(34, 0, 0, 9, x); SOL_F(34, 1, 0, 9, y); SOL_F(34, 2, 0, 9, z); SOL_F(34, 3, 0, 9, w);
        SOL_F(34, 4, 0, 10, x); SOL_F(34, 5, 0, 10, y); SOL_F(34, 6, 0, 10, z); SOL_F(34, 7, 0, 10, w);
        SOL_F(34, 8, 0, 11, x); SOL_F(34, 9, 0, 11, y); SOL_F(34, 10, 0, 11, z); SOL_F(34, 11, 0, 11, w);
        __builtin_amdgcn_sched_barrier(0);
        SOL_L(0, 0, 2404); SOL_L(0, 1, 2408); SOL_L(0, 2, 2412); SOL_L(0, 3, 2448); SOL_L(0, 4, 2452); SOL_L(0, 5, 2456); SOL_L(0, 6, 2460); SOL_L(0, 7, 2464); SOL_L(0, 8, 2468); SOL_L(0, 9, 2472); SOL_L(0, 10, 2476); SOL_L(0, 11, 2480);
        __builtin_amdgcn_sched_barrier(0);
        SOL_F(34, 12, 1, 0, x); SOL_F(34, 13, 1, 0, y); SOL_F(34, 14, 1, 0, z); SOL_F(34, 15, 1, 0, w);
        SOL_F(34, 16, 1, 1, x); SOL_F(34, 17, 1, 1, y); SOL_F(34, 18, 1, 1, z); SOL_F(34, 19, 1, 1, w);
        SOL_F(34, 20, 1, 2, x); SOL_F(34, 21, 1, 2, y); SOL_F(34, 22, 1, 2, z); SOL_F(34, 23, 1, 2, w);
        SOL_F(34, 24, 1, 3, x); SOL_F(34, 25, 1, 3, y); SOL_F(34, 26, 1, 3, z); SOL_F(34, 27, 1, 3, w);
        SOL_F(34, 28, 1, 4, x); SOL_F(34, 29, 1, 4, y); SOL_F(34, 30, 1, 4, z); SOL_F(34, 31, 1, 4, w);
        SOL_F(34, 32, 1, 5, x); SOL_F(34, 33, 1, 5, y);
        SOL_F(35, 0, 1, 6, x); SOL_F(35, 1, 1, 6, y); SOL_F(35, 2, 1, 6, z); SOL_F(35, 3, 1, 6, w);
        SOL_F(35, 4, 1, 7, x); SOL_F(35, 5, 1, 7, y); SOL_F(35, 6, 1, 7, z); SOL_F(35, 7, 1, 7, w);
        SOL_F(35, 8, 1, 8, x); SOL_F(35, 9, 1, 8, y); SOL_F(35, 10, 1, 8, z); SOL_F(35, 11, 1, 8, w);
        SOL_F(35, 12, 1, 9, x); SOL_F(35, 13, 1, 9, y); SOL_F(35, 14, 1, 9, z); SOL_F(35, 15, 1, 9, w);
        SOL_F(35, 16, 1, 10, x); SOL_F(35, 17, 1, 10, y); SOL_F(35, 18, 1, 10, z); SOL_F(35, 19, 1, 10, w);
        SOL_F(35, 20, 1, 11, x); SOL_F(35, 21, 1, 11, y); SOL_F(35, 22, 1, 11, z); SOL_F(35, 23, 1, 11, w);
        __builtin_amdgcn_sched_barrier(0);
        SOL_L(1, 0, 2516); SOL_L(1, 1, 2520); SOL_L(1, 2, 2524); SOL_L(1, 3, 2528); SOL_L(1, 4, 2532); SOL_L(1, 5, 2536); SOL_L(1, 6, 2540); SOL_L(1, 7, 2544); SOL_L(1, 8, 2548); SOL_L(1, 9, 2552); SOL_L(1, 10, 2584); SOL_L(1, 11, 2588);
        __builtin_amdgcn_sched_barrier(0);
        SOL_F(35, 24, 0, 0, x); SOL_F(35, 25, 0, 0, y); SOL_F(35, 26, 0, 0, z); SOL_F(35, 27, 0, 0, w);
        SOL_F(35, 28, 0, 1, x); SOL_F(35, 29, 0, 1, y); SOL_F(35, 30, 0, 1, z); SOL_F(35, 31, 0, 1, w);
        SOL_F(35, 32, 0, 2, x); SOL_F(35, 33, 0, 2, y); SOL_F(35, 34, 0, 2, z);
        SOL_F(36, 0, 0, 3, x); SOL_F(36, 1, 0, 3, y); SOL_F(36, 2, 0, 3, z); SOL_F(36, 3, 0, 3, w);
        SOL_F(36, 4, 0, 4, x); SOL_F(36, 5, 0, 4, y); SOL_F(36, 6, 0, 4, z); SOL_F(36, 7, 0, 4, w);
        SOL_F(36, 8, 0, 5, x); SOL_F(36, 9, 0, 5, y); SOL_F(36, 10, 0, 5, z); SOL_F(36, 11, 0, 5, w);
        SOL_F(36, 12, 0, 6, x); SOL_F(36, 13, 0, 6, y); SOL_F(36, 14, 0, 6, z); SOL_F(36, 15, 0, 6, w);
        SOL_F(36, 16, 0, 7, x); SOL_F(36, 17, 0, 7, y); SOL_F(36, 18, 0, 7, z); SOL_F(36, 19, 0, 7, w);
        SOL_F(36, 20, 0, 8, x); SOL_F(36, 21, 0, 8, y); SOL_F(36, 22, 0, 8, z); SOL_F(36, 23, 0, 8, w);
        SOL_F(36, 24, 0, 9, x); SOL_F(36, 25, 0, 9, y); SOL_F(36, 26, 0, 9, z); SOL_F(36, 27, 0, 9, w);
        SOL_F(36, 28, 0, 10, x); SOL_F(36, 29, 0, 10, y); SOL_F(36, 30, 0, 10, z); SOL_F(36, 31, 0, 10, w);
        SOL_F(36, 32, 0, 11, x); SOL_F(36, 33, 0, 11, y); SOL_F(36, 34, 0, 11, z); SOL_F(36, 35, 0, 11, w);
        __builtin_amdgcn_sched_barrier(0);
        SOL_L(0, 0, 2592); SOL_L(0, 1, 2596); SOL_L(0, 2, 2600); SOL_L(0, 3, 2604); SOL_L(0, 4, 2608); SOL_L(0, 5, 2612); SOL_L(0, 6, 2616); SOL_L(0, 7, 2620); SOL_L(0, 8, 2652); SOL_L(0, 9, 2656); SOL_L(0, 10, 2660); SOL_L(0, 11, 2664);
        __builtin_amdgcn_sched_barrier(0);
        SOL_F(37, 0, 1, 0, x); SOL_F(37, 1, 1, 0, y); SOL_F(37, 2, 1, 0, z); SOL_F(37, 3, 1, 0, w);
        SOL_F(37, 4, 1, 1, x); SOL_F(37, 5, 1, 1, y); SOL_F(37, 6, 1, 1, z); SOL_F(37, 7, 1, 1, w);
        SOL_F(37, 8, 1, 2, x); SOL_F(37, 9, 1, 2, y); SOL_F(37, 10, 1, 2, z); SOL_F(37, 11, 1, 2, w);
        SOL_F(37, 12, 1, 3, x); SOL_F(37, 13, 1, 3, y); SOL_F(37, 14, 1, 3, z); SOL_F(37, 15, 1, 3, w);
        SOL_F(37, 16, 1, 4, x); SOL_F(37, 17, 1, 4, y); SOL_F(37, 18, 1, 4, z); SOL_F(37, 19, 1, 4, w);
        SOL_F(37, 20, 1, 5, x); SOL_F(37, 21, 1, 5, y); SOL_F(37, 22, 1, 5, z); SOL_F(37, 23, 1, 5, w);
        SOL_F(37, 24, 1, 6, x); SOL_F(37, 25, 1, 6, y); SOL_F(37, 26, 1, 6, z); SOL_F(37, 27, 1, 6, w);
        SOL_F(37, 28, 1, 7, x); SOL_F(37, 29, 1, 7, y); SOL_F(37, 30, 1, 7, z); SOL_F(37, 31, 1, 7, w);
        SOL_F(37, 32, 1, 8, x); SOL_F(37, 33, 1, 8, y); SOL_F(37, 34, 1, 8, z); SOL_F(37, 35, 1, 8, w);
        SOL_F(37, 36, 1, 9, x);
        SOL_F(38, 0, 1, 10, x); SOL_F(38, 1, 1, 10, y); SOL_F(38, 2, 1, 10, z); SOL_F(38, 3, 1, 10, w);
        SOL_F(38, 4, 1, 11, x); SOL_F(38, 5, 1, 11, y); SOL_F(38, 6, 1, 11, z); SOL_F(38, 7, 1, 11, w);
        __builtin_amdgcn_sched_barrier(0);
        SOL_L(1, 0, 2668); SOL_L(1, 1, 2672); SOL_L(1, 2, 2676); SOL_L(1, 3, 2680); SOL_L(1, 4, 2684); SOL_L(1, 5, 2688); SOL_L(1, 6, 2720); SOL_L(1, 7, 2724); SOL_L(1, 8, 2728); SOL_L(1, 9, 2732); SOL_L(1, 10, 2736); SOL_L(1, 11, 2740);
        __builtin_amdgcn_sched_barrier(0);
        SOL_F(38, 8, 0, 0, x); SOL_F(38, 9, 0, 0, y); SOL_F(38, 10, 0, 0, z); SOL_F(38, 11, 0, 0, w);
        SOL_F(38, 12, 0, 1, x); SOL_F(38, 13, 0, 1, y); SOL_F(38, 14, 0, 1, z); SOL_F(38, 15, 0, 1, w);
        SOL_F(38, 16, 0, 2, x); SOL_F(38, 17, 0, 2, y); SOL_F(38, 18, 0, 2, z); SOL_F(38, 19, 0, 2, w);
        SOL_F(38, 20, 0, 3, x); SOL_F(38, 21, 0, 3, y); SOL_F(38, 22, 0, 3, z); SOL_F(38, 23, 0, 3, w);
        SOL_F(38, 24, 0, 4, x); SOL_F(38, 25, 0, 4, y); SOL_F(38, 26, 0, 4, z); SOL_F(38, 27, 0, 4, w);
        SOL_F(38, 28, 0, 5, x); SOL_F(38, 29, 0, 5, y); SOL_F(38, 30, 0, 5, z); SOL_F(38, 31, 0, 5, w);
        SOL_F(38, 32, 0, 6, x); SOL_F(38, 33, 0, 6, y); SOL_F(38, 34, 0, 6, z); SOL_F(38, 35, 0, 6, w);
        SOL_F(38, 36, 0, 7, x); SOL_F(38, 37, 0, 7, y);
        SOL_F(39, 0, 0, 8, x); SOL_F(39, 1, 0, 8, y); SOL_F(39, 2, 0, 8, z); SOL_F(39, 3, 0, 8, w);
        SOL_F(39, 4, 0, 9, x); SOL_F(39, 5, 0, 9, y); SOL_F(39, 6, 0, 9, z); SOL_F(39, 7, 0, 9, w);
        SOL_F(39, 8, 0, 10, x); SOL_F(39, 9, 0, 10, y); SOL_F(39, 10, 0, 10, z); SOL_F(39, 11, 0, 10, w);
        SOL_F(39, 12, 0, 11, x); SOL_F(39, 13, 0, 11, y); SOL_F(39, 14, 0, 11, z); SOL_F(39, 15, 0, 11, w);
        __builtin_amdgcn_sched_barrier(0);
        SOL_L(0, 0, 2744); SOL_L(0, 1, 2748); SOL_L(0, 2, 2752); SOL_L(0, 3, 2756); SOL_L(0, 4, 2788); SOL_L(0, 5, 2792); SOL_L(0, 6, 2796); SOL_L(0, 7, 2800); SOL_L(0, 8, 2804); SOL_L(0, 9, 2808); SOL_L(0, 10, 2812); SOL_L(0, 11, 2816);
        __builtin_amdgcn_sched_barrier(0);
        SOL_F(39, 16, 1, 0, x); SOL_F(39, 17, 1, 0, y); SOL_F(39, 18, 1, 0, z); SOL_F(39, 19, 1, 0, w);
        SOL_F(39, 20, 1, 1, x); SOL_F(39, 21, 1, 1, y); SOL_F(39, 22, 1, 1, z); SOL_F(39, 23, 1, 1, w);
        SOL_F(39, 24, 1, 2, x); SOL_F(39, 25, 1, 2, y); SOL_F(39, 26, 1, 2, z); SOL_F(39, 27, 1, 2, w);
        SOL_F(39, 28, 1, 3, x); SOL_F(39, 29, 1, 3, y); SOL_F(39, 30, 1, 3, z); SOL_F(39, 31, 1, 3, w);
        SOL_F(39, 32, 1, 4, x); SOL_F(39, 33, 1, 4, y); SOL_F(39, 34, 1, 4, z); SOL_F(39, 35, 1, 4, w);
        SOL_F(39, 36, 1, 5, x); SOL_F(39, 37, 1, 5, y); SOL_F(39, 38, 1, 5, z);
        SOL_F(40, 0, 1, 6, x); SOL_F(40, 1, 1, 6, y); SOL_F(40, 2, 1, 6, z); SOL_F(40, 3, 1, 6, w);
        SOL_F(40, 4, 1, 7, x); SOL_F(40, 5, 1, 7, y); SOL_F(40, 6, 1, 7, z); SOL_F(40, 7, 1, 7, w);
        SOL_F(40, 8, 1, 8, x); SOL_F(40, 9, 1, 8, y); SOL_F(40, 10, 1, 8, z); SOL_F(40, 11, 1, 8, w);
        SOL_F(40, 12, 1, 9, x); SOL_F(40, 13, 1, 9, y); SOL_F(40, 14, 1, 9, z); SOL_F(40, 15, 1, 9, w);
        SOL_F(40, 16, 1, 10, x); SOL_F(40, 17, 1, 10, y); SOL_F(40, 18, 1, 10, z); SOL_F(40, 19, 1, 10, w);
        SOL_F(40, 20, 1, 11, x); SOL_F(40, 21, 1, 11, y); SOL_F(40, 22, 1, 11, z); SOL_F(40, 23, 1, 11, w);
        __builtin_amdgcn_sched_barrier(0);
        SOL_L(1, 0, 2820); SOL_L(1, 1, 2824); SOL_L(1, 2, 2828); SOL_L(1, 3, 2856); SOL_L(1, 4, 2860); SOL_L(1, 5, 2864); SOL_L(1, 6, 2868); SOL_L(1, 7, 2872); SOL_L(1, 8, 2876); SOL_L(1, 9, 2880); SOL_L(1, 10, 2884); SOL_L(1, 11, 2888);
        __builtin_amdgcn_sched_barrier(0);
        SOL_F(40, 24, 0, 0, x); SOL_F(40, 25, 0, 0, y); SOL_F(40, 26, 0, 0, z); SOL_F(40, 27, 0, 0, w);
        SOL_F(40, 28, 0, 1, x); SOL_F(40, 29, 0, 1, y); SOL_F(40, 30, 0, 1, z); SOL_F(40, 31, 0, 1, w);
        SOL_F(40, 32, 0, 2, x); SOL_F(40, 33, 0, 2, y); SOL_F(40, 34, 0, 2, z); SOL_F(40, 35, 0, 2, w);
        SOL_F(40, 36, 0, 3, x); SOL_F(40, 37, 0, 3, y); SOL_F(40, 38, 0, 3, z); SOL_F(40, 39, 0, 3, w);
        SOL_F(41, 0, 0, 4, x); SOL_F(41, 1, 0, 4, y); SOL_F(41, 2, 0, 4, z); SOL_F(41, 3, 0, 4, w);
        SOL_F(41, 4, 0, 5, x); SOL_F(41, 5, 0, 5, y); SOL_F(41, 6, 0, 5, z); SOL_F(41, 7, 0, 5, w);
        SOL_F(41, 8, 0, 6, x); SOL_F(41, 9, 0, 6, y); SOL_F(41, 10, 0, 6, z); SOL_F(41, 11, 0, 6, w);
        SOL_F(41, 12, 0, 7, x); SOL_F(41, 13, 0, 7, y); SOL_F(41, 14, 0, 7, z); SOL_F(41, 15, 0, 7, w);
        SOL_F(41, 16, 0, 8, x); SOL_F(41, 17, 0, 8, y); SOL_F(41, 18, 0, 8, z); SOL_F(41, 19, 0, 8, w);
        SOL_F(41, 20, 0, 9, x); SOL_F(41, 21, 0, 9, y); SOL_F(41, 22, 0, 9, z); SOL_F(41, 23, 0, 9, w);
        SOL_F(41, 24, 0, 10, x); SOL_F(41, 25, 0, 10, y); SOL_F(41, 26, 0, 10, z); SOL_F(41, 27, 0, 10, w);
        SOL_F(41, 28, 0, 11, x); SOL_F(41, 29, 0, 11, y); SOL_F(41, 30, 0, 11, z); SOL_F(41, 31, 0, 11, w);
        __builtin_amdgcn_sched_barrier(0);
        SOL_L(0, 0, 2892); SOL_L(0, 1, 2896); SOL_L(0, 2, 2924); SOL_L(0, 3, 2928); SOL_L(0, 4, 2932); SOL_L(0, 5, 2936); SOL_L(0, 6, 2940); SOL_L(0, 7, 2944); SOL_L(0, 8, 2948); SOL_L(0, 9, 2952); SOL_L(0, 10, 2956); SOL_L(0, 11, 2960);
        __builtin_amdgcn_sched_barrier(0);
        SOL_F(41, 32, 1, 0, x); SOL_F(41, 33, 1, 0, y); SOL_F(41, 34, 1, 0, z); SOL_F(41, 35, 1, 0, w);
        SOL_F(41, 36, 1, 1, x); SOL_F(41, 37, 1, 1, y); SOL_F(41, 38, 1, 1, z); SOL_F(41, 39, 1, 1, w);
        SOL_F(41, 40, 1, 2, x);
        SOL_F(42, 0, 1, 3, x); SOL_F(42, 1, 1, 3, y); SOL_F(42, 2, 1, 3, z); SOL_F(42, 3, 1, 3, w);
        SOL_F(42, 4, 1, 4, x); SOL_F(42, 5, 1, 4, y); SOL_F(42, 6, 1, 4, z); SOL_F(42, 7, 1, 4, w);
        SOL_F(42, 8, 1, 5, x); SOL_F(42, 9, 1, 5, y); SOL_F(42, 10, 1, 5, z); SOL_F(42, 11, 1, 5, w);
        SOL_F(42, 12, 1, 6, x); SOL_F(42, 13, 1, 6, y); SOL_F(42, 14, 1, 6, z); SOL_F(42, 15, 1, 6, w);
        SOL_F(42, 16, 1, 7, x); SOL_F(42, 17, 1, 7, y); SOL_F(42, 18, 1, 7, z); SOL_F(42, 19, 1, 7, w);
        SOL_F(42, 20, 1, 8, x); SOL_F(42, 21, 1, 8, y); SOL_F(42, 22, 1, 8, z); SOL_F(42, 23, 1, 8, w);
        SOL_F(42, 24, 1, 9, x); SOL_F(42, 25, 1, 9, y); SOL_F(42, 26, 1, 9, z); SOL_F(42, 27, 1, 9, w);
        SOL_F(42, 28, 1, 10, x); SOL_F(42, 29, 1, 10, y); SOL_F(42, 30, 1, 10, z); SOL_F(42, 31, 1, 10, w);
        SOL_F(42, 32, 1, 11, x); SOL_F(42, 33, 1, 11, y); SOL_F(42, 34, 1, 11, z); SOL_F(42, 35, 1, 11, w);
        __builtin_amdgcn_sched_barrier(0);
        SOL_L(1, 0, 2964); SOL_L(1, 1, 2992); SOL_L(1, 2, 2996); SOL_L(1, 3, 3000); SOL_L(1, 4, 3004); SOL_L(1, 5, 3008); SOL_L(1, 6, 3012); SOL_L(1, 7, 3016); SOL_L(1, 8, 3020); SOL_L(1, 9, 3024); SOL_L(1, 10, 3028); SOL_L(1, 11, 3032);
        __builtin_amdgcn_sched_barrier(0);
        SOL_F(42, 36, 0, 0, x); SOL_F(42, 37, 0, 0, y); SOL_F(42, 38, 0, 0, z); SOL_F(42, 39, 0, 0, w);
        SOL_F(42, 40, 0, 1, x); SOL_F(42, 41, 0, 1, y);
        SOL_F(43, 0, 0, 2, x); SOL_F(43, 1, 0, 2, y); SOL_F(43, 2, 0, 2, z); SOL_F(43, 3, 0, 2, w);
        SOL_F(43, 4, 0, 3, x); SOL_F(43, 5, 0, 3, y); SOL_F(43, 6, 0, 3, z); SOL_F(43, 7, 0, 3, w);
        SOL_F(43, 8, 0, 4, x); SOL_F(43, 9, 0, 4, y); SOL_F(43, 10, 0, 4, z); SOL_F(43, 11, 0, 4, w);
        SOL_F(43, 12, 0, 5, x); SOL_F(43, 13, 0, 5, y); SOL_F(43, 14, 0, 5, z); SOL_F(43, 15, 0, 5, w);
        SOL_F(43, 16, 0, 6, x); SOL_F(43, 17, 0, 6, y); SOL_F(43, 18, 0, 6, z); SOL_F(43, 19, 0, 6, w);
        SOL_F(43, 20, 0, 7, x); SOL_F(43, 21, 0, 7, y); SOL_F(43, 22, 0, 7, z); SOL_F(43, 23, 0, 7, w);
        SOL_F(43, 24, 0, 8, x); SOL_F(43, 25, 0, 8, y); SOL_F(43, 26, 0, 8, z); SOL_F(43, 27, 0, 8, w);
        SOL_F(43, 28, 0, 9, x); SOL_F(43, 29, 0, 9, y); SOL_F(43, 30, 0, 9, z); SOL_F(43, 31, 0, 9, w);
        SOL_F(43, 32, 0, 10, x); SOL_F(43, 33, 0, 10, y); SOL_F(43, 34, 0, 10, z); SOL_F(43, 35, 0, 10, w);
        SOL_F(43, 36, 0, 11, x); SOL_F(43, 37, 0, 11, y); SOL_F(43, 38, 0, 11, z); SOL_F(43, 39, 0, 11, w);
        __builtin_amdgcn_sched_barrier(0);
        SOL_L(0, 0, 3060); SOL_L(0, 1, 3064); SOL_L(0, 2, 3068); SOL_L(0, 3, 3072); SOL_L(0, 4, 3076); SOL_L(0, 5, 3080); SOL_L(0, 6, 3084); SOL_L(0, 7, 3088); SOL_L(0, 8, 3092); SOL_L(0, 9, 3096); SOL_L(0, 10, 3100); SOL_L(0, 11, 3104);
        __builtin_amdgcn_sched_barrier(0);
        SOL_F(43, 40, 1, 0, x); SOL_F(43, 41, 1, 0, y); SOL_F(43, 42, 1, 0, z);
        SOL_F(44, 0, 1, 1, x); SOL_F(44, 1, 1, 1, y); SOL_F(44, 2, 1, 1, z); SOL_F(44, 3, 1, 1, w);
        SOL_F(44, 4, 1, 2, x); SOL_F(44, 5, 1, 2, y); SOL_F(44, 6, 1, 2, z); SOL_F(44, 7, 1, 2, w);
        SOL_F(44, 8, 1, 3, x); SOL_F(44, 9, 1, 3, y); SOL_F(44, 10, 1, 3, z); SOL_F(44, 11, 1, 3, w);
        SOL_F(44, 12, 1, 4, x); SOL_F(44, 13, 1, 4, y); SOL_F(44, 14, 1, 4, z); SOL_F(44, 15, 1, 4, w);
        SOL_F(44, 16, 1, 5, x); SOL_F(44, 17, 1, 5, y); SOL_F(44, 18, 1, 5, z); SOL_F(44, 19, 1, 5, w);
        SOL_F(44, 20, 1, 6, x); SOL_F(44, 21, 1, 6, y); SOL_F(44, 22, 1, 6, z); SOL_F(44, 23, 1, 6, w);
        SOL_F(44, 24, 1, 7, x); SOL_F(44, 25, 1, 7, y); SOL_F(44, 26, 1, 7, z); SOL_F(44, 27, 1, 7, w);
        SOL_F(44, 28, 1, 8, x); SOL_F(44, 29, 1, 8, y); SOL_F(44, 30, 1, 8, z); SOL_F(44, 31, 1, 8, w);
        SOL_F(44, 32, 1, 9, x); SOL_F(44, 33, 1, 9, y); SOL_F(44, 34, 1, 9, z); SOL_F(44, 35, 1, 9, w);
        SOL_F(44, 36, 1, 10, x); SOL_F(44, 37, 1, 10, y); SOL_F(44, 38, 1, 10, z); SOL_F(44, 39, 1, 10, w);
        SOL_F(44, 40, 1, 11, x); SOL_F(44, 41, 1, 11, y); SOL_F(44, 42, 1, 11, z); SOL_F(44, 43, 1, 11, w);
        __builtin_amdgcn_sched_barrier(0);
        SOL_L(1, 0, 3128); SOL_L(1, 1, 3132); SOL_L(1, 2, 3136); SOL_L(1, 3, 3140); SOL_L(1, 4, 3144); SOL_L(1, 5, 3148); SOL_L(1, 6, 3152); SOL_L(1, 7, 3156); SOL_L(1, 8, 3160); SOL_L(1, 9, 3164); SOL_L(1, 10, 3168); SOL_L(1, 11, 3172);
        __builtin_amdgcn_sched_barrier(0);
        SOL_F(45, 0, 0, 0, x); SOL_F(45, 1, 0, 0, y); SOL_F(45, 2, 0, 0, z); SOL_F(45, 3, 0, 0, w);
        SOL_F(45, 4, 0, 1, x); SOL_F(45, 5, 0, 1, y); SOL_F(45, 6, 0, 1, z); SOL_F(45, 7, 0, 1, w);
        SOL_F(45, 8, 0, 2, x); SOL_F(45, 9, 0, 2, y); SOL_F(45, 10, 0, 2, z); SOL_F(45, 11, 0, 2, w);
        SOL_F(45, 12, 0, 3, x); SOL_F(45, 13, 0, 3, y); SOL_F(45, 14, 0, 3, z); SOL_F(45, 15, 0, 3, w);
        SOL_F(45, 16, 0, 4, x); SOL_F(45, 17, 0, 4, y); SOL_F(45, 18, 0, 4, z); SOL_F(45, 19, 0, 4, w);
        SOL_F(45, 20, 0, 5, x); SOL_F(45, 21, 0, 5, y); SOL_F(45, 22, 0, 5, z); SOL_F(45, 23, 0, 5, w);
        SOL_F(45, 24, 0, 6, x); SOL_F(45, 25, 0, 6, y); SOL_F(45, 26, 0, 6, z); SOL_F(45, 27, 0, 6, w);
        SOL_F(45, 28, 0, 7, x); SOL_F(45, 29, 0, 7, y); SOL_F(45, 30, 0, 7, z); SOL_F(45, 31, 0, 7, w);
        SOL_F(45, 32, 0, 8, x); SOL_F(45, 33, 0, 8, y); SOL_F(45, 34, 0, 8, z); SOL_F(45, 35, 0, 8, w);
        SOL_F(45, 36, 0, 9, x); SOL_F(45, 37, 0, 9, y); SOL_F(45, 38, 0, 9, z); SOL_F(45, 39, 0, 9, w);
        SOL_F(45, 40, 0, 10, x); SOL_F(45, 41, 0, 10, y); SOL_F(45, 42, 0, 10, z); SOL_F(45, 43, 0, 10, w);
        SOL_F(45, 44, 0, 11, x);
        __builtin_amdgcn_sched_barrier(0);
        SOL_L(0, 0, 3196); SOL_L(0, 1, 3200); SOL_L(0, 2, 3204); SOL_L(0, 3, 3208); SOL_L(0, 4, 3212); SOL_L(0, 5, 3216); SOL_L(0, 6, 3220); SOL_L(0, 7, 3224); SOL_L(0, 8, 3228); SOL_L(0, 9, 3232); SOL_L(0, 10, 3236); SOL_L(0, 11, 3240);
        __builtin_amdgcn_sched_barrier(0);
        SOL_F(46, 0, 1, 0, x); SOL_F(46, 1, 1, 0, y); SOL_F(46, 2, 1, 0, z); SOL_F(46, 3, 1, 0, w);
        SOL_F(46, 4, 1, 1, x); SOL_F(46, 5, 1, 1, y); SOL_F(46, 6, 1, 1, z); SOL_F(46, 7, 1, 1, w);
        SOL_F(46, 8, 1, 2, x); SOL_F(46, 9, 1, 2, y); SOL_F(46, 10, 1, 2, z); SOL_F(46, 11, 1, 2, w);
        SOL_F(46, 12, 1, 3, x); SOL_F(46, 13, 1, 3, y); SOL_F(46, 14, 1, 3, z); SOL_F(46, 15, 1, 3, w);
        SOL_F(46, 16, 1, 4, x); SOL_F(46, 17, 1, 4, y); SOL_F(46, 18, 1, 4, z); SOL_F(46, 19, 1, 4, w);
        SOL_F(46, 20, 1, 5, x); SOL_F(46, 21, 1, 5, y); SOL_F(46, 22, 1, 5, z); SOL_F(46, 23, 1, 5, w);
        SOL_F(46, 24, 1, 6, x); SOL_F(46, 25, 1, 6, y); SOL_F(46, 26, 1, 6, z); SOL_F(46, 27, 1, 6, w);
        SOL_F(46, 28, 1, 7, x); SOL_F(46, 29, 1, 7, y); SOL_F(46, 30, 1, 7, z); SOL_F(46, 31, 1, 7, w);
        SOL_F(46, 32, 1, 8, x); SOL_F(46, 33, 1, 8, y); SOL_F(46, 34, 1, 8, z); SOL_F(46, 35, 1, 8, w);
        SOL_F(46, 36, 1, 9, x); SOL_F(46, 37, 1, 9, y); SOL_F(46, 38, 1, 9, z); SOL_F(46, 39, 1, 9, w);
        SOL_F(46, 40, 1, 10, x); SOL_F(46, 41, 1, 10, y); SOL_F(46, 42, 1, 10, z); SOL_F(46, 43, 1, 10, w);
        SOL_F(46, 44, 1, 11, x); SOL_F(46, 45, 1, 11, y);
        __builtin_amdgcn_sched_barrier(0);
        SOL_L(1, 0, 3264); SOL_L(1, 1, 3268); SOL_L(1, 2, 3272); SOL_L(1, 3, 3276); SOL_L(1, 4, 3280); SOL_L(1, 5, 3284); SOL_L(1, 6, 3288); SOL_L(1, 7, 3292); SOL_L(1, 8, 3296); SOL_L(1, 9, 3300); SOL_L(1, 10, 3304); SOL_L(1, 11, 3308);
        __builtin_amdgcn_sched_barrier(0);
        SOL_F(47, 0, 0, 0, x); SOL_F(47, 1, 0, 0, y); SOL_F(47, 2, 0, 0, z); SOL_F(47, 3, 0, 0, w);
        SOL_F(47, 4, 0, 1, x); SOL_F(47, 5, 0, 1, y); SOL_F(47, 6, 0, 1, z); SOL_F(47, 7, 0, 1, w);
        SOL_F(47, 8, 0, 2, x); SOL_F(47, 9, 0, 2, y); SOL_F(47, 10, 0, 2, z); SOL_F(47, 11, 0, 2, w);
        SOL_F(47, 12, 0, 3, x); SOL_F(47, 13, 0, 3, y); SOL_F(47, 14, 0, 3, z); SOL_F(47, 15, 0, 3, w);
        SOL_F(47, 16, 0, 4, x); SOL_F(47, 17, 0, 4, y); SOL_F(47, 18, 0, 4, z); SOL_F(47, 19, 0, 4, w);
        SOL_F(47, 20, 0, 5, x); SOL_F(47, 21, 0, 5, y); SOL_F(47, 22, 0, 5, z); SOL_F(47, 23, 0, 5, w);
        SOL_F(47, 24, 0, 6, x); SOL_F(47, 25, 0, 6, y); SOL_F(47, 26, 0, 6, z); SOL_F(47, 27, 0, 6, w);
        SOL_F(47, 28, 0, 7, x); SOL_F(47, 29, 0, 7, y); SOL_F(47, 30, 0, 7, z); SOL_F(47, 31, 0, 7, w);
        SOL_F(47, 32, 0, 8, x); SOL_F(47, 33, 0, 8, y); SOL_F(47, 34, 0, 8, z); SOL_F(47, 35, 0, 8, w);
        SOL_F(47, 36, 0, 9, x); SOL_F(47, 37, 0, 9, y); SOL_F(47, 38, 0, 9, z); SOL_F(47, 39, 0, 9, w);
        SOL_F(47, 40, 0, 10, x); SOL_F(47, 41, 0, 10, y); SOL_F(47, 42, 0, 10, z); SOL_F(47, 43, 0, 10, w);
        SOL_F(47, 44, 0, 11, x); SOL_F(47, 45, 0, 11, y); SOL_F(47, 46, 0, 11, z);
        __builtin_amdgcn_sched_barrier(0);
        SOL_L(0, 0, 3332); SOL_L(0, 1, 3336); SOL_L(0, 2, 3340); SOL_L(0, 3, 3344); SOL_L(0, 4, 3348); SOL_L(0, 5, 3352); SOL_L(0, 6, 3356); SOL_L(0, 7, 3360); SOL_L(0, 8, 3364); SOL_L(0, 9, 3368); SOL_L(0, 10, 3372); SOL_L(0, 11, 3376);
        __builtin_amdgcn_sched_barrier(0);
        SOL_F(48, 0, 1, 0, x); SOL_F(48, 1, 1, 0, y); SOL_F(48, 2, 1, 0, z); SOL_F(48, 3, 1, 0, w);
        SOL_F(48, 4, 1, 1, x); SOL_F(48, 5, 1, 1, y); SOL_F(48, 6, 1, 1, z); SOL_F(48, 7, 1, 1, w);
        SOL_F(48, 8, 1, 2, x); SOL_F(48, 9, 1, 2, y); SOL_F(48, 10, 1, 2, z); SOL_F(48, 11, 1, 2, w);
        SOL_F(48, 12, 1, 3, x); SOL_F(48, 13, 1, 3, y); SOL_F(48, 14, 1, 3, z); SOL_F(48, 15, 1, 3, w);
        SOL_F(48, 16, 1, 4, x); SOL_F(48, 17, 1, 4, y); SOL_F(48, 18, 1, 4, z); SOL_F(48, 19, 1, 4, w);
        SOL_F(48, 20, 1, 5, x); SOL_F(48, 21, 1, 5, y); SOL_F(48, 22, 1, 5, z); SOL_F(48, 23, 1, 5, w);
        SOL_F(48, 24, 1, 6, x); SOL_F(48, 25, 1, 6, y); SOL_F(48, 26, 1, 6, z); SOL_F(48, 27, 1, 6, w);
        SOL_F(48, 28, 1, 7, x); SOL_F(48, 29, 1, 7, y); SOL_F(48, 30, 1, 7, z); SOL_F(48, 31, 1, 7, w);
        SOL_F(48, 32, 1, 8, x); SOL_F(48, 33, 1, 8, y); SOL_F(48, 34, 1, 8, z); SOL_F(48, 35, 1, 8, w);
        SOL_F(48, 36, 1, 9, x); SOL_F(48, 37, 1, 9, y); SOL_F(48, 38, 1, 9, z); SOL_F(48, 39, 1, 9, w);
        SOL_F(48, 40, 1, 10, x); SOL_F(48, 41, 1, 10, y); SOL_F(48, 42, 1, 10, z); SOL_F(48, 43, 1, 10, w);
        SOL_F(48, 44, 1, 11, x); SOL_F(48, 45, 1, 11, y); SOL_F(48, 46, 1, 11, z); SOL_F(48, 47, 1, 11, w);
        __builtin_amdgcn_sched_barrier(0);
        SOL_L(1, 0, 3380); SOL_L(1, 1, 3400); SOL_L(1, 2, 3404); SOL_L(1, 3, 3408); SOL_L(1, 4, 3412); SOL_L(1, 5, 3416); SOL_L(1, 6, 3420); SOL_L(1, 7, 3424); SOL_L(1, 8, 3428); SOL_L(1, 9, 3432); SOL_L(1, 10, 3436); SOL_L(1, 11, 3440);
        __builtin_amdgcn_sched_barrier(0);
        SOL_F(49, 0, 0, 0, x); SOL_F(49, 1, 0, 0, y); SOL_F(49, 2, 0, 0, z); SOL_F(49, 3, 0, 0, w);
        SOL_F(49, 4, 0, 1, x); SOL_F(49, 5, 0, 1, y); SOL_F(49, 6, 0, 1, z); SOL_F(49, 7, 0, 1, w);
        SOL_F(49, 8, 0, 2, x); SOL_F(49, 9, 0, 2, y); SOL_F(49, 10, 0, 2, z); SOL_F(49, 11, 0, 2, w);
        SOL_F(49, 12, 0, 3, x); SOL_F(49, 13, 0, 3, y); SOL_F(49, 14, 0, 3, z); SOL_F(49, 15, 0, 3, w);
        SOL_F(49, 16, 0, 4, x); SOL_F(49, 17, 0, 4, y); SOL_F(49, 18, 0, 4, z); SOL_F(49, 19, 0, 4, w);
        SOL_F(49, 20, 0, 5, x); SOL_F(49, 21, 0, 5, y); SOL_F(49, 22, 0, 5, z); SOL_F(49, 23, 0, 5, w);
        SOL_F(49, 24, 0, 6, x); SOL_F(49, 25, 0, 6, y); SOL_F(49, 26, 0, 6, z); SOL_F(49, 27, 0, 6, w);
        SOL_F(49, 28, 0, 7, x); SOL_F(49, 29, 0, 7, y); SOL_F(49, 30, 0, 7, z); SOL_F(49, 31, 0, 7, w);
        SOL_F(49, 32, 0, 8, x); SOL_F(49, 33, 0, 8, y); SOL_F(49, 34, 0, 8, z); SOL_F(49, 35, 0, 8, w);
        SOL_F(49, 36, 0, 9, x); SOL_F(49, 37, 0, 9, y); SOL_F(49, 38, 0, 9, z); SOL_F(49, 39, 0, 9, w);
        SOL_F(49, 40, 0, 10, x); SOL_F(49, 41, 0, 10, y); SOL_F(49, 42, 0, 10, z); SOL_F(49, 43, 0, 10, w);
        SOL_F(49, 44, 0, 11, x); SOL_F(49, 45, 0, 11, y); SOL_F(49, 46, 0, 11, z); SOL_F(49, 47, 0, 11, w);
        __builtin_amdgcn_sched_barrier(0);
        SOL_L(0, 0, 3444); SOL_L(0, 1, 3448); SOL_L(0, 2, 3468); SOL_L(0, 3, 3472); SOL_L(0, 4, 3476); SOL_L(0, 5, 3480); SOL_L(0, 6, 3484); SOL_L(0, 7, 3488); SOL_L(0, 8, 3492); SOL_L(0, 9, 3496); SOL_L(0, 10, 3500); SOL_L(0, 11, 3504);
        __builtin_amdgcn_sched_barrier(0);
        SOL_F(49, 48, 1, 0, x);
        SOL_F(50, 0, 1, 1, x); SOL_F(50, 1, 1, 1, y); SOL_F(50, 2, 1, 1, z); SOL_F(50, 3, 1, 1, w);
        SOL_F(50, 4, 1, 2, x); SOL_F(50, 5, 1, 2, y); SOL_F(50, 6, 1, 2, z); SOL_F(50, 7, 1, 2, w);
        SOL_F(50, 8, 1, 3, x); SOL_F(50, 9, 1, 3, y); SOL_F(50, 10, 1, 3, z); SOL_F(50, 11, 1, 3, w);
        SOL_F(50, 12, 1, 4, x); SOL_F(50, 13, 1, 4, y); SOL_F(50, 14, 1, 4, z); SOL_F(50, 15, 1, 4, w);
        SOL_F(50, 16, 1, 5, x); SOL_F(50, 17, 1, 5, y); SOL_F(50, 18, 1, 5, z); SOL_F(50, 19, 1, 5, w);
        SOL_F(50, 20, 1, 6, x); SOL_F(50, 21, 1, 6, y); SOL_F(50, 22, 1, 6, z); SOL_F(50, 23, 1, 6, w);
        SOL_F(50, 24, 1, 7, x); SOL_F(50, 25, 1, 7, y); SOL_F(50, 26, 1, 7, z); SOL_F(50, 27, 1, 7, w);
        SOL_F(50, 28, 1, 8, x); SOL_F(50, 29, 1, 8, y); SOL_F(50, 30, 1, 8, z); SOL_F(50, 31, 1, 8, w);
        SOL_F(50, 32, 1, 9, x); SOL_F(50, 33, 1, 9, y); SOL_F(50, 34, 1, 9, z); SOL_F(50, 35, 1, 9, w);
        SOL_F(50, 36, 1, 10, x); SOL_F(50, 37, 1, 10, y); SOL_F(50, 38, 1, 10, z); SOL_F(50, 39, 1, 10, w);
        SOL_F(50, 40, 1, 11, x); SOL_F(50, 41, 1, 11, y); SOL_F(50, 42, 1, 11, z); SOL_F(50, 43, 1, 11, w);
        __builtin_amdgcn_sched_barrier(0);
        SOL_L(1, 0, 3508); SOL_L(1, 1, 3512); SOL_L(1, 2, 3516); SOL_L(1, 3, 3536); SOL_L(1, 4, 3540); SOL_L(1, 5, 3544); SOL_L(1, 6, 3548); SOL_L(1, 7, 3552); SOL_L(1, 8, 3556); SOL_L(1, 9, 3560); SOL_L(1, 10, 3564); SOL_L(1, 11, 3568);
        __builtin_amdgcn_sched_barrier(0);
        SOL_F(50, 44, 0, 0, x); SOL_F(50, 45, 0, 0, y); SOL_F(50, 46, 0, 0, z); SOL_F(50, 47, 0, 0, w);
        SOL_F(50, 48, 0, 1, x); SOL_F(50, 49, 0, 1, y);
        SOL_F(51, 0, 0, 2, x); SOL_F(51, 1, 0, 2, y); SOL_F(51, 2, 0, 2, z); SOL_F(51, 3, 0, 2, w);
        SOL_F(51, 4, 0, 3, x); SOL_F(51, 5, 0, 3, y); SOL_F(51, 6, 0, 3, z); SOL_F(51, 7, 0, 3, w);
        SOL_F(51, 8, 0, 4, x); SOL_F(51, 9, 0, 4, y); SOL_F(51, 10, 0, 4, z); SOL_F(51, 11, 0, 4, w);
        SOL_F(51, 12, 0, 5, x); SOL_F(51, 13, 0, 5, y); SOL_F(51, 14, 0, 5, z); SOL_F(51, 15, 0, 5, w);
        SOL_F(51, 16, 0, 6, x); SOL_F(51, 17, 0, 6, y); SOL_F(51, 18, 0, 6, z); SOL_F(51, 19, 0, 6, w);
        SOL_F(51, 20, 0, 7, x); SOL_F(51, 21, 0, 7, y); SOL_F(51, 22, 0, 7, z); SOL_F(51, 23, 0, 7, w);
        SOL_F(51, 24, 0, 8, x); SOL_F(51, 25, 0, 8, y); SOL_F(51, 26, 0, 8, z); SOL_F(51, 27, 0, 8, w);
        SOL_F(51, 28, 0, 9, x); SOL_F(51, 29, 0, 9, y); SOL_F(51, 30, 0, 9, z); SOL_F(51, 31, 0, 9, w);
        SOL_F(51, 32, 0, 10, x); SOL_F(51, 33, 0, 10, y); SOL_F(51, 34, 0, 10, z); SOL_F(51, 35, 0, 10, w);
        SOL_F(51, 36, 0, 11, x); SOL_F(51, 37, 0, 11, y); SOL_F(51, 38, 0, 11, z); SOL_F(51, 39, 0, 11, w);
        __builtin_amdgcn_sched_barrier(0);
        SOL_L(0, 0, 3572); SOL_L(0, 1, 3576); SOL_L(0, 2, 3580); SOL_L(0, 3, 3584); SOL_L(0, 4, 3604); SOL_L(0, 5, 3608); SOL_L(0, 6, 3612); SOL_L(0, 7, 3616); SOL_L(0, 8, 3620); SOL_L(0, 9, 3624); SOL_L(0, 10, 3628); SOL_L(0, 11, 3632);
        __builtin_amdgcn_sched_barrier(0);
        SOL_F(51, 40, 1, 0, x); SOL_F(51, 41, 1, 0, y); SOL_F(51, 42, 1, 0, z); SOL_F(51, 43, 1, 0, w);
        SOL_F(51, 44, 1, 1, x); SOL_F(51, 45, 1, 1, y); SOL_F(51, 46, 1, 1, z); SOL_F(51, 47, 1, 1, w);
        SOL_F(51, 48, 1, 2, x); SOL_F(51, 49, 1, 2, y); SOL_F(51, 50, 1, 2, z);
        SOL_F(52, 0, 1, 3, x); SOL_F(52, 1, 1, 3, y); SOL_F(52, 2, 1, 3, z); SOL_F(52, 3, 1, 3, w);
        SOL_F(52, 4, 1, 4, x); SOL_F(52, 5, 1, 4, y); SOL_F(52, 6, 1, 4, z); SOL_F(52, 7, 1, 4, w);
        SOL_F(52, 8, 1, 5, x); SOL_F(52, 9, 1, 5, y); SOL_F(52, 10, 1, 5, z); SOL_F(52, 11, 1, 5, w);
        SOL_F(52, 12, 1, 6, x); SOL_F(52, 13, 1, 6, y); SOL_F(52, 14, 1, 6, z); SOL_F(52, 15, 1, 6, w);
        SOL_F(52, 16, 1, 7, x); SOL_F(52, 17, 1, 7, y); SOL_F(52, 18, 1, 7, z); SOL_F(52, 19, 1, 7, w);
        SOL_F(52, 20, 1, 8, x); SOL_F(52, 21, 1, 8, y); SOL_F(52, 22, 1, 8, z); SOL_F(52, 23, 1, 8, w);
        SOL_F(52, 24, 1, 9, x); SOL_F(52, 25, 1, 9, y); SOL_F(52, 26, 1, 9, z); SOL_F(52, 27, 1, 9, w);
        SOL_F(52, 28, 1, 10, x); SOL_F(52, 29, 1, 10, y); SOL_F(52, 30, 1, 10, z); SOL_F(52, 31, 1, 10, w);
        SOL_F(52, 32, 1, 11, x); SOL_F(52, 33, 1, 11, y); SOL_F(52, 34, 1, 11, z); SOL_F(52, 35, 1, 11, w);
        __builtin_amdgcn_sched_barrier(0);
        SOL_L(1, 0, 3636); SOL_L(1, 1, 3640); SOL_L(1, 2, 3644); SOL_L(1, 3, 3648); SOL_L(1, 4, 3652); SOL_L(1, 5, 3656); SOL_L(1, 6, 3672); SOL_L(1, 7, 3676); SOL_L(1, 8, 3680); SOL_L(1, 9, 3684); SOL_L(1, 10, 3688); SOL_L(1, 11, 3692);
        __builtin_amdgcn_sched_barrier(0);
        SOL_F(52, 36, 0, 0, x); SOL_F(52, 37, 0, 0, y); SOL_F(52, 38, 0, 0, z); SOL_F(52, 39, 0, 0, w);
        SOL_F(52, 40, 0, 1, x); SOL_F(52, 41, 0, 1, y); SOL_F(52, 42, 0, 1, z); SOL_F(52, 43, 0, 1, w);
        SOL_F(52, 44, 0, 2, x); SOL_F(52, 45, 0, 2, y); SOL_F(52, 46, 0, 2, z); SOL_F(52, 47, 0, 2, w);
        SOL_F(52, 48, 0, 3, x); SOL_F(52, 49, 0, 3, y); SOL_F(52, 50, 0, 3, z); SOL_F(52, 51, 0, 3, w);
        SOL_F(53, 0, 0, 4, x); SOL_F(53, 1, 0, 4, y); SOL_F(53, 2, 0, 4, z); SOL_F(53, 3, 0, 4, w);
        SOL_F(53, 4, 0, 5, x); SOL_F(53, 5, 0, 5, y); SOL_F(53, 6, 0, 5, z); SOL_F(53, 7, 0, 5, w);
        SOL_F(53, 8, 0, 6, x); SOL_F(53, 9, 0, 6, y); SOL_F(53, 10, 0, 6, z); SOL_F(53, 11, 0, 6, w);
        SOL_F(53, 12, 0, 7, x); SOL_F(53, 13, 0, 7, y); SOL_F(53, 14, 0, 7, z); SOL_F(53, 15, 0, 7, w);
        SOL_F(53, 16, 0, 8, x); SOL_F(53, 17, 0, 8, y); SOL_F(53, 18, 0, 8, z); SOL_F(53, 19, 0, 8, w);
        SOL_F(53, 20, 0, 9, x); SOL_F(53, 21, 0, 9, y); SOL_F(53, 22, 0, 9, z); SOL_F(53, 23, 0, 9, w);
        SOL_F(53, 24, 0, 10, x); SOL_F(53, 25, 0, 10, y); SOL_F(53, 26, 0, 10, z); SOL_F(53, 27, 0, 10, w);
        SOL_F(53, 28, 0, 11, x); SOL_F(53, 29, 0, 11, y); SOL_F(53, 30, 0, 11, z); SOL_F(53, 31, 0, 11, w);
        __builtin_amdgcn_sched_barrier(0);
        SOL_L(0, 0, 3696); SOL_L(0, 1, 3700); SOL_L(0, 2, 3704); SOL_L(0, 3, 3708); SOL_L(0, 4, 3712); SOL_L(0, 5, 3716); SOL_L(0, 6, 3720); SOL_L(0, 7, 3724); SOL_L(0, 8, 3740); SOL_L(0, 9, 3744); SOL_L(0, 10, 3748); SOL_L(0, 11, 3752);
        __builtin_amdgcn_sched_barrier(0);
        SOL_F(53, 32, 1, 0, x); SOL_F(53, 33, 1, 0, y); SOL_F(53, 34, 1, 0, z); SOL_F(53, 35, 1, 0, w);
        SOL_F(53, 36, 1, 1, x); SOL_F(53, 37, 1, 1, y); SOL_F(53, 38, 1, 1, z); SOL_F(53, 39, 1, 1, w);
        SOL_F(53, 40, 1, 2, x); SOL_F(53, 41, 1, 2, y); SOL_F(53, 42, 1, 2, z); SOL_F(53, 43, 1, 2, w);
        SOL_F(53, 44, 1, 3, x); SOL_F(53, 45, 1, 3, y); SOL_F(53, 46, 1, 3, z); SOL_F(53, 47, 1, 3, w);
        SOL_F(53, 48, 1, 4, x); SOL_F(53, 49, 1, 4, y); SOL_F(53, 50, 1, 4, z); SOL_F(53, 51, 1, 4, w);
        SOL_F(53, 52, 1, 5, x);
        SOL_F(54, 0, 1, 6, x); SOL_F(54, 1, 1, 6, y); SOL_F(54, 2, 1, 6, z); SOL_F(54, 3, 1, 6, w);
        SOL_F(54, 4, 1, 7, x); SOL_F(54, 5, 1, 7, y); SOL_F(54, 6, 1, 7, z); SOL_F(54, 7, 1, 7, w);
        SOL_F(54, 8, 1, 8, x); SOL_F(54, 9, 1, 8, y); SOL_F(54, 10, 1, 8, z); SOL_F(54, 11, 1, 8, w);
        SOL_F(54, 12, 1, 9, x); SOL_F(54, 13, 1, 9, y); SOL_F(54, 14, 1, 9, z); SOL_F(54, 15, 1, 9, w);
        SOL_F(54, 16, 1, 10, x); SOL_F(54, 17, 1, 10, y); SOL_F(54, 18, 1, 10, z); SOL_F(54, 19, 1, 10, w);
        SOL_F(54, 20, 1, 11, x); SOL_F(54, 21, 1, 11, y); SOL_F(54, 22, 1, 11, z); SOL_F(54, 23, 1, 11, w);
        __builtin_amdgcn_sched_barrier(0);
        SOL_L(1, 0, 3756); SOL_L(1, 1, 3760); SOL_L(1, 2, 3764); SOL_L(1, 3, 3768); SOL_L(1, 4, 3772); SOL_L(1, 5, 3776); SOL_L(1, 6, 3780); SOL_L(1, 7, 3784); SOL_L(1, 8, 3788); SOL_L(1, 9, 3792); SOL_L(1, 10, 3808); SOL_L(1, 11, 3812);
        __builtin_amdgcn_sched_barrier(0);
        SOL_F(54, 24, 0, 0, x); SOL_F(54, 25, 0, 0, y); SOL_F(54, 26, 0, 0, z); SOL_F(54, 27, 0, 0, w);
        SOL_F(54, 28, 0, 1, x); SOL_F(54, 29, 0, 1, y); SOL_F(54, 30, 0, 1, z); SOL_F(54, 31, 0, 1, w);
        SOL_F(54, 32, 0, 2, x); SOL_F(54, 33, 0, 2, y); SOL_F(54, 34, 0, 2, z); SOL_F(54, 35, 0, 2, w);
        SOL_F(54, 36, 0, 3, x); SOL_F(54, 37, 0, 3, y); SOL_F(54, 38, 0, 3, z); SOL_F(54, 39, 0, 3, w);
        SOL_F(54, 40, 0, 4, x); SOL_F(54, 41, 0, 4, y); SOL_F(54, 42, 0, 4, z); SOL_F(54, 43, 0, 4, w);
        SOL_F(54, 44, 0, 5, x); SOL_F(54, 45, 0, 5, y); SOL_F(54, 46, 0, 5, z); SOL_F(54, 47, 0, 5, w);
        SOL_F(54, 48, 0, 6, x); SOL_F(54, 49, 0, 6, y); SOL_F(54, 50, 0, 6, z); SOL_F(54, 51, 0, 6, w);
        SOL_F(54, 52, 0, 7, x); SOL_F(54, 53, 0, 7, y);
        SOL_F(55, 0, 0, 8, x); SOL_F(55, 1, 0, 8, y); SOL_F(55, 2, 0, 8, z); SOL_F(55, 3, 0, 8, w);
        SOL_F(55, 4, 0, 9, x); SOL_F(55, 5, 0, 9, y); SOL_F(55, 6, 0, 9, z); SOL_F(55, 7, 0, 9, w);
        SOL_F(55, 8, 0, 10, x); SOL_F(55, 9, 0, 10, y); SOL_F(55, 10, 0, 10, z); SOL_F(55, 11, 0, 10, w);
        SOL_F(55, 12, 0, 11, x); SOL_F(55, 13, 0, 11, y); SOL_F(55, 14, 0, 11, z); SOL_F(55, 15, 0, 11, w);
        __builtin_amdgcn_sched_barrier(0);
        SOL_L(0, 0, 3816); SOL_L(0, 1, 3820); SOL_L(0, 2, 3824); SOL_L(0, 3, 3828); SOL_L(0, 4, 3832); SOL_L(0, 5, 3836); SOL_L(0, 6, 3840); SOL_L(0, 7, 3844); SOL_L(0, 8, 3848); SOL_L(0, 9, 3852); SOL_L(0, 10, 3856); SOL_L(0, 11, 3860);
        __builtin_amdgcn_sched_barrier(0);
        SOL_F(55, 16, 1, 0, x); SOL_F(55, 17, 1, 0, y); SOL_F(55, 18, 1, 0, z); SOL_F(55, 19, 1, 0, w);
        SOL_F(55, 20, 1, 1, x); SOL_F(55, 21, 1, 1, y); SOL_F(55, 22, 1, 1, z); SOL_F(55, 23, 1, 1, w);
        SOL_F(55, 24, 1, 2, x); SOL_F(55, 25, 1, 2, y); SOL_F(55, 26, 1, 2, z); SOL_F(55, 27, 1, 2, w);
        SOL_F(55, 28, 1, 3, x); SOL_F(55, 29, 1, 3, y); SOL_F(55, 30, 1, 3, z); SOL_F(55, 31, 1, 3, w);
        SOL_F(55, 32, 1, 4, x); SOL_F(55, 33, 1, 4, y); SOL_F(55, 34, 1, 4, z); SOL_F(55, 35, 1, 4, w);
        SOL_F(55, 36, 1, 5, x); SOL_F(55, 37, 1, 5, y); SOL_F(55, 38, 1, 5, z); SOL_F(55, 39, 1, 5, w);
        SOL_F(55, 40, 1, 6, x); SOL_F(55, 41, 1, 6, y); SOL_F(55, 42, 1, 6, z); SOL_F(55, 43, 1, 6, w);
        SOL_F(55, 44, 1, 7, x); SOL_F(55, 45, 1, 7, y); SOL_F(55, 46, 1, 7, z); SOL_F(55, 47, 1, 7, w);
        SOL_F(55, 48, 1, 8, x); SOL_F(55, 49, 1, 8, y); SOL_F(55, 50, 1, 8, z); SOL_F(55, 51, 1, 8, w);
        SOL_F(55, 52, 1, 9, x); SOL_F(55, 53, 1, 9, y); SOL_F(55, 54, 1, 9, z);
        SOL_F(56, 0, 1, 10, x); SOL_F(56, 1, 1, 10, y); SOL_F(56, 2, 1, 10, z); SOL_F(56, 3, 1, 10, w);
        SOL_F(56, 4, 1, 11, x); SOL_F(56, 5, 1, 11, y); SOL_F(56, 6, 1, 11, z); SOL_F(56, 7, 1, 11, w);
        __builtin_amdgcn_sched_barrier(0);
        SOL_L(1, 0, 3876); SOL_L(1, 1, 3880); SOL_L(1, 2, 3884); SOL_L(1, 3, 3888); SOL_L(1, 4, 3892); SOL_L(1, 5, 3896); SOL_L(1, 6, 3900); SOL_L(1, 7, 3904); SOL_L(1, 8, 3908); SOL_L(1, 9, 3912); SOL_L(1, 10, 3916); SOL_L(1, 11, 3920);
        __builtin_amdgcn_sched_barrier(0);
        SOL_F(56, 8, 0, 0, x); SOL_F(56, 9, 0, 0, y); SOL_F(56, 10, 0, 0, z); SOL_F(56, 11, 0, 0, w);
        SOL_F(56, 12, 0, 1, x); SOL_F(56, 13, 0, 1, y); SOL_F(56, 14, 0, 1, z); SOL_F(56, 15, 0, 1, w);
        SOL_F(56, 16, 0, 2, x); SOL_F(56, 17, 0, 2, y); SOL_F(56, 18, 0, 2, z); SOL_F(56, 19, 0, 2, w);
        SOL_F(56, 20, 0, 3, x); SOL_F(56, 21, 0, 3, y); SOL_F(56, 22, 0, 3, z); SOL_F(56, 23, 0, 3, w);
        SOL_F(56, 24, 0, 4, x); SOL_F(56, 25, 0, 4, y); SOL_F(56, 26, 0, 4, z); SOL_F(56, 27, 0, 4, w);
        SOL_F(56, 28, 0, 5, x); SOL_F(56, 29, 0, 5, y); SOL_F(56, 30, 0, 5, z); SOL_F(56, 31, 0, 5, w);
        SOL_F(56, 32, 0, 6, x); SOL_F(56, 33, 0, 6, y); SOL_F(56, 34, 0, 6, z); SOL_F(56, 35, 0, 6, w);
        SOL_F(56, 36, 0, 7, x); SOL_F(56, 37, 0, 7, y); SOL_F(56, 38, 0, 7, z); SOL_F(56, 39, 0, 7, w);
        SOL_F(56, 40, 0, 8, x); SOL_F(56, 41, 0, 8, y); SOL_F(56, 42, 0, 8, z); SOL_F(56, 43, 0, 8, w);
        SOL_F(56, 44, 0, 9, x); SOL_F(56, 45, 0, 9, y); SOL_F(56, 46, 0, 9, z); SOL_F(56, 47, 0, 9, w);
        SOL_F(56, 48, 0, 10, x); SOL_F(56, 49, 0, 10, y); SOL_F(56, 50, 0, 10, z); SOL_F(56, 51, 0, 10, w);
        SOL_F(56, 52, 0, 11, x); SOL_F(56, 53, 0, 11, y); SOL_F(56, 54, 0, 11, z); SOL_F(56, 55, 0, 11, w);
        __builtin_amdgcn_sched_barrier(0);
        SOL_L(0, 0, 3924); SOL_L(0, 1, 3928); SOL_L(0, 2, 3932); SOL_L(0, 3, 3944); SOL_L(0, 4, 3948); SOL_L(0, 5, 3952); SOL_L(0, 6, 3956); SOL_L(0, 7, 3960); SOL_L(0, 8, 3964); SOL_L(0, 9, 3968); SOL_L(0, 10, 3972); SOL_L(0, 11, 3976);
        __builtin_amdgcn_sched_barrier(0);
        SOL_F(57, 0, 1, 0, x); SOL_F(57, 1, 1, 0, y); SOL_F(57, 2, 1, 0, z); SOL_F(57, 3, 1, 0, w);
        SOL_F(57, 4, 1, 1, x); SOL_F(57, 5, 1, 1, y); SOL_F(57, 6, 1, 1, z); SOL_F(57, 7, 1, 1, w);
        SOL_F(57, 8, 1, 2, x); SOL_F(57, 9, 1, 2, y); SOL_F(57, 10, 1, 2, z); SOL_F(57, 11, 1, 2, w);
        SOL_F(57, 12, 1, 3, x); SOL_F(57, 13, 1, 3, y); SOL_F(57, 14, 1, 3, z); SOL_F(57, 15, 1, 3, w);
        SOL_F(57, 16, 1, 4, x); SOL_F(57, 17, 1, 4, y); SOL_F(57, 18, 1, 4, z); SOL_F(57, 19, 1, 4, w);
        SOL_F(57, 20, 1, 5, x); SOL_F(57, 21, 1, 5, y); SOL_F(57, 22, 1, 5, z); SOL_F(57, 23, 1, 5, w);
        SOL_F(57, 24, 1, 6, x); SOL_F(57, 25, 1, 6, y); SOL_F(57, 26, 1, 6, z); SOL_F(57, 27, 1, 6, w);
        SOL_F(57, 28, 1, 7, x); SOL_F(57, 29, 1, 7, y); SOL_F(57, 30, 1, 7, z); SOL_F(57, 31, 1, 7, w);
        SOL_F(57, 32, 1, 8, x); SOL_F(57, 33, 1, 8, y); SOL_F(57, 34, 1, 8, z); SOL_F(57, 35, 1, 8, w);
        SOL_F(57, 36, 1, 9, x); SOL_F(57, 37, 1, 9, y); SOL_F(57, 38, 1, 9, z); SOL_F(57, 39, 1, 9, w);
        SOL_F(57, 40, 1, 10, x); SOL_F(57, 41, 1, 10, y); SOL_F(57, 42, 1, 10, z); SOL_F(57, 43, 1, 10, w);
        SOL_F(57, 44, 1, 11, x); SOL_F(57, 45, 1, 11, y); SOL_F(57, 46, 1, 11, z); SOL_F(57, 47, 1, 11, w);
        __builtin_amdgcn_sched_barrier(0);
        SOL_L(1, 0, 3980); SOL_L(1, 1, 3984); SOL_L(1, 2, 3988); SOL_L(1, 3, 3992); SOL_L(1, 4, 3996); SOL_L(1, 5, 4000); SOL_L(1, 6, 4012); SOL_L(1, 7, 4016); SOL_L(1, 8, 4020); SOL_L(1, 9, 4024); SOL_L(1, 10, 4028); SOL_L(1, 11, 4032);
        __builtin_amdgcn_sched_barrier(0);
        SOL_F(57, 48, 0, 0, x); SOL_F(57, 49, 0, 0, y); SOL_F(57, 50, 0, 0, z); SOL_F(57, 51, 0, 0, w);
        SOL_F(57, 52, 0, 1, x); SOL_F(57, 53, 0, 1, y); SOL_F(57, 54, 0, 1, z); SOL_F(57, 55, 0, 1, w);
        SOL_F(57, 56, 0, 2, x);
        SOL_F(58, 0, 0, 3, x); SOL_F(58, 1, 0, 3, y); SOL_F(58, 2, 0, 3, z); SOL_F(58, 3, 0, 3, w);
        SOL_F(58, 4, 0, 4, x); SOL_F(58, 5, 0, 4, y); SOL_F(58, 6, 0, 4, z); SOL_F(58, 7, 0, 4, w);
        SOL_F(58, 8, 0, 5, x); SOL_F(58, 9, 0, 5, y); SOL_F(58, 10, 0, 5, z); SOL_F(58, 11, 0, 5, w);
        SOL_F(58, 12, 0, 6, x); SOL_F(58, 13, 0, 6, y); SOL_F(58, 14, 0, 6, z); SOL_F(58, 15, 0, 6, w);
        SOL_F(58, 16, 0, 7, x); SOL_F(58, 17, 0, 7, y); SOL_F(58, 18, 0, 7, z); SOL_F(58, 19, 0, 7, w);
        SOL_F(58, 20, 0, 8, x); SOL_F(58, 21, 0, 8, y); SOL_F(58, 22, 0, 8, z); SOL_F(58, 23, 0, 8, w);
        SOL_F(58, 24, 0, 9, x); SOL_F(58, 25, 0, 9, y); SOL_F(58, 26, 0, 9, z); SOL_F(58, 27, 0, 9, w);
        SOL_F(58, 28, 0, 10, x); SOL_F(58, 29, 0, 10, y); SOL_F(58, 30, 0, 10, z); SOL_F(58, 31, 0, 10, w);
        SOL_F(58, 32, 0, 11, x); SOL_F(58, 33, 0, 11, y); SOL_F(58, 34, 0, 11, z); SOL_F(58, 35, 0, 11, w);
        __builtin_amdgcn_sched_barrier(0);
        SOL_L(0, 0, 4036); SOL_L(0, 1, 4040); SOL_L(0, 2, 4044); SOL_L(0, 3, 4048); SOL_L(0, 4, 4052); SOL_L(0, 5, 4056); SOL_L(0, 6, 4060); SOL_L(0, 7, 4064); SOL_L(0, 8, 4068); SOL_L(0, 9, 4080); SOL_L(0, 10, 4084); SOL_L(0, 11, 4088);
        __builtin_amdgcn_sched_barrier(0);
        SOL_F(58, 36, 1, 0, x); SOL_F(58, 37, 1, 0, y); SOL_F(58, 38, 1, 0, z); SOL_F(58, 39, 1, 0, w);
        SOL_F(58, 40, 1, 1, x); SOL_F(58, 41, 1, 1, y); SOL_F(58, 42, 1, 1, z); SOL_F(58, 43, 1, 1, w);
        SOL_F(58, 44, 1, 2, x); SOL_F(58, 45, 1, 2, y); SOL_F(58, 46, 1, 2, z); SOL_F(58, 47, 1, 2, w);
        SOL_F(58, 48, 1, 3, x); SOL_F(58, 49, 1, 3, y); SOL_F(58, 50, 1, 3, z); SOL_F(58, 51, 1, 3, w);
        SOL_F(58, 52, 1, 4, x); SOL_F(58, 53, 1, 4, y); SOL_F(58, 54, 1, 4, z); SOL_F(58, 55, 1, 4, w);
        SOL_F(58, 56, 1, 5, x); SOL_F(58, 57, 1, 5, y);
        SOL_F(59, 0, 1, 6, x); SOL_F(59, 1, 1, 6, y); SOL_F(59, 2, 1, 6, z); SOL_F(59, 3, 1, 6, w);
        SOL_F(59, 4, 1, 7, x); SOL_F(59, 5, 1, 7, y); SOL_F(59, 6, 1, 7, z); SOL_F(59, 7, 1, 7, w);
        SOL_F(59, 8, 1, 8, x); SOL_F(59, 9, 1, 8, y); SOL_F(59, 10, 1, 8, z); SOL_F(59, 11, 1, 8, w);
        SOL_F(59, 12, 1, 9, x); SOL_F(59, 13, 1, 9, y); SOL_F(59, 14, 1, 9, z); SOL_F(59, 15, 1, 9, w);
        SOL_F(59, 16, 1, 10, x); SOL_F(59, 17, 1, 10, y); SOL_F(59, 18, 1, 10, z); SOL_F(59, 19, 1, 10, w);
        SOL_F(59, 20, 1, 11, x); SOL_F(59, 21, 1, 11, y); SOL_F(59, 22, 1, 11, z); SOL_F(59, 23, 1, 11, w);
        __builtin_amdgcn_sched_barrier(0);
        SOL_L(1, 0, 4092); SOL_L(1, 1, 4096); SOL_L(1, 2, 4100); SOL_L(1, 3, 4104); SOL_L(1, 4, 4108); SOL_L(1, 5, 4112); SOL_L(1, 6, 4116); SOL_L(1, 7, 4120); SOL_L(1, 8, 4124); SOL_L(1, 9, 4128); SOL_L(1, 10, 4132); SOL_L(1, 11, 4136);
        __builtin_amdgcn_sched_barrier(0);
        SOL_F(59, 24, 0, 0, x); SOL_F(59, 25, 0, 0, y); SOL_F(59, 26, 0, 0, z); SOL_F(59, 27, 0, 0, w);
        SOL_F(59, 28, 0, 1, x); SOL_F(59, 29, 0, 1, y); SOL_F(59, 30, 0, 1, z); SOL_F(59, 31, 0, 1, w);
        SOL_F(59, 32, 0, 2, x); SOL_F(59, 33, 0, 2, y); SOL_F(59, 34, 0, 2, z); SOL_F(59, 35, 0, 2, w);
        SOL_F(59, 36, 0, 3, x); SOL_F(59, 37, 0, 3, y); SOL_F(59, 38, 0, 3, z); SOL_F(59, 39, 0, 3, w);
        SOL_F(59, 40, 0, 4, x); SOL_F(59, 41, 0, 4, y); SOL_F(59, 42, 0, 4, z); SOL_F(59, 43, 0, 4, w);
        SOL_F(59, 44, 0, 5, x); SOL_F(59, 45, 0, 5, y); SOL_F(59, 46, 0, 5, z); SOL_F(59, 47, 0, 5, w);
        SOL_F(59, 48, 0, 6, x); SOL_F(59, 49, 0, 6, y); SOL_F(59, 50, 0, 6, z); SOL_F(59, 51, 0, 6, w);
        SOL_F(59, 52, 0, 7, x); SOL_F(59, 53, 0, 7, y); SOL_F(59, 54, 0, 7, z); SOL_F(59, 55, 0, 7, w);
        SOL_F(59, 56, 0, 8, x); SOL_F(59, 57, 0, 8, y); SOL_F(59, 58, 0, 8, z);
        SOL_F(60, 0, 0, 9, x); SOL_F(60, 1, 0, 9, y); SOL_F(60, 2, 0, 9, z); SOL_F(60, 3, 0, 9, w);
        SOL_F(60, 4, 0, 10, x); SOL_F(60, 5, 0, 10, y); SOL_F(60, 6, 0, 10, z); SOL_F(60, 7, 0, 10, w);
        SOL_F(60, 8, 0, 11, x); SOL_F(60, 9, 0, 11, y); SOL_F(60, 10, 0, 11, z); SOL_F(60, 11, 0, 11, w);
        __builtin_amdgcn_sched_barrier(0);
        SOL_L(0, 0, 4148); SOL_L(0, 1, 4152); SOL_L(0, 2, 4156); SOL_L(0, 3, 4160); SOL_L(0, 4, 4164); SOL_L(0, 5, 4168); SOL_L(0, 6, 4172); SOL_L(0, 7, 4176); SOL_L(0, 8, 4180); SOL_L(0, 9, 4184); SOL_L(0, 10, 4188); SOL_L(0, 11, 4192);
        __builtin_amdgcn_sched_barrier(0);
        SOL_F(60, 12, 1, 0, x); SOL_F(60, 13, 1, 0, y); SOL_F(60, 14, 1, 0, z); SOL_F(60, 15, 1, 0, w);
        SOL_F(60, 16, 1, 1, x); SOL_F(60, 17, 1, 1, y); SOL_F(60, 18, 1, 1, z); SOL_F(60, 19, 1, 1, w);
        SOL_F(60, 20, 1, 2, x); SOL_F(60, 21, 1, 2, y); SOL_F(60, 22, 1, 2, z); SOL_F(60, 23, 1, 2, w);
        SOL_F(60, 24, 1, 3, x); SOL_F(60, 25, 1, 3, y); SOL_F(60, 26, 1, 3, z); SOL_F(60, 27, 1, 3, w);
        SOL_F(60, 28, 1, 4, x); SOL_F(60, 29, 1, 4, y); SOL_F(60, 30, 1, 4, z); SOL_F(60, 31, 1, 4, w);
        SOL_F(60, 32, 1, 5, x); SOL_F(60, 33, 1, 5, y); SOL_F(60, 34, 1, 5, z); SOL_F(60, 35, 1, 5, w);
        SOL_F(60, 36, 1, 6, x); SOL_F(60, 37, 1, 6, y); SOL_F(60, 38, 1, 6, z); SOL_F(60, 39, 1, 6, w);
        SOL_F(60, 40, 1, 7, x); SOL_F(60, 41, 1, 7, y); SOL_F(60, 42, 1, 7, z); SOL_F(60, 43, 1, 7, w);
        SOL_F(60, 44, 1, 8, x); SOL_F(60, 45, 1, 8, y); SOL_F(60, 46, 1, 8, z); SOL_F(60, 47, 1, 8, w);
        SOL_F(60, 48, 1, 9, x); SOL_F(60, 49, 1, 9, y); SOL_F(60, 50, 1, 9, z); SOL_F(60, 51, 1, 9, w);
        SOL_F(60, 52, 1, 10, x); SOL_F(60, 53, 1, 10, y); SOL_F(60, 54, 1, 10, z); SOL_F(60, 55, 1, 10, w);
        SOL_F(60, 56, 1, 11, x); SOL_F(60, 57, 1, 11, y); SOL_F(60, 58, 1, 11, z); SOL_F(60, 59, 1, 11, w);
        __builtin_amdgcn_sched_barrier(0);
        SOL_L(1, 0, 4196); SOL_L(1, 1, 4200); SOL_L(1, 2, 4204); SOL_L(1, 3, 4208); SOL_L(1, 4, 4216); SOL_L(1, 5, 4220); SOL_L(1, 6, 4224); SOL_L(1, 7, 4228); SOL_L(1, 8, 4232); SOL_L(1, 9, 4236); SOL_L(1, 10, 4240); SOL_L(1, 11, 4244);
        __builtin_amdgcn_sched_barrier(0);
        SOL_F(61, 0, 0, 0, x); SOL_F(61, 1, 0, 0, y); SOL_F(61, 2, 0, 0, z); SOL_F(61, 3, 0, 0, w);
        SOL_F(61, 4, 0, 1, x); SOL_F(61, 5, 0, 1, y); SOL_F(61, 6, 0, 1, z); SOL_F(61, 7, 0, 1, w);
        SOL_F(61, 8, 0, 2, x); SOL_F(61, 9, 0, 2, y); SOL_F(61, 10, 0, 2, z); SOL_F(61, 11, 0, 2, w);
        SOL_F(61, 12, 0, 3, x); SOL_F(61, 13, 0, 3, y); SOL_F(61, 14, 0, 3, z); SOL_F(61, 15, 0, 3, w);
        SOL_F(61, 16, 0, 4, x); SOL_F(61, 17, 0, 4, y); SOL_F(61, 18, 0, 4, z); SOL_F(61, 19, 0, 4, w);
        SOL_F(61, 20, 0, 5, x); SOL_F(61, 21, 0, 5, y); SOL_F(61, 22, 0, 5, z); SOL_F(61, 23, 0, 5, w);
        SOL_F(61, 24, 0, 6, x); SOL_F(61, 25, 0, 6, y); SOL_F(61, 26, 0, 6, z); SOL_F(61, 27, 0, 6, w);
        SOL_F(61, 28, 0, 7, x); SOL_F(61, 29, 0, 7, y); SOL_F(61, 30, 0, 7, z); SOL_F(61, 31, 0, 7, w);
        SOL_F(61, 32, 0, 8, x); SOL_F(61, 33, 0, 8, y); SOL_F(61, 34, 0, 8, z); SOL_F(61, 35, 0, 8, w);
        SOL_F(61, 36, 0, 9, x); SOL_F(61, 37, 0, 9, y); SOL_F(61, 38, 0, 9, z); SOL_F(61, 39, 0, 9, w);
        SOL_F(61, 40, 0, 10, x); SOL_F(61, 41, 0, 10, y); SOL_F(61, 42, 0, 10, z); SOL_F(61, 43, 0, 10, w);
        SOL_F(61, 44, 0, 11, x); SOL_F(61, 45, 0, 11, y); SOL_F(61, 46, 0, 11, z); SOL_F(61, 47, 0, 11, w);
        __builtin_amdgcn_sched_barrier(0);
        SOL_L(0, 0, 4248); SOL_L(0, 1, 4252); SOL_L(0, 2, 4256); SOL_L(0, 3, 4260); SOL_L(0, 4, 4264); SOL_L(0, 5, 4268); SOL_L(0, 6, 4272); SOL_L(0, 7, 4276); SOL_L(0, 8, 4284); SOL_L(0, 9, 4288); SOL_L(0, 10, 4292); SOL_L(0, 11, 4296);
        __builtin_amdgcn_sched_barrier(0);
        SOL_F(61, 48, 1, 0, x); SOL_F(61, 49, 1, 0, y); SOL_F(61, 50, 1, 0, z); SOL_F(61, 51, 1, 0, w);
        SOL_F(61, 52, 1, 1, x); SOL_F(61, 53, 1, 1, y); SOL_F(61, 54, 1, 1, z); SOL_F(61, 55, 1, 1, w);
        SOL_F(61, 56, 1, 2, x); SOL_F(61, 57, 1, 2, y); SOL_F(61, 58, 1, 2, z); SOL_F(61, 59, 1, 2, w);
        SOL_F(61, 60, 1, 3, x);
        SOL_F(62, 0, 1, 4, x); SOL_F(62, 1, 1, 4, y); SOL_F(62, 2, 1, 4, z); SOL_F(62, 3, 1, 4, w);
        SOL_F(62, 4, 1, 5, x); SOL_F(62, 5, 1, 5, y); SOL_F(62, 6, 1, 5, z); SOL_F(62, 7, 1, 5, w);
        SOL_F(62, 8, 1, 6, x); SOL_F(62, 9, 1, 6, y); SOL_F(62, 10, 1, 6, z); SOL_F(62, 11, 1, 6, w);
        SOL_F(62, 12, 1, 7, x); SOL_F(62, 13, 1, 7, y); SOL_F(62, 14, 1, 7, z); SOL_F(62, 15, 1, 7, w);
        SOL_F(62, 16, 1, 8, x); SOL_F(62, 17, 1, 8, y); SOL_F(62, 18, 1, 8, z); SOL_F(62, 19, 1, 8, w);
        SOL_F(62, 20, 1, 9, x); SOL_F(62, 21, 1, 9, y); SOL_F(62, 22, 1, 9, z); SOL_F(62, 23, 1, 9, w);
        SOL_F(62, 24, 1, 10, x); SOL_F(62, 25, 1, 10, y); SOL_F(62, 26, 1, 10, z); SOL_F(62, 27, 1, 10, w);
        SOL_F(62, 28, 1, 11, x); SOL_F(62, 29, 1, 11, y); SOL_F(62, 30, 1, 11, z); SOL_F(62, 31, 1, 11, w);
        __builtin_amdgcn_sched_barrier(0);
        SOL_L(1, 0, 4300); SOL_L(1, 1, 4304); SOL_L(1, 2, 4308); SOL_L(1, 3, 4312); SOL_L(1, 4, 4316); SOL_L(1, 5, 4320); SOL_L(1, 6, 4324); SOL_L(1, 7, 4328); SOL_L(1, 8, 4332); SOL_L(1, 9, 4336); SOL_L(1, 10, 4340); SOL_L(1, 11, 4344);
        __builtin_amdgcn_sched_barrier(0);
        SOL_F(62, 32, 0, 0, x); SOL_F(62, 33, 0, 0, y); SOL_F(62, 34, 0, 0, z); SOL_F(62, 35, 0, 0, w);
        SOL_F(62, 36, 0, 1, x); SOL_F(62, 37, 0, 1, y); SOL_F(62, 38, 0, 1, z); SOL_F(62, 39, 0, 1, w);
        SOL_F(62, 40, 0, 2, x); SOL_F(62, 41, 0, 2, y); SOL_F(62, 42, 0, 2, z); SOL_F(62, 43, 0, 2, w);
        SOL_F(62, 44, 0, 3, x); SOL_F(62, 45, 0, 3, y); SOL_F(62, 46, 0, 3, z); SOL_F(62, 47, 0, 3, w);
        SOL_F(62, 48, 0, 4, x); SOL_F(62, 49, 0, 4, y); SOL_F(62, 50, 0, 4, z); SOL_F(62, 51, 0, 4, w);
        SOL_F(62, 52, 0, 5, x); SOL_F(62, 53, 0, 5, y); SOL_F(62, 54, 0, 5, z); SOL_F(62, 55, 0, 5, w);
        SOL_F(62, 56, 0, 6, x); SOL_F(62, 57, 0, 6, y); SOL_F(62, 58, 0, 6, z); SOL_F(62, 59, 0, 6, w);
        SOL_F(62, 60, 0, 7, x); SOL_F(62, 61, 0, 7, y);
        SOL_F(63, 0, 0, 8, x); SOL_F(63, 1, 0, 8, y); SOL_F(63, 2, 0, 8, z); SOL_F(63, 3, 0, 8, w);
        SOL_F(63, 4, 0, 9, x); SOL_F(63, 5, 0, 9, y); SOL_F(63, 6, 0, 9, z); SOL_F(63, 7, 0, 9, w);
        SOL_F(63, 8, 0, 10, x); SOL_F(63, 9, 0, 10, y); SOL_F(63, 10, 0, 10, z); SOL_F(63, 11, 0, 10, w);
        SOL_F(63, 12, 0, 11, x); SOL_F(63, 13, 0, 11, y); SOL_F(63, 14, 0, 11, z); SOL_F(63, 15, 0, 11, w);
        __builtin_amdgcn_sched_barrier(0);
        __builtin_amdgcn_sched_barrier(0);
        SOL_F(63, 16, 1, 0, x); SOL_F(63, 17, 1, 0, y); SOL_F(63, 18, 1, 0, z); SOL_F(63, 19, 1, 0, w);
        SOL_F(63, 20, 1, 1, x); SOL_F(63, 21, 1, 1, y); SOL_F(63, 22, 1, 1, z); SOL_F(63, 23, 1, 1, w);
        SOL_F(63, 24, 1, 2, x); SOL_F(63, 25, 1, 2, y); SOL_F(63, 26, 1, 2, z); SOL_F(63, 27, 1, 2, w);
        SOL_F(63, 28, 1, 3, x); SOL_F(63, 29, 1, 3, y); SOL_F(63, 30, 1, 3, z); SOL_F(63, 31, 1, 3, w);
        SOL_F(63, 32, 1, 4, x); SOL_F(63, 33, 1, 4, y); SOL_F(63, 34, 1, 4, z); SOL_F(63, 35, 1, 4, w);
        SOL_F(63, 36, 1, 5, x); SOL_F(63, 37, 1, 5, y); SOL_F(63, 38, 1, 5, z); SOL_F(63, 39, 1, 5, w);
        SOL_F(63, 40, 1, 6, x); SOL_F(63, 41, 1, 6, y); SOL_F(63, 42, 1, 6, z); SOL_F(63, 43, 1, 6, w);
        SOL_F(63, 44, 1, 7, x); SOL_F(63, 45, 1, 7, y); SOL_F(63, 46, 1, 7, z); SOL_F(63, 47, 1, 7, w);
        SOL_F(63, 48, 1, 8, x); SOL_F(63, 49, 1, 8, y); SOL_F(63, 50, 1, 8, z); SOL_F(63, 51, 1, 8, w);
        SOL_F(63, 52, 1, 9, x); SOL_F(63, 53, 1, 9, y); SOL_F(63, 54, 1, 9, z); SOL_F(63, 55, 1, 9, w);
        SOL_F(63, 56, 1, 10, x); SOL_F(63, 57, 1, 10, y); SOL_F(63, 58, 1, 10, z); SOL_F(63, 59, 1, 10, w);
        SOL_F(63, 60, 1, 11, x); SOL_F(63, 61, 1, 11, y); SOL_F(63, 62, 1, 11, z);
        __builtin_amdgcn_sched_barrier(0);
#undef SOL_L
#undef SOL_F
        if (isu) {
#pragma unroll
            for (int q = 0; q < 8; ++q) { u32x4 o; o.x = pk2(xs[8 * q], xs[8 * q + 1]); o.y = pk2(xs[8 * q + 2], xs[8 * q + 3]); o.z = pk2(xs[8 * q + 4], xs[8 * q + 5]); o.w = pk2(xs[8 * q + 6], xs[8 * q + 7]);
                bf16_t* up = uT + ((col >> 5) * 8 + q) * 256 + (col & 31) * 4;
                *(u32x2*)up = (u32x2){o.x, o.y}; *(u32x2*)(up + 128) = (u32x2){o.z, o.w}; }
        } else {
            const int dk = col - 128, pos = (dk & ~15) + pinv16(dk & 15);
            LAS unsigned short* Wp = (LAS unsigned short*)(lds + P3_Q) + pos;
            unsigned wpk[32];
#pragma unroll
            for (int i = 0; i < 32; ++i) wpk[i] = pk2(xs[2 * i], xs[2 * i + 1]);
            __builtin_amdgcn_sched_barrier(0);
#pragma unroll
            for (int i = 0; i < 32; ++i) { Wp[(2 * i) * 136] = (unsigned short)(wpk[i] & 0xffffu); Wp[(2 * i + 1) * 136] = (unsigned short)(wpk[i] >> 16); }
        }
    } else {
        const int t2 = tid - 256; const float gl = gcs[63];
        const LAS unsigned short* Kb = (const LAS unsigned short*)(lds + P3_K);
#pragma unroll
        for (int i = 0; i < 4; ++i) {
            const int idx = t2 + 256 * i, dk = idx >> 3, ch = idx & 7, cb0 = (ch >> 1) * 16 + (ch & 1) * 4;
            float v[8];
#pragma unroll
            for (int e = 0; e < 8; ++e) { const int c = cb0 + (e & 3) + (e >> 2) * 8; v[e] = bf2f(Kb[c * 136 + dk]) * __expf(gl - gcs[c]); }
            u32x4 o; o.x = pk2(v[0], v[1]); o.y = pk2(v[2], v[3]); o.z = pk2(v[4], v[5]); o.w = pk2(v[6], v[7]);
            *(u32x4*)(kdT + dk * 64 + ch * 8) = o;
        }
        if (tid == 256) ((float*)(a.ws + WS_GLAST))[bh * 64 + n] = gl;
        p3_ret_half(a, lds + 73728, rb, rn, rh, t2);
    }
    __syncthreads();
#pragma unroll
    for (int i = 0; i < 2; ++i) { const int p = tid + 512 * i, row = p >> 4, pc = p & 15; *(u32x4*)(wG + row * 128 + pc * 8) = *(const LAS u32x4*)(lds + P3_Q + row * 272 + pc * 16); }
    __syncthreads();
}

DI void p3_ret_half(const Args& a, LAS unsigned char* lds, int b, int n, int h, int t2in) {
    int tid_ = t2in; asm volatile("" : "+v"(tid_));
    const int tid = tid_, lane = tid & 63, wave = tid >> 6;
    const bf16_t* proj = (const bf16_t*)(a.ws + WS_PROJ);
    const int bh = b * 4 + h;
    unsigned char* rec = (unsigned char*)a.out + (size_t)(bh * 64 + n) * RREC;
    bf16_t* vT = (bf16_t*)rec; bf16_t* qgG = (bf16_t*)(rec + 16384); bf16_t* kdT = (bf16_t*)(rec + 32768); bf16_t* atG = (bf16_t*)(rec + 49152);
    const float lg = log1pf(-exp2f(-5.f - (float)h));
#pragma unroll 1
    for (int ps = 0; ps < 2; ++ps) {
    const int r = (tid >> 3) + 32 * ps, cb = tid & 7;
    const bf16_t* prow = proj + (size_t)(b * SEQ + n * 64 + r) * NPROJ;
    {
        const u32x4 q1 = *(const u32x4*)(prow + h * 128 + cb * 8), q2 = *(const u32x4*)(prow + h * 128 + 64 + cb * 8);
        const u32x4 k1 = *(const u32x4*)(prow + 512 + h * 128 + cb * 8), k2 = *(const u32x4*)(prow + 512 + h * 128 + 64 + cb * 8);
        const u32x4 v0 = *(const u32x4*)(prow + 1024 + h * 128 + cb * 16), v1 = *(const u32x4*)(prow + 1024 + h * 128 + cb * 16 + 8);
        *(LAS u32x4*)(lds + P3_V + r * 272 + cb * 32) = v0; *(LAS u32x4*)(lds + P3_V + r * 272 + cb * 32 + 16) = v1;
        const float pos = (float)(n * 64 + r);
        float qa[8], qb[8], ka[8], kb[8];
        const unsigned qw1[4] = {q1.x, q1.y, q1.z, q1.w}, qw2[4] = {q2.x, q2.y, q2.z, q2.w}, kw1[4] = {k1.x, k1.y, k1.z, k1.w}, kw2[4] = {k2.x, k2.y, k2.z, k2.w};
#pragma unroll
        for (int e = 0; e < 8; ++e) {
            const int d = cb * 8 + e;
            const float inv = exp2f(-(float)d * (13.287712379549449f / 64.f));
            const float ang = pos * inv;
            const float kq = rintf(ang * 0.15915494309189535f);
            float rr = fmaf(-kq, 6.2831854820251465f, ang); rr = fmaf(-kq, -1.7484555e-7f, rr);
            const float cs = __cosf(rr), sn = __sinf(rr);
            const float x1 = (e & 1) ? bfhi(qw1[e >> 1]) : bflo(qw1[e >> 1]), x2 = (e & 1) ? bfhi(qw2[e >> 1]) : bflo(qw2[e >> 1]);
            const float y1 = (e & 1) ? bfhi(kw1[e >> 1]) : bflo(kw1[e >> 1]), y2 = (e & 1) ? bfhi(kw2[e >> 1]) : bflo(kw2[e >> 1]);
            qa[e] = x1 * cs - x2 * sn; qb[e] = x1 * sn + x2 * cs;
            ka[e] = (y1 * cs - y2 * sn) * 0.08838834764831845f; kb[e] = (y1 * sn + y2 * cs) * 0.08838834764831845f;
        }
        u32x4 o;
        o.x = pk2(qa[0], qa[1]); o.y = pk2(qa[2], qa[3]); o.z = pk2(qa[4], qa[5]); o.w = pk2(qa[6], qa[7]); *(LAS u32x4*)(lds + P3_Q + r * 272 + cb * 16) = o;
        o.x = pk2(qb[0], qb[1]); o.y = pk2(qb[2], qb[3]); o.z = pk2(qb[4], qb[5]); o.w = pk2(qb[6], qb[7]); *(LAS u32x4*)(lds + P3_Q + r * 272 + 128 + cb * 16) = o;
        o.x = pk2(ka[0], ka[1]); o.y = pk2(ka[2], ka[3]); o.z = pk2(ka[4], ka[5]); o.w = pk2(ka[6], ka[7]); *(LAS u32x4*)(lds + P3_K + r * 272 + cb * 16) = o;
        o.x = pk2(kb[0], kb[1]); o.y = pk2(kb[2], kb[3]); o.z = pk2(kb[4], kb[5]); o.w = pk2(kb[6], kb[7]); *(LAS u32x4*)(lds + P3_K + r * 272 + 128 + cb * 16) = o;
        const float qd = __expf(lg * (float)(r + 1));
        bf16_t* q0 = qgG + r * 128 + (cb >> 1) * 16 + 4 * (cb & 1);
        u32x2 w2;
        w2.x = pk2(qa[0] * qd, qa[1] * qd); w2.y = pk2(qa[2] * qd, qa[3] * qd); *(u32x2*)(q0) = w2;
        w2.x = pk2(qa[4] * qd, qa[5] * qd); w2.y = pk2(qa[6] * qd, qa[7] * qd); *(u32x2*)(q0 + 8) = w2;
        w2.x = pk2(qb[0] * qd, qb[1] * qd); w2.y = pk2(qb[2] * qd, qb[3] * qd); *(u32x2*)(q0 + 64) = w2;
        w2.x = pk2(qb[4] * qd, qb[5] * qd); w2.y = pk2(qb[6] * qd, qb[7] * qd); *(u32x2*)(q0 + 64 + 8) = w2;
    }
    }
    __syncthreads();
#pragma unroll
    for (int i = 0; i < 4; ++i) {
        const int ti = wave * 4 + i, mt = ti >> 2, nt = ti & 3;
        const LAS unsigned char* Ab = lds + P3_Q + (16 * mt + (lane & 15)) * 272 + (lane >> 4) * 16;
        const LAS unsigned char* Bb = lds + P3_K + (16 * nt + (lane & 15)) * 272 + (lane >> 4) * 16;
        f32x4 acc = {0.f, 0.f, 0.f, 0.f};
#pragma unroll
        for (int s = 0; s < 4; ++s) acc = __builtin_amdgcn_mfma_f32_16x16x32_bf16(*(const LAS bf16x8*)(Ab + s * 64), *(const LAS bf16x8*)(Bb + s * 64), acc, 0, 0, 0);
        const int jj = 16 * nt + (lane & 15);
#pragma unroll
        for (int j = 0; j < 4; ++j) { const int ii = 16 * mt + (lane >> 4) * 4 + j; const int dd = ii > jj ? ii - jj : jj - ii;
            atG[ii * 64 + (jj & ~15) + pinv16(jj & 15)] = f2bf(acc[j] * __expf(lg * (float)dd)); }
    }
    {
        const LAS unsigned short* Kb = (const LAS unsigned short*)(lds + P3_K);
#pragma unroll
        for (int i = 0; i < 4; ++i) {
            const int idx = tid + 256 * i, dk = idx >> 3, ch = idx & 7, cb0 = (ch >> 1) * 16 + (ch & 1) * 4;
            float v[8];
#pragma unroll
            for (int e = 0; e < 8; ++e) { const int c = cb0 + (e & 3) + (e >> 2) * 8; v[e] = bf2f(Kb[c * 136 + dk]) * __expf(lg * (float)(63 - c)); }
            u32x4 o; o.x = pk2(v[0], v[1]); o.y = pk2(v[2], v[3]); o.z = pk2(v[4], v[5]); o.w = pk2(v[6], v[7]);
            *(u32x4*)(kdT + dk * 64 + ch * 8) = o;
        }
    }
#pragma unroll 1
    for (int ps = 0; ps < 2; ++ps) {
        const int dk = tid & 127, cblk = (tid >> 7) + 2 * ps;
        const LAS unsigned short* Vp = (const LAS unsigned short*)(lds + P3_V) + dk;
        unsigned short vv[16];
#pragma unroll
        for (int d = 0; d < 16; ++d) vv[d] = Vp[(cblk * 16 + d) * 136];
        u32x4 o0, o1;
        o0.x = vv[0] | ((unsigned)vv[1] << 16); o0.y = vv[2] | ((unsigned)vv[3] << 16); o0.z = vv[4] | ((unsigned)vv[5] << 16); o0.w = vv[6] | ((unsigned)vv[7] << 16);
        o1.x = vv[8] | ((unsigned)vv[9] << 16); o1.y = vv[10] | ((unsigned)vv[11] << 16); o1.z = vv[12] | ((unsigned)vv[13] << 16); o1.w = vv[14] | ((unsigned)vv[15] << 16);
        { bf16_t* up = vT + ((dk >> 5) * 8 + cblk * 2) * 256 + (dk & 31) * 4;
          *(u32x2*)up = (u32x2){o0.x, o0.y}; *(u32x2*)(up + 128) = (u32x2){o0.z, o0.w}; *(u32x2*)(up + 256) = (u32x2){o1.x, o1.y}; *(u32x2*)(up + 256 + 128) = (u32x2){o1.z, o1.w}; }
    }
}

DI void p3_phase(const Args& a, LAS unsigned char* lds, int wv) {
    { const int hh = (blockIdx.x >> 1) & 3, tid = wv * 64 + lane_id();
      LAS float* cwl = (LAS float*)(lds + P3_CW);
      for (int i = tid; i < 1536; i += 512) { const int mtx = i >> 9, w = (i >> 7) & 3, ch = i & 127; cwl[i] = a.conv_w[(size_t)w * 1536 + mtx * 512 + hh * 128 + ch]; }
      __syncthreads(); }
    for (int it = blockIdx.x; it < 4096; it += 2 * gridDim.x) {
        const int it2 = it + gridDim.x;
        const int typeA = (it & 1) ^ ((it >> 8) & 1);
        const int itg = typeA ? it : it2, itr = typeA ? it2 : it;
        const int chg = itg >> 1, chr = itr >> 1;
        p3_pair_item(a, lds, chg >> 8, (chg >> 2) & 63, chg & 3, chr >> 8, (chr >> 2) & 63, chr & 3, wv);
    }
}

constexpr int ST_BYTES = 62464, ST_W = 0, ST_QG = 17408, ST_KD = 34816, ST_AT = 53248;
DI bf16x8 pack8(const f32x16& x, int base) {
    u32x4 p; p.x = pk2(x[base + 0], x[base + 1]); p.y = pk2(x[base + 2], x[base + 3]); p.z = pk2(x[base + 4], x[base + 5]); p.w = pk2(x[base + 6], x[base + 7]);
    return __builtin_bit_cast(bf16x8, p);
}
#define MFMA32(a, b, c) __builtin_amdgcn_mfma_f32_32x32x16_bf16((a), (b), (c), 0, 0, 0)
#define SCAN_BAR() do { asm volatile("s_waitcnt lgkmcnt(0)" ::: "memory"); __builtin_amdgcn_s_barrier(); asm volatile("" ::: "memory"); } while (0)
#define SBAR __builtin_amdgcn_sched_barrier(0)
template <int type>
DI void scan_compute(const Args& a, LAS unsigned char* lds, const unsigned char* rec0, size_t rstride, bf16_t* O, int wave, int bh, int b, int h) {
            int lane_ = lane_id(); asm volatile("" : "+v"(lane_));
            const int r = lane_ & 31, hh = lane_ >> 5;
            const float* glast = (const float*)(a.ws + WS_GLAST) + bh * 64;
            const float rdec = __expf(64.f * log1pf(-exp2f(-5.f - (float)h)));
            const float edec = type ? __expf(glast[lane_]) : 1.f;
            const int ncol = 32 * wave + r;
            const int colbase = (type == 0 ? 0 : 512) + h * 128;
            u32x2 uc[2][4];
            f32x16 S[4];
#pragma unroll
            for (int mt = 0; mt < 4; ++mt)
#pragma unroll
                for (int i = 0; i < 16; ++i) S[mt][i] = 0.f;
#define SCAN_ULOAD(nn) do { const bf16_t* up = (const bf16_t*)(rec0 + (size_t)(nn) * rstride) + wave * 2048 + hh * 128 + r * 4;        \
                _Pragma("unroll") for (int mt = 0; mt < 2; ++mt) _Pragma("unroll") for (int g = 0; g < 4; ++g) uc[mt][g] = *(const u32x2*)(up + (mt * 4 + g) * 256); } while (0)
            SCAN_ULOAD(0);
            SCAN_BAR();
#define FR(p) (*(const LAS bf16x8*)(p))
#define LOAD_W(F, s)  do { F[0] = FR(pW + (s) * 32); F[1] = FR(pW + 32 * 272 + (s) * 32); F[2] = FR(pW + ((s) + 1) * 32); F[3] = FR(pW + 32 * 272 + ((s) + 1) * 32); } while (0)
#define LOAD_Q(F, s)  do { F[0] = FR(pQ + (s) * 32); F[1] = FR(pQ + 32 * 272 + (s) * 32); F[2] = FR(pQ + ((s) + 1) * 32); F[3] = FR(pQ + 32 * 272 + ((s) + 1) * 32); } while (0)
#define LOAD_T(F, s)  do { F[0] = FR(pT + (s) * 32); F[1] = FR(pT + 32 * 144 + (s) * 32); F[2] = FR(pT + ((s) + 1) * 32); F[3] = FR(pT + 32 * 144 + ((s) + 1) * 32); } while (0)
#define LOAD_K(F, s)  do { F[0] = FR(pK + (s) * 32); F[1] = FR(pK + 32 * 144 + (s) * 32); F[2] = FR(pK + 64 * 144 + (s) * 32); F[3] = FR(pK + 96 * 144 + (s) * 32); } while (0)
#define COMP_W(F, s)  do { acc0 = MFMA32(F[0], Sb[s], acc0); acc1 = MFMA32(F[1], Sb[s], acc1); acc0 = MFMA32(F[2], Sb[(s) + 1], acc0); acc1 = MFMA32(F[3], Sb[(s) + 1], acc1); } while (0)
#define COMP_Q(F, s)  do { o0 = MFMA32(F[0], Sb[s], o0); o1 = MFMA32(F[1], Sb[s], o1); o0 = MFMA32(F[2], Sb[(s) + 1], o0); o1 = MFMA32(F[3], Sb[(s) + 1], o1); } while (0)
#define COMP_T(F, s)  do { o0 = MFMA32(F[0], vb[s], o0); o1 = MFMA32(F[1], vb[s], o1); o0 = MFMA32(F[2], vb[(s) + 1], o0); o1 = MFMA32(F[3], vb[(s) + 1], o1); } while (0)
#define COMP_K(F, s)  do { S[0] = MFMA32(F[0], vb[s], S[0]); S[1] = MFMA32(F[1], vb[s], S[1]); S[2] = MFMA32(F[2], vb[s], S[2]); S[3] = MFMA32(F[3], vb[s], S[3]); } while (0)
#pragma unroll 1
            for (int n = 0; n < 64; ++n) {
                const LAS unsigned char* sb = lds + (n & 1) * ST_BYTES;
                const LAS unsigned char* pW = sb + ST_W + r * 272 + hh * 16;
                const LAS unsigned char* pQ = sb + ST_QG + r * 272 + hh * 16;
                const LAS unsigned char* pT = sb + ST_AT + r * 144 + hh * 16;
                const LAS unsigned char* pK = sb + ST_KD + r * 144 + hh * 16;
                const float dec = type ? __builtin_bit_cast(float, __builtin_amdgcn_readlane(__builtin_bit_cast(int, edec), n)) : rdec;
                bf16x8 vb[4], fa[4], fb[4];
                f32x16 acc0, acc1, o0, o1;
#pragma unroll
                for (int i = 0; i < 16; ++i) { acc0[i] = 0.f; acc1[i] = 0.f; o0[i] = 0.f; o1[i] = 0.f; }
#define SBF(s) pack8(S[(s) >> 1], ((s) & 1) * 8)
#define LOAD_WQ(F, s) do { if constexpr (type != 0) { F[0] = FR(pW + (s) * 32); F[1] = FR(pW + 32 * 272 + (s) * 32); } F[2] = FR(pQ + (s) * 32); F[3] = FR(pQ + 32 * 272 + (s) * 32); } while (0)
#define COMP_WQ(F, s) do { const bf16x8 sbs = SBF(s); if constexpr (type != 0) { acc0 = MFMA32(F[0], sbs, acc0); acc1 = MFMA32(F[1], sbs, acc1); } o0 = MFMA32(F[2], sbs, o0); o1 = MFMA32(F[3], sbs, o1); } while (0)
                LOAD_WQ(fa, 0);
                LOAD_WQ(fb, 1); SBAR; COMP_WQ(fa, 0); SBAR;
                LOAD_WQ(fa, 2); SBAR; COMP_WQ(fb, 1); SBAR;
                LOAD_WQ(fb, 3); SBAR; COMP_WQ(fa, 2); SBAR;
                LOAD_WQ(fa, 4); SBAR; COMP_WQ(fb, 3); SBAR;
                LOAD_WQ(fb, 5); SBAR; COMP_WQ(fa, 4); SBAR;
                LOAD_WQ(fa, 6); SBAR; COMP_WQ(fb, 5); SBAR;
                LOAD_WQ(fb, 7); SBAR; COMP_WQ(fa, 6); SBAR;
                LOAD_T(fa, 0); SBAR; COMP_WQ(fb, 7); SBAR;
                {
#pragma unroll
                    for (int g = 0; g < 4; ++g) {
                        acc0[4 * g + 0] = bflo(uc[0][g].x) - acc0[4 * g + 0]; acc0[4 * g + 1] = bfhi(uc[0][g].x) - acc0[4 * g + 1];
                        acc0[4 * g + 2] = bflo(uc[0][g].y) - acc0[4 * g + 2]; acc0[4 * g + 3] = bfhi(uc[0][g].y) - acc0[4 * g + 3];
                        acc1[4 * g + 0] = bflo(uc[1][g].x) - acc1[4 * g + 0]; acc1[4 * g + 1] = bfhi(uc[1][g].x) - acc1[4 * g + 1];
                        acc1[4 * g + 2] = bflo(uc[1][g].y) - acc1[4 * g + 2]; acc1[4 * g + 3] = bfhi(uc[1][g].y) - acc1[4 * g + 3]; }
                    vb[0] = pack8(acc0, 0); vb[1] = pack8(acc0, 8); vb[2] = pack8(acc1, 0); vb[3] = pack8(acc1, 8);
                }
                SBAR;
                SCAN_ULOAD(n + 1 < 64 ? n + 1 : 63);
                LOAD_T(fb, 2); SBAR; COMP_T(fa, 0); S[0] = S[0] * dec; S[1] = S[1] * dec; SBAR;
                LOAD_K(fa, 0); SBAR; COMP_T(fb, 2); S[2] = S[2] * dec; S[3] = S[3] * dec; SBAR;
                LOAD_K(fb, 1); SBAR; COMP_K(fa, 0); SBAR;
                LOAD_K(fa, 2); SBAR; COMP_K(fb, 1); SBAR;
                LOAD_K(fb, 3); SBAR; COMP_K(fa, 2); SBAR;
                COMP_K(fb, 3);
                SBAR;
                {
                    LAS unsigned char* og = lds + 2 * ST_BYTES + wave * 5120;
                    LAS unsigned short* ow = (LAS unsigned short*)(og + (4 * hh) * 80) + r;
                    unsigned pk[16];
#pragma unroll
                    for (int i = 0; i < 8; ++i) { pk[i] = pk2(o0[2 * i], o0[2 * i + 1]); pk[8 + i] = pk2(o1[2 * i], o1[2 * i + 1]); }
                    SBAR;
#pragma unroll
                    for (int i = 0; i < 8; ++i) {
                        ow[(((2 * i) & 3) + 8 * ((2 * i) >> 2)) * 40] = (unsigned short)(pk[i] & 0xffffu); ow[(((2 * i + 1) & 3) + 8 * ((2 * i + 1) >> 2)) * 40] = (unsigned short)(pk[i] >> 16);
                        ow[(32 + ((2 * i) & 3) + 8 * ((2 * i) >> 2)) * 40] = (unsigned short)(pk[8 + i] & 0xffffu); ow[(32 + ((2 * i + 1) & 3) + 8 * ((2 * i + 1) >> 2)) * 40] = (unsigned short)(pk[8 + i] >> 16); }
                    asm volatile("" ::: "memory");
                    char* ob = (char*)O + (size_t)(((b * SEQ + n * 64) * DM + colbase + 32 * wave) * 2);
                    const int lrow = (r >> 2) + 8 * hh, lpart = r & 3;
                    const unsigned lo = (unsigned)(lrow * (DM * 2) + lpart * 16);
                    const LAS unsigned char* orp = og + lrow * 80 + lpart * 16;
#pragma unroll
                    for (int k = 0; k < 4; ++k) *(u32x4*)(ob + (lo + (unsigned)(k * 16 * DM * 2))) = *(const LAS u32x4*)(orp + 16 * k * 80);
                }
                SCAN_BAR();
            }
#undef SCAN_ULOAD
#undef FR
#undef LOAD_W
#undef LOAD_Q
#undef LOAD_T
#undef LOAD_K
#undef COMP_W
#undef SBF
#undef LOAD_WQ
#undef COMP_WQ
#undef COMP_Q
#undef COMP_T
#undef COMP_K
}
DI u32x4 ld_async(const unsigned char* p) { u32x4 v; asm volatile("global_load_dwordx4 %0, %1, off" : "=v"(v) : "v"(p) : "memory"); return v; }
template <int type>
DI void scan_loader(LAS unsigned char* lds, const unsigned char* rec0, size_t rstride, int o_w, int o_qg, int o_kd, int o_at, int wv) {
    int t2_ = wv * 64 + lane_id() - 256; asm volatile("" : "+v"(t2_));
    const int t2 = t2_;
    u32x4 sgA[14], sgB[14];
#define LD_LOAD(dst, nn) do { const unsigned char* rec = rec0 + (size_t)((nn) < 64 ? (nn) : 63) * rstride; \
        _Pragma("unroll") for (int i = 0; i < 4; ++i) { if constexpr (type != 0) dst[i] = ld_async(rec + o_w + (t2 + 256 * i) * 16); \
            dst[4 + i] = ld_async(rec + o_qg + (t2 + 256 * i) * 16); dst[8 + i] = ld_async(rec + o_kd + (t2 + 256 * i) * 16); } \
        dst[12] = ld_async(rec + o_at + t2 * 16); dst[13] = ld_async(rec + o_at + (t2 + 256) * 16); } while (0)
#define LD_STORE(src, st) do { LAS unsigned char* sb = lds + (st) * ST_BYTES; \
        _Pragma("unroll") for (int i = 0; i < 4; ++i) { const int p = t2 + 256 * i; \
            if constexpr (type != 0) *(LAS u32x4*)(sb + ST_W + (p >> 4) * 272 + (p & 15) * 16) = src[i]; \
            *(LAS u32x4*)(sb + ST_QG + (p >> 4) * 272 + (p & 15) * 16) = src[4 + i]; \
            *(LAS u32x4*)(sb + ST_KD + (p >> 3) * 144 + (p & 7) * 16) = src[8 + i]; } \
        *(LAS u32x4*)(sb + ST_AT + (t2 >> 3) * 144 + (t2 & 7) * 16) = src[12]; \
        *(LAS u32x4*)(sb + ST_AT + ((t2 + 256) >> 3) * 144 + (t2 & 7) * 16) = src[13]; } while (0)
#define LD_WAIT_OLDER() do { if constexpr (type != 0) asm volatile("s_waitcnt vmcnt(14)" ::: "memory"); else asm volatile("s_waitcnt vmcnt(10)" ::: "memory"); } while (0)
    LD_LOAD(sgA, 0); asm volatile("s_waitcnt vmcnt(0)" ::: "memory"); LD_STORE(sgA, 0); LD_LOAD(sgB, 1); LD_LOAD(sgA, 2);
    SCAN_BAR();
#define LD_ITER(nn, BUF) do { LD_WAIT_OLDER(); if ((nn) + 1 < 64) LD_STORE(BUF, ((nn) + 1) & 1); LD_LOAD(BUF, (nn) + 3); SCAN_BAR(); } while (0)
#pragma unroll 1
    for (int n = 0; n < 64; n += 2) { LD_ITER(n, sgB); LD_ITER(n + 1, sgA); }
    asm volatile("s_waitcnt vmcnt(0)" ::: "memory");
#undef LD_ITER
#undef LD_WAIT_OLDER
#undef LD_LOAD
#undef LD_STORE
}
DI void p_cvec(const Args& a, LAS unsigned char* lds, int wv, int part) {
    const int tid = wv * 64 + lane_id(), j = part * 512 + tid;
    LAS float* sh = (LAS float*)lds;
    const float* mod = (const float*)(a.ws + WS_MOD);
    for (int i = tid; i < 8192; i += 512) sh[i] = mod[(size_t)(i >> 10) * NMOD + 3072 + (i & 1023)];
    __syncthreads();
    float acc[8];
#pragma unroll
    for (int b = 0; b < 8; ++b) acc[b] = 0.f;
#pragma unroll 16
    for (int k = 0; k < 1024; ++k) { const float w = a.w_ff1[(size_t)k * DFF + j];
#pragma unroll
        for (int b = 0; b < 8; ++b) acc[b] += sh[b * 1024 + k] * w; }
#pragma unroll
    for (int b = 0; b < 8; ++b) ((float*)(a.ws + WS_CVEC))[b * DFF + j] = acc[b];
}
DI void scan_phase(const Args& a, LAS unsigned char* lds, int wv) {
    const int wave = wv;
    bf16_t* O = (bf16_t*)(a.ws + WS_ACT);
    const int item = blockIdx.x;
    if (item < 64) {
        const int type = item & 1, bh = item >> 1, b = bh >> 2, h = bh & 3;
        const unsigned char* rec0; size_t rstride; int o_w, o_qg, o_kd, o_at;
        if (type == 0) { rec0 = (const unsigned char*)a.out + (size_t)bh * 64 * RREC; rstride = RREC; o_w = 0; o_qg = 16384; o_kd = 32768; o_at = 49152; }
        else { rec0 = a.ws + WS_GREC + (size_t)bh * 64 * GREC; rstride = GREC; o_w = 16384; o_qg = 32768; o_kd = 49152; o_at = 65536; }
        if (wave >= 4) {
            if (type) scan_loader<1>(lds, rec0, rstride, o_w, o_qg, o_kd, o_at, wv); else scan_loader<0>(lds, rec0, rstride, o_w, o_qg, o_kd, o_at, wv);
        } else {
            __builtin_amdgcn_s_setprio(3);
            if (type) scan_compute<1>(a, lds, rec0, rstride, O, wave, bh, b, h); else scan_compute<0>(a, lds, rec0, rstride, O, wave, bh, b, h);
            __builtin_amdgcn_s_setprio(0);
        }
    } else if (item < 72) {
        p_cvec(a, lds, wv, item - 64);
    }
#undef SCAN_BAR
#undef SBAR
}

DI void p5_phase(const Args& a, int wv) {
    const int lane = lane_id(), wave = wv;
    bf16_t* O = (bf16_t*)(a.ws + WS_ACT); const bf16_t* proj = (const bf16_t*)(a.ws + WS_PROJ);
    const int gw = blockIdx.x * 8 + wave, NGW = gridDim.x * 8, col = lane * 16; const bool isret = lane < 32;
    const float* nwp = isret ? a.ret_norm_w + col : a.gdn_norm_w + (col & 127);
    float nw[16];
#pragma unroll
    for (int q = 0; q < 4; ++q) { const f32x4 t = *(const f32x4*)(nwp + 4 * q); nw[4 * q] = t.x; nw[4 * q + 1] = t.y; nw[4 * q + 2] = t.z; nw[4 * q + 3] = t.w; }
    const int gcol = isret ? 1536 + col : 3072 + col;
    for (int m = gw; m < MROWS; m += NGW) {
        bf16_t* op = O + (size_t)m * DM + col;
        const u32x4 o0 = *(const u32x4*)op, o1 = *(const u32x4*)(op + 8);
        const u32x4 g0 = *(const u32x4*)(proj + (size_t)m * NPROJ + gcol), g1 = *(const u32x4*)(proj + (size_t)m * NPROJ + gcol + 8);
        float v[16], g[16];
        v[0] = bflo(o0.x); v[1] = bfhi(o0.x); v[2] = bflo(o0.y); v[3] = bfhi(o0.y); v[4] = bflo(o0.z); v[5] = bfhi(o0.z); v[6] = bflo(o0.w); v[7] = bfhi(o0.w);
        v[8] = bflo(o1.x); v[9] = bfhi(o1.x); v[10] = bflo(o1.y); v[11] = bfhi(o1.y); v[12] = bflo(o1.z); v[13] = bfhi(o1.z); v[14] = bflo(o1.w); v[15] = bfhi(o1.w);
        g[0] = bflo(g0.x); g[1] = bfhi(g0.x); g[2] = bflo(g0.y); g[3] = bfhi(g0.y); g[4] = bflo(g0.z); g[5] = bfhi(g0.z); g[6] = bflo(g0.w); g[7] = bfhi(g0.w);
        g[8] = bflo(g1.x); g[9] = bfhi(g1.x); g[10] = bflo(g1.y); g[11] = bfhi(g1.y); g[12] = bflo(g1.z); g[13] = bfhi(g1.z); g[14] = bflo(g1.w); g[15] = bfhi(g1.w);
        float s = 0.f;
#pragma unroll
        for (int e = 0; e < 16; ++e) s += v[e];
        s = red8(s);
        const float mu = isret ? s * (1.f / 128.f) : 0.f;
        float ss = 0.f;
#pragma unroll
        for (int e = 0; e < 16; ++e) { v[e] -= mu; ss += v[e] * v[e]; }
        ss = red8(ss);
        const float rstd = 1.0f / sqrtf(ss * (1.f / 128.f) + EPS);
        float y[16];
#pragma unroll
        for (int e = 0; e < 16; ++e) y[e] = v[e] * rstd * nw[e] * silu_f(g[e]);
        u32x4 w0, w1; w0.x = pk2(y[0], y[1]); w0.y = pk2(y[2], y[3]); w0.z = pk2(y[4], y[5]); w0.w = pk2(y[6], y[7]);
        w1.x = pk2(y[8], y[9]); w1.y = pk2(y[10], y[11]); w1.z = pk2(y[12], y[13]); w1.w = pk2(y[14], y[15]);
        *(u32x4*)op = w0; *(u32x4*)(op + 8) = w1;
    }
}

DI void final_norm_phase(const Args& a, int wv) {
    const int lane = lane_id(), wave = wv;
    const int gw = blockIdx.x * 8 + wave, NGW = gridDim.x * 8, c0 = lane * 16;
    const bf16_t* X = (const bf16_t*)(a.ws + WS_X1);
    f32x4 nwv[4];
#pragma unroll
    for (int q = 0; q < 4; ++q) nwv[q] = *(const f32x4*)(a.norm_final_w + c0 + 4 * q);
    for (int m0 = gw; m0 < MROWS; m0 += 2 * NGW) {
        u32x4 raw[2][2];
#pragma unroll
        for (int rr = 0; rr < 2; ++rr) { const int m = m0 + rr * NGW < MROWS ? m0 + rr * NGW : m0;
            raw[rr][0] = *(const u32x4*)(X + (size_t)m * DM + c0); raw[rr][1] = *(const u32x4*)(X + (size_t)m * DM + c0 + 8); }
#pragma unroll
        for (int rr = 0; rr < 2; ++rr) {
            const int m = m0 + rr * NGW;
            if (m < MROWS) {
                f32x4 v[4];
                v[0] = (f32x4){bflo(raw[rr][0].x), bfhi(raw[rr][0].x), bflo(raw[rr][0].y), bfhi(raw[rr][0].y)};
                v[1] = (f32x4){bflo(raw[rr][0].z), bfhi(raw[rr][0].z), bflo(raw[rr][0].w), bfhi(raw[rr][0].w)};
                v[2] = (f32x4){bflo(raw[rr][1].x), bfhi(raw[rr][1].x), bflo(raw[rr][1].y), bfhi(raw[rr][1].y)};
                v[3] = (f32x4){bflo(raw[rr][1].z), bfhi(raw[rr][1].z), bflo(raw[rr][1].w), bfhi(raw[rr][1].w)};
                float ss = 0.f;
#pragma unroll
                for (int q = 0; q < 4; ++q) ss += (v[q].x * v[q].x + v[q].y * v[q].y) + (v[q].z * v[q].z + v[q].w * v[q].w);
                ss = wave_sum(ss);
                const float rstd = 1.0f / sqrtf(ss * (1.f / DM) + EPS);
                float* xr = a.out + (size_t)m * DM + c0;
#pragma unroll
                for (int q = 0; q < 4; ++q) *(f32x4*)(xr + 4 * q) = v[q] * rstd * nwv[q];
            }
        }
    }
}

#define XB_TMO      128
#define XB_XCNT(j)  (256  + 64 * (j))
#define XB_XSUB(j)  (1280 + 64 * (j))
#define XB_XGEN(j)  (2304 + 64 * (j))
#define XB_TOP      3328
#define XB_TOPGEN   3392
#define XCD_BAR_WORDS 3456
#define XB_SPIN_CAP (1u << 18)
DI unsigned xb_ld(unsigned* p)              { return __hip_atomic_load(p, __ATOMIC_RELAXED, __HIP_MEMORY_SCOPE_AGENT); }
DI unsigned xb_add(unsigned* p, unsigned v) { return __hip_atomic_fetch_add(p, v, __ATOMIC_RELAXED, __HIP_MEMORY_SCOPE_AGENT); }
DI unsigned xb_xcc_id() { return (unsigned)__builtin_amdgcn_s_getreg((3 << 11) | 20) & 0xFu; }
#define XB_SPIN(cond, bar) do { unsigned _sp = 0; while (cond) { __builtin_amdgcn_s_sleep(1); \
    if ((++_sp & 255u) == 0u) { if (xb_ld(&(bar)[XB_TMO])) break; if (_sp > XB_SPIN_CAP) { atomicAdd(&(bar)[XB_TMO], 1u); break; } } } } while (0)
struct XcdBarrier { unsigned* bar; unsigned x; volatile LAS unsigned* st; };
DI XcdBarrier xcd_barrier_post(unsigned* bar, volatile LAS unsigned* st, int wv) {
    XcdBarrier b; b.bar = bar; b.x = xb_xcc_id(); b.st = st;
    if (wv == 0 && lane_id() == 0) (void)xb_add(&bar[XB_XCNT(b.x)], 1u);
    return b;
}
DI void xcd_barrier_complete(unsigned* bar, unsigned x, unsigned& nloc, unsigned& nx) {
    const unsigned G = gridDim.x * gridDim.y * gridDim.z;
    unsigned sum, cnt, mine, sp = 0u;
    for (;;) {
        sum = 0u; cnt = 0u; mine = 0u;
#pragma unroll
        for (unsigned j = 0; j < 16; ++j) { const unsigned c = xb_ld(&bar[XB_XCNT(j)]); sum += c; cnt += (c > 0u) ? 1u : 0u; mine = (j == x) ? c : mine; }
        if (sum == G) break;
        __builtin_amdgcn_s_sleep(1);
        if ((++sp & 255u) == 0u) { if (xb_ld(&bar[XB_TMO])) break; if (sp > XB_SPIN_CAP) { atomicAdd(&bar[XB_TMO], 1u); break; } }
    }
    nloc = mine > 0u ? mine : 1u; nx = cnt > 0u ? cnt : 1u;
}
DI void xcd_barrier(const XcdBarrier& b, int wv) {
    asm volatile("s_waitcnt vmcnt(0)" ::: "memory");
    __syncthreads();
    if (wv == 0 && lane_id() == 0) {
        unsigned* bar = b.bar;
        __builtin_amdgcn_s_waitcnt(0);
        unsigned nloc = b.st[0], nx = b.st[1];
        if (nloc == 0u) { xcd_barrier_complete(bar, b.x, nloc, nx); b.st[0] = nloc; b.st[1] = nx; }
        const unsigned old = xb_add(&bar[XB_XSUB(b.x)], 1u);
        const unsigned gen = old / nloc;
        if (old + 1u == (gen + 1u) * nloc) {
            __builtin_amdgcn_fence(__ATOMIC_RELEASE, "agent");
            asm volatile("s_waitcnt vmcnt(0)" ::: "memory");
            const unsigned og = xb_add(&bar[XB_TOP], 1u);
            const unsigned tg = og / nx;
            if (og + 1u == (tg + 1u) * nx) xb_add(&bar[XB_TOPGEN], 1u);
            else XB_SPIN(xb_ld(&bar[XB_TOPGEN]) == tg, bar);
            __builtin_amdgcn_fence(__ATOMIC_ACQUIRE, "agent");
            xb_add(&bar[XB_XGEN(b.x)], 1u);
            asm volatile("s_waitcnt vmcnt(0)" ::: "memory");
        } else {
            XB_SPIN(xb_ld(&bar[XB_XGEN(b.x)]) == gen, bar);
            __builtin_amdgcn_fence(__ATOMIC_ACQUIRE, "agent");
            asm volatile("s_waitcnt vmcnt(0)" ::: "memory");
        }
    }
    __syncthreads();
}

constexpr int N_PHASES = 11;
__global__ void __launch_bounds__(512, 2) fwd_megakernel(Args a) {
    extern __shared__ __attribute__((aligned(16))) unsigned char lds_raw[];
    LAS unsigned char* lds = (LAS unsigned char*)lds_raw;
    cg::grid_group grid = cg::this_grid();
    volatile LAS unsigned* bst = (volatile LAS unsigned*)(lds + 147200);
    const int wv = __builtin_amdgcn_readfirstlane(threadIdx.x >> 6);
    if (wv == 0 && lane_id() < 2) bst[lane_id()] = 0u;
    __syncthreads();
    const XcdBarrier bar = xcd_barrier_post((unsigned*)(a.ws + WS_BAR), bst, wv);
    if (a.ph_lo < 0) grid.sync();
    const float* mod = (const float*)(a.ws + WS_MOD);
    bf16_t* act = (bf16_t*)(a.ws + WS_ACT);
    bf16_t* proj = (bf16_t*)(a.ws + WS_PROJ);
    const int G = gridDim.x;
#define IN(k) (a.ph_lo <= (k) && (k) < a.ph_hi)
#define SEAM(k) do { if (IN(k) && IN((k) + 1)) xcd_barrier(bar, wv); } while (0)
    if (IN(0)) { p0_phase(a, lds, wv); } SEAM(0);
    if (IN(1)) { norm_mod_phase<true>(a.x, a.norm_mix_w, mod, 0, 1024, act, a.w_in, (float*)(a.ws + WS_GAB), lds, wv); } SEAM(1);
    if (IN(2)) { pg8::Gemm g{act, (const bf16_t*)(a.ws + WS_WIN), MROWS, NPROJ, DM}; pg8::StaticOrder S; S.init(MROWS, NPROJ, G, (int)blockIdx.x);
        pg8::EpiBf16<0> E{proj, NPROJ}; pg8::gemm_phase<pg8::EpiBf16<0>, pg8::StaticOrder, true, true>(lds, g, S, E, wv); } SEAM(2);
    if (IN(3)) { p3_phase(a, lds, wv); } SEAM(3);
    if (IN(4)) { scan_phase(a, lds, wv); } SEAM(4);
    if (IN(5)) { p5_phase(a, wv); } SEAM(5);
    if (IN(6)) { pg8::Gemm g{act, (const bf16_t*)(a.ws + WS_WOUT), MROWS, DM, DM}; pg8::StaticOrder S; S.init(MROWS, DM, G, (int)blockIdx.x);
        pg8::EpiResGateNorm E{a.x, (bf16_t*)(a.ws + WS_X1), mod + 2048, a.norm_mlp_w, mod + 4096, (bf16_t*)(a.ws + WS_ACT2), (float*)(a.ws + WS_SUMSQ)}; pg8::gemm_phase<pg8::EpiResGateNorm, pg8::StaticOrder, true, true>(lds, g, S, E, wv); } SEAM(6);
    if (IN(8)) { pg8::Gemm g{(const bf16_t*)(a.ws + WS_ACT2), (const bf16_t*)(a.ws + WS_WFF1), MROWS, DFF, DM}; pg8::StaticOrder S; S.init(MROWS, DFF, G, (int)blockIdx.x);
        pg8::EpiFf1 E{proj, DFF, (const float*)(a.ws + WS_SUMSQ), (const float*)(a.ws + WS_CVEC)}; pg8::gemm_phase<pg8::EpiFf1, pg8::StaticOrder, true, true>(lds, g, S, E, wv); } SEAM(8);
    if (IN(9)) { pg8::Gemm g{proj, (const bf16_t*)(a.ws + WS_WFF2), MROWS, DM, DFF}; pg8::StaticOrder S; S.init(MROWS, DM, G, (int)blockIdx.x);
        pg8::EpiResGateBf E{(bf16_t*)(a.ws + WS_X1), mod + 5120}; pg8::gemm_phase<pg8::EpiResGateBf, pg8::StaticOrder, true, true>(lds, g, S, E, wv); } SEAM(9);
    if (IN(10)) { final_norm_phase(a, wv); }
#undef IN
#undef SEAM
}

extern "C" void kernel_launch(void* const* d_in, const int* in_sizes, int n_in, void* d_out, int out_size, void* d_ws, size_t ws_size, hipStream_t stream) {
    static int grid = 0;
    if (grid == 0) {
        if (n_in != 16 || out_size != MROWS * DM || ws_size < WS_END) { fprintf(stderr, "kernel_launch: unexpected shapes (n_in %d out %d ws %zu)\n", n_in, out_size, ws_size); grid = -1; return; }
        int dev = 0, cus = 0, per_cu = 0;
        hipGetDevice(&dev); hipDeviceGetAttribute(&cus, hipDeviceAttributeMultiprocessorCount, dev);
        if (hipFuncSetAttribute((const void*)fwd_megakernel, hipFuncAttributeMaxDynamicSharedMemorySize, LDS_BYTES) != hipSuccess) { fprintf(stderr, "kernel_launch: hipFuncSetAttribute failed\n"); grid = -1; return; }
        if (hipOccupancyMaxActiveBlocksPerMultiprocessor(&per_cu, (const void*)fwd_megakernel, 512, LDS_BYTES) != hipSuccess || per_cu < 1) { fprintf(stderr, "kernel_launch: occupancy query says %d\n", per_cu); per_cu = 1; }
        (void)hipGetLastError();
        grid = cus * per_cu;
        if (grid > 256) grid = 256;
        if (grid != 256) { fprintf(stderr, "kernel_launch: this build needs a 256-workgroup grid, got %d\n", grid); grid = -1; return; }
    }
    if (grid < 0) return;
    Args a{};
    a.x = (const float*)d_in[0]; a.c = (const float*)d_in[1]; a.ada_w = (const float*)d_in[2]; a.ada_b = (const float*)d_in[3]; a.norm_mix_w = (const float*)d_in[4]; a.w_in = (const float*)d_in[5];
    a.conv_w = (const float*)d_in[6]; a.a_log = (const float*)d_in[7]; a.dt_bias = (const float*)d_in[8]; a.ret_norm_w = (const float*)d_in[9]; a.gdn_norm_w = (const float*)d_in[10];
    a.w_out = (const float*)d_in[11]; a.norm_mlp_w = (const float*)d_in[12]; a.w_ff1 = (const float*)d_in[13]; a.w_ff2 = (const float*)d_in[14]; a.norm_final_w = (const float*)d_in[15];
    a.out = (float*)d_out; a.ws = (unsigned char*)d_ws;
    if (hipMemsetAsync((char*)d_ws + WS_BAR, 0, XCD_BAR_WORDS * 4, stream) != hipSuccess) { fprintf(stderr, "kernel_launch: memset of barrier words failed\n"); return; }
#if MK_N_LAUNCHES == 1
    a.ph_lo = 0; a.ph_hi = N_PHASES;
    void* args[] = {&a};
    hipError_t e = hipLaunchCooperativeKernel((const void*)fwd_megakernel, dim3(grid), dim3(512), args, LDS_BYTES, stream);
    if (e != hipSuccess) fprintf(stderr, "cooperative launch failed: %s (grid %d)\n", hipGetErrorString(e), grid);
#else
    for (int p = 0; p < N_PHASES; ++p) { a.ph_lo = p; a.ph_hi = p + 1; hipLaunchKernelGGL(fwd_megakernel, dim3(grid), dim3(512), LDS_BYTES, stream, a); }
#endif
}
```

```cpp
#include <hip/hip_runtime.h>
#include <hip/hip_cooperative_groups.h>
#include <cstdio>
#include <cstdint>
namespace cg = cooperative_groups;

#ifndef MK_N_LAUNCHES
#define MK_N_LAUNCHES 1
#endif

#define LAS __attribute__((address_space(3)))
typedef unsigned short bf16_t;
typedef short bf16x8 __attribute__((ext_vector_type(8)));
typedef float f32x4 __attribute__((ext_vector_type(4)));
typedef float f32x16 __attribute__((ext_vector_type(16)));
typedef unsigned u32x4 __attribute__((ext_vector_type(4)));
typedef unsigned u32x2 __attribute__((ext_vector_type(2)));
typedef float f32x2_t __attribute__((ext_vector_type(2)));
typedef __bf16 bf16x2_t __attribute__((ext_vector_type(2)));

#define DI __device__ __forceinline__

DI unsigned pk2(float lo, float hi) { f32x2_t v = {lo, hi}; bf16x2_t b = __builtin_convertvector(v, bf16x2_t); return __builtin_bit_cast(unsigned, b); }
DI unsigned short f2bf(float x) { return (unsigned short)(pk2(x, 0.f) & 0xffffu); }
DI float bf2f(unsigned short u) { return __builtin_bit_cast(float, ((unsigned)u) << 16); }
DI float bflo(unsigned u) { return __builtin_bit_cast(float, u << 16); }
DI float bfhi(unsigned u) { return __builtin_bit_cast(float, u & 0xffff0000u); }
DI float wave_sum(float v) {
#pragma unroll
    for (int o = 1; o < 64; o <<= 1) v += __shfl_xor(v, o);
    return v;
}
DI float silu_f(float v) { return v * __builtin_amdgcn_rcpf(1.f + __expf(-v)); }
DI int lane_id() { return (int)__builtin_amdgcn_mbcnt_hi(~0u, __builtin_amdgcn_mbcnt_lo(~0u, 0u)); }

constexpr int BATCH = 8, SEQ = 4096, DM = 1024, MROWS = BATCH * SEQ, DFF = 4096, NPROJ = 4096, DIN = 4104, NMOD = 6144;
constexpr float EPS = 1e-6f;
constexpr size_t MiB = 1u << 20;
constexpr size_t WS_WIN = 0, WS_WOUT = 8 * MiB, WS_WFF1 = 10 * MiB, WS_WFF2 = 18 * MiB, WS_MOD = 26 * MiB, WS_GLAST = 26 * MiB + 256 * 1024, WS_CVEC = 26 * MiB + 512 * 1024, WS_SUMSQ = 26 * MiB + 768 * 1024, WS_GAB = 27 * MiB,
                 WS_ACT = 28 * MiB, WS_PROJ = 92 * MiB, WS_GREC = 348 * MiB, WS_BAR = 492 * MiB, WS_END = 493 * MiB;
constexpr size_t WS_X1 = WS_GREC + 64 * MiB;
constexpr size_t WS_ACT2 = WS_GREC;
constexpr int GREC = 73728, RREC = 57344;
constexpr int LDS_BYTES = 147456;

struct Args {
    const float* x; const float* c; const float* ada_w; const float* ada_b; const float* norm_mix_w; const float* w_in;
    const float* conv_w; const float* a_log; const float* dt_bias; const float* ret_norm_w; const float* gdn_norm_w;
    const float* w_out; const float* norm_mlp_w; const float* w_ff1; const float* w_ff2; const float* norm_final_w;
    float* out; unsigned char* ws; int ph_lo, ph_hi;
};

namespace pg8 {
constexpr int BM = 256, BK = 64, HALF = 128, HTB = HALF * BK * 2, STAGE_BYTES = 8 * HTB, NXCD = 8, WGM = 8;
__host__ __device__ __forceinline__ int lds_byte(int r, int c) { const int st = (r >> 4) * 2 + (c >> 5), rr = r & 15, cc = c & 31, ob = rr * 64 + cc * 2; return st * 1024 + (ob ^ (((ob >> 9) & 1) << 5)); }
__host__ __device__ __forceinline__ void stage_rc(int b, int& R, int& C) { const int st = b / 1024, sb = b % 1024, swz = sb ^ (((sb >> 9) & 1) << 5); R = (st >> 1) * 16 + swz / 64; C = (st & 1) * 32 + (swz % 64) / 2; }
__host__ __device__ __forceinline__ int perm32(int rho) { const int n = rho >> 4, i = rho & 15; return 8 * (i >> 2) + 4 * n + (i & 3); }

struct Unit { int pm, pn; };
struct Gemm { const bf16_t* A; const bf16_t* Bt; int M, N, K; };

struct StaticOrder {
    int nM, nN, nwg, G, c;
    __host__ __device__ void init(int M, int N, int G_, int c_) { nM = M / BM; nN = N / BM; nwg = nM * nN; G = G_; c = c_; }
    __host__ __device__ bool next(int i, Unit& u) const {
        const long L = (long)i * G + c; if (L >= nwg) return false;
        int wgid = (int)L; { const int q = nwg / NXCD, r = nwg % NXCD, xcd = wgid % NXCD, off = wgid / NXCD; wgid = (xcd < r ? xcd * (q + 1) : r * (q + 1) + (xcd - r) * q) + off; }
        const int nig = WGM * nN, gid = wgid / nig, fm = gid * WGM, gsz = (nM - fm) < WGM ? (nM - fm) : WGM;
        u.pm = fm + ((wgid % nig) % gsz); u.pn = (wgid % nig) / gsz; return true;
    }
    __device__ __forceinline__ void a_ready(const Unit&) const {}
    __device__ __forceinline__ void done(const Unit&) const {}
};

template <int ACT  > struct EpiBf16 {
    static constexpr bool PERM = true, AFTER_DRAIN = false;
    bf16_t* O; int ldc;
    __device__ __forceinline__ void operator()(const f32x4 (&acc)[2][2][4][2], const Unit& u, int wr, int wc, int fr, int fq) const {
        const int row0 = u.pm * BM + wr * 64 + fr; const int col0 = u.pn * BM + wc * 32 + 8 * fq;
#pragma unroll
        for (int ai = 0; ai < 2; ++ai)
#pragma unroll
            for (int m = 0; m < 4; ++m) { bf16_t* rowp = O + (size_t)(row0 + ai * HALF + m * 16) * ldc + col0;
#pragma unroll
                for (int bj = 0; bj < 2; ++bj) { f32x4 v0 = acc[ai][bj][m][0], v1 = acc[ai][bj][m][1];
                    if (ACT == 1) {
#pragma unroll
                        for (int e = 0; e < 4; ++e) { float a0 = fmaxf(v0[e], 0.f), a1 = fmaxf(v1[e], 0.f); v0[e] = a0 * a0; v1[e] = a1 * a1; } }
                    u32x4 w; w.x = pk2(v0[0], v0[1]); w.y = pk2(v0[2], v0[3]); w.z = pk2(v1[0], v1[1]); w.w = pk2(v1[2], v1[3]);
                    *(u32x4*)(rowp + bj * HALF) = w; } }
    }
};
struct EpiResGate {
    static constexpr bool PERM = true, AFTER_DRAIN = false;
    const float* res; float* out; const float* gate;
    __device__ __forceinline__ void operator()(const f32x4 (&acc)[2][2][4][2], const Unit& u, int wr, int wc, int fr, int fq) const {
        const int row0 = u.pm * BM + wr * 64 + fr; const int col0 = u.pn * BM + wc * 32 + 8 * fq;
        const float* g = gate + (size_t)(u.pm >> 4) * NMOD + col0;
        f32x4 gv[2][2];
#pragma unroll
        for (int bj = 0; bj < 2; ++bj) { gv[bj][0] = *(const f32x4*)(g + bj * HALF); gv[bj][1] = *(const f32x4*)(g + bj * HALF + 4); }
#pragma unroll
        for (int ai = 0; ai < 2; ++ai)
#pragma unroll
            for (int m = 0; m < 4; ++m) { const size_t p = (size_t)(row0 + ai * HALF + m * 16) * DM + col0;
#pragma unroll
                for (int bj = 0; bj < 2; ++bj) {
                    const f32x4 r0 = *(const f32x4*)(res + p + bj * HALF), r1 = *(const f32x4*)(res + p + bj * HALF + 4);
                    *(f32x4*)(out + p + bj * HALF) = r0 + gv[bj][0] * acc[ai][bj][m][0];
                    *(f32x4*)(out + p + bj * HALF + 4) = r1 + gv[bj][1] * acc[ai][bj][m][1]; } }
    }
};

struct EpiResGateNorm {
    static constexpr bool PERM = true, AFTER_DRAIN = false;
    const float* res; bf16_t* out; const float* gate; const float* nw; const float* scale; bf16_t* A2; float* sumsq;
    __device__ __forceinline__ void operator()(const f32x4 (&acc)[2][2][4][2], const Unit& u, int wr, int wc, int fr, int fq) const {
        const int row0 = u.pm * BM + wr * 64 + fr; const int col0 = u.pn * BM + wc * 32 + 8 * fq;
        const float* g = gate + (size_t)(u.pm >> 4) * NMOD + col0; const float* sc = scale + (size_t)(u.pm >> 4) * NMOD + col0;
        f32x4 gv[2][2], gm[2][2];
#pragma unroll
        for (int bj = 0; bj < 2; ++bj)
#pragma unroll
            for (int q = 0; q < 2; ++q) { gv[bj][q] = *(const f32x4*)(g + bj * HALF + 4 * q);
                gm[bj][q] = *(const f32x4*)(nw + col0 + bj * HALF + 4 * q) * (*(const f32x4*)(sc + bj * HALF + 4 * q) + 1.0f); }
#pragma unroll
        for (int ai = 0; ai < 2; ++ai)
#pragma unroll
            for (int m = 0; m < 4; ++m) { const int row = row0 + ai * HALF + m * 16; const size_t p = (size_t)row * DM + col0; float ss = 0.f;
#pragma unroll
                for (int bj = 0; bj < 2; ++bj) {
                    const f32x4 x0 = *(const f32x4*)(res + p + bj * HALF) + gv[bj][0] * acc[ai][bj][m][0], x1 = *(const f32x4*)(res + p + bj * HALF + 4) + gv[bj][1] * acc[ai][bj][m][1];
                    { u32x4 xw; xw.x = pk2(x0.x, x0.y); xw.y = pk2(x0.z, x0.w); xw.z = pk2(x1.x, x1.y); xw.w = pk2(x1.z, x1.w); *(u32x4*)(out + p + bj * HALF) = xw; }
                    ss += (x0.x * x0.x + x0.y * x0.y) + (x0.z * x0.z + x0.w * x0.w) + (x1.x * x1.x + x1.y * x1.y) + (x1.z * x1.z + x1.w * x1.w);
                    const f32x4 a0 = x0 * gm[bj][0], a1 = x1 * gm[bj][1];
                    u32x4 w; w.x = pk2(a0.x, a0.y); w.y = pk2(a0.z, a0.w); w.z = pk2(a1.x, a1.y); w.w = pk2(a1.z, a1.w);
                    *(u32x4*)(A2 + p + bj * HALF) = w; }
                ss += __shfl_xor(ss, 16); ss += __shfl_xor(ss, 32);
                if (fq == 0) unsafeAtomicAdd(sumsq + row, ss); }
    }
};
struct EpiResGateBf {
    static constexpr bool PERM = true, AFTER_DRAIN = false;
    bf16_t* X; const float* gate;
    __device__ __forceinline__ void operator()(const f32x4 (&acc)[2][2][4][2], const Unit& u, int wr, int wc, int fr, int fq) const {
        const int row0 = u.pm * BM + wr * 64 + fr; const int col0 = u.pn * BM + wc * 32 + 8 * fq;
        const float* g = gate + (size_t)(u.pm >> 4) * NMOD + col0;
        f32x4 gv[2][2];
#pragma unroll
        for (int bj = 0; bj < 2; ++bj) { gv[bj][0] = *(const f32x4*)(g + bj * HALF); gv[bj][1] = *(const f32x4*)(g + bj * HALF + 4); }
#pragma unroll
        for (int ai = 0; ai < 2; ++ai)
#pragma unroll
            for (int m = 0; m < 4; ++m) { bf16_t* rp = X + (size_t)(row0 + ai * HALF + m * 16) * DM + col0;
#pragma unroll
                for (int bj = 0; bj < 2; ++bj) {
                    const u32x4 xr = *(const u32x4*)(rp + bj * HALF);
                    const f32x4 r0 = (f32x4){bflo(xr.x), bfhi(xr.x), bflo(xr.y), bfhi(xr.y)}, r1 = (f32x4){bflo(xr.z), bfhi(xr.z), bflo(xr.w), bfhi(xr.w)};
                    const f32x4 y0 = r0 + gv[bj][0] * acc[ai][bj][m][0], y1 = r1 + gv[bj][1] * acc[ai][bj][m][1];
                    u32x4 w; w.x = pk2(y0.x, y0.y); w.y = pk2(y0.z, y0.w); w.z = pk2(y1.x, y1.y); w.w = pk2(y1.z, y1.w);
                    *(u32x4*)(rp + bj * HALF) = w; } }
    }
};
struct EpiFf1 {
    static constexpr bool PERM = true, AFTER_DRAIN = false;
    bf16_t* O; int ldc; const float* sumsq; const float* cvec;
    __device__ __forceinline__ void operator()(const f32x4 (&acc)[2][2][4][2], const Unit& u, int wr, int wc, int fr, int fq) const {
        const int row0 = u.pm * BM + wr * 64 + fr; const int col0 = u.pn * BM + wc * 32 + 8 * fq;
        const float* cv = cvec + (size_t)(u.pm >> 4) * DFF + col0;
        f32x4 cq[2][2];
#pragma unroll
        for (int bj = 0; bj < 2; ++bj)
#pragma unroll
            for (int q = 0; q < 2; ++q) cq[bj][q] = *(const f32x4*)(cv + bj * HALF + 4 * q);
#pragma unroll
        for (int ai = 0; ai < 2; ++ai)
#pragma unroll
            for (int m = 0; m < 4; ++m) { const int row = row0 + ai * HALF + m * 16; bf16_t* rowp = O + (size_t)row * ldc + col0;
                const float rstd = 1.0f / sqrtf(sumsq[row] * (1.f / DM) + EPS);
#pragma unroll
                for (int bj = 0; bj < 2; ++bj) { f32x4 v0 = acc[ai][bj][m][0] * rstd + cq[bj][0], v1 = acc[ai][bj][m][1] * rstd + cq[bj][1];
#pragma unroll
                    for (int e = 0; e < 4; ++e) { const float a0 = fmaxf(v0[e], 0.f), a1 = fmaxf(v1[e], 0.f); v0[e] = a0 * a0; v1[e] = a1 * a1; }
                    u32x4 w; w.x = pk2(v0[0], v0[1]); w.y = pk2(v0[2], v0[3]); w.z = pk2(v1[0], v1[1]); w.w = pk2(v1[2], v1[3]);
                    *(u32x4*)(rowp + bj * HALF) = w; } }
    }
};

template <class Epi, class Sched, bool ALIGN_EPI = false, bool SP2 = false>
__device__ __forceinline__ void gemm_phase(LAS unsigned char* lds, const Gemm g, const Sched& S, const Epi& E, int wv) {
    const int wid = wv, lane = lane_id(), tid = wv * 64 + lane, wr = wid >> 2, wc = wid & 3, fr = lane & 15, fq = lane >> 4;
    const int K = g.K, nt = K / BK;
    unsigned voffA[2], voffB[2];
#pragma unroll
    for (int i = 0; i < 2; ++i) { int R, C; stage_rc(tid * 16 + i * 8192, R, C); const int Rb = Epi::PERM ? ((R & ~31) + perm32(R & 31)) : R;
        voffA[i] = (unsigned)(R * K + C) * 2u; voffB[i] = (unsigned)(Rb * K + C) * 2u; }
    const size_t kstep = (size_t)(BK * 2);
    const size_t hstep = (size_t)HALF * K * 2;
    const size_t tstep = 2 * hstep;
    const unsigned ldsw = (unsigned)wid * 1024u;
    const int aoff = lds_byte(wr * 64 + fr, fq * 8), boff = lds_byte(wc * 32 + fr, fq * 8);
#define PG8_SA(b, h) (((b) * 2 + (h)) * HTB)
#define PG8_SB(b, h) ((4 + (b) * 2 + (h)) * HTB)
#define PG8_STAGE(bufoff, gbase, voff) do { _Pragma("unroll") for (int _i = 0; _i < 2; ++_i) \
        __builtin_amdgcn_global_load_lds((const unsigned*)((const char*)(gbase) + (voff)[_i]), (LAS unsigned*)(lds + (bufoff) + ldsw + _i * 8192), 16, 0, 0); } while (0)
#define PG8_LDA(dst, b, h) do { _Pragma("unroll") for (int m = 0; m < 4; ++m) _Pragma("unroll") for (int k = 0; k < 2; ++k) dst[m][k] = *(const LAS bf16x8*)(lds + PG8_SA(b, h) + aoff + m * 2048 + k * 1024); } while (0)
#define PG8_LDB(dst, b, h) do { _Pragma("unroll") for (int n = 0; n < 2; ++n) _Pragma("unroll") for (int k = 0; k < 2; ++k) dst[n][k] = *(const LAS bf16x8*)(lds + PG8_SB(b, h) + boff + n * 2048 + k * 1024); } while (0)
#define PG8_MMA(ai, bj, At, Bt) do { __builtin_amdgcn_s_setprio(1); _Pragma("unroll") for (int m = 0; m < 4; ++m) _Pragma("unroll") for (int n = 0; n < 2; ++n) _Pragma("unroll") for (int k = 0; k < 2; ++k) \
        acc[ai][bj][m][n] = __builtin_amdgcn_mfma_f32_16x16x32_bf16(Bt[n][k], At[m][k], acc[ai][bj][m][n], 0, 0, 0); __builtin_amdgcn_s_setprio(0); } while (0)
#define PG8_WAIT_V(n) asm volatile("s_waitcnt vmcnt(" #n ")" ::: "memory")
#define PG8_WAIT_L(n) asm volatile("s_waitcnt lgkmcnt(" #n ")" ::: "memory")
#define PG8_BAR __builtin_amdgcn_s_barrier()
#define PG8_SCHED __builtin_amdgcn_sched_barrier(0)
    Unit cur, nxt; int ui = 0;
    if (!S.next(0, cur)) return;
    f32x4 acc[2][2][4][2];
#pragma unroll
    for (int a = 0; a < 2; ++a)
#pragma unroll
        for (int b = 0; b < 2; ++b)
#pragma unroll
            for (int m = 0; m < 4; ++m)
#pragma unroll
                for (int n = 0; n < 2; ++n) acc[a][b][m][n] = (f32x4){0.f, 0.f, 0.f, 0.f};
    bf16x8 At[4][2], B0[2][2], B1[2][2];
    const char* cA = (const char*)g.A + (size_t)cur.pm * tstep; const char* cB = (const char*)g.Bt + (size_t)cur.pn * tstep;
    S.a_ready(cur);
    if constexpr (SP2) {
        PG8_STAGE(PG8_SB(0, 0), cB, voffB); PG8_STAGE(PG8_SB(0, 1), cB + hstep, voffB); PG8_STAGE(PG8_SA(0, 0), cA, voffA); PG8_STAGE(PG8_SA(0, 1), cA + hstep, voffA);
        if (wr == 1) PG8_BAR;
        PG8_WAIT_V(2); PG8_BAR;
        PG8_STAGE(PG8_SB(1, 0), cB + kstep, voffB); PG8_STAGE(PG8_SA(1, 0), cA + kstep, voffA); PG8_STAGE(PG8_SB(1, 1), cB + hstep + kstep, voffB);
        PG8_WAIT_V(6); PG8_BAR;
    } else {
        PG8_STAGE(PG8_SB(0, 0), cB, voffB); PG8_STAGE(PG8_SA(0, 0), cA, voffA); PG8_STAGE(PG8_SB(0, 1), cB + hstep, voffB); PG8_STAGE(PG8_SA(0, 1), cA + hstep, voffA);
        if (wr == 1) PG8_BAR;
        PG8_WAIT_V(4); PG8_BAR;
        PG8_STAGE(PG8_SB(1, 0), cB + kstep, voffB); PG8_STAGE(PG8_SA(1, 0), cA + kstep, voffA); PG8_STAGE(PG8_SB(1, 1), cB + hstep + kstep, voffB);
        PG8_WAIT_V(6); PG8_BAR;
    }
    for (;;) {
        const bool has_next = S.next(ui + 1, nxt);
        const char* nA = has_next ? (const char*)g.A + (size_t)nxt.pm * tstep : cA; const char* nB = has_next ? (const char*)g.Bt + (size_t)nxt.pn * tstep : cB;
        for (int t = 0; t < nt; t += 2) {
            const bool last = (t == nt - 2);
            const char* a1 = cA + (size_t)(t + 1) * kstep;
            const char* a2 = last ? nA : cA + (size_t)(t + 2) * kstep; const char* b2 = last ? nB : cB + (size_t)(t + 2) * kstep;
            const char* a3 = a2 + kstep; const char* b3 = b2 + kstep;
            if (last && has_next) S.a_ready(nxt);
            if constexpr (SP2) {
            PG8_LDB(B0, 0, 0); PG8_LDB(B1, 0, 1); PG8_SCHED; PG8_LDA(At, 0, 0); PG8_STAGE(PG8_SA(1, 1), a1 + hstep, voffA);
            PG8_WAIT_V(8); PG8_WAIT_L(0); PG8_BAR; PG8_MMA(0, 0, At, B0); PG8_MMA(0, 1, At, B1); PG8_BAR; PG8_SCHED;
            PG8_LDA(At, 0, 1); PG8_STAGE(PG8_SB(0, 0), b2, voffB); PG8_STAGE(PG8_SB(0, 1), b2 + hstep, voffB); PG8_STAGE(PG8_SA(0, 0), a2, voffA);
            PG8_WAIT_V(8); PG8_WAIT_L(0); PG8_BAR; PG8_MMA(1, 0, At, B0); PG8_MMA(1, 1, At, B1); PG8_BAR; PG8_SCHED;
            PG8_LDB(B0, 1, 0); PG8_LDB(B1, 1, 1); PG8_SCHED; PG8_LDA(At, 1, 0); PG8_STAGE(PG8_SA(0, 1), a2 + hstep, voffA);
            PG8_WAIT_V(8); PG8_WAIT_L(0); PG8_BAR; PG8_MMA(0, 0, At, B0); PG8_MMA(0, 1, At, B1); PG8_BAR; PG8_SCHED;
            PG8_LDA(At, 1, 1); PG8_STAGE(PG8_SB(1, 0), b3, voffB); PG8_STAGE(PG8_SB(1, 1), b3 + hstep, voffB); PG8_STAGE(PG8_SA(1, 0), a3, voffA);
            PG8_WAIT_V(8); PG8_WAIT_L(0); PG8_BAR; PG8_MMA(1, 0, At, B0); PG8_MMA(1, 1, At, B1); PG8_BAR; PG8_SCHED;
            } else {
            PG8_LDB(B0, 0, 0); PG8_SCHED; PG8_LDA(At, 0, 0); PG8_STAGE(PG8_SA(1, 1), a1 + hstep, voffA);
            PG8_WAIT_L(8); PG8_BAR; PG8_WAIT_L(0); PG8_MMA(0, 0, At, B0); PG8_BAR; PG8_SCHED;
            PG8_LDB(B1, 0, 1); PG8_STAGE(PG8_SB(0, 0), b2, voffB);
            PG8_BAR; PG8_WAIT_L(0); PG8_MMA(0, 1, At, B1); PG8_BAR;
            PG8_LDA(At, 0, 1); PG8_STAGE(PG8_SA(0, 0), a2, voffA);
            PG8_BAR; PG8_WAIT_L(0); PG8_MMA(1, 0, At, B0); PG8_BAR; PG8_SCHED;
            PG8_STAGE(PG8_SB(0, 1), b2 + hstep, voffB);
            PG8_WAIT_V(6); PG8_BAR; PG8_MMA(1, 1, At, B1); PG8_BAR;
            PG8_LDB(B0, 1, 0); PG8_SCHED; PG8_LDA(At, 1, 0); PG8_STAGE(PG8_SA(0, 1), a2 + hstep, voffA);
            PG8_WAIT_L(8); PG8_BAR; PG8_WAIT_L(0); PG8_MMA(0, 0, At, B0); PG8_BAR; PG8_SCHED;
            PG8_LDB(B1, 1, 1); PG8_STAGE(PG8_SB(1, 0), b3, voffB);
            PG8_BAR; PG8_WAIT_L(0); PG8_MMA(0, 1, At, B1); PG8_BAR;
            PG8_LDA(At, 1, 1); PG8_STAGE(PG8_SA(1, 0), a3, voffA);
            PG8_BAR; PG8_WAIT_L(0); PG8_MMA(1, 0, At, B0); PG8_BAR; PG8_SCHED;
            PG8_STAGE(PG8_SB(1, 1), b3 + hstep, voffB);
            PG8_WAIT_V(6); PG8_BAR; PG8_MMA(1, 1, At, B1); PG8_BAR;
            }
        }
        if constexpr (ALIGN_EPI) { if (wr == 0) PG8_BAR; }
        if constexpr (!Epi::AFTER_DRAIN) { E(acc, cur, wr, wc, fr, fq); S.done(cur); }
        if (!has_next) break;
#pragma unroll
        for (int a = 0; a < 2; ++a)
#pragma unroll
            for (int b = 0; b < 2; ++b)
#pragma unroll
                for (int m = 0; m < 4; ++m)
#pragma unroll
                    for (int n = 0; n < 2; ++n) acc[a][b][m][n] = (f32x4){0.f, 0.f, 0.f, 0.f};
        cur = nxt; cA = nA; cB = nB; ++ui;
        if constexpr (ALIGN_EPI) { if (wr == 1) PG8_BAR; }
    }
    PG8_WAIT_V(0);
    if constexpr (!ALIGN_EPI) { if (wr == 0) PG8_BAR; }
    PG8_BAR;
#undef PG8_SA
#undef PG8_SB
#undef PG8_STAGE
#undef PG8_LDA
#undef PG8_LDB
#undef PG8_MMA
#undef PG8_WAIT_V
#undef PG8_WAIT_L
#undef PG8_BAR
#undef PG8_SCHED
}
}

DI void p0_transpose_job(const float* W, int ldn, int K, bf16_t* WT, int kb, int nb, LAS unsigned char* lds, int wv) {
    LAS float* tile = (LAS float*)lds;
    const int tid = wv * 64 + lane_id(), k0 = kb * 64, n0 = nb * 256;
    f32x4 v[8];
#pragma unroll
    for (int i = 0; i < 8; ++i) v[i] = *(const f32x4*)(W + (size_t)(k0 + (tid >> 6) + 8 * i) * ldn + n0 + (tid & 63) * 4);
#pragma unroll
    for (int i = 0; i < 8; ++i) { LAS float* t = tile + ((tid >> 6) + 8 * i) * 257 + (tid & 63) * 4; t[0] = v[i].x; t[1] = v[i].y; t[2] = v[i].z; t[3] = v[i].w; }
    __syncthreads();
#pragma unroll
    for (int j = 0; j < 4; ++j) { const int n = (tid >> 3) + 64 * j, k8 = (tid & 7) * 8; const LAS float* s = tile + k8 * 257 + n;
      u32x4 o; o.x = pk2(s[0], s[257]); o.y = pk2(s[2 * 257], s[3 * 257]); o.z = pk2(s[4 * 257], s[5 * 257]); o.w = pk2(s[6 * 257], s[7 * 257]);
      *(u32x4*)(WT + (size_t)(n0 + n) * K + k0 + k8) = o; }
    __syncthreads();
}
DI void p0_phase(const Args& a, LAS unsigned char* lds, int wv) {
    const int tid = wv * 64 + lane_id(), G = gridDim.x, blk = blockIdx.x;
    for (int i = blk * 512 + tid; i < MROWS; i += G * 512) ((float*)(a.ws + WS_SUMSQ))[i] = 0.f;
    for (int cg_ = blk; cg_ < NMOD / 32; cg_ += G) {
        LAS float* sc = (LAS float*)lds;
        LAS float* red = (LAS float*)(lds + 32768);
        for (int i = tid; i < 8192; i += 512) sc[i] = silu_f(a.c[i]);
        __syncthreads();
        const int ks = tid >> 5, col = tid & 31, j0 = cg_ * 32;
        float acc[8];
#pragma unroll
        for (int b = 0; b < 8; ++b) acc[b] = 0.f;
#pragma unroll 16
        for (int kk = 0; kk < 64; ++kk) { const int k = ks * 64 + kk; const float w = a.ada_w[(size_t)k * NMOD + j0 + col];
#pragma unroll
            for (int b = 0; b < 8; ++b) acc[b] += sc[b * 1024 + k] * w; }
#pragma unroll
        for (int b = 0; b < 8; ++b) red[(ks * 8 + b) * 32 + col] = acc[b];
        __syncthreads();
        if (tid < 256) { const int b = tid >> 5, cc = tid & 31; float s = a.ada_b[j0 + cc];
#pragma unroll
            for (int q = 0; q < 16; ++q) s += red[(q * 8 + b) * 32 + cc];
            ((float*)(a.ws + WS_MOD))[b * NMOD + j0 + cc] = s; }
        __syncthreads();
    }
    constexpr int J_IN = 16 * 16, J_OUT = 16 * 4, J_F1 = 16 * 16, J_F2 = 64 * 4, NJ = J_IN + J_OUT + J_F1 + J_F2;
    for (int j = (blk + 64) % G; j < NJ; j += G) {
        int r = j;
        if (r < J_IN) { p0_transpose_job(a.w_in, DIN, 1024, (bf16_t*)(a.ws + WS_WIN), r / 16, r % 16, lds, wv); continue; } r -= J_IN;
        if (r < J_OUT) { p0_transpose_job(a.w_out, 1024, 1024, (bf16_t*)(a.ws + WS_WOUT), r / 4, r % 4, lds, wv); continue; } r -= J_OUT;
        if (r < J_F1) { p0_transpose_job(a.w_ff1, 4096, 1024, (bf16_t*)(a.ws + WS_WFF1), r / 16, r % 16, lds, wv); continue; } r -= J_F1;
        p0_transpose_job(a.w_ff2, 1024, 4096, (bf16_t*)(a.ws + WS_WFF2), r / 4, r % 4, lds, wv);
    }
}

template <bool GAB>
DI void norm_mod_phase(const float* src, const float* nw, const float* mod, int shift_off, int scale_off, bf16_t* dst, const float* w_in, float* gab, LAS unsigned char* lds, int wv) {
    const int lane = lane_id(), wave = wv, tid = wv * 64 + lane;
    LAS float* W8 = (LAS float*)lds;
    if (GAB) { for (int i = tid; i < 8192; i += 512) { const int k = i >> 3, j = i & 7; W8[j * 1024 + k] = w_in[(size_t)k * DIN + 4096 + j]; } __syncthreads(); }
    const int gw = blockIdx.x * 8 + wave, NGW = gridDim.x * 8, c0 = lane * 8;
    f32x4 nwv[2][2];
#pragma unroll
    for (int i = 0; i < 2; ++i)
#pragma unroll
        for (int q = 0; q < 2; ++q) nwv[i][q] = *(const f32x4*)(nw + c0 + 512 * i + 4 * q);
    for (int m = gw; m < MROWS; m += NGW) {
        const float* xr = src + (size_t)m * DM;
        f32x4 v[2][2]; float ss = 0.f;
#pragma unroll
        for (int i = 0; i < 2; ++i)
#pragma unroll
            for (int q = 0; q < 2; ++q) { v[i][q] = *(const f32x4*)(xr + c0 + 512 * i + 4 * q); ss += (v[i][q].x * v[i][q].x + v[i][q].y * v[i][q].y) + (v[i][q].z * v[i][q].z + v[i][q].w * v[i][q].w); }
        ss = wave_sum(ss);
        const float rstd = 1.0f / sqrtf(ss * (1.f / DM) + EPS);
        const float* sh = mod + (size_t)(m >> 12) * NMOD + shift_off; const float* sc = mod + (size_t)(m >> 12) * NMOD + scale_off;
        float p[8];
#pragma unroll
        for (int j = 0; j < 8; ++j) p[j] = 0.f;
#pragma unroll
        for (int i = 0; i < 2; ++i) {
            f32x4 hq[2];
#pragma unroll
            for (int q = 0; q < 2; ++q) { const f32x4 shv = *(const f32x4*)(sh + c0 + 512 * i + 4 * q), scv = *(const f32x4*)(sc + c0 + 512 * i + 4 * q);
                hq[q] = v[i][q] * rstd * nwv[i][q] * (scv + 1.0f) + shv; }
            u32x4 w; w.x = pk2(hq[0].x, hq[0].y); w.y = pk2(hq[0].z, hq[0].w); w.z = pk2(hq[1].x, hq[1].y); w.w = pk2(hq[1].z, hq[1].w);
            *(u32x4*)(dst + (size_t)m * DM + c0 + 512 * i) = w;
            if (GAB) {
#pragma unroll
                for (int q = 0; q < 2; ++q)
#pragma unroll
                    for (int j = 0; j < 8; ++j) { const f32x4 wv = *(const LAS f32x4*)(W8 + j * 1024 + c0 + 512 * i + 4 * q);
                        p[j] += (hq[q].x * wv.x + hq[q].y * wv.y) + (hq[q].z * wv.z + hq[q].w * wv.w); } }
        }
        if (GAB) {
#pragma unroll
            for (int j = 0; j < 8; ++j) p[j] = wave_sum(p[j]);
            if (lane == 0) { *(f32x4*)(gab + (size_t)m * 8) = (f32x4){p[0], p[1], p[2], p[3]}; *(f32x4*)(gab + (size_t)m * 8 + 4) = (f32x4){p[4], p[5], p[6], p[7]}; }
        }
    }
    if (GAB) __syncthreads();
}

DI int pinv16(int d) { return ((d >> 2) & 1) * 8 + (d >> 3) * 4 + (d & 3); }
constexpr int P3_Q = 0, P3_K = 17408, P3_V = 34816, P3_L = 52224, P3_GC = 69632, P3_BETA = 69888, P3_BE = 70144;
DI u32x4 pack16lo(const float* v) { u32x4 o; o.x = pk2(v[0], v[1]); o.y = pk2(v[2], v[3]); o.z = pk2(v[8], v[9]); o.w = pk2(v[10], v[11]); return o; }
DI u32x4 pack16hi(const float* v) { u32x4 o; o.x = pk2(v[4], v[5]); o.y = pk2(v[6], v[7]); o.z = pk2(v[12], v[13]); o.w = pk2(v[14], v[15]); return o; }

constexpr int P3_CW = 126976;
DI void conv_silu16(const bf16_t* proj, const LAS float* cwl, int b, int tpos, int colbase, int chl, float* val) {
#pragma unroll
    for (int e = 0; e < 16; ++e) val[e] = 0.f;
#pragma unroll
    for (int w = 0; w < 4; ++w) {
        const int tt = tpos - 3 + w;
        if (tt >= 0) {
            const bf16_t* src = proj + (size_t)(b * SEQ + tt) * NPROJ + colbase;
            const u32x4 x0 = *(const u32x4*)src, x1 = *(const u32x4*)(src + 8);
            const LAS float* cw = cwl + w * 128 + chl;
            const f32x4 c0 = *(const LAS f32x4*)cw, c1 = *(const LAS f32x4*)(cw + 4), c2 = *(const LAS f32x4*)(cw + 8), c3 = *(const LAS f32x4*)(cw + 12);
            val[0] += c0.x * bflo(x0.x); val[1] += c0.y * bfhi(x0.x); val[2] += c0.z * bflo(x0.y); val[3] += c0.w * bfhi(x0.y);
            val[4] += c1.x * bflo(x0.z); val[5] += c1.y * bfhi(x0.z); val[6] += c1.z * bflo(x0.w); val[7] += c1.w * bfhi(x0.w);
            val[8] += c2.x * bflo(x1.x); val[9] += c2.y * bfhi(x1.x); val[10] += c2.z * bflo(x1.y); val[11] += c2.w * bfhi(x1.y);
            val[12] += c3.x * bflo(x1.z); val[13] += c3.y * bfhi(x1.z); val[14] += c3.z * bflo(x1.w); val[15] += c3.w * bfhi(x1.w);
        }
    }
#pragma unroll
    for (int e = 0; e < 16; ++e) val[e] = silu_f(val[e]);
}
DI void st16_lds(LAS unsigned char* p, const float* v) {
    u32x4 o0, o1; o0.x = pk2(v[0], v[1]); o0.y = pk2(v[2], v[3]); o0.z = pk2(v[4], v[5]); o0.w = pk2(v[6], v[7]);
    o1.x = pk2(v[8], v[9]); o1.y = pk2(v[10], v[11]); o1.z = pk2(v[12], v[13]); o1.w = pk2(v[14], v[15]);
    *(LAS u32x4*)p = o0; *(LAS u32x4*)(p + 16) = o1;
}
DI float red8(float v) { v += __shfl_xor(v, 1); v += __shfl_xor(v, 2); v += __shfl_xor(v, 4); return v; }

DI void p3_ret_half(const Args& a, LAS unsigned char* lds, int b, int n, int h, int t2in);
DI void p3_pair_item(const Args& a, LAS unsigned char* lds, int b, int n, int h, int rb, int rn, int rh, int wv) {
    int tid_ = wv * 64 + lane_id(); asm volatile("" : "+v"(tid_));
    const int tid = tid_, lane = tid & 63, wave = tid >> 6;
    const bf16_t* proj = (const bf16_t*)(a.ws + WS_PROJ);
    const float* gab = (const float*)(a.ws + WS_GAB);
    const int bh = b * 4 + h;
    unsigned char* rec = a.ws + WS_GREC + (size_t)(bh * 64 + n) * GREC;
    bf16_t* uT = (bf16_t*)rec; bf16_t* wG = (bf16_t*)(rec + 16384); bf16_t* qgG = (bf16_t*)(rec + 32768); bf16_t* kdT = (bf16_t*)(rec + 49152); bf16_t* atG = (bf16_t*)(rec + 65536);
    LAS float* gcs = (LAS float*)(lds + P3_GC); LAS float* betas = (LAS float*)(lds + P3_BETA); LAS float* bes = (LAS float*)(lds + P3_BE); LAS float* Ls = (LAS float*)(lds + P3_L);
    if (wave == 0) {
        const size_t m = (size_t)b * SEQ + n * 64 + lane;
        const float ga = gab[m * 8 + h], gb = gab[m * 8 + 4 + h];
        const float beta = 1.f / (1.f + __expf(-gb));
        const float xx = ga + a.dt_bias[h];
        const float sp = fmaxf(xx, 0.f) + log1pf(__expf(-fabsf(xx)));
        float g = -__expf(a.a_log[h]) * sp;
#pragma unroll
        for (int o = 1; o < 64; o <<= 1) { const float t = __shfl_up(g, o); if (lane >= o) g += t; }
        gcs[lane] = g; betas[lane] = beta; bes[lane] = beta * __expf(g);
    }
    const int r = tid >> 3, cb = tid & 7, c0 = cb * 16, tpos = n * 64 + r;
    float qv[16];
    {
        conv_silu16(proj, (const LAS float*)(lds + P3_CW), b, tpos, 2048 + h * 128 + c0, c0, qv);
        float ss = 0.f;
#pragma unroll
        for (int e = 0; e < 16; ++e) ss += qv[e] * qv[e];
        ss = red8(ss); const float rn = (1.0f / sqrtf(ss + EPS)) * 0.08838834764831845f;
#pragma unroll
        for (int e = 0; e < 16; ++e) qv[e] *= rn;
        st16_lds(lds + P3_Q + r * 272 + c0 * 2, qv);
    }
    {
        float kv[16];
        conv_silu16(proj, (const LAS float*)(lds + P3_CW) + 512, b, tpos, 2560 + h * 128 + c0, c0, kv);
        float ss = 0.f;
#pragma unroll
        for (int e = 0; e < 16; ++e) ss += kv[e] * kv[e];
        ss = red8(ss); const float rn = 1.0f / sqrtf(ss + EPS);
#pragma unroll
        for (int e = 0; e < 16; ++e) kv[e] *= rn;
        st16_lds(lds + P3_K + r * 272 + c0 * 2, kv);
    }
    {
        float vv[16];
        conv_silu16(proj, (const LAS float*)(lds + P3_CW) + 1024, b, tpos, 3072 + h * 128 + c0, c0, vv);
        st16_lds(lds + P3_V + r * 272 + c0 * 2, vv);
    }
    __syncthreads();
    {
        const float eg = __expf(gcs[r]);
#pragma unroll
        for (int e = 0; e < 16; ++e) qv[e] *= eg;
        *(u32x4*)(qgG + r * 128 + c0) = pack16lo(qv); *(u32x4*)(qgG + r * 128 + c0 + 8) = pack16hi(qv);
    }
#pragma unroll
    for (int i = 0; i < 4; ++i) {
        const int ti = wave * 4 + i, mat = ti >> 4, mt = (ti >> 2) & 3, nt = ti & 3;
        const LAS unsigned char* Ab = lds + (mat ? P3_Q : P3_K) + (16 * mt + (lane & 15)) * 272 + (lane >> 4) * 16;
        const LAS unsigned char* Bb = lds + P3_K + (16 * nt + (lane & 15)) * 272 + (lane >> 4) * 16;
        f32x4 acc = {0.f, 0.f, 0.f, 0.f};
#pragma unroll
        for (int s = 0; s < 4; ++s) acc = __builtin_amdgcn_mfma_f32_16x16x32_bf16(*(const LAS bf16x8*)(Ab + s * 64), *(const LAS bf16x8*)(Bb + s * 64), acc, 0, 0, 0);
        const int jj = 16 * nt + (lane & 15); const float gj = gcs[jj];
#pragma unroll
        for (int j = 0; j < 4; ++j) {
            const int ii = 16 * mt + (lane >> 4) * 4 + j; const float gi = gcs[ii];
            if (mat == 0) { Ls[ii * 68 + jj] = (ii > jj) ? betas[ii] * acc[j] * __expf(gi - gj) : 0.f; }
            else { const float v = (ii >= jj) ? acc[j] * __expf(gi - gj) : 0.f; atG[ii * 64 + (jj & ~15) + pinv16(jj & 15)] = f2bf(v); }
        }
    }
    __syncthreads();
    if (tid < 256) {
        const int col = tid; const bool isu = col < 128;
        int xoff = (isu ? P3_V : P3_K) + 2 * (isu ? col : col - 128), coff = isu ? P3_BETA : P3_BE;
        asm volatile("" : "+v"(xoff), "+v"(coff));
        const LAS unsigned short* Xp = (const LAS unsigned short*)(lds + xoff);
        const LAS float* cf = (const LAS float*)(lds + coff);
        float xs[64];
#pragma unroll
        for (int i = 0; i < 64; ++i) xs[i] = cf[i] * bf2f(Xp[i * 136]);
        f32x4 LB0[12], LB1[12];
        int zlane; asm volatile("v_mov_b32 %0, 0" : "=v"(zlane));
        const LAS float* Lv = Ls + zlane;
#define SOL_L(b, k, off) LB##b[k] = *(const LAS f32x4*)(Lv + (off))
#define SOL_F(i, j, b, k, c) xs[i] = fmaf(-LB##b[k].c, xs[j], xs[i])
        SOL_L(0, 0, 68); SOL_L(0, 1, 136); SOL_L(0, 2, 204); SOL_L(0, 3, 272); SOL_L(0, 4, 340); SOL_L(0, 5, 344); SOL_L(0, 6, 408); SOL_L(0, 7, 412); SOL_L(0, 8, 476); SOL_L(0, 9, 480); SOL_L(0, 10, 544); SOL_L(0, 11, 548);
        SOL_L(1, 0, 612); SOL_L(1, 1, 616); SOL_L(1, 2, 620); SOL_L(1, 3, 680); SOL_L(1, 4, 684); SOL_L(1, 5, 688); SOL_L(1, 6, 748); SOL_L(1, 7, 752); SOL_L(1, 8, 756); SOL_L(1, 9, 816); SOL_L(1, 10, 820); SOL_L(1, 11, 824);
        __builtin_amdgcn_sched_barrier(0);
        SOL_F(1, 0, 0, 0, x);
        SOL_F(2, 0, 0, 1, x); SOL_F(2, 1, 0, 1, y);
        SOL_F(3, 0, 0, 2, x); SOL_F(3, 1, 0, 2, y); SOL_F(3, 2, 0, 2, z);
        SOL_F(4, 0, 0, 3, x); SOL_F(4, 1, 0, 3, y); SOL_F(4, 2, 0, 3, z); SOL_F(4, 3, 0, 3, w);
        SOL_F(5, 0, 0, 4, x); SOL_F(5, 1, 0, 4, y); SOL_F(5, 2, 0, 4, z); SOL_F(5, 3, 0, 4, w);
        SOL_F(5, 4, 0, 5, x);
        SOL_F(6, 0, 0, 6, x); SOL_F(6, 1, 0, 6, y); SOL_F(6, 2, 0, 6, z); SOL_F(6, 3, 0, 6, w);
        SOL_F(6, 4, 0, 7, x); SOL_F(6, 5, 0, 7, y);
        SOL_F(7, 0, 0, 8, x); SOL_F(7, 1, 0, 8, y); SOL_F(7, 2, 0, 8, z); SOL_F(7, 3, 0, 8, w);
        SOL_F(7, 4, 0, 9, x); SOL_F(7, 5, 0, 9, y); SOL_F(7, 6, 0, 9, z);
        SOL_F(8, 0, 0, 10, x); SOL_F(8, 1, 0, 10, y); SOL_F(8, 2, 0, 10, z); SOL_F(8, 3, 0, 10, w);
        SOL_F(8, 4, 0, 11, x); SOL_F(8, 5, 0, 11, y); SOL_F(8, 6, 0, 11, z); SOL_F(8, 7, 0, 11, w);
        __builtin_amdgcn_sched_barrier(0);
        SOL_L(0, 0, 884); SOL_L(0, 1, 888); SOL_L(0, 2, 892); SOL_L(0, 3, 896); SOL_L(0, 4, 952); SOL_L(0, 5, 956); SOL_L(0, 6, 960); SOL_L(0, 7, 964); SOL_L(0, 8, 1020); SOL_L(0, 9, 1024); SOL_L(0, 10, 1028); SOL_L(0, 11, 1032);
        __builtin_amdgcn_sched_barrier(0);
        SOL_F(9, 0, 1, 0, x); SOL_F(9, 1, 1, 0, y); SOL_F(9, 2, 1, 0, z); SOL_F(9, 3, 1, 0, w);
        SOL_F(9, 4, 1, 1, x); SOL_F(9, 5, 1, 1, y); SOL_F(9, 6, 1, 1, z); SOL_F(9, 7, 1, 1, w);
        SOL_F(9, 8, 1, 2, x);
        SOL_F(10, 0, 1, 3, x); SOL_F(10, 1, 1, 3, y); SOL_F(10, 2, 1, 3, z); SOL_F(10, 3, 1, 3, w);
        SOL_F(10, 4, 1, 4, x); SOL_F(10, 5, 1, 4, y); SOL_F(10, 6, 1, 4, z); SOL_F(10, 7, 1, 4, w);
        SOL_F(10, 8, 1, 5, x); SOL_F(10, 9, 1, 5, y);
        SOL_F(11, 0, 1, 6, x); SOL_F(11, 1, 1, 6, y); SOL_F(11, 2, 1, 6, z); SOL_F(11, 3, 1, 6, w);
        SOL_F(11, 4, 1, 7, x); SOL_F(11, 5, 1, 7, y); SOL_F(11, 6, 1, 7, z); SOL_F(11, 7, 1, 7, w);
        SOL_F(11, 8, 1, 8, x); SOL_F(11, 9, 1, 8, y); SOL_F(11, 10, 1, 8, z);
        SOL_F(12, 0, 1, 9, x); SOL_F(12, 1, 1, 9, y); SOL_F(12, 2, 1, 9, z); SOL_F(12, 3, 1, 9, w);
        SOL_F(12, 4, 1, 10, x); SOL_F(12, 5, 1, 10, y); SOL_F(12, 6, 1, 10, z); SOL_F(12, 7, 1, 10, w);
        SOL_F(12, 8, 1, 11, x); SOL_F(12, 9, 1, 11, y); SOL_F(12, 10, 1, 11, z); SOL_F(12, 11, 1, 11, w);
        __builtin_amdgcn_sched_barrier(0);
        SOL_L(1, 0, 1088); SOL_L(1, 1, 1092); SOL_L(1, 2, 1096); SOL_L(1, 3, 1100); SOL_L(1, 4, 1156); SOL_L(1, 5, 1160); SOL_L(1, 6, 1164); SOL_L(1, 7, 1168); SOL_L(1, 8, 1172); SOL_L(1, 9, 1224); SOL_L(1, 10, 1228); SOL_L(1, 11, 1232);
        __builtin_amdgcn_sched_barrier(0);
        SOL_F(13, 0, 0, 0, x); SOL_F(13, 1, 0, 0, y); SOL_F(13, 2, 0, 0, z); SOL_F(13, 3, 0, 0, w);
        SOL_F(13, 4, 0, 1, x); SOL_F(13, 5, 0, 1, y); SOL_F(13, 6, 0, 1, z); SOL_F(13, 7, 0, 1, w);
        SOL_F(13, 8, 0, 2, x); SOL_F(13, 9, 0, 2, y); SOL_F(13, 10, 0, 2, z); SOL_F(13, 11, 0, 2, w);
        SOL_F(13, 12, 0, 3, x);
        SOL_F(14, 0, 0, 4, x); SOL_F(14, 1, 0, 4, y); SOL_F(14, 2, 0, 4, z); SOL_F(14, 3, 0, 4, w);
        SOL_F(14, 4, 0, 5, x); SOL_F(14, 5, 0, 5, y); SOL_F(14, 6, 0, 5, z); SOL_F(14, 7, 0, 5, w);
        SOL_F(14, 8, 0, 6, x); SOL_F(14, 9, 0, 6, y); SOL_F(14, 10, 0, 6, z); SOL_F(14, 11, 0, 6, w);
        SOL_F(14, 12, 0, 7, x); SOL_F(14, 13, 0, 7, y);
        SOL_F(15, 0, 0, 8, x); SOL_F(15, 1, 0, 8, y); SOL_F(15, 2, 0, 8, z); SOL_F(15, 3, 0, 8, w);
        SOL_F(15, 4, 0, 9, x); SOL_F(15, 5, 0, 9, y); SOL_F(15, 6, 0, 9, z); SOL_F(15, 7, 0, 9, w);
        SOL_F(15, 8, 0, 10, x); SOL_F(15, 9, 0, 10, y); SOL_F(15, 10, 0, 10, z); SOL_F(15, 11, 0, 10, w);
        SOL_F(15, 12, 0, 11, x); SOL_F(15, 13, 0, 11, y); SOL_F(15, 14, 0, 11, z);
        __builtin_amdgcn_sched_barrier(0);
        SOL_L(0, 0, 1236); SOL_L(0, 1, 1240); SOL_L(0, 2, 1292); SOL_L(0, 3, 1296); SOL_L(0, 4, 1300); SOL_L(0, 5, 1304); SOL_L(0, 6, 1308); SOL_L(0, 7, 1360); SOL_L(0, 8, 1364); SOL_L(0, 9, 1368); SOL_L(0, 10, 1372); SOL_L(0, 11, 1376);
        __builtin_amdgcn_sched_barrier(0);
        SOL_F(16, 0, 1, 0, x); SOL_F(16, 1, 1, 0, y); SOL_F(16, 2, 1, 0, z); SOL_F(16, 3, 1, 0, w);
        SOL_F(16, 4, 1, 1, x); SOL_F(16, 5, 1, 1, y); SOL_F(16, 6, 1, 1, z); SOL_F(16, 7, 1, 1, w);
        SOL_F(16, 8, 1, 2, x); SOL_F(16, 9, 1, 2, y); SOL_F(16, 10, 1, 2, z); SOL_F(16, 11, 1, 2, w);
        SOL_F(16, 12, 1, 3, x); SOL_F(16, 13, 1, 3, y); SOL_F(16, 14, 1, 3, z); SOL_F(16, 15, 1, 3, w);
        SOL_F(17, 0, 1, 4, x); SOL_F(17, 1, 1, 4, y); SOL_F(17, 2, 1, 4, z); SOL_F(17, 3, 1, 4, w);
        SOL_F(17, 4, 1, 5, x); SOL_F(17, 5, 1, 5, y); SOL_F(17, 6, 1, 5, z); SOL_F(17, 7, 1, 5, w);
        SOL_F(17, 8, 1, 6, x); SOL_F(17, 9, 1, 6, y); SOL_F(17, 10, 1, 6, z); SOL_F(17, 11, 1, 6, w);
        SOL_F(17, 12, 1, 7, x); SOL_F(17, 13, 1, 7, y); SOL_F(17, 14, 1, 7, z); SOL_F(17, 15, 1, 7, w);
        SOL_F(17, 16, 1, 8, x);
        SOL_F(18, 0, 1, 9, x); SOL_F(18, 1, 1, 9, y); SOL_F(18, 2, 1, 9, z); SOL_F(18, 3, 1, 9, w);
        SOL_F(18, 4, 1, 10, x); SOL_F(18, 5, 1, 10, y); SOL_F(18, 6, 1, 10, z); SOL_F(18, 7, 1, 10, w);
        SOL_F(18, 8, 1, 11, x); SOL_F(18, 9, 1, 11, y); SOL_F(18, 10, 1, 11, z); SOL_F(18, 11, 1, 11, w);
        __builtin_amdgcn_sched_barrier(0);
        SOL_L(1, 0, 1428); SOL_L(1, 1, 1432); SOL_L(1, 2, 1436); SOL_L(1, 3, 1440); SOL_L(1, 4, 1444); SOL_L(1, 5, 1448); SOL_L(1, 6, 1496); SOL_L(1, 7, 1500); SOL_L(1, 8, 1504); SOL_L(1, 9, 1508); SOL_L(1, 10, 1512); SOL_L(1, 11, 1516);
        __builtin_amdgcn_sched_barrier(0);
        SOL_F(18, 12, 0, 0, x); SOL_F(18, 13, 0, 0, y); SOL_F(18, 14, 0, 0, z); SOL_F(18, 15, 0, 0, w);
        SOL_F(18, 16, 0, 1, x); SOL_F(18, 17, 0, 1, y);
        SOL_F(19, 0, 0, 2, x); SOL_F(19, 1, 0, 2, y); SOL_F(19, 2, 0, 2, z); SOL_F(19, 3, 0, 2, w);
        SOL_F(19, 4, 0, 3, x); SOL_F(19, 5, 0, 3, y); SOL_F(19, 6, 0, 3, z); SOL_F(19, 7, 0, 3, w);
        SOL_F(19, 8, 0, 4, x); SOL_F(19, 9, 0, 4, y); SOL_F(19, 10, 0, 4, z); SOL_F(19, 11, 0, 4, w);
        SOL_F(19, 12, 0, 5, x); SOL_F(19, 13, 0, 5, y); SOL_F(19, 14, 0, 5, z); SOL_F(19, 15, 0, 5, w);
        SOL_F(19, 16, 0, 6, x); SOL_F(19, 17, 0, 6, y); SOL_F(19, 18, 0, 6, z);
        SOL_F(20, 0, 0, 7, x); SOL_F(20, 1, 0, 7, y); SOL_F(20, 2, 0, 7, z); SOL_F(20, 3, 0, 7, w);
        SOL_F(20, 4, 0, 8, x); SOL_F(20, 5, 0, 8, y); SOL_F(20, 6, 0, 8, z); SOL_F(20, 7, 0, 8, w);
        SOL_F(20, 8, 0, 9, x); SOL_F(20, 9, 0, 9, y); SOL_F(20, 10, 0, 9, z); SOL_F(20, 11, 0, 9, w);
        SOL_F(20, 12, 0, 10, x); SOL_F(20, 13, 0, 10, y); SOL_F(20, 14, 0, 10, z); SOL_F(20, 15, 0, 10, w);
        SOL_F(20, 16, 0, 11, x); SOL_F(20, 17, 0, 11, y); SOL_F(20, 18, 0, 11, z); SOL_F(20, 19, 0, 11, w);
        __builtin_amdgcn_sched_barrier(0);
        SOL_L(0, 0, 1564); SOL_L(0, 1, 1568); SOL_L(0, 2, 1572); SOL_L(0, 3, 1576); SOL_L(0, 4, 1580); SOL_L(0, 5, 1584); SOL_L(0, 6, 1632); SOL_L(0, 7, 1636); SOL_L(0, 8, 1640); SOL_L(0, 9, 1644); SOL_L(0, 10, 1648); SOL_L(0, 11, 1652);
        __builtin_amdgcn_sched_barrier(0);
        SOL_F(21, 0, 1, 0, x); SOL_F(21, 1, 1, 0, y); SOL_F(21, 2, 1, 0, z); SOL_F(21, 3, 1, 0, w);
        SOL_F(21, 4, 1, 1, x); SOL_F(21, 5, 1, 1, y); SOL_F(21, 6, 1, 1, z); SOL_F(21, 7, 1, 1, w);
        SOL_F(21, 8, 1, 2, x); SOL_F(21, 9, 1, 2, y); SOL_F(21, 10, 1, 2, z); SOL_F(21, 11, 1, 2, w);
        SOL_F(21, 12, 1, 3, x); SOL_F(21, 13, 1, 3, y); SOL_F(21, 14, 1, 3, z); SOL_F(21, 15, 1, 3, w);
        SOL_F(21, 16, 1, 4, x); SOL_F(21, 17, 1, 4, y); SOL_F(21, 18, 1, 4, z); SOL_F(21, 19, 1, 4, w);
        SOL_F(21, 20, 1, 5, x);
        SOL_F(22, 0, 1, 6, x); SOL_F(22, 1, 1, 6, y); SOL_F(22, 2, 1, 6, z); SOL_F(22, 3, 1, 6, w);
        SOL_F(22, 4, 1, 7, x); SOL_F(22, 5, 1, 7, y); SOL_F(22, 6, 1, 7, z); SOL_F(22, 7, 1, 7, w);
        SOL_F(22, 8, 1, 8, x); SOL_F(22, 9, 1, 8, y); SOL_F(22, 10, 1, 8, z); SOL_F(22, 11, 1, 8, w);
        SOL_F(22, 12, 1, 9, x); SOL_F(22, 13, 1, 9, y); SOL_F(22, 14, 1, 9, z); SOL_F(22, 15, 1, 9, w);
        SOL_F(22, 16, 1, 10, x); SOL_F(22, 17, 1, 10, y); SOL_F(22, 18, 1, 10, z); SOL_F(22, 19, 1, 10, w);
        SOL_F(22, 20, 1, 11, x); SOL_F(22, 21, 1, 11, y);
        __builtin_amdgcn_sched_barrier(0);
        SOL_L(1, 0, 1700); SOL_L(1, 1, 1704); SOL_L(1, 2, 1708); SOL_L(1, 3, 1712); SOL_L(1, 4, 1716); SOL_L(1, 5, 1720); SOL_L(1, 6, 1724); SOL_L(1, 7, 1768); SOL_L(1, 8, 1772); SOL_L(1, 9, 1776); SOL_L(1, 10, 1780); SOL_L(1, 11, 1784);
        __builtin_amdgcn_sched_barrier(0);
        SOL_F(23, 0, 0, 0, x); SOL_F(23, 1, 0, 0, y); SOL_F(23, 2, 0, 0, z); SOL_F(23, 3, 0, 0, w);
        SOL_F(23, 4, 0, 1, x); SOL_F(23, 5, 0, 1, y); SOL_F(23, 6, 0, 1, z); SOL_F(23, 7, 0, 1, w);
        SOL_F(23, 8, 0, 2, x); SOL_F(23, 9, 0, 2, y); SOL_F(23, 10, 0, 2, z); SOL_F(23, 11, 0, 2, w);
        SOL_F(23, 12, 0, 3, x); SOL_F(23, 13, 0, 3, y); SOL_F(23, 14, 0, 3, z); SOL_F(23, 15, 0, 3, w);
        SOL_F(23, 16, 0, 4, x); SOL_F(23, 17, 0, 4, y); SOL_F(23, 18, 0, 4, z); SOL_F(23, 19, 0, 4, w);
        SOL_F(23, 20, 0, 5, x); SOL_F(23, 21, 0, 5, y); SOL_F(23, 22, 0, 5, z);
        SOL_F(24, 0, 0, 6, x); SOL_F(24, 1, 0, 6, y); SOL_F(24, 2, 0, 6, z); SOL_F(24, 3, 0, 6, w);
        SOL_F(24, 4, 0, 7, x); SOL_F(24, 5, 0, 7, y); SOL_F(24, 6, 0, 7, z); SOL_F(24, 7, 0, 7, w);
        SOL_F(24, 8, 0, 8, x); SOL_F(24, 9, 0, 8, y); SOL_F(24, 10, 0, 8, z); SOL_F(24, 11, 0, 8, w);
        SOL_F(24, 12, 0, 9, x); SOL_F(24, 13, 0, 9, y); SOL_F(24, 14, 0, 9, z); SOL_F(24, 15, 0, 9, w);
        SOL_F(24, 16, 0, 10, x); SOL_F(24, 17, 0, 10, y); SOL_F(24, 18, 0, 10, z); SOL_F(24, 19, 0, 10, w);
        SOL_F(24, 20, 0, 11, x); SOL_F(24, 21, 0, 11, y); SOL_F(24, 22, 0, 11, z); SOL_F(24, 23, 0, 11, w);
        __builtin_amdgcn_sched_barrier(0);
        SOL_L(0, 0, 1788); SOL_L(0, 1, 1792); SOL_L(0, 2, 1836); SOL_L(0, 3, 1840); SOL_L(0, 4, 1844); SOL_L(0, 5, 1848); SOL_L(0, 6, 1852); SOL_L(0, 7, 1856); SOL_L(0, 8, 1860); SOL_L(0, 9, 1904); SOL_L(0, 10, 1908); SOL_L(0, 11, 1912);
        __builtin_amdgcn_sched_barrier(0);
        SOL_F(25, 0, 1, 0, x); SOL_F(25, 1, 1, 0, y); SOL_F(25, 2, 1, 0, z); SOL_F(25, 3, 1, 0, w);
        SOL_F(25, 4, 1, 1, x); SOL_F(25, 5, 1, 1, y); SOL_F(25, 6, 1, 1, z); SOL_F(25, 7, 1, 1, w);
        SOL_F(25, 8, 1, 2, x); SOL_F(25, 9, 1, 2, y); SOL_F(25, 10, 1, 2, z); SOL_F(25, 11, 1, 2, w);
        SOL_F(25, 12, 1, 3, x); SOL_F(25, 13, 1, 3, y); SOL_F(25, 14, 1, 3, z); SOL_F(25, 15, 1, 3, w);
        SOL_F(25, 16, 1, 4, x); SOL_F(25, 17, 1, 4, y); SOL_F(25, 18, 1, 4, z); SOL_F(25, 19, 1, 4, w);
        SOL_F(25, 20, 1, 5, x); SOL_F(25, 21, 1, 5, y); SOL_F(25, 22, 1, 5, z); SOL_F(25, 23, 1, 5, w);
        SOL_F(25, 24, 1, 6, x);
        SOL_F(26, 0, 1, 7, x); SOL_F(26, 1, 1, 7, y); SOL_F(26, 2, 1, 7, z); SOL_F(26, 3, 1, 7, w);
        SOL_F(26, 4, 1, 8, x); SOL_F(26, 5, 1, 8, y); SOL_F(26, 6, 1, 8, z); SOL_F(26, 7, 1, 8, w);
        SOL_F(26, 8, 1, 9, x); SOL_F(26, 9, 1, 9, y); SOL_F(26, 10, 1, 9, z); SOL_F(26, 11, 1, 9, w);
        SOL_F(26, 12, 1, 10, x); SOL_F(26, 13, 1, 10, y); SOL_F(26, 14, 1, 10, z); SOL_F(26, 15, 1, 10, w);
        SOL_F(26, 16, 1, 11, x); SOL_F(26, 17, 1, 11, y); SOL_F(26, 18, 1, 11, z); SOL_F(26, 19, 1, 11, w);
        __builtin_amdgcn_sched_barrier(0);
        SOL_L(1, 0, 1916); SOL_L(1, 1, 1920); SOL_L(1, 2, 1924); SOL_L(1, 3, 1928); SOL_L(1, 4, 1972); SOL_L(1, 5, 1976); SOL_L(1, 6, 1980); SOL_L(1, 7, 1984); SOL_L(1, 8, 1988); SOL_L(1, 9, 1992); SOL_L(1, 10, 1996); SOL_L(1, 11, 2000);
        __builtin_amdgcn_sched_barrier(0);
        SOL_F(26, 20, 0, 0, x); SOL_F(26, 21, 0, 0, y); SOL_F(26, 22, 0, 0, z); SOL_F(26, 23, 0, 0, w);
        SOL_F(26, 24, 0, 1, x); SOL_F(26, 25, 0, 1, y);
        SOL_F(27, 0, 0, 2, x); SOL_F(27, 1, 0, 2, y); SOL_F(27, 2, 0, 2, z); SOL_F(27, 3, 0, 2, w);
        SOL_F(27, 4, 0, 3, x); SOL_F(27, 5, 0, 3, y); SOL_F(27, 6, 0, 3, z); SOL_F(27, 7, 0, 3, w);
        SOL_F(27, 8, 0, 4, x); SOL_F(27, 9, 0, 4, y); SOL_F(27, 10, 0, 4, z); SOL_F(27, 11, 0, 4, w);
        SOL_F(27, 12, 0, 5, x); SOL_F(27, 13, 0, 5, y); SOL_F(27, 14, 0, 5, z); SOL_F(27, 15, 0, 5, w);
        SOL_F(27, 16, 0, 6, x); SOL_F(27, 17, 0, 6, y); SOL_F(27, 18, 0, 6, z); SOL_F(27, 19, 0, 6, w);
        SOL_F(27, 20, 0, 7, x); SOL_F(27, 21, 0, 7, y); SOL_F(27, 22, 0, 7, z); SOL_F(27, 23, 0, 7, w);
        SOL_F(27, 24, 0, 8, x); SOL_F(27, 25, 0, 8, y); SOL_F(27, 26, 0, 8, z);
        SOL_F(28, 0, 0, 9, x); SOL_F(28, 1, 0, 9, y); SOL_F(28, 2, 0, 9, z); SOL_F(28, 3, 0, 9, w);
        SOL_F(28, 4, 0, 10, x); SOL_F(28, 5, 0, 10, y); SOL_F(28, 6, 0, 10, z); SOL_F(28, 7, 0, 10, w);
        SOL_F(28, 8, 0, 11, x); SOL_F(28, 9, 0, 11, y); SOL_F(28, 10, 0, 11, z); SOL_F(28, 11, 0, 11, w);
        __builtin_amdgcn_sched_barrier(0);
        SOL_L(0, 0, 2040); SOL_L(0, 1, 2044); SOL_L(0, 2, 2048); SOL_L(0, 3, 2052); SOL_L(0, 4, 2056); SOL_L(0, 5, 2060); SOL_L(0, 6, 2064); SOL_L(0, 7, 2068); SOL_L(0, 8, 2108); SOL_L(0, 9, 2112); SOL_L(0, 10, 2116); SOL_L(0, 11, 2120);
        __builtin_amdgcn_sched_barrier(0);
        SOL_F(28, 12, 1, 0, x); SOL_F(28, 13, 1, 0, y); SOL_F(28, 14, 1, 0, z); SOL_F(28, 15, 1, 0, w);
        SOL_F(28, 16, 1, 1, x); SOL_F(28, 17, 1, 1, y); SOL_F(28, 18, 1, 1, z); SOL_F(28, 19, 1, 1, w);
        SOL_F(28, 20, 1, 2, x); SOL_F(28, 21, 1, 2, y); SOL_F(28, 22, 1, 2, z); SOL_F(28, 23, 1, 2, w);
        SOL_F(28, 24, 1, 3, x); SOL_F(28, 25, 1, 3, y); SOL_F(28, 26, 1, 3, z); SOL_F(28, 27, 1, 3, w);
        SOL_F(29, 0, 1, 4, x); SOL_F(29, 1, 1, 4, y); SOL_F(29, 2, 1, 4, z); SOL_F(29, 3, 1, 4, w);
        SOL_F(29, 4, 1, 5, x); SOL_F(29, 5, 1, 5, y); SOL_F(29, 6, 1, 5, z); SOL_F(29, 7, 1, 5, w);
        SOL_F(29, 8, 1, 6, x); SOL_F(29, 9, 1, 6, y); SOL_F(29, 10, 1, 6, z); SOL_F(29, 11, 1, 6, w);
        SOL_F(29, 12, 1, 7, x); SOL_F(29, 13, 1, 7, y); SOL_F(29, 14, 1, 7, z); SOL_F(29, 15, 1, 7, w);
        SOL_F(29, 16, 1, 8, x); SOL_F(29, 17, 1, 8, y); SOL_F(29, 18, 1, 8, z); SOL_F(29, 19, 1, 8, w);
        SOL_F(29, 20, 1, 9, x); SOL_F(29, 21, 1, 9, y); SOL_F(29, 22, 1, 9, z); SOL_F(29, 23, 1, 9, w);
        SOL_F(29, 24, 1, 10, x); SOL_F(29, 25, 1, 10, y); SOL_F(29, 26, 1, 10, z); SOL_F(29, 27, 1, 10, w);
        SOL_F(29, 28, 1, 11, x);
        __builtin_amdgcn_sched_barrier(0);
        SOL_L(1, 0, 2124); SOL_L(1, 1, 2128); SOL_L(1, 2, 2132); SOL_L(1, 3, 2136); SOL_L(1, 4, 2176); SOL_L(1, 5, 2180); SOL_L(1, 6, 2184); SOL_L(1, 7, 2188); SOL_L(1, 8, 2192); SOL_L(1, 9, 2196); SOL_L(1, 10, 2200); SOL_L(1, 11, 2204);
        __builtin_amdgcn_sched_barrier(0);
        SOL_F(30, 0, 0, 0, x); SOL_F(30, 1, 0, 0, y); SOL_F(30, 2, 0, 0, z); SOL_F(30, 3, 0, 0, w);
        SOL_F(30, 4, 0, 1, x); SOL_F(30, 5, 0, 1, y); SOL_F(30, 6, 0, 1, z); SOL_F(30, 7, 0, 1, w);
        SOL_F(30, 8, 0, 2, x); SOL_F(30, 9, 0, 2, y); SOL_F(30, 10, 0, 2, z); SOL_F(30, 11, 0, 2, w);
        SOL_F(30, 12, 0, 3, x); SOL_F(30, 13, 0, 3, y); SOL_F(30, 14, 0, 3, z); SOL_F(30, 15, 0, 3, w);
        SOL_F(30, 16, 0, 4, x); SOL_F(30, 17, 0, 4, y); SOL_F(30, 18, 0, 4, z); SOL_F(30, 19, 0, 4, w);
        SOL_F(30, 20, 0, 5, x); SOL_F(30, 21, 0, 5, y); SOL_F(30, 22, 0, 5, z); SOL_F(30, 23, 0, 5, w);
        SOL_F(30, 24, 0, 6, x); SOL_F(30, 25, 0, 6, y); SOL_F(30, 26, 0, 6, z); SOL_F(30, 27, 0, 6, w);
        SOL_F(30, 28, 0, 7, x); SOL_F(30, 29, 0, 7, y);
        SOL_F(31, 0, 0, 8, x); SOL_F(31, 1, 0, 8, y); SOL_F(31, 2, 0, 8, z); SOL_F(31, 3, 0, 8, w);
        SOL_F(31, 4, 0, 9, x); SOL_F(31, 5, 0, 9, y); SOL_F(31, 6, 0, 9, z); SOL_F(31, 7, 0, 9, w);
        SOL_F(31, 8, 0, 10, x); SOL_F(31, 9, 0, 10, y); SOL_F(31, 10, 0, 10, z); SOL_F(31, 11, 0, 10, w);
        SOL_F(31, 12, 0, 11, x); SOL_F(31, 13, 0, 11, y); SOL_F(31, 14, 0, 11, z); SOL_F(31, 15, 0, 11, w);
        __builtin_amdgcn_sched_barrier(0);
        SOL_L(0, 0, 2244); SOL_L(0, 1, 2248); SOL_L(0, 2, 2252); SOL_L(0, 3, 2256); SOL_L(0, 4, 2260); SOL_L(0, 5, 2264); SOL_L(0, 6, 2268); SOL_L(0, 7, 2272); SOL_L(0, 8, 2276); SOL_L(0, 9, 2312); SOL_L(0, 10, 2316); SOL_L(0, 11, 2320);
        __builtin_amdgcn_sched_barrier(0);
        SOL_F(31, 16, 1, 0, x); SOL_F(31, 17, 1, 0, y); SOL_F(31, 18, 1, 0, z); SOL_F(31, 19, 1, 0, w);
        SOL_F(31, 20, 1, 1, x); SOL_F(31, 21, 1, 1, y); SOL_F(31, 22, 1, 1, z); SOL_F(31, 23, 1, 1, w);
        SOL_F(31, 24, 1, 2, x); SOL_F(31, 25, 1, 2, y); SOL_F(31, 26, 1, 2, z); SOL_F(31, 27, 1, 2, w);
        SOL_F(31, 28, 1, 3, x); SOL_F(31, 29, 1, 3, y); SOL_F(31, 30, 1, 3, z);
        SOL_F(32, 0, 1, 4, x); SOL_F(32, 1, 1, 4, y); SOL_F(32, 2, 1, 4, z); SOL_F(32, 3, 1, 4, w);
        SOL_F(32, 4, 1, 5, x); SOL_F(32, 5, 1, 5, y); SOL_F(32, 6, 1, 5, z); SOL_F(32, 7, 1, 5, w);
        SOL_F(32, 8, 1, 6, x); SOL_F(32, 9, 1, 6, y); SOL_F(32, 10, 1, 6, z); SOL_F(32, 11, 1, 6, w);
        SOL_F(32, 12, 1, 7, x); SOL_F(32, 13, 1, 7, y); SOL_F(32, 14, 1, 7, z); SOL_F(32, 15, 1, 7, w);
        SOL_F(32, 16, 1, 8, x); SOL_F(32, 17, 1, 8, y); SOL_F(32, 18, 1, 8, z); SOL_F(32, 19, 1, 8, w);
        SOL_F(32, 20, 1, 9, x); SOL_F(32, 21, 1, 9, y); SOL_F(32, 22, 1, 9, z); SOL_F(32, 23, 1, 9, w);
        SOL_F(32, 24, 1, 10, x); SOL_F(32, 25, 1, 10, y); SOL_F(32, 26, 1, 10, z); SOL_F(32, 27, 1, 10, w);
        SOL_F(32, 28, 1, 11, x); SOL_F(32, 29, 1, 11, y); SOL_F(32, 30, 1, 11, z); SOL_F(32, 31, 1, 11, w);
        __builtin_amdgcn_sched_barrier(0);
        __syncthreads();
        SOL_L(1, 0, 2324); SOL_L(1, 1, 2328); SOL_L(1, 2, 2332); SOL_L(1, 3, 2336); SOL_L(1, 4, 2340); SOL_L(1, 5, 2344); SOL_L(1, 6, 2380); SOL_L(1, 7, 2384); SOL_L(1, 8, 2388); SOL_L(1, 9, 2392); SOL_L(1, 10, 2396); SOL_L(1, 11, 2400);
        __builtin_amdgcn_sched_barrier(0);
        SOL_F(33, 0, 0, 0, x); SOL_F(33, 1, 0, 0, y); SOL_F(33, 2, 0, 0, z); SOL_F(33, 3, 0, 0, w);
        SOL_F(33, 4, 0, 1, x); SOL_F(33, 5, 0, 1, y); SOL_F(33, 6, 0, 1, z); SOL_F(33, 7, 0, 1, w);
        SOL_F(33, 8, 0, 2, x); SOL_F(33, 9, 0, 2, y); SOL_F(33, 10, 0, 2, z); SOL_F(33, 11, 0, 2, w);
        SOL_F(33, 12, 0, 3, x); SOL_F(33, 13, 0, 3, y); SOL_F(33, 14, 0, 3, z); SOL_F(33, 15, 0, 3, w);
        SOL_F(33, 16, 0, 4, x); SOL_F(33, 17, 0, 4, y); SOL_F(33, 18, 0, 4, z); SOL_F(33, 19, 0, 4, w);
        SOL_F(33, 20, 0, 5, x); SOL_F(33, 21, 0, 5, y); SOL_F(33, 22, 0, 5, z); SOL_F(33, 23, 0, 5, w);
        SOL_F(33, 24, 0, 6, x); SOL_F(33, 25, 0, 6, y); SOL_F(33, 26, 0, 6, z); SOL_F(33, 27, 0, 6, w);
        SOL_F(33, 28, 0, 7, x); SOL_F(33, 29, 0, 7, y); SOL_F(33, 30, 0, 7, z); SOL_F(33, 31, 0, 7, w);
        SOL_F(33, 32, 0, 8, x);
        SOL_F(34, 0, 0, 9, x); SOL_F(34, 1, 0, 9, y); SOL_F(34, 2, 0, 9, z); SOL_F(34, 3, 0, 9, w);
        SOL_F(34, 4, 0, 10, x); SOL_F(34, 5, 0, 10, y); SOL_F(34, 6, 0, 10, z); SOL_F(34, 7, 0, 10, w);
        SOL_F(34, 8, 0, 11, x); SOL_F(34, 9, 0, 11, y); SOL_F(34, 10, 0, 11, z); SOL_F(34, 11, 0, 11, w);
        __builtin_amdgcn_sched_barrier(0);
        SOL_L(0, 0, 2404); SOL_L(0, 1, 2408); SOL_L(0, 2, 2412); SOL_L(0, 3, 2448); SOL_L(0, 4, 2452); SOL_L(0, 5, 2456); SOL_L(0, 6, 2460); SOL_L(0, 7, 2464); SOL_L(0, 8, 2468); SOL_L(0, 9, 2472); SOL_L(0, 10, 2476); SOL_L(0, 11, 2480);
        __builtin_amdgcn_sched_barrier(0);
        SOL_F(34, 12, 1, 0, x); SOL_F(34, 13, 1, 0, y); SOL_F(34, 14, 1, 0, z); SOL_F(34, 15, 1, 0, w);
        SOL_F(34, 16, 1, 1, x); SOL_F(34, 17, 1, 1, y); SOL_F(34, 18, 1, 1, z); SOL_F(34, 19, 1, 1, w);
        SOL_F(34, 20, 1, 2, x); SOL_F(34, 21, 1, 2, y); SOL_F(34, 22, 1, 2, z); SOL_F(34, 23, 1, 2, w);
        SOL_F(34, 24, 1, 3, x); SOL_F(34, 25, 1, 3, y); SOL_F(34, 26, 1, 3, z); SOL_F(34, 27, 1, 3, w);
        SOL_F(34, 28, 1, 4, x); SOL_F(34, 29, 1, 4, y); SOL_F(34, 30, 1, 4, z); SOL_F(34, 31, 1, 4, w);
        SOL_F(34, 32, 1, 5, x); SOL_F(34, 33, 1, 5, y);
        SOL_F(35, 0, 1, 6, x); SOL_F(35, 1, 1, 6, y); SOL_F(35, 2, 1, 6, z); SOL_F(35, 3, 1, 6, w);
        SOL_F(35, 4, 1, 7, x); SOL_F(35, 5, 1, 7, y); SOL_F(35, 6, 1, 7, z); SOL_F(35, 7, 1, 7, w);
        SOL_F(35, 8, 1, 8, x); SOL_F(35, 9, 1, 8, y); SOL_F(35, 10, 1, 8, z); SOL_F(35, 11, 1, 8, w);
        SOL_F(35, 12, 1, 9, x); SOL_F(35, 13, 1, 9, y); SOL_F(35, 14, 1, 9, z); SOL_F(35, 15, 1, 9, w);
        SOL_F(35, 16, 1, 10, x); SOL_F(35, 17, 1, 10, y); SOL_F(35, 18, 1, 10, z); SOL_F(35, 19, 1, 10, w);
        SOL_F(35, 20, 1, 11, x); SOL_F(35, 21, 1, 11, y); SOL_F(35, 22, 1, 11, z); SOL_F(35, 23, 1, 11, w);
        __builtin_amdgcn_sched_barrier(0);
        SOL_L(1, 0, 2516); SOL_L(1, 1, 2520); SOL_L(1, 2, 2524); SOL_L(1, 3, 2528); SOL_L(1, 4, 2532); SOL_L(1, 5, 2536); SOL_L(1, 6, 2540); SOL_L(1, 7, 2544); SOL_L(1, 8, 2548); SOL_L(1, 9, 2552); SOL_L(1, 10, 2584); SOL_L(1, 11, 2588);
        __builtin_amdgcn_sched_barrier(0);
        SOL_F(35, 24, 0, 0, x); SOL_F(35, 25, 0, 0, y); SOL_F(35, 26, 0, 0, z); SOL_F(35, 27, 0, 0, w);
        SOL_F(35, 28, 0, 1, x); SOL_F(35, 29, 0, 1, y); SOL_F(35, 30, 0, 1, z); SOL_F(35, 31, 0, 1, w);
        SOL_F(35, 32, 0, 2, x); SOL_F(35, 33, 0, 2, y); SOL_F(35, 34, 0, 2, z);
        SOL_F(36, 0, 0, 3, x); SOL_F(36, 1, 0, 3, y); SOL_F(36, 2, 0, 3, z); SOL_F(36, 3, 0, 3, w);
        SOL_F(36, 4, 0, 4, x); SOL_F(36, 5, 0, 4, y); SOL_F(36, 6, 0, 4, z); SOL_F(36, 7, 0, 4, w);
        SOL_F(36, 8, 0, 5, x); SOL_F(36, 9, 0, 5, y); SOL_F(36, 10, 0, 5, z); SOL_F(36, 11, 0, 5, w);
        SOL_F(36, 12, 0, 6, x); SOL_F(36, 13, 0, 6, y); SOL_F(36, 14, 0, 6, z); SOL_F(36, 15, 0, 6, w);
        SOL_F(36, 16, 0, 7, x); SOL_F(36, 17, 0, 7, y); SOL_F(36, 18, 0, 7, z); SOL_F(36, 19, 0, 7, w);
        SOL_F(36, 20, 0, 8, x); SOL_F(36, 21, 0, 8, y); SOL_F(36, 22, 0, 8, z); SOL_F(36, 23, 0, 8, w);
        SOL_F(36, 24, 0, 9, x); SOL_F(36, 25, 0, 9, y); SOL_F(36, 26, 0, 9, z); SOL_F(36, 27, 0, 9, w);
        SOL_F(36, 28, 0, 10, x); SOL_F(36, 29, 0, 10, y); SOL_F(36, 30, 0, 10, z); SOL_F(36, 31, 0, 10, w);
        SOL_F(36, 32, 0, 11, x); SOL_F(36, 33, 0, 11, y); SOL_F(36, 34, 0, 11, z); SOL_F(36, 35, 0, 11, w);
        __builtin_amdgcn_sched_barrier(0);
        SOL_L(0, 0, 2592); SOL_L(0, 1, 2596); SOL_L(0, 2, 2600); SOL_L(0, 3, 2604); SOL_L(0, 4, 2608); SOL_L(0, 5, 2612); SOL_L(0, 6, 2616); SOL_L(0, 7, 2620); SOL_L(0, 8, 2652); SOL_L(0, 9, 2656); SOL_L(0, 10, 2660); SOL_L(0, 11, 2664);
        __builtin_amdgcn_sched_barrier(0);
        SOL_F(37, 0, 1, 0, x); SOL_F(37, 1, 1, 0, y); SOL_F(37, 2, 1, 0, z); SOL_F(37, 3, 1, 0, w);
        SOL_F(37, 4, 1, 1, x); SOL_F(37, 5, 1, 1, y); SOL_F(37, 6, 1, 1, z); SOL_F(37, 7, 1, 1, w);
        SOL_F(37, 8, 1, 2, x); SOL_F(37, 9, 1, 2, y); SOL_F(37, 10, 1, 2, z); SOL_F(37, 11, 1, 2, w);
        SOL_F(37, 12, 1, 3, x); SOL_F(37, 13, 1, 3, y); SOL_F(37, 14, 1, 3, z); SOL_F(37, 15, 1, 3, w);
        SOL_F(37, 16, 1, 4, x); SOL_F(37, 17, 1, 4, y); SOL_F(37, 18, 1, 4, z); SOL_F(37, 19, 1, 4, w);
        SOL_F(37, 20, 1, 5, x); SOL_F(37, 21, 1, 5, y); SOL_F(37, 22, 1, 5, z); SOL_F(37, 23, 1, 5, w);
        SOL_F(37, 24, 1, 6, x); SOL_F(37, 25, 1, 6, y); SOL_F(37, 26, 1, 6, z); SOL_F(37, 27, 1, 6, w);
        SOL_F(37, 28, 1, 7, x); SOL_F(37, 29, 1, 7, y); SOL_F(37, 30, 1, 7, z); SOL_F(37, 31, 1, 7, w);
        SOL_F(37, 32, 1, 8, x); SOL_F(37, 33, 1, 8, y); SOL_F(37, 34, 1, 8, z); SOL_F(37, 35, 1, 8, w);
        SOL_F(37, 36, 1, 9, x);
        SOL_F(38, 0, 1, 10, x); SOL_F(38, 1, 1, 10, y); SOL_F(38, 2, 1, 10, z); SOL_F(38, 3, 1, 10, w);
        SOL_F(38, 4, 1, 11, x); SOL_F(38, 5, 1, 11, y); SOL_F(38, 6, 1, 11, z); SOL_F(38, 7, 1, 11, w);
        __builtin_amdgcn_sched_barrier(0);
        SOL_L(1, 0, 2668); SOL_L(1, 1, 2672); SOL_L(1, 2, 2676); SOL_L(1, 3, 2680); SOL_L(1, 4, 2684); SOL_L(1, 5, 2688); SOL_L(1, 6, 2720); SOL_L(1, 7, 2724); SOL_L(1, 8, 2728); SOL_L(1, 9, 2732); SOL_L(1, 10, 2736); SOL_L(1, 11, 2740);
        __builtin_amdgcn_sched_barrier(0);
        SOL_F(38, 8, 0, 0, x); SOL_F(38, 9, 0, 0, y); SOL_F(38, 10, 0, 0, z); SOL_F(38, 11, 0, 0, w);
        SOL_F(38, 12, 0, 1, x); SOL_F(38, 13, 0, 1, y); SOL_F(38, 14, 0, 1, z); SOL_F(38, 15, 0, 1, w);
        SOL_F(38, 16, 0, 2, x); SOL_F(38, 17, 0, 2, y); SOL_F(38, 18, 0, 2, z); SOL_F(38, 19, 0, 2, w);
        SOL_F(38, 20, 0, 3, x); SOL_F(38, 21, 0, 3, y); SOL_F(38, 22, 0, 3, z); SOL_F(38, 23, 0, 3, w);
        SOL_F(38, 24, 0, 4, x); SOL_F(38, 25, 0, 4, y); SOL_F(38, 26, 0, 4, z); SOL_F(38, 27, 0, 4, w);
        SOL_F(38, 28, 0, 5, x); SOL_F(38, 29, 0, 5, y); SOL_F(38, 30, 0, 5, z); SOL_F(38, 31, 0, 5, w);
        SOL_F(38, 32, 0, 6, x); SOL_F(38, 33, 0, 6, y); SOL_F(38, 34, 0, 6, z); SOL_F(38, 35, 0, 6, w);
        SOL_F(38, 36, 0, 7, x); SOL_F(38, 37, 0, 7, y);
        SOL_F(39, 0, 0, 8, x); SOL_F(39, 1, 0, 8, y); SOL_F(39, 2, 0, 8, z); SOL_F(39, 3, 0, 8, w);
        SOL_F(39, 4, 0, 9, x); SOL_F(39, 5, 0, 9, y); SOL_F(39, 6, 0, 9, z); SOL_F(39, 7, 0, 9, w);
        SOL_F(39, 8, 0, 10, x); SOL_F(39, 9, 0, 10, y); SOL_F(39, 10, 0, 10, z); SOL_F(39, 11, 0, 10, w);
        SOL_F(39, 12, 0, 11, x); SOL_F(39, 13, 0, 11, y); SOL_F(39, 14, 0, 11, z); SOL_F(39, 15, 0, 11, w);
        __builtin_amdgcn_sched_barrier(0);
        SOL_L(0, 0, 2744); SOL_L(0, 1, 2748); SOL_L(0, 2, 2752); SOL_L(0, 3, 2756); SOL_L(0, 4, 2788); SOL_L(0, 5, 2792); SOL_L(0, 6, 2796); SOL_L(0, 7, 2800); SOL_L(0, 8, 2804); SOL_L(0, 9, 2808); SOL_L(0, 10, 2812); SOL_L(0, 11, 2816);
        __builtin_amdgcn_sched_barrier(0);
        SOL_F(39, 16, 1, 0, x); SOL_F(39, 17, 1, 0, y); SOL_F(39, 18, 1, 0, z); SOL_F(39, 19, 1, 0, w);
        SOL_F(39, 20, 1, 1, x); SOL_F(39, 21, 1, 1, y); SOL_F(39, 22, 1, 1, z); SOL_F(39, 23, 1, 1, w);
        SOL_F(39, 24, 1, 2, x); SOL_F(39, 25, 1, 2, y); SOL_F(39, 26, 1, 2, z); SOL_F(39, 27, 1, 2, w);
        SOL_F(39, 28, 1, 3, x); SOL_F(39, 29, 1, 3, y); SOL_F(39, 30, 1, 3, z); SOL_F(39, 31, 1, 3, w);
        SOL_F(39, 32, 1, 4, x); SOL_F(39, 33, 1, 4, y); SOL_F(39, 34, 1, 4, z); SOL_F(39, 35, 1, 4, w);
        SOL_F(39, 36, 1, 5, x); SOL_F(39, 37, 1, 5, y); SOL_F(39, 38, 1, 5, z);
        SOL_F(40, 0, 1, 6, x); SOL_F(40, 1, 1, 6, y); SOL_F(40, 2, 1, 6, z); SOL_F(40, 3, 1, 6, w);
        SOL_F(40, 4, 1, 7, x); SOL_F(40, 5, 1, 7, y); SOL_F(40, 6, 1, 7, z); SOL_F(40, 7, 1, 7, w);
        SOL_F(40, 8, 1, 8, x); SOL_F(40, 9, 1, 8, y); SOL_F(40, 10, 1, 8, z); SOL_F(40, 11, 1, 8, w);
        SOL_F(40, 12, 1, 9, x); SOL_F(40, 13, 1, 9, y); SOL_F(40, 14, 1, 9, z); SOL_F(40, 15, 1, 9, w);
        SOL_F(40, 16, 1, 10, x); SOL_F(40, 17, 1, 10, y); SOL_F(40, 18, 1, 10, z); SOL_F(40, 19, 1, 10, w);
        SOL_F(40, 20, 1, 11, x); SOL_F(40, 21, 1, 11, y); SOL_F(40, 22, 1, 11, z); SOL_F(40, 23, 1, 11, w);
        __builtin_amdgcn_sched_barrier(0);
        SOL_L(1, 0, 2820); SOL_L(1, 1, 2824); SOL_L(1, 2, 2828); SOL_L(1, 3, 2856); SOL_L(1, 4, 2860); SOL_L(1, 5, 2864); SOL_L(1, 6, 2868); SOL_L(1, 7, 2872); SOL_L(1, 8, 2876); SOL_L(1, 9, 2880); SOL_L(1, 10, 2884); SOL_L(1, 11, 2888);
        __builtin_amdgcn_sched_barrier(0);
        SOL_F(40, 24, 0, 0, x); SOL_F(40, 25, 0, 0, y); SOL_F(40, 26, 0, 0, z); SOL_F(40, 27, 0, 0, w);
        SOL_F(40, 28, 0, 1, x); SOL_F(40, 29, 0, 1, y); SOL_F(40, 30, 0, 1, z); SOL_F(40, 31, 0, 1, w);
        SOL_F(40, 32, 0, 2, x); SOL_F(40, 33, 0, 2, y); SOL_F(40, 34, 0, 2, z); SOL_F(40, 35, 0, 2, w);
        SOL_F(40, 36, 0, 3, x); SOL_F(40, 37, 0, 3, y); SOL_F(40, 38, 0, 3, z); SOL_F(40, 39, 0, 3, w);
        SOL_F(41, 0, 0, 4, x); SOL_F(41, 1, 0, 4, y); SOL_F(41, 2, 0, 4, z); SOL_F(41, 3, 0, 4, w);
        SOL_F(41, 4, 0, 5, x); SOL_F(41, 5, 0, 5, y); SOL_F(41, 6, 0, 5, z); SOL_F(41, 7, 0, 5, w);
        SOL_F(41, 8, 0, 6, x); SOL_F(41, 9, 0, 6, y); SOL_F(41, 10, 0, 6, z); SOL_F(41, 11, 0, 6, w);
        SOL_F(41, 12, 0, 7, x); SOL_F(41, 13, 0, 7, y); SOL_F(41, 14, 0, 7, z); SOL_F(41, 15, 0, 7, w);
        SOL_F(41, 16, 0, 8, x); SOL_F(41, 17, 0, 8, y); SOL_F(41, 18, 0, 8, z); SOL_F(41, 19, 0, 8, w);
        SOL_F(41, 20, 0, 9, x); SOL_F(41, 21, 0, 9, y); SOL_F(41, 22, 0, 9, z); SOL_F(41, 23, 0, 9, w);
        SOL_F(41, 24, 0, 10, x); SOL_F(41, 25, 0, 10, y); SOL_F(41, 26, 0, 10, z); SOL_F(41, 27, 0, 10, w);
        SOL_F(41, 28, 0, 11, x); SOL_F(41, 29, 0, 11, y); SOL_F(41, 30, 0, 11, z); SOL_F(41, 31, 0, 11, w);
        __builtin_amdgcn_sched_barrier(0);
        SOL_L(0, 0, 2892); SOL_L(0, 1, 2896); SOL_L(0, 2, 2924); SOL_L(0, 3, 2928); SOL_L(0, 4, 2932); SOL_L(0, 5, 2936); SOL_L(0, 6, 2940); SOL_L(0, 7, 2944); SOL_L(0, 8, 2948); SOL_L(0, 9, 2952); SOL_L(0, 10, 2956); SOL_L(0, 11, 2960);
        __builtin_amdgcn_sched_barrier(0);
        SOL_F(41, 32, 1, 0, x); SOL_F(41, 33, 1, 0, y); SOL_F(41, 34, 1, 0, z); SOL_F(41, 35, 1, 0, w);
        SOL_F(41, 36, 1, 1, x); SOL_F(41, 37, 1, 1, y); SOL_F(41, 38, 1, 1, z); SOL_F(41, 39, 1, 1, w);
        SOL_F(41, 40, 1, 2, x);
        SOL_F(42, 0, 1, 3, x); SOL_F(42, 1, 1, 3, y); SOL_F(42, 2, 1, 3, z); SOL_F(42, 3, 1, 3, w);
        SOL_F(42, 4, 1, 4, x); SOL_F(42, 5, 1, 4, y); SOL_F(42, 6, 1, 4, z); SOL_F(42, 7, 1, 4, w);
        SOL_F(42, 8, 1, 5, x); SOL_F(42, 9, 1, 5, y); SOL_F(42, 10, 1, 5, z); SOL_F(42, 11, 1, 5, w);
        SOL_F(42, 12, 1, 6, x); SOL_F(42, 13, 1, 6, y); SOL_F(42, 14, 1, 6, z); SOL_F(42, 15, 1, 6, w);
        SOL_F(42, 16, 1, 7, x); SOL_F(42, 17, 1, 7, y); SOL_F(42, 18, 1, 7, z); SOL_F(42, 19, 1, 7, w);
        SOL_F(42, 20, 1, 8, x); SOL_F(42, 21, 1, 8, y); SOL_F(42, 22, 1, 8, z); SOL_F(42, 23, 1, 8, w);
        SOL_F(42, 24, 1, 9, x); SOL_F(42, 25, 1, 9, y); SOL_F(42, 26, 1, 9, z); SOL_F(42, 27, 1, 9, w);
        SOL_F(42, 28, 1, 10, x); SOL_F(42, 29, 1, 10, y); SOL_F(42, 30, 1, 10, z); SOL_F(42, 31, 1, 10, w);
        SOL_F(42, 32, 1, 11, x); SOL_F(42, 33, 1, 11, y); SOL_F(42, 34, 1, 11, z); SOL_F(42, 35, 1, 11, w);
        __builtin_amdgcn_sched_barrier(0);
        SOL_L(1, 0, 2964); SOL_L(1, 1, 2992); SOL_L(1, 2, 2996); SOL_L(1, 3, 3000); SOL_L(1, 4, 3004); SOL_L(1, 5, 3008); SOL_L(1, 6, 3012); SOL_L(1, 7, 3016); SOL_L(1, 8, 3020); SOL_L(1, 9, 3024); SOL_L(1, 10, 3028); SOL_L(1, 11, 3032);
        __builtin_amdgcn_sched_barrier(0);
        SOL_F(42, 36, 0, 0, x); SOL_F(42, 37, 0, 0, y); SOL_F(42, 38, 0, 0, z); SOL_F(42, 39, 0, 0, w);
        SOL_F(42, 40, 0, 1, x); SOL_F(42, 41, 0, 1, y);
        SOL_F(43, 0, 0, 2, x); SOL_F(43, 1, 0, 2, y); SOL_F(43, 2, 0, 2, z); SOL_F(43, 3, 0, 2, w);
        SOL_F(43, 4, 0, 3, x); SOL_F(43, 5, 0, 3, y); SOL_F(43, 6, 0, 3, z); SOL_F(43, 7, 0, 3, w);
        SOL_F(43, 8, 0, 4, x); SOL_F(43, 9, 0, 4, y); SOL_F(43, 10, 0, 4, z); SOL_F(43, 11, 0, 4, w);
        SOL_F(43, 12, 0, 5, x); SOL_F(43, 13, 0, 5, y); SOL_F(43, 14, 0, 5, z); SOL_F(43, 15, 0, 5, w);
        SOL_F(43, 16, 0, 6, x); SOL_F(43, 17, 0, 6, y); SOL_F(43, 18, 0, 6, z); SOL_F(43, 19, 0, 6, w);
        SOL_F(43, 20, 0, 7, x); SOL_F(43, 21, 0, 7, y); SOL_F(43, 22, 0, 7, z); SOL_F(43, 23, 0, 7, w);
        SOL_F(43, 24, 0, 8, x); SOL_F(43, 25, 0, 8, y); SOL_F(43, 26, 0, 8, z); SOL_F(43, 27, 0, 8, w);
        SOL_F(43, 28, 0, 9, x); SOL_F(43, 29, 0, 9, y); SOL_F(43, 30, 0, 9, z); SOL_F(43, 31, 0, 9, w);
        SOL_F(43, 32, 0, 10, x); SOL_F(43, 33, 0, 10, y); SOL_F(43, 34, 0, 10, z); SOL_F(43, 35, 0, 10, w);
        SOL_F(43, 36, 0, 11, x); SOL_F(43, 37, 0, 11, y); SOL_F(43, 38, 0, 11, z); SOL_F(43, 39, 0, 11, w);
        __builtin_amdgcn_sched_barrier(0);
        SOL_L(0, 0, 3060); SOL_L(0, 1, 3064); SOL_L(0, 2, 3068); SOL_L(0, 3, 3072); SOL_L(0, 4, 3076); SOL_L(0, 5, 3080); SOL_L(0, 6, 3084); SOL_L(0, 7, 3088); SOL_L(0, 8, 3092); SOL_L(0, 9, 3096); SOL_L(0, 10, 3100); SOL_L(0, 11, 3104);
        __builtin_amdgcn_sched_barrier(0);
        SOL_F(43, 40, 1, 0, x); SOL_F(43, 41, 1, 0, y); SOL_F(43, 42, 1, 0, z);
        SOL_F(44, 0, 1, 1, x); SOL_F(44, 1, 1, 1, y); SOL_F(44, 2, 1, 1, z); SOL_F(44, 3, 1, 1, w);
        SOL_F(44, 4, 1, 2, x); SOL_F(44, 5, 1, 2, y); SOL_F(44, 6, 1, 2, z); SOL_F(44, 7, 1, 2, w);
        SOL_F(44, 8, 1, 3, x); SOL_F(44, 9, 1, 3, y); SOL_F(44, 10, 1, 3, z); SOL_F(44, 11, 1, 3, w);
        SOL_F(44, 12, 1, 4, x); SOL_F(44, 13, 1, 4, y); SOL_F(44, 14, 1, 4, z); SOL_F(44, 15, 1, 4, w);
        SOL_F(44, 16, 1, 5, x); SOL_F(44, 17, 1, 5, y); SOL_F(44, 18, 1, 5, z); SOL_F(44, 19, 1, 5, w);
        SOL_F(44, 20, 1, 6, x); SOL_F(44, 21, 1, 6, y); SOL_F(44, 22, 1, 6, z); SOL_F(44, 23, 1, 6, w);
        SOL_F(44, 24, 1, 7, x); SOL_F(44, 25, 1, 7, y); SOL_F(44, 26, 1, 7, z); SOL_F(44, 27, 1, 7, w);
        SOL_F(44, 28, 1, 8, x); SOL_F(44, 29, 1, 8, y); SOL_F(44, 30, 1, 8, z); SOL_F(44, 31, 1, 8, w);
        SOL_F(44, 32, 1, 9, x); SOL_F(44, 33, 1, 9, y); SOL_F(44, 34, 1, 9, z); SOL_F(44, 35, 1, 9, w);
        SOL_F(44, 36, 1, 10, x); SOL_F(44, 37, 1, 10, y); SOL_F(44, 38, 1, 10, z); SOL_F(44, 39, 1, 10, w);
        SOL_F(44, 40, 1, 11, x); SOL_F(44, 41, 1, 11, y); SOL_F(44, 42, 1, 11, z); SOL_F(44, 43, 1, 11, w);
        __builtin_amdgcn_sched_barrier(0);
        SOL_L(1, 0, 3128); SOL_L(1, 1, 3132); SOL_L(1, 2, 3136); SOL_L(1, 3, 3140); SOL_L(1, 4, 3144); SOL_L(1, 5, 3148); SOL_L(1, 6, 3152); SOL_L(1, 7, 3156); SOL_L(1, 8, 3160); SOL_L(1, 9, 3164); SOL_L(1, 10, 3168); SOL_L(1, 11, 3172);
        __builtin_amdgcn_sched_barrier(0);
        SOL_F(45, 0, 0, 0, x); SOL_F(45, 1, 0, 0, y); SOL_F(45, 2, 0, 0, z); SOL_F(45, 3, 0, 0, w);
        SOL_F(45, 4, 0, 1, x); SOL_F(45, 5, 0, 1, y); SOL_F(45, 6, 0, 1, z); SOL_F(45, 7, 0, 1, w);
        SOL_F(45, 8, 0, 2, x); SOL_F(45, 9, 0, 2, y); SOL_F(45, 10, 0, 2, z); SOL_F(45, 11, 0, 2, w);
        SOL_F(45, 12, 0, 3, x); SOL_F(45, 13, 0, 3, y); SOL_F(45, 14, 0, 3, z); SOL_F(45, 15, 0, 3, w);
        SOL_F(45, 16, 0, 4, x); SOL_F(45, 17, 0, 4, y); SOL_F(45, 18, 0, 4, z); SOL_F(45, 19, 0, 4, w);
        SOL_F(45, 20, 0, 5, x); SOL_F(45, 21, 0, 5, y); SOL_F(45, 22, 0, 5, z); SOL_F(45, 23, 0, 5, w);
        SOL_F(45, 24, 0, 6, x); SOL_F(45, 25, 0, 6, y); SOL_F(45, 26, 0, 6, z); SOL_F(45, 27, 0, 6, w);
        SOL_F(45, 28, 0, 7, x); SOL_F(45, 29, 0, 7, y); SOL_F(45, 30, 0, 7, z); SOL_F(45, 31, 0, 7, w);
        SOL_F(45, 32, 0, 8, x); SOL_F(45, 33, 0, 8, y); SOL_F(45, 34, 0, 8, z); SOL_F(45, 35, 0, 8, w);
        SOL_F(45, 36, 0, 9, x); SOL_F(45, 37, 0, 9, y); SOL_F(45, 38, 0, 9, z); SOL_F(45, 39, 0, 9, w);
        SOL_F(45, 40, 0, 10, x); SOL_F(45, 41, 0, 10, y); SOL_F(45, 42, 0, 10, z); SOL_F(45, 43, 0, 10, w);
        SOL_F(45, 44, 0, 11, x);
        __builtin_amdgcn_sched_barrier(0);
        SOL_L(0, 0, 3196); SOL_L(0, 1, 3200); SOL_L(0, 2, 3204); SOL_L(0, 3, 3208); SOL_L(0, 4, 3212); SOL_L(0, 5, 3216); SOL_L(0, 6, 3220); SOL_L(0, 7, 3224); SOL_L(0, 8, 3228); SOL_L(0, 9, 3232); SOL_L(0, 10, 3236); SOL_L(0, 11, 3240);
        __builtin_amdgcn_sched_barrier(0);
        SOL_F(46, 0, 1, 0, x); SOL_F(46, 1, 1, 0, y); SOL_F(46, 2, 1, 0, z); SOL_F(46, 3, 1, 0, w);
        SOL_F(46, 4, 1, 1, x); SOL_F(46, 5, 1, 1, y); SOL_F(46, 6, 1, 1, z); SOL_F(46, 7, 1, 1, w);
        SOL_F(46, 8, 1, 2, x); SOL_F(46, 9, 1, 2, y); SOL_F(46, 10, 1, 2, z); SOL_F(46, 11, 1, 2, w);
        SOL_F(46, 12, 1, 3, x); SOL_F(46, 13, 1, 3, y); SOL_F(46, 14, 1, 3, z); SOL_F(46, 15, 1, 3, w);
        SOL_F(46, 16, 1, 4, x); SOL_F(46, 17, 1, 4, y); SOL_F(46, 18, 1, 4, z); SOL_F(46, 19, 1, 4, w);
        SOL_F(46, 20, 1, 5, x); SOL_F(46, 21, 1, 5, y); SOL_F(46, 22, 1, 5, z); SOL_F(46, 23, 1, 5, w);
        SOL_F(46, 24, 1, 6, x); SOL_F(46, 25, 1, 6, y); SOL_F(46, 26, 1, 6, z); SOL_F(46, 27, 1, 6, w);
        SOL_F(46, 28, 1, 7, x); SOL_F(46, 29, 1, 7, y); SOL_F(46, 30, 1, 7, z); SOL_F(46, 31, 1, 7, w);
        SOL_F(46, 32, 1, 8, x); SOL_F(46, 33, 1, 8, y); SOL_F(46, 34, 1, 8, z); SOL_F(46, 35, 1, 8, w);
        SOL_F(46, 36, 1, 9, x); SOL_F(46, 37, 1, 9, y); SOL_F(46, 38, 1, 9, z); SOL_F(46, 39, 1, 9, w);
        SOL_F(46, 40, 1, 10, x); SOL_F(46, 41, 1, 10, y); SOL_F(46, 42, 1, 10, z); SOL_F(46, 43, 1, 10, w);
        SOL_F(46, 44, 1, 11, x); SOL_F(46, 45, 1, 11, y);
        __builtin_amdgcn_sched_barrier(0);
        SOL_L(1, 0, 3264); SOL_L(1, 1, 3268); SOL_L(1, 2, 3272); SOL_L(1, 3, 3276); SOL_L(1, 4, 3280); SOL_L(1, 5, 3284); SOL_L(1, 6, 3288); SOL_L(1, 7, 3292); SOL_L(1, 8, 3296); SOL_L(1, 9, 3300); SOL_L(1, 10, 3304); SOL_L(1, 11, 3308);
        __builtin_amdgcn_sched_barrier(0);
        SOL_F(47, 0, 0, 0, x); SOL_F(47, 1, 0, 0, y); SOL_F(47, 2, 0, 0, z); SOL_F(47, 3, 0, 0, w);
        SOL_F(47, 4, 0, 1, x); SOL_F(47, 5, 0, 1, y); SOL_F(47, 6, 0, 1, z); SOL_F(47, 7, 0, 1, w);
        SOL_F(47, 8, 0, 2, x); SOL_F(47, 9, 0, 2, y); SOL_F(47, 10, 0, 2, z); SOL_F(47, 11, 0, 2, w);
        SOL_F(47, 12, 0, 3, x); SOL_F(47, 13, 0, 3, y); SOL_F(47, 14, 0, 3, z); SOL_F(47, 15, 0, 3, w);
        SOL_F(47, 16, 0, 4, x); SOL_F(47, 17, 0, 4, y); SOL_F(47, 18, 0, 4, z); SOL_F(47, 19, 0, 4, w);
        SOL_F(47, 20, 0, 5, x); SOL_F(47, 21, 0, 5, y); SOL_F(47, 22, 0, 5, z); SOL_F(47, 23, 0, 5, w);
        SOL_F(47, 24, 0, 6, x); SOL_F(47, 25, 0, 6, y); SOL_F(47, 26, 0, 6, z); SOL_F(47, 27, 0, 6, w);
        SOL_F(47, 28, 0, 7, x); SOL_F(47, 29, 0, 7, y); SOL_F(47, 30, 0, 7, z); SOL_F(47, 31, 0, 7, w);
        SOL_F(47, 32, 0, 8, x); SOL_F(47, 33, 0, 8, y); SOL_F(47, 34, 0, 8, z); SOL_F(47, 35, 0, 8, w);
        SOL_F(47, 36, 0, 9, x); SOL_F(47, 37, 0, 9, y); SOL_F(47, 38, 0, 9, z); SOL_F(47, 39, 0, 9, w);
        SOL_F(47, 40, 0, 10, x); SOL_F(47, 41, 0, 10, y); SOL_F(47, 42, 0, 10, z); SOL_F(47, 43, 0, 10, w);
        SOL_F(47, 44, 0, 11, x); SOL_F(47, 45, 0, 11, y); SOL_F(47, 46, 0, 11, z);
        __builtin_amdgcn_sched_barrier(0);
        SOL_L(0, 0, 3332); SOL_L(0, 1, 3336); SOL_L(0, 2, 3340); SOL_L(0, 3, 3344); SOL_L(0, 4, 3348); SOL_L(0, 5, 3352); SOL_L(0, 6, 3356); SOL_L(0, 7, 3360); SOL_L(0, 8, 3364); SOL_L(0, 9, 3368); SOL_L(0, 10, 3372); SOL_L(0, 11, 3376);
        __builtin_amdgcn_sched_barrier(0);
        SOL_F(48, 0, 1, 0, x); SOL_F(48, 1, 1, 0, y); SOL_F(48, 2, 1, 0, z); SOL_F(48, 3, 1, 0, w);
        SOL_F(48, 4, 1, 1, x); SOL_F(48, 5, 1, 1, y); SOL_F(48, 6, 1, 1, z); SOL_F(48, 7, 1, 1, w);
        SOL_F(48, 8, 1, 2, x); SOL_F(48, 9, 1, 2, y); SOL_F(48, 10, 1, 2, z); SOL_F(48, 11, 1, 2, w);
        SOL_F(48, 12, 1, 3, x); SOL_F(48, 13, 1, 3, y); SOL_F(48, 14, 1, 3, z); SOL_F(48, 15, 1, 3, w);
        SOL_F(48, 16, 1, 4, x); SOL_F(48, 17, 1, 4, y); SOL_F(48, 18, 1, 4, z); SOL_F(48, 19, 1, 4, w);
        SOL_F(48, 20, 1, 5, x); SOL_F(48, 21, 1, 5, y); SOL_F(48, 22, 1, 5, z); SOL_F(48, 23, 1, 5, w);
        SOL_F(48, 24, 1, 6, x); SOL_F(48, 25, 1, 6, y); SOL_F(48, 26, 1, 6, z); SOL_F(48, 27, 1, 6, w);
        SOL_F(48, 28, 1, 7, x); SOL_F(48, 29, 1, 7, y); SOL_F(48, 30, 1, 7, z); SOL_F(48, 31, 1, 7, w);
        SOL_F(48, 32, 1, 8, x); SOL_F(48, 33, 1, 8, y); SOL_F(48, 34, 1, 8, z); SOL_F(48, 35, 1, 8, w);
        SOL_F(48, 36, 1, 9, x); SOL_F(48, 37, 1, 9, y); SOL_F(48, 38, 1, 9, z); SOL_F(48, 39, 1, 9, w);
        SOL_F(48, 40, 1, 10, x); SOL_F(48, 41, 1, 10, y); SOL_F(48, 42, 1, 10, z); SOL_F(48, 43, 1, 10, w);
        SOL_F(48, 44, 1, 11, x); SOL_F(48, 45, 1, 11, y); SOL_F(48, 46, 1, 11, z); SOL_F(48, 47, 1, 11, w);
        __builtin_amdgcn_sched_barrier(0);
        SOL_L(1, 0, 3380); SOL_L(1, 1, 3400); SOL_L(1, 2, 3404); SOL_L(1, 3, 3408); SOL_L(1, 4, 3412); SOL_L(1, 5, 3416); SOL_L(1, 6, 3420); SOL_L(1, 7, 3424); SOL_L(1, 8, 3428); SOL_L(1, 9, 3432); SOL_L(1, 10, 3436); SOL_L(1, 11, 3440);
        __builtin_amdgcn_sched_barrier(0);
        SOL_F(49, 0, 0, 0, x); SOL_F(49, 1, 0, 0, y); SOL_F(49, 2, 0, 0, z); SOL_F(49, 3, 0, 0, w);
        SOL_F(49, 4, 0, 1, x); SOL_F(49, 5, 0, 1, y); SOL_F(49, 6, 0, 1, z); SOL_F(49, 7, 0, 1, w);
        SOL_F(49, 8, 0, 2, x); SOL_F(49, 9, 0, 2, y); SOL_F(49, 10, 0, 2, z); SOL_F(49, 11, 0, 2, w);
        SOL_F(49, 12, 0, 3, x); SOL_F(49, 13, 0, 3, y); SOL_F(49, 14, 0, 3, z); SOL_F(49, 15, 0, 3, w);
        SOL_F(49, 16, 0, 4, x); SOL_F(49, 17, 0, 4, y); SOL_F(49, 18, 0, 4, z); SOL_F(49, 19, 0, 4, w);
        SOL_F(49, 20, 0, 5, x); SOL_F(49, 21, 0, 5, y); SOL_F(49, 22, 0, 5, z); SOL_F(49, 23, 0, 5, w);
        SOL_F(49, 24, 0, 6, x); SOL_F(49, 25, 0, 6, y); SOL_F(49, 26, 0, 6, z); SOL_F(49, 27, 0, 6, w);
        SOL_F(49, 28, 0, 7, x); SOL_F(49, 29, 0, 7, y); SOL_F(49, 30, 0, 7, z); SOL_F(49, 31, 0, 7, w);
        SOL_F(49, 32, 0, 8, x); SOL_F(49, 33, 0, 8, y); SOL_F(49, 34, 0, 8, z); SOL_F(49, 35, 0, 8, w);
        SOL_F(49, 36, 0, 9, x); SOL_F(49, 37, 0, 9, y); SOL_F(49, 38, 0, 9, z); SOL_F(49, 39, 0, 9, w);
        SOL_F(49, 40, 0, 10, x); SOL_F(49, 41, 0, 10, y); SOL_F(49, 42, 0, 10, z); SOL_F(49, 43, 0, 10, w);
        SOL_F(49, 44, 0, 11, x); SOL_F(49, 45, 0, 11, y); SOL_F(49, 46, 0, 11, z); SOL_F(49, 47, 0, 11, w);
        __builtin_amdgcn_sched_barrier(0);
        SOL_L(0, 0, 3444); SOL_L(0, 1, 3448); SOL_L(0, 2, 3468); SOL_L(0, 3, 3472); SOL_L(0, 4, 3476); SOL_L(0, 5, 3480); SOL_L(0, 6, 3484); SOL_L(0, 7, 3488); SOL_L(0, 8, 3492); SOL_L(0, 9, 3496); SOL_L(0, 10, 3500); SOL_L(0, 11, 3504);
        __builtin_amdgcn_sched_barrier(0);
        SOL_F(49, 48, 1, 0, x);
        SOL_F(50, 0, 1, 1, x); SOL_F(50, 1, 1, 1, y); SOL_F(50, 2, 1, 1, z); SOL_F(50, 3, 1, 1, w);
        SOL_F(50, 4, 1, 2, x); SOL_F(50, 5, 1, 2, y); SOL_F(50, 6, 1, 2, z); SOL_F(50, 7, 1, 2, w);
        SOL_F(50, 8, 1, 3, x); SOL_F(50, 9, 1, 3, y); SOL_F(50, 10, 1, 3, z); SOL_F(50, 11, 1, 3, w);
        SOL_F(50, 12, 1, 4, x); SOL_F(50, 13, 1, 4, y); SOL_F(50, 14, 1, 4, z); SOL_F(50, 15, 1, 4, w);
        SOL_F(50, 16, 1, 5, x); SOL_F(50, 17, 1, 5, y); SOL_F(50, 18, 1, 5, z); SOL_F(50, 19, 1, 5, w);
        SOL_F(50, 20, 1, 6, x); SOL_F(50, 21, 1, 6, y); SOL_F(50, 22, 1, 6, z); SOL_F(50, 23, 1, 6, w);
        SOL_F(50, 24, 1, 7, x); SOL_F(50, 25, 1, 7, y); SOL_F(50, 26, 1, 7, z); SOL_F(50, 27, 1, 7, w);
        SOL_F(50, 28, 1, 8, x); SOL_F(50, 29, 1, 8, y); SOL_F(50, 30, 1, 8, z); SOL_F(50, 31, 1, 8, w);
        SOL_F(50, 32, 1, 9, x); SOL_F(50, 33, 1, 9, y); SOL_F(50, 34, 1, 9, z); SOL_F(50, 35, 1, 9, w);
        SOL_F(50, 36, 1, 10, x); SOL_F(50, 37, 1, 10, y); SOL_F(50, 38, 1, 10, z); SOL_F(50, 39, 1, 10, w);
        SOL_F(50, 40, 1, 11, x); SOL_F(50, 41, 1, 11, y); SOL_F(50, 42, 1, 11, z); SOL_F(50, 43, 1, 11, w);
        __builtin_amdgcn_sched_barrier(0);
        SOL_L(1, 0, 3508); SOL_L(1, 1, 3512); SOL_L(1, 2, 3516); SOL_L(1, 3, 3536); SOL_L(1, 4, 3540); SOL_L(1, 5, 3544); SOL_L(1, 6, 3548); SOL_L(1, 7, 3552); SOL_L(1, 8, 3556); SOL_L(1, 9, 3560); SOL_L(1, 10, 3564); SOL_L(1, 11, 3568);
        __builtin_amdgcn_sched_barrier(0);
        SOL_F(50, 44, 0, 0, x); SOL_F(50, 45, 0, 0, y); SOL_F(50, 46, 0, 0, z); SOL_F(50, 47, 0, 0, w);
        SOL_F(50, 48, 0, 1, x); SOL_F(50, 49, 0, 1, y);
        SOL_F(51, 0, 0, 2, x); SOL_F(51, 1, 0, 2, y); SOL_F(51, 2, 0, 2, z); SOL_F(51, 3, 0, 2, w);
        SOL_F(51, 4, 0, 3, x); SOL_F(51, 5, 0, 3, y); SOL_F(51, 6, 0, 3, z); SOL_F(51, 7, 0, 3, w);
        SOL_F(51, 8, 0, 4, x); SOL_F(51, 9, 0, 4, y); SOL_F(51, 10, 0, 4, z); SOL_F(51, 11, 0, 4, w);
        SOL_F(51, 12, 0, 5, x); SOL_F(51, 13, 0, 5, y); SOL_F(51, 14, 0, 5, z); SOL_F(51, 15, 0, 5, w);
        SOL_F(51, 16, 0, 6, x); SOL_F(51, 17, 0, 6, y); SOL_F(51, 18, 0, 6, z); SOL_F(51, 19, 0, 6, w);
        SOL_F(51, 20, 0, 7, x); SOL_F(51, 21, 0, 7, y); SOL_F(51, 22, 0, 7, z); SOL_F(51, 23, 0, 7, w);
        SOL_F(51, 24, 0, 8, x); SOL_F(51, 25, 0, 8, y); SOL_F(51, 26, 0, 8, z); SOL_F(51, 27, 0, 8, w);
        SOL_F(51, 28, 0, 9, x); SOL_F(51, 29, 0, 9, y); SOL_F(51, 30, 0, 9, z); SOL_F(51, 31, 0, 9, w);
        SOL_F(51, 32, 0, 10, x); SOL_F(51, 33, 0, 10, y); SOL_F(51, 34, 0, 10, z); SOL_F(51, 35, 0, 10, w);
        SOL_F(51, 36, 0, 11, x); SOL_F(51, 37, 0, 11, y); SOL_F(51, 38, 0, 11, z); SOL_F(51, 39, 0, 11, w);
        __builtin_amdgcn_sched_barrier(0);
        SOL_L(0, 0, 3572); SOL_L(0, 1, 3576); SOL_L(0, 2, 3580); SOL_L(0, 3, 3584); SOL_L(0, 4, 3604); SOL_L(0, 5, 3608); SOL_L(0, 6, 3612); SOL_L(0, 7, 3616); SOL_L(0, 8, 3620); SOL_L(0, 9, 3624); SOL_L(0, 10, 3628); SOL_L(0, 11, 3632);
        __builtin_amdgcn_sched_barrier(0);
        SOL_F(51, 40, 1, 0, x); SOL_F(51, 41, 1, 0, y); SOL_F(51, 42, 1, 0, z); SOL_F(51, 43, 1, 0, w);
        SOL_F(51, 44, 1, 1, x); SOL_F(51, 45, 1, 1, y); SOL_F(51, 46, 1, 1, z); SOL_F(51, 47, 1, 1, w);
        SOL_F(51, 48, 1, 2, x); SOL_F(51, 49, 1, 2, y); SOL_F(51, 50, 1, 2, z);
        SOL_F(52, 0, 1, 3, x); SOL_F(52, 1, 1, 3, y); SOL_F(52, 2, 1, 3, z); SOL_F(52, 3, 1, 3, w);
        SOL_F(52, 4, 1, 4, x); SOL_F(52, 5, 1, 4, y); SOL_F(52, 6, 1, 4, z); SOL_F(52, 7, 1, 4, w);
        SOL_F(52, 8, 1, 5, x); SOL_F(52, 9, 1, 5, y); SOL_F(52, 10, 1, 5, z); SOL_F(52, 11, 1, 5, w);
        SOL_F(52, 12, 1, 6, x); SOL_F(52, 13, 1, 6, y); SOL_F(52, 14, 1, 6, z); SOL_F(52, 15, 1, 6, w);
        SOL_F(52, 16, 1, 7, x); SOL_F(52, 17, 1, 7, y); SOL_F(52, 18, 1, 7, z); SOL_F(52, 19, 1, 7, w);
        SOL_F(52, 20, 1, 8, x); SOL_F(52, 21, 1, 8, y); SOL_F(52, 22, 1, 8, z); SOL_F(52, 23, 1, 8, w);
        SOL_F(52, 24, 1, 9, x); SOL_F(52, 25, 1, 9, y); SOL_F(52, 26, 1, 9, z); SOL_F(52, 27, 1, 9, w);
        SOL_F(52, 28, 1, 10, x); SOL_F(52, 29, 1, 10, y); SOL_F(52, 30, 1, 10, z); SOL_F(52, 31, 1, 10, w);
        SOL_F(52, 32, 1, 11, x); SOL_F(52, 33, 1, 11, y); SOL_F(52, 34, 1, 11, z); SOL_F(52, 35, 1, 11, w);
        __builtin_amdgcn_sched_barrier(0);
        SOL_L(1, 0, 3636); SOL_L(1, 1, 3640); SOL_L(1, 2, 3644); SOL_L(1, 3, 3648); SOL_L(1, 4, 3652); SOL_L(1, 5, 3656); SOL_L(1, 6, 3672); SOL_L(1, 7, 3676); SOL_L(1, 8, 3680); SOL_L(1, 9, 3684); SOL_L(1, 10, 3688); SOL_L(1, 11, 3692);
        __builtin_amdgcn_sched_barrier(0);
        SOL_F(52, 36, 0, 0, x); SOL_F(52, 37, 0, 0, y); SOL_F(52, 38, 0, 0, z); SOL_F(52, 39, 0, 0, w);
        SOL_F(52, 40, 0, 1, x); SOL_F(52, 41, 0, 1, y); SOL_F(52, 42, 0, 1, z); SOL_F(52, 43, 0, 1, w);
        SOL_F(52, 44, 0, 2, x); SOL_F(52, 45, 0, 2, y); SOL_F(52, 46, 0, 2, z); SOL_F(52, 47, 0, 2, w);
        SOL_F(52, 48, 0, 3, x); SOL_F(52, 49, 0, 3, y); SOL_F(52, 50, 0, 3, z); SOL_F(52, 51, 0, 3, w);
        SOL_F(53, 0, 0, 4, x); SOL_F(53, 1, 0, 4, y); SOL_F(53, 2, 0, 4, z); SOL_F(53, 3, 0, 4, w);
        SOL_F(53, 4, 0, 5, x); SOL_F(53, 5, 0, 5, y); SOL_F(53, 6, 0, 5, z); SOL_F(53, 7, 0, 5, w);
        SOL_F(53, 8, 0, 6, x); SOL_F(53, 9, 0, 6, y); SOL_F(53, 10, 0, 6, z); SOL_F(53, 11, 0, 6, w);
        SOL_F(53, 12, 0, 7, x); SOL_F(53, 13, 0, 7, y); SOL_F(53, 14, 0, 7, z); SOL_F(53, 15, 0, 7, w);
        SOL_F(53, 16, 0, 8, x); SOL_F(53, 17, 0, 8, y); SOL_F(53, 18, 0, 8, z); SOL_F(53, 19, 0, 8, w);
        SOL_F(53, 20, 0, 9, x); SOL_F(53, 21, 0, 9, y); SOL_F(53, 22, 0, 9, z); SOL_F(53, 23, 0, 9, w);
        SOL_F(53, 24, 0, 10, x); SOL_F(53, 25, 0, 10, y); SOL_F(53, 26, 0, 10, z); SOL_F(53, 27, 0, 10, w);
        SOL_F(53, 28, 0, 11, x); SOL_F(53, 29, 0, 11, y); SOL_F(53, 30, 0, 11, z); SOL_F(53, 31, 0, 11, w);
        __builtin_amdgcn_sched_barrier(0);
        SOL_L(0, 0, 3696); SOL_L(0, 1, 3700); SOL_L(0, 2, 3704); SOL_L(0, 3, 3708); SOL_L(0, 4, 3712); SOL_L(0, 5, 3716); SOL_L(0, 6, 3720); SOL_L(0, 7, 3724); SOL_L(0, 8, 3740); SOL_L(0, 9, 3744); SOL_L(0, 10, 3748); SOL_L(0, 11, 3752);
        __builtin_amdgcn_sched_barrier(0);
        SOL_F(53, 32, 1, 0, x); SOL_F(53, 33, 1, 0, y); SOL_F(53, 34, 1, 0, z); SOL_F(53, 35, 1, 0, w);
        SOL_F(53, 36, 1, 1, x); SOL_F(53, 37, 1, 1, y); SOL_F(53, 38, 1, 1, z); SOL_F(53, 39, 1, 1, w);
        SOL_F(53, 40, 1, 2, x); SOL_F(53, 41, 1, 2, y); SOL_F(53, 42, 1, 2, z); SOL_F(53, 43, 1, 2, w);
        SOL_F(53, 44, 1, 3, x); SOL_F(53, 45, 1, 3, y); SOL_F(53, 46, 1, 3, z); SOL_F(53, 47, 1, 3, w);
        SOL_F(53, 48, 1, 4, x); SOL_F(53, 49, 1, 4, y); SOL_F(53, 50, 1, 4, z); SOL_F(53, 51, 1, 4, w);
        SOL_F(53, 52, 1, 5, x);
        SOL_F(54, 0, 1, 6, x); SOL_F(54, 1, 1, 6, y); SOL_F(54, 2, 1, 6, z); SOL_F(54, 3, 1, 6, w);
        SOL_F(54, 4, 1, 7, x); SOL_F(54, 5, 1, 7, y); SOL_F(54, 6, 1, 7, z); SOL_F(54, 7, 1, 7, w);
        SOL_F(54, 8, 1, 8, x); SOL_F(54, 9, 1, 8, y); SOL_F(54, 10, 1, 8, z); SOL_F(54, 11, 1, 8, w);
        SOL_F(54, 12, 1, 9, x); SOL_F(54, 13, 1, 9, y); SOL_F(54, 14, 1, 9, z); SOL_F(54, 15, 1, 9, w);
        SOL_F(54, 16, 1, 10, x); SOL_F(54, 17, 1, 10, y); SOL_F(54, 18, 1, 10, z); SOL_F(54, 19, 1, 10, w);
        SOL_F(54, 20, 1, 11, x); SOL_F(54, 21, 1, 11, y); SOL_F(54, 22, 1, 11, z); SOL_F(54, 23, 1, 11, w);
        __builtin_amdgcn_sched_barrier(0);
        SOL_L(1, 0, 3756); SOL_L(1, 1, 3760); SOL_L(1, 2, 3764); SOL_L(1, 3, 3768); SOL_L(1, 4, 3772); SOL_L(1, 5, 3776); SOL_L(1, 6, 3780); SOL_L(1, 7, 3784); SOL_L(1, 8, 3788); SOL_L(1, 9, 3792); SOL_L(1, 10, 3808); SOL_L(1, 11, 3812);
        __builtin_amdgcn_sched_barrier(0);
        SOL_F(54, 24, 0, 0, x); SOL_F(54, 25, 0, 0, y); SOL_F(54, 26, 0, 0, z); SOL_F(54, 27, 0, 0, w);
        SOL_F(54, 28, 0, 1, x); SOL_F(54, 29, 0, 1, y); SOL_F(54, 30, 0, 1, z); SOL_F(54, 31, 0, 1, w);
        SOL_F(54, 32, 0, 2, x); SOL_F(54, 33, 0, 2, y); SOL_F(54, 34, 0, 2, z); SOL_F(54, 35, 0, 2, w);
        SOL_F(54, 36, 0, 3, x); SOL_F(54, 37, 0, 3, y); SOL_F(54, 38, 0, 3, z); SOL_F(54, 39, 0, 3, w);
        SOL_F(54, 40, 0, 4, x); SOL_F(54, 41, 0, 4, y); SOL_F(54, 42, 0, 4, z); SOL_F(54, 43, 0, 4, w);
        SOL_F(54, 44, 0, 5, x); SOL_F(54, 45, 0, 5, y); SOL_F(54, 46, 0, 5, z); SOL_F(54, 47, 0, 5, w);
        SOL_F(54, 48, 0, 6, x); SOL_F(54, 49, 0, 6, y); SOL_F(54, 50, 0, 6, z); SOL_F(54, 51, 0, 6, w);
        SOL_F(54, 52, 0, 7, x); SOL_F(54, 53, 0, 7, y);
        SOL_F(55, 0, 0, 8, x); SOL_F(55, 1, 0, 8, y); SOL_F(55, 2, 0, 8, z); SOL_F(55, 3, 0, 8, w);
        SOL_F(55, 4, 0, 9, x); SOL_F(55, 5, 0, 9, y); SOL_F(55, 6, 0, 9, z); SOL_F(55, 7, 0, 9, w);
        SOL_F(55, 8, 0, 10, x); SOL_F(55, 9, 0, 10, y); SOL_F(55, 10, 0, 10, z); SOL_F(55, 11, 0, 10, w);
        SOL_F(55, 12, 0, 11, x); SOL_F(55, 13, 0, 11, y); SOL_F(55, 14, 0, 11, z); SOL_F(55, 15, 0, 11, w);
        __builtin_amdgcn_sched_barrier(0);
        SOL_L(0, 0, 3816); SOL_L(0, 1, 3820); SOL_L(0, 2, 3824); SOL_L(0, 3, 3828); SOL_L(0, 4, 3832); SOL_L(0, 5, 3836); SOL_L(0, 6, 3840); SOL_L(0, 7, 3844); SOL_L(0, 8, 3848); SOL_L(0, 9, 3852); SOL_L(0, 10, 3856); SOL_L(0, 11, 3860);
        __builtin_amdgcn_sched_barrier(0);
        SOL_F(55, 16, 1, 0, x); SOL_F(55, 17, 1, 0, y); SOL_F(55, 18, 1, 0, z); SOL_F(55, 19, 1, 0, w);
        SOL_F(55, 20, 1, 1, x); SOL_F(55, 21, 1, 1, y); SOL_F(55, 22, 1, 1, z); SOL_F(55, 23, 1, 1, w);
        SOL_F(55, 24, 1, 2, x); SOL_F(55, 25, 1, 2, y); SOL_F(55, 26, 1, 2, z); SOL_F(55, 27, 1, 2, w);
        SOL_F(55, 28, 1, 3, x); SOL_F(55, 29, 1, 3, y); SOL_F(55, 30, 1, 3, z); SOL_F(55, 31, 1, 3, w);
        SOL_F(55, 32, 1, 4, x); SOL_F(55, 33, 1, 4, y); SOL_F(55, 34, 1, 4, z); SOL_F(55, 35, 1, 4, w);
        SOL_F(55, 36, 1, 5, x); SOL_F(55, 37, 1, 5, y); SOL_F(55, 38, 1, 5, z); SOL_F(55, 39, 1, 5, w);
        SOL_F(55, 40, 1, 6, x); SOL_F(55, 41, 1, 6, y); SOL_F(55, 42, 1, 6, z); SOL_F(55, 43, 1, 6, w);
        SOL_F(55, 44, 1, 7, x); SOL_F(55, 45, 1, 7, y); SOL_F(55, 46, 1, 7, z); SOL_F(55, 47, 1, 7, w);
        SOL_F(55, 48, 1, 8, x); SOL_F(55, 49, 1, 8, y); SOL_F(55, 50, 1, 8, z); SOL_F(55, 51, 1, 8, w);
        SOL_F(55, 52, 1, 9, x); SOL_F(55, 53, 1, 9, y); SOL_F(55, 54, 1, 9, z);
        SOL_F(56, 0, 1, 10, x); SOL_F(56, 1, 1, 10, y); SOL_F(56, 2, 1, 10, z); SOL_F(56, 3, 1, 10, w);
        SOL_F(56, 4, 1, 11, x); SOL_F(56, 5, 1, 11, y); SOL_F(56, 6, 1, 11, z); SOL_F(56, 7, 1, 11, w);
        __builtin_amdgcn_sched_barrier(0);
        SOL_L(1, 0, 3876); SOL_L(1, 1, 3880); SOL_L(1, 2, 3884); SOL_L(1, 3, 3888); SOL_L(1, 4, 3892); SOL_L(1, 5, 3896); SOL_L(1, 6, 3900); SOL_L(1, 7, 3904); SOL_L(1, 8, 3908); SOL_L(1, 9, 3912); SOL_L(1, 10, 3916); SOL_L(1, 11, 3920);
        __builtin_amdgcn_sched_barrier(0);
        SOL_F(56, 8, 0, 0, x); SOL_F(56, 9, 0, 0, y); SOL_F(56, 10, 0, 0, z); SOL_F(56, 11, 0, 0, w);
        SOL_F(56, 12, 0, 1, x); SOL_F(56, 13, 0, 1, y); SOL_F(56, 14, 0, 1, z); SOL_F(56, 15, 0, 1, w);
        SOL_F(56, 16, 0, 2, x); SOL_F(56, 17, 0, 2, y); SOL_F(56, 18, 0, 2, z); SOL_F(56, 19, 0, 2, w);
        SOL_F(56, 20, 0, 3, x); SOL_F(56, 21, 0, 3, y); SOL_F(56, 22, 0, 3, z); SOL_F(56, 23, 0, 3, w);
        SOL_F(56, 24, 0, 4, x); SOL_F(56, 25, 0, 4, y); SOL_F(56, 26, 0, 4, z); SOL_F(56, 27, 0, 4, w);
        SOL_F(56, 28, 0, 5, x); SOL_F(56, 29, 0, 5, y); SOL_F(56, 30, 0, 5, z); SOL_F(56, 31, 0, 5, w);
        SOL_F(56, 32, 0, 6, x); SOL_F(56, 33, 0, 6, y); SOL_F(56, 34, 0, 6, z); SOL_F(56, 35, 0, 6, w);
        SOL_F(56, 36, 0, 7, x); SOL_F(56, 37, 0, 7, y); SOL_F(56, 38, 0, 7, z); SOL_F(56, 39, 0, 7, w);
        SOL_F(56, 40, 0, 8, x); SOL_F(56, 41, 0, 8, y); SOL_F(56, 42, 0, 8, z); SOL_F(56, 43, 0, 8, w);
        SOL_F(56, 44, 0, 9, x); SOL_F(56, 45, 0, 9, y); SOL_F(56, 46, 0, 9, z); SOL_F(56, 47, 0, 9, w);
        SOL_F(56, 48, 0, 10, x); SOL_F(56, 49, 0, 10, y); SOL_F(56, 50, 0, 10, z); SOL_F(56, 51, 0, 10, w);
        SOL_F(56, 52, 0, 11, x); SOL_F(56, 53, 0, 11, y); SOL_F(56, 54, 0, 11, z); SOL_F(56, 55, 0, 11, w);
        __builtin_amdgcn_sched_barrier(0);
        SOL_L(0, 0, 3924); SOL_L(0, 1, 3928); SOL_L(0, 2, 3932); SOL_L(0, 3, 3944); SOL_L(0, 4, 3948); SOL_L(0, 5, 3952); SOL_L(0, 6, 3956); SOL_L(0, 7, 3960); SOL_L(0, 8, 3964); SOL_L(0, 9, 3968); SOL_L(0, 10, 3972); SOL_L(0, 11, 3976);
        __builtin_amdgcn_sched_barrier(0);
        SOL_F(57, 0, 1, 0, x); SOL_F(57, 1, 1, 0, y); SOL_F(57, 2, 1, 0, z); SOL_F(57, 3, 1, 0, w);
        SOL_F(57, 4, 1, 1, x); SOL_F(57, 5, 1, 1, y); SOL_F(57, 6, 1, 1, z); SOL_F(57, 7, 1, 1, w);
        SOL_F(57, 8, 1, 2, x); SOL_F(57, 9, 1, 2, y); SOL_F(57, 10, 1, 2, z); SOL_F(57, 11, 1, 2, w);
        SOL_F(57, 12, 1, 3, x); SOL_F(57, 13, 1, 3, y); SOL_F(57, 14, 1, 3, z); SOL_F(57, 15, 1, 3, w);
        SOL_F(57, 16, 1, 4, x); SOL_F(57, 17, 1, 4, y); SOL_F(57, 18, 1, 4, z); SOL_F(57, 19, 1, 4, w);
        SOL_F(57, 20, 1, 5, x); SOL_F(57, 21, 1, 5, y); SOL_F(57, 22, 1, 5, z); SOL_F(57, 23, 1, 5, w);
        SOL_F(57, 24, 1, 6, x); SOL_F(57, 25, 1, 6, y); SOL_F(57, 26, 1, 6, z); SOL_F(57, 27, 1, 6, w);
        SOL_F(57, 28, 1, 7, x); SOL_F(57, 29, 1, 7, y); SOL_F(57, 30, 1, 7, z); SOL_F(57, 31, 1, 7, w);
        SOL_F(57, 32, 1, 8, x); SOL_F(57, 33, 1, 8, y); SOL_F(57, 34, 1, 8, z); SOL_F(57, 35, 1, 8, w);
        SOL_F(57, 36, 1, 9, x); SOL_F(57, 37, 1, 9, y); SOL_F(57, 38, 1, 9, z); SOL_F(57, 39, 1, 9, w);
        SOL_F(57, 40, 1, 10, x); SOL_F(57, 41, 1, 10, y); SOL_F(57, 42, 1, 10, z); SOL_F(57, 43, 1, 10, w);
        SOL_F(57, 44, 1, 11, x); SOL_F(57, 45, 1, 11, y); SOL_F(57, 46, 1, 11, z); SOL_F(57, 47, 1, 11, w);
        __builtin_amdgcn_sched_barrier(0);
        SOL_L(1, 0, 3980); SOL_L(1, 1, 3984); SOL_L(1, 2, 3988); SOL_L(1, 3, 3992); SOL_L(1, 4, 3996); SOL_L(1, 5, 4000); SOL_L(1, 6, 4012); SOL_L(1, 7, 4016); SOL_L(1, 8, 4020); SOL_L(1, 9, 4024); SOL_L(1, 10, 4028); SOL_L(1, 11, 4032);
        __builtin_amdgcn_sched_barrier(0);
        SOL_F(57, 48, 0, 0, x); SOL_F(57, 49, 0, 0, y); SOL_F(57, 50, 0, 0, z); SOL_F(57, 51, 0, 0, w);
        SOL_F(57, 52, 0, 1, x); SOL_F(57, 53, 0, 1, y); SOL_F(57, 54, 0, 1, z); SOL_F(57, 55, 0, 1, w);
        SOL_F(57, 56, 0, 2, x);
        SOL_F(58, 0, 0, 3, x); SOL_F(58, 1, 0, 3, y); SOL_F(58, 2, 0, 3, z); SOL_F(58, 3, 0, 3, w);
        SOL_F(58, 4, 0, 4, x); SOL_F(58, 5, 0, 4, y); SOL_F(58, 6, 0, 4, z); SOL_F(58, 7, 0, 4, w);
        SOL_F(58, 8, 0, 5, x); SOL_F(58, 9, 0, 5, y); SOL_F(58, 10, 0, 5, z); SOL_F(58, 11, 0, 5, w);
        SOL_F(58, 12, 0, 6, x); SOL_F(58, 13, 0, 6, y); SOL_F(58, 14, 0, 6, z); SOL_F(58, 15, 0, 6, w);
        SOL_F(58, 16, 0, 7, x); SOL_F(58, 17, 0, 7, y); SOL_F(58, 18, 0, 7, z); SOL_F(58, 19, 0, 7, w);
        SOL_F(58, 20, 0, 8, x); SOL_F(58, 21, 0, 8, y); SOL_F(58, 22, 0, 8, z); SOL_F(58, 23, 0, 8, w);
        SOL_F(58, 24, 0, 9, x); SOL_F(58, 25, 0, 9, y); SOL_F(58, 26, 0, 9, z); SOL_F(58, 27, 0, 9, w);
        SOL_F(58, 28, 0, 10, x); SOL_F(58, 29, 0, 10, y); SOL_F(58, 30, 0, 10, z); SOL_F(58, 31, 0, 10, w);
        SOL_F(58, 32, 0, 11, x); SOL_F(58, 33, 0, 11, y); SOL_F(58, 34, 0, 11, z); SOL_F(58, 35, 0, 11, w);
        __builtin_amdgcn_sched_barrier(0);
        SOL_L(0, 0, 4036); SOL_L(0, 1, 4040); SOL_L(0, 2, 4044); SOL_L(0, 3, 4048); SOL_L(0, 4, 4052); SOL_L(0, 5, 4056); SOL_L(0, 6, 4060); SOL_L(0, 7, 4064); SOL_L(0, 8, 4068); SOL_L(0, 9, 4080); SOL_L(0, 10, 4084); SOL_L(0, 11, 4088);
        __builtin_amdgcn_sched_barrier(0);
        SOL_F(58, 36, 1, 0, x); SOL_F(58, 37, 1, 0, y); SOL_F(58, 38, 1, 0, z); SOL_F(58, 39, 1, 0, w);
        SOL_F(58, 40, 1, 1, x); SOL_F(58, 41, 1, 1, y); SOL_F(58, 42, 1, 1, z); SOL_F(58, 43, 1, 1, w);
        SOL_F(58, 44, 1, 2, x); SOL_F(58, 45, 1, 2, y); SOL_F(58, 46, 1, 2, z); SOL_F(58, 47, 1, 2, w);
        SOL_F(58, 48, 1, 3, x); SOL_F(58, 49, 1, 3, y); SOL_F(58, 50, 1, 3, z); SOL_F(58, 51, 1, 3, w);
        SOL_F(58, 52, 1, 4, x); SOL_F(58, 53, 1, 4, y); SOL_F(58, 54, 1, 4, z); SOL_F(58, 55, 1, 4, w);
        SOL_F(58, 56, 1, 5, x); SOL_F(58, 57, 1, 5, y);
        SOL_F(59, 0, 1, 6, x); SOL_F(59, 1, 1, 6, y); SOL_F(59, 2, 1, 6, z); SOL_F(59, 3, 1, 6, w);
        SOL_F(59, 4, 1, 7, x); SOL_F(59, 5, 1, 7, y); SOL_F(59, 6, 1, 7, z); SOL_F(59, 7, 1, 7, w);
        SOL_F(59, 8, 1, 8, x); SOL_F(59, 9, 1, 8, y); SOL_F(59, 10, 1, 8, z); SOL_F(59, 11, 1, 8, w);
        SOL_F(59, 12, 1, 9, x); SOL_F(59, 13, 1, 9, y); SOL_F(59, 14, 1, 9, z); SOL_F(59, 15, 1, 9, w);
        SOL_F(59, 16, 1, 10, x); SOL_F(59, 17, 1, 10, y); SOL_F(59, 18, 1, 10, z); SOL_F(59, 19, 1, 10, w);
        SOL_F(59, 20, 1, 11, x); SOL_F(59, 21, 1, 11, y); SOL_F(59, 22, 1, 11, z); SOL_F(59, 23, 1, 11, w);
        __builtin_amdgcn_sched_barrier(0);
        SOL_L(1, 0, 4092); SOL_L(1, 1, 4096); SOL_L(1, 2, 4100); SOL_L(1, 3, 4104); SOL_L(1, 4, 4108); SOL_L(1, 5, 4112); SOL_L(1, 6, 4116); SOL_L(1, 7, 4120); SOL_L(1, 8, 4124); SOL_L(1, 9, 4128); SOL_L(1, 10, 4132); SOL_L(1, 11, 4136);
        __builtin_amdgcn_sched_barrier(0);
        SOL_F(59, 24, 0, 0, x); SOL_F(59, 25, 0, 0, y); SOL_F(59, 26, 0, 0, z); SOL_F(59, 27, 0, 0, w);
        SOL_F(59, 28, 0, 1, x); SOL_F(59, 29, 0, 1, y); SOL_F(59, 30, 0, 1, z); SOL_F(59, 31, 0, 1, w);
        SOL_F(59, 32, 0, 2, x); SOL_F(59, 33, 0, 2, y); SOL_F(59, 34, 0, 2, z); SOL_F(59, 35, 0, 2, w);
        SOL_F(59, 36, 0, 3, x); SOL_F(59, 37, 0, 3, y); SOL_F(59, 38, 0, 3, z); SOL_F(59, 39, 0, 3, w);
        SOL_F(59, 40, 0, 4, x); SOL_F(59, 41, 0, 4, y); SOL_F(59, 42, 0, 4, z); SOL_F(59, 43, 0, 4, w);
        SOL_F(59, 44, 0, 5, x); SOL_F(59, 45, 0, 5, y); SOL_F(59, 46, 0, 5, z); SOL_F(59, 47, 0, 5, w);
        SOL_F(59, 48, 0, 6, x); SOL_F(59, 49, 0, 6, y); SOL_F(59, 50, 0, 6, z); SOL_F(59, 51, 0, 6, w);
        SOL_F(59, 52, 0, 7, x); SOL_F(59, 53, 0, 7, y); SOL_F(59, 54, 0, 7, z); SOL_F(59, 55, 0, 7, w);
        SOL_F(59, 56, 0, 8, x); SOL_F(59, 57, 0, 8, y); SOL_F(59, 58, 0, 8, z);
        SOL_F(60, 0, 0, 9, x); SOL_F(60, 1, 0, 9, y); SOL_F(60, 2, 0, 9, z); SOL_F(60, 3, 0, 9, w);
        SOL_F(60, 4, 0, 10, x); SOL_F(60, 5, 0, 10, y); SOL_F(60, 6, 0, 10, z); SOL_F(60, 7, 0, 10, w);
        SOL_F(60, 8, 0, 11, x); SOL_F(60, 9, 0, 11, y); SOL_F(60, 10, 0, 11, z); SOL_F(60, 11, 0, 11, w);
        __builtin_amdgcn_sched_barrier(0);
        SOL_L(0, 0, 4148); SOL_L(0, 1, 4152); SOL_L(0, 2, 4156); SOL_L(0, 3, 4160); SOL_L(0, 4, 4164); SOL_L(0, 5, 4168); SOL_L(0, 6, 4172); SOL_L(0, 7, 4176); SOL_L(0, 8, 4180); SOL_L(0, 9, 4184); SOL_L(0, 10, 4188); SOL_L(0, 11, 4192);
        __builtin_amdgcn_sched_barrier(0);
        SOL_F(60, 12, 1, 0, x); SOL_F(60, 13, 1, 0, y); SOL_F(60, 14, 1, 0, z); SOL_F(60, 15, 1, 0, w);
        SOL_F(60, 16, 1, 1, x); SOL_F(60, 17, 1, 1, y); SOL_F(60, 18, 1, 1, z); SOL_F(60, 19, 1, 1, w);
        SOL_F(60, 20, 1, 2, x); SOL_F(60, 21, 1, 2, y); SOL_F(60, 22, 1, 2, z); SOL_F(60, 23, 1, 2, w);
        SOL_F(60, 24, 1, 3, x); SOL_F(60, 25, 1, 3, y); SOL_F(60, 26, 1, 3, z); SOL_F(60, 27, 1, 3, w);
        SOL_F(60, 28, 1, 4, x); SOL_F(60, 29, 1, 4, y); SOL_F(60, 30, 1, 4, z); SOL_F(60, 31, 1, 4, w);
        SOL_F(60, 32, 1, 5, x); SOL_F(60, 33, 1, 5, y); SOL_F(60, 34, 1, 5, z); SOL_F(60, 35, 1, 5, w);
        SOL_F(60, 36, 1, 6, x); SOL_F(60, 37, 1, 6, y); SOL_F(60, 38, 1, 6, z); SOL_F(60, 39, 1, 6, w);
        SOL_F(60, 40, 1, 7, x); SOL_F(60, 41, 1, 7, y); SOL_F(60, 42, 1, 7, z); SOL_F(60, 43, 1, 7, w);
        SOL_F(60, 44, 1, 8, x); SOL_F(60, 45, 1, 8, y); SOL_F(60, 46, 1, 8, z); SOL_F(60, 47, 1, 8, w);
        SOL_F(60, 48, 1, 9, x); SOL_F(60, 49, 1, 9, y); SOL_F(60, 50, 1, 9, z); SOL_F(60, 51, 1, 9, w);
        SOL_F(60, 52, 1, 10, x); SOL_F(60, 53, 1, 10, y); SOL_F(60, 54, 1, 10, z); SOL_F(60, 55, 1, 10, w);
        SOL_F(60, 56, 1, 11, x); SOL_F(60, 57, 1, 11, y); SOL_F(60, 58, 1, 11, z); SOL_F(60, 59, 1, 11, w);
        __builtin_amdgcn_sched_barrier(0);
        SOL_L(1, 0, 4196); SOL_L(1, 1, 4200); SOL_L(1, 2, 4204); SOL_L(1, 3, 4208); SOL_L(1, 4, 4216); SOL_L(1, 5, 4220); SOL_L(1, 6, 4224); SOL_L(1, 7, 4228); SOL_L(1, 8, 4232); SOL_L(1, 9, 4236); SOL_L(1, 10, 4240); SOL_L(1, 11, 4244);
        __builtin_amdgcn_sched_barrier(0);
        SOL_F(61, 0, 0, 0, x); SOL_F(61, 1, 0, 0, y); SOL_F(61, 2, 0, 0, z); SOL_F(61, 3, 0, 0, w);
        SOL_F(61, 4, 0, 1, x); SOL_F(61, 5, 0, 1, y); SOL_F(61, 6, 0, 1, z); SOL_F(61, 7, 0, 1, w);
        SOL_F(61, 8, 0, 2, x); SOL_F(61, 9, 0, 2, y); SOL_F(61, 10, 0, 2, z); SOL_F(61, 11, 0, 2, w);
        SOL_F(61, 12, 0, 3, x); SOL_F(61, 13, 0, 3, y); SOL_F(61, 14, 0, 3, z); SOL_F(61, 15, 0, 3, w);
        SOL_F(61, 16, 0, 4, x); SOL_F(61, 17, 0, 4, y); SOL_F(61, 18, 0, 4, z); SOL_F(61, 19, 0, 4, w);
        SOL_F(61, 20, 0, 5, x); SOL_F(61, 21, 0, 5, y); SOL_F(61, 22, 0, 5, z); SOL_F(61, 23, 0, 5, w);
        SOL_F(61, 24, 0, 6, x); SOL_F(61, 25, 0, 6, y); SOL_F(61, 26, 0, 6, z); SOL_F(61, 27, 0, 6, w);
        SOL_F(61, 28, 0, 7, x); SOL_F(61, 29, 0, 7, y); SOL_F(61, 30, 0, 7, z); SOL_F(61, 31, 0, 7, w);
        SOL_F(61, 32, 0, 8, x); SOL_F(61, 33, 0, 8, y); SOL_F(61, 34, 0, 8, z); SOL_F(61, 35, 0, 8, w);
        SOL_F(61, 36, 0, 9, x); SOL_F(61, 37, 0, 9, y); SOL_F(61, 38, 0, 9, z); SOL_F(61, 39, 0, 9, w);
        SOL_F(61, 40, 0, 10, x); SOL_F(61, 41, 0, 10, y); SOL_F(61, 42, 0, 10, z); SOL_F(61, 43, 0, 10, w);
        SOL_F(61, 44, 0, 11, x); SOL_F(61, 45, 0, 11, y); SOL_F(61, 46, 0, 11, z); SOL_F(61, 47, 0, 11, w);
        __builtin_amdgcn_sched_barrier(0);
        SOL_L(0, 0, 4248); SOL_L(0, 1, 4252); SOL_L(0, 2, 4256); SOL_L(0, 3, 4260); SOL_L(0, 4, 4264); SOL_L(0, 5, 4268); SOL_L(0, 6, 4272); SOL_L(0, 7, 4276); SOL_L(0, 8, 4284); SOL_L(0, 9, 4288); SOL_L(0, 10, 4292); SOL_L(0, 11, 4296);
        __builtin_amdgcn_sched_barrier(0);
        SOL_F(61, 48, 1, 0, x); SOL_F(61, 49, 1, 0, y); SOL_F(61, 50, 1, 0, z); SOL_F(61, 51, 1, 0, w);
        SOL_F(61, 52, 1, 1, x); SOL_F(61, 53, 1, 1, y); SOL_F(61, 54, 1, 1, z); SOL_F(61, 55, 1, 1, w);
        SOL_F(61, 56, 1, 2, x); SOL_F(61, 57, 1, 2, y); SOL_F(61, 58, 1, 2, z); SOL_F(61, 59, 1, 2, w);
        SOL_F(61, 60, 1, 3, x);
        SOL_F(62, 0, 1, 4, x); SOL_F(62, 1, 1, 4, y); SOL_F(62, 2, 1, 4, z); SOL_F(62, 3, 1, 4, w);
        SOL_F(62, 4, 1, 5, x); SOL_F(62, 5, 1, 5, y); SOL_F(62, 6, 1, 5, z); SOL_F(62, 7, 1, 5, w);
        SOL_F(62, 8, 1, 6, x); SOL_F(62, 9, 1, 6, y); SOL_F(62, 10, 1, 6, z); SOL_F(62, 11, 1, 6, w);
        SOL_F(62, 12, 1, 7, x); SOL_F(62, 13, 1, 7, y); SOL_F(62, 14, 1, 7, z); SOL_F(62, 15, 1, 7, w);
        SOL_F(62, 16, 1, 8, x); SOL_F(62, 17, 1, 8, y); SOL_F(62, 18, 1, 8, z); SOL_F(62, 19, 1, 8, w);
        SOL_F(62, 20, 1, 9, x); SOL_F(62, 21, 1, 9, y); SOL_F(62, 22, 1, 9, z); SOL_F(62, 23, 1, 9, w);
        SOL_F(62, 24, 1, 10, x); SOL_F(62, 25, 1, 10, y); SOL_F(62, 26, 1, 10, z); SOL_F(62, 27, 1, 10, w);
        SOL_F(62, 28, 1, 11, x); SOL_F(62, 29, 1, 11, y); SOL_F(62, 30, 1, 11, z); SOL_F(62, 31, 1, 11, w);
        __builtin_amdgcn_sched_barrier(0);
        SOL_L(1, 0, 4300); SOL_L(1, 1, 4304); SOL_L(1, 2, 4308); SOL_L(1, 3, 4312); SOL_L(1, 4, 4316); SOL_L(1, 5, 4320); SOL_L(1, 6, 4324); SOL_L(1, 7, 4328); SOL_L(1, 8, 4332); SOL_L(1, 9, 4336); SOL_L(1, 10, 4340); SOL_L(1, 11, 4344);
        __builtin_amdgcn_sched_barrier(0);
        SOL_F(62, 32, 0, 0, x); SOL_F(62, 33, 0, 0, y); SOL_F(62, 34, 0, 0, z); SOL_F(62, 35, 0, 0, w);
        SOL_F(62, 36, 0, 1, x); SOL_F(62, 37, 0, 1, y); SOL_F(62, 38, 0, 1, z); SOL_F(62, 39, 0, 1, w);
        SOL_F(62, 40, 0, 2, x); SOL_F(62, 41, 0, 2, y); SOL_F(62, 42, 0, 2, z); SOL_F(62, 43, 0, 2, w);
        SOL_F(62, 44, 0, 3, x); SOL_F(62, 45, 0, 3, y); SOL_F(62, 46, 0, 3, z); SOL_F(62, 47, 0, 3, w);
        SOL_F(62, 48, 0, 4, x); SOL_F(62, 49, 0, 4, y); SOL_F(62, 50, 0, 4, z); SOL_F(62, 51, 0, 4, w);
        SOL_F(62, 52, 0, 5, x); SOL_F(62, 53, 0, 5, y); SOL_F(62, 54, 0, 5, z); SOL_F(62, 55, 0, 5, w);
        SOL_F(62, 56, 0, 6, x); SOL_F(62, 57, 0, 6, y); SOL_F(62, 58, 0, 6, z); SOL_F(62, 59, 0, 6, w);
        SOL_F(62, 60, 0, 7, x); SOL_F(62, 61, 0, 7, y);
        SOL_F(63, 0, 0, 8, x); SOL_F(63, 1, 0, 8, y); SOL_F(63, 2, 0, 8, z); SOL_F(63, 3, 0, 8, w);
        SOL_F(63, 4, 0, 9, x); SOL_F(63, 5, 0, 9, y); SOL_F(63, 6, 0, 9, z); SOL_F(63, 7, 0, 9, w);
        SOL_F(63, 8, 0, 10, x); SOL_F(63, 9, 0, 10, y); SOL_F(63, 10, 0, 10, z); SOL_F(63, 11, 0, 10, w);
        SOL_F(63, 12, 0, 11, x); SOL_F(63, 13, 0, 11, y); SOL_F(63, 14, 0, 11, z); SOL_F(63, 15, 0, 11, w);
        __builtin_amdgcn_sched_barrier(0);
        __builtin_amdgcn_sched_barrier(0);
        SOL_F(63, 16, 1, 0, x); SOL_F(63, 17, 1, 0, y); SOL_F(63, 18, 1, 0, z); SOL_F(63, 19, 1, 0, w);
        SOL_F(63, 20, 1, 1, x); SOL_F(63, 21, 1, 1, y); SOL_F(63, 22, 1, 1, z); SOL_F(63, 23, 1, 1, w);
        SOL_F(63, 24, 1, 2, x); SOL_F(63, 25, 1, 2, y); SOL_F(63, 26, 1, 2, z); SOL_F(63, 27, 1, 2, w);
        SOL_F(63, 28, 1, 3, x); SOL_F(63, 29, 1, 3, y); SOL_F(63, 30, 1, 3, z); SOL_F(63, 31, 1, 3, w);
        SOL_F(63, 32, 1, 4, x); SOL_F(63, 33, 1, 4, y); SOL_F(63, 34, 1, 4, z); SOL_F(63, 35, 1, 4, w);
        SOL_F(63, 36, 1, 5, x); SOL_F(63, 37, 1, 5, y); SOL_F(63, 38, 1, 5, z); SOL_F(63, 39, 1, 5, w);
        SOL_F(63, 40, 1, 6, x); SOL_F(63, 41, 1, 6, y); SOL_F(63, 42, 1, 6, z); SOL_F(63, 43, 1, 6, w);
        SOL_F(63, 44, 1, 7, x); SOL_F(63, 45, 1, 7, y); SOL_F(63, 46, 1, 7, z); SOL_F(63, 47, 1, 7, w);
        SOL_F(63, 48, 1, 8, x); SOL_F(63, 49, 1, 8, y); SOL_F(63, 50, 1, 8, z); SOL_F(63, 51, 1, 8, w);
        SOL_F(63, 52, 1, 9, x); SOL_F(63, 53, 1, 9, y); SOL_F(63, 54, 1, 9, z); SOL_F(63, 55, 1, 9, w);
        SOL_F(63, 56, 1, 10, x); SOL_F(63, 57, 1, 10, y); SOL_F(63, 58, 1, 10, z); SOL_F(63, 59, 1, 10, w);
        SOL_F(63, 60, 1, 11, x); SOL_F(63, 61, 1, 11, y); SOL_F(63, 62, 1, 11, z);
        __builtin_amdgcn_sched_barrier(0);
#undef SOL_L
#undef SOL_F
        if (isu) {
#pragma unroll
            for (int q = 0; q < 8; ++q) { u32x4 o; o.x = pk2(xs[8 * q], xs[8 * q + 1]); o.y = pk2(xs[8 * q + 2], xs[8 * q + 3]); o.z = pk2(xs[8 * q + 4], xs[8 * q + 5]); o.w = pk2(xs[8 * q + 6], xs[8 * q + 7]);
                bf16_t* up = uT + ((col >> 5) * 8 + q) * 256 + (col & 31) * 4;
                *(u32x2*)up = (u32x2){o.x, o.y}; *(u32x2*)(up + 128) = (u32x2){o.z, o.w}; }
        } else {
            const int dk = col - 128, pos = (dk & ~15) + pinv16(dk & 15);
            LAS unsigned short* Wp = (LAS unsigned short*)(lds + P3_Q) + pos;
            unsigned wpk[32];
#pragma unroll
            for (int i = 0; i < 32; ++i) wpk[i] = pk2(xs[2 * i], xs[2 * i + 1]);
            __builtin_amdgcn_sched_barrier(0);
#pragma unroll
            for (int i = 0; i < 32; ++i) { Wp[(2 * i) * 136] = (unsigned short)(wpk[i] & 0xffffu); Wp[(2 * i + 1) * 136] = (unsigned short)(wpk[i] >> 16); }
        }
    } else {
        const int t2 = tid - 256; const float gl = gcs[63];
        const LAS unsigned short* Kb = (const LAS unsigned short*)(lds + P3_K);
#pragma unroll
        for (int i = 0; i < 4; ++i) {
            const int idx = t2 + 256 * i, dk = idx >> 3, ch = idx & 7, cb0 = (ch >> 1) * 16 + (ch & 1) * 4;
            float v[8];
#pragma unroll
            for (int e = 0; e < 8; ++e) { const int c = cb0 + (e & 3) + (e >> 2) * 8; v[e] = bf2f(Kb[c * 136 + dk]) * __expf(gl - gcs[c]); }
            u32x4 o; o.x = pk2(v[0], v[1]); o.y = pk2(v[2], v[3]); o.z = pk2(v[4], v[5]); o.w = pk2(v[6], v[7]);
            *(u32x4*)(kdT + dk * 64 + ch * 8) = o;
        }
        if (tid == 256) ((float*)(a.ws + WS_GLAST))[bh * 64 + n] = gl;
        p3_ret_half(a, lds + 73728, rb, rn, rh, t2);
    }
    __syncthreads();
#pragma unroll
    for (int i = 0; i < 2; ++i) { const int p = tid + 512 * i, row = p >> 4, pc = p & 15; *(u32x4*)(wG + row * 128 + pc * 8) = *(const LAS u32x4*)(lds + P3_Q + row * 272 + pc * 16); }
    __syncthreads();
}

DI void p3_ret_half(const Args& a, LAS unsigned char* lds, int b, int n, int h, int t2in) {
    int tid_ = t2in; asm volatile("" : "+v"(tid_));
    const int tid = tid_, lane = tid & 63, wave = tid >> 6;
    const bf16_t* proj = (const bf16_t*)(a.ws + WS_PROJ);
    const int bh = b * 4 + h;
    unsigned char* rec = (unsigned char*)a.out + (size_t)(bh * 64 + n) * RREC;
    bf16_t* vT = (bf16_t*)rec; bf16_t* qgG = (bf16_t*)(rec + 16384); bf16_t* kdT = (bf16_t*)(rec + 32768); bf16_t* atG = (bf16_t*)(rec + 49152);
    const float lg = log1pf(-exp2f(-5.f - (float)h));
#pragma unroll 1
    for (int ps = 0; ps < 2; ++ps) {
    const int r = (tid >> 3) + 32 * ps, cb = tid & 7;
    const bf16_t* prow = proj + (size_t)(b * SEQ + n * 64 + r) * NPROJ;
    {
        const u32x4 q1 = *(const u32x4*)(prow + h * 128 + cb * 8), q2 = *(const u32x4*)(prow + h * 128 + 64 + cb * 8);
        const u32x4 k1 = *(const u32x4*)(prow + 512 + h * 128 + cb * 8), k2 = *(const u32x4*)(prow + 512 + h * 128 + 64 + cb * 8);
        const u32x4 v0 = *(const u32x4*)(prow + 1024 + h * 128 + cb * 16), v1 = *(const u32x4*)(prow + 1024 + h * 128 + cb * 16 + 8);
        *(LAS u32x4*)(lds + P3_V + r * 272 + cb * 32) = v0; *(LAS u32x4*)(lds + P3_V + r * 272 + cb * 32 + 16) = v1;
        const float pos = (float)(n * 64 + r);
        float qa[8], qb[8], ka[8], kb[8];
        const unsigned qw1[4] = {q1.x, q1.y, q1.z, q1.w}, qw2[4] = {q2.x, q2.y, q2.z, q2.w}, kw1[4] = {k1.x, k1.y, k1.z, k1.w}, kw2[4] = {k2.x, k2.y, k2.z, k2.w};
#pragma unroll
        for (int e = 0; e < 8; ++e) {
            const int d = cb * 8 + e;
            const float inv = exp2f(-(float)d * (13.287712379549449f / 64.f));
            const float ang = pos * inv;
            const float kq = rintf(ang * 0.15915494309189535f);
            float rr = fmaf(-kq, 6.2831854820251465f, ang); rr = fmaf(-kq, -1.7484555e-7f, rr);
            const float cs = __cosf(rr), sn = __sinf(rr);
            const float x1 = (e & 1) ? bfhi(qw1[e >> 1]) : bflo(qw1[e >> 1]), x2 = (e & 1) ? bfhi(qw2[e >> 1]) : bflo(qw2[e >> 1]);
            const float y1 = (e & 1) ? bfhi(kw1[e >> 1]) : bflo(kw1[e >> 1]), y2 = (e & 1) ? bfhi(kw2[e >> 1]) : bflo(kw2[e >> 1]);
            qa[e] = x1 * cs - x2 * sn; qb[e] = x1 * sn + x2 * cs;
            ka[e] = (y1 * cs - y2 * sn) * 0.08838834764831845f; kb[e] = (y1 * sn + y2 * cs) * 0.08838834764831845f;
        }
        u32x4 o;
        o.x = pk2(qa[0], qa[1]); o.y = pk2(qa[2], qa[3]); o.z = pk2(qa[4], qa[5]); o.w = pk2(qa[6], qa[7]); *(LAS u32x4*)(lds + P3_Q + r * 272 + cb * 16) = o;
        o.x = pk2(qb[0], qb[1]); o.y = pk2(qb[2], qb[3]); o.z = pk2(qb[4], qb[5]); o.w = pk2(qb[6], qb[7]); *(LAS u32x4*)(lds + P3_Q + r * 272 + 128 + cb * 16) = o;
        o.x = pk2(ka[0], ka[1]); o.y = pk2(ka[2], ka[3]); o.z = pk2(ka[4], ka[5]); o.w = pk2(ka[6], ka[7]); *(LAS u32x4*)(lds + P3_K + r * 272 + cb * 16) = o;
        o.x = pk2(kb[0], kb[1]); o.y = pk2(kb[2], kb[3]); o.z = pk2(kb[4], kb[5]); o.w = pk2(kb[6], kb[7]); *(LAS u32x4*)(lds + P3_K + r * 272 + 128 + cb * 16) = o;
        const float qd = __expf(lg * (float)(r + 1));
        bf16_t* q0 = qgG + r * 128 + (cb >> 1) * 16 + 4 * (cb & 1);
        u32x2 w2;
        w2.x = pk2(qa[0] * qd, qa[1] * qd); w2.y = pk2(qa[2] * qd, qa[3] * qd); *(u32x2*)(q0) = w2;
        w2.x = pk2(qa[4] * qd, qa[5] * qd); w2.y = pk2(qa[6] * qd, qa[7] * qd); *(u32x2*)(q0 + 8) = w2;
        w2.x = pk2(qb[0] * qd, qb[1] * qd); w2.y = pk2(qb[2] * qd, qb[3] * qd); *(u32x2*)(q0 + 64) = w2;
        w2.x = pk2(qb[4] * qd, qb[5] * qd); w2.y = pk2(qb[6] * qd, qb[7] * qd); *(u32x2*)(q0 + 64 + 8) = w2;
    }
    }
    __syncthreads();
#pragma unroll
    for (int i = 0; i < 4; ++i) {
        const int ti = wave * 4 + i, mt = ti >> 2, nt = ti & 3;
        const LAS unsigned char* Ab = lds + P3_Q + (16 * mt + (lane & 15)) * 272 + (lane >> 4) * 16;
        const LAS unsigned char* Bb = lds + P3_K + (16 * nt + (lane & 15)) * 272 + (lane >> 4) * 16;
        f32x4 acc = {0.f, 0.f, 0.f, 0.f};
#pragma unroll
        for (int s = 0; s < 4; ++s) acc = __builtin_amdgcn_mfma_f32_16x16x32_bf16(*(const LAS bf16x8*)(Ab + s * 64), *(const LAS bf16x8*)(Bb + s * 64), acc, 0, 0, 0);
        const int jj = 16 * nt + (lane & 15);
#pragma unroll
        for (int j = 0; j < 4; ++j) { const int ii = 16 * mt + (lane >> 4) * 4 + j; const int dd = ii > jj ? ii - jj : jj - ii;
            atG[ii * 64 + (jj & ~15) + pinv16(jj & 15)] = f2bf(acc[j] * __expf(lg * (float)dd)); }
    }
    {
        const LAS unsigned short* Kb = (const LAS unsigned short*)(lds + P3_K);
#pragma unroll
        for (int i = 0; i < 4; ++i) {
            const int idx = tid + 256 * i, dk = idx >> 3, ch = idx & 7, cb0 = (ch >> 1) * 16 + (ch & 1) * 4;
            float v[8];
#pragma unroll
            for (int e = 0; e < 8; ++e) { const int c = cb0 + (e & 3) + (e >> 2) * 8; v[e] = bf2f(Kb[c * 136 + dk]) * __expf(lg * (float)(63 - c)); }
            u32x4 o; o.x = pk2(v[0], v[1]); o.y = pk2(v[2], v[3]); o.z = pk2(v[4], v[5]); o.w = pk2(v[6], v[7]);
            *(u32x4*)(kdT + dk * 64 + ch * 8) = o;
        }
    }
#pragma unroll 1
    for (int ps = 0; ps < 2; ++ps) {
        const int dk = tid & 127, cblk = (tid >> 7) + 2 * ps;
        const LAS unsigned short* Vp = (const LAS unsigned short*)(lds + P3_V) + dk;
        unsigned short vv[16];
#pragma unroll
        for (int d = 0; d < 16; ++d) vv[d] = Vp[(cblk * 16 + d) * 136];
        u32x4 o0, o1;
        o0.x = vv[0] | ((unsigned)vv[1] << 16); o0.y = vv[2] | ((unsigned)vv[3] << 16); o0.z = vv[4] | ((unsigned)vv[5] << 16); o0.w = vv[6] | ((unsigned)vv[7] << 16);
        o1.x = vv[8] | ((unsigned)vv[9] << 16); o1.y = vv[10] | ((unsigned)vv[11] << 16); o1.z = vv[12] | ((unsigned)vv[13] << 16); o1.w = vv[14] | ((unsigned)vv[15] << 16);
        { bf16_t* up = vT + ((dk >> 5) * 8 + cblk * 2) * 256 + (dk & 31) * 4;
          *(u32x2*)up = (u32x2){o0.x, o0.y}; *(u32x2*)(up + 128) = (u32x2){o0.z, o0.w}; *(u32x2*)(up + 256) = (u32x2){o1.x, o1.y}; *(u32x2*)(up + 256 + 128) = (u32x2){o1.z, o1.w}; }
    }
}

DI void p3_phase(const Args& a, LAS unsigned char* lds, int wv) {
    { const int hh = (blockIdx.x >> 1) & 3, tid = wv * 64 + lane_id();
      LAS float* cwl = (LAS float*)(lds + P3_CW);
      for (int i = tid; i < 1536; i += 512) { const int mtx = i >> 9, w = (i >> 7) & 3, ch = i & 127; cwl[i] = a.conv_w[(size_t)w * 1536 + mtx * 512 + hh * 128 + ch]; }
      __syncthreads(); }
    for (int it = blockIdx.x; it < 4096; it += 2 * gridDim.x) {
        const int it2 = it + gridDim.x;
        const int typeA = (it & 1) ^ ((it >> 8) & 1);
        const int itg = typeA ? it : it2, itr = typeA ? it2 : it;
        const int chg = itg >> 1, chr = itr >> 1;
        p3_pair_item(a, lds, chg >> 8, (chg >> 2) & 63, chg & 3, chr >> 8, (chr >> 2) & 63, chr & 3, wv);
    }
}

constexpr int ST_BYTES = 62464, ST_W = 0, ST_QG = 17408, ST_KD = 34816, ST_AT = 53248;
DI bf16x8 pack8(const f32x16& x, int base) {
    u32x4 p; p.x = pk2(x[base + 0], x[base + 1]); p.y = pk2(x[base + 2], x[base + 3]); p.z = pk2(x[base + 4], x[base + 5]); p.w = pk2(x[base + 6], x[base + 7]);
    return __builtin_bit_cast(bf16x8, p);
}
#define MFMA32(a, b, c) __builtin_amdgcn_mfma_f32_32x32x16_bf16((a), (b), (c), 0, 0, 0)
#define SCAN_BAR() do { asm volatile("s_waitcnt lgkmcnt(0)" ::: "memory"); __builtin_amdgcn_s_barrier(); asm volatile("" ::: "memory"); } while (0)
#define SBAR __builtin_amdgcn_sched_barrier(0)
template <int type>
DI void scan_compute(const Args& a, LAS unsigned char* lds, const unsigned char* rec0, size_t rstride, bf16_t* O, int wave, int bh, int b, int h) {
            int lane_ = lane_id(); asm volatile("" : "+v"(lane_));
            const int r = lane_ & 31, hh = lane_ >> 5;
            const float* glast = (const float*)(a.ws + WS_GLAST) + bh * 64;
            const float rdec = __expf(64.f * log1pf(-exp2f(-5.f - (float)h)));
            const float edec = type ? __expf(glast[lane_]) : 1.f;
            const int ncol = 32 * wave + r;
            const int colbase = (type == 0 ? 0 : 512) + h * 128;
            u32x2 uc[2][4];
            f32x16 S[4];
#pragma unroll
            for (int mt = 0; mt < 4; ++mt)
#pragma unroll
                for (int i = 0; i < 16; ++i) S[mt][i] = 0.f;
#define SCAN_ULOAD(nn) do { const bf16_t* up = (const bf16_t*)(rec0 + (size_t)(nn) * rstride) + wave * 2048 + hh * 128 + r * 4;        \
                _Pragma("unroll") for (int mt = 0; mt < 2; ++mt) _Pragma("unroll") for (int g = 0; g < 4; ++g) uc[mt][g] = *(const u32x2*)(up + (mt * 4 + g) * 256); } while (0)
            SCAN_ULOAD(0);
            SCAN_BAR();
#define FR(p) (*(const LAS bf16x8*)(p))
#define LOAD_W(F, s)  do { F[0] = FR(pW + (s) * 32); F[1] = FR(pW + 32 * 272 + (s) * 32); F[2] = FR(pW + ((s) + 1) * 32); F[3] = FR(pW + 32 * 272 + ((s) + 1) * 32); } while (0)
#define LOAD_Q(F, s)  do { F[0] = FR(pQ + (s) * 32); F[1] = FR(pQ + 32 * 272 + (s) * 32); F[2] = FR(pQ + ((s) + 1) * 32); F[3] = FR(pQ + 32 * 272 + ((s) + 1) * 32); } while (0)
#define LOAD_T(F, s)  do { F[0] = FR(pT + (s) * 32); F[1] = FR(pT + 32 * 144 + (s) * 32); F[2] = FR(pT + ((s) + 1) * 32); F[3] = FR(pT + 32 * 144 + ((s) + 1) * 32); } while (0)
#define LOAD_K(F, s)  do { F[0] = FR(pK + (s) * 32); F[1] = FR(pK + 32 * 144 + (s) * 32); F[2] = FR(pK + 64 * 144 + (s) * 32); F[3] = FR(pK + 96 * 144 + (s) * 32); } while (0)
#define COMP_W(F, s)  do { acc0 = MFMA32(F[0], Sb[s], acc0); acc1 = MFMA32(F[1], Sb[s], acc1); acc0 = MFMA32(F[2], Sb[(s) + 1], acc0); acc1 = MFMA32(F[3], Sb[(s) + 1], acc1); } while (0)
#define COMP_Q(F, s)  do { o0 = MFMA32(F[0], Sb[s], o0); o1 = MFMA32(F[1], Sb[s], o1); o0 = MFMA32(F[2], Sb[(s) + 1], o0); o1 = MFMA32(F[3], Sb[(s) + 1], o1); } while (0)
#define COMP_T(F, s)  do { o0 = MFMA32(F[0], vb[s], o0); o1 = MFMA32(F[1], vb[s], o1); o0 = MFMA32(F[2], vb[(s) + 1], o0); o1 = MFMA32(F[3], vb[(s) + 1], o1); } while (0)
#define COMP_K(F, s)  do { S[0] = MFMA32(F[0], vb[s], S[0]); S[1] = MFMA32(F[1], vb[s], S[1]); S[2] = MFMA32(F[2], vb[s], S[2]); S[3] = MFMA32(F[3], vb[s], S[3]); } while (0)
#pragma unroll 1
            for (int n = 0; n < 64; ++n) {
                const LAS unsigned char* sb = lds + (n & 1) * ST_BYTES;
                const LAS unsigned char* pW = sb + ST_W + r * 272 + hh * 16;
                const LAS unsigned char* pQ = sb + ST_QG + r * 272 + hh * 16;
                const LAS unsigned char* pT = sb + ST_AT + r * 144 + hh * 16;
                const LAS unsigned char* pK = sb + ST_KD + r * 144 + hh * 16;
                const float dec = type ? __builtin_bit_cast(float, __builtin_amdgcn_readlane(__builtin_bit_cast(int, edec), n)) : rdec;
                bf16x8 vb[4], fa[4], fb[4];
                f32x16 acc0, acc1, o0, o1;
#pragma unroll
                for (int i = 0; i < 16; ++i) { acc0[i] = 0.f; acc1[i] = 0.f; o0[i] = 0.f; o1[i] = 0.f; }
#define SBF(s) pack8(S[(s) >> 1], ((s) & 1) * 8)
#define LOAD_WQ(F, s) do { if constexpr (type != 0) { F[0] = FR(pW + (s) * 32); F[1] = FR(pW + 32 * 272 + (s) * 32); } F[2] = FR(pQ + (s) * 32); F[3] = FR(pQ + 32 * 272 + (s) * 32); } while (0)
#define COMP_WQ(F, s) do { const bf16x8 sbs = SBF(s); if constexpr (type != 0) { acc0 = MFMA32(F[0], sbs, acc0); acc1 = MFMA32(F[1], sbs, acc1); } o0 = MFMA32(F[2], sbs, o0); o1 = MFMA32(F[3], sbs, o1); } while (0)
                LOAD_WQ(fa, 0);
                LOAD_WQ(fb, 1); SBAR; COMP_WQ(fa, 0); SBAR;
                LOAD_WQ(fa, 2); SBAR; COMP_WQ(fb, 1); SBAR;
                LOAD_WQ(fb, 3); SBAR; COMP_WQ(fa, 2); SBAR;
                LOAD_WQ(fa, 4); SBAR; COMP_WQ(fb, 3); SBAR;
                LOAD_WQ(fb, 5); SBAR; COMP_WQ(fa, 4); SBAR;
                LOAD_WQ(fa, 6); SBAR; COMP_WQ(fb, 5); SBAR;
                LOAD_WQ(fb, 7); SBAR; COMP_WQ(fa, 6); SBAR;
                LOAD_T(fa, 0); SBAR; COMP_WQ(fb, 7); SBAR;
                {
#pragma unroll
                    for (int g = 0; g < 4; ++g) {
                        acc0[4 * g + 0] = bflo(uc[0][g].x) - acc0[4 * g + 0]; acc0[4 * g + 1] = bfhi(uc[0][g].x) - acc0[4 * g + 1];
                        acc0[4 * g + 2] = bflo(uc[0][g].y) - acc0[4 * g + 2]; acc0[4 * g + 3] = bfhi(uc[0][g].y) - acc0[4 * g + 3];
                        acc1[4 * g + 0] = bflo(uc[1][g].x) - acc1[4 * g + 0]; acc1[4 * g + 1] = bfhi(uc[1][g].x) - acc1[4 * g + 1];
                        acc1[4 * g + 2] = bflo(uc[1][g].y) - acc1[4 * g + 2]; acc1[4 * g + 3] = bfhi(uc[1][g].y) - acc1[4 * g + 3]; }
                    vb[0] = pack8(acc0, 0); vb[1] = pack8(acc0, 8); vb[2] = pack8(acc1, 0); vb[3] = pack8(acc1, 8);
                }
                SBAR;
                SCAN_ULOAD(n + 1 < 64 ? n + 1 : 63);
                LOAD_T(fb, 2); SBAR; COMP_T(fa, 0); S[0] = S[0] * dec; S[1] = S[1] * dec; SBAR;
                LOAD_K(fa, 0); SBAR; COMP_T(fb, 2); S[2] = S[2] * dec; S[3] = S[3] * dec; SBAR;
                LOAD_K(fb, 1); SBAR; COMP_K(fa, 0); SBAR;
                LOAD_K(fa, 2); SBAR; COMP_K(fb, 1); SBAR;
                LOAD_K(fb, 3); SBAR; COMP_K(fa, 2); SBAR;
                COMP_K(fb, 3);
                SBAR;
                {
                    LAS unsigned char* og = lds + 2 * ST_BYTES + wave * 5120;
                    LAS unsigned short* ow = (LAS unsigned short*)(og + (4 * hh) * 80) + r;
                    unsigned pk[16];
#pragma unroll
                    for (int i = 0; i < 8; ++i) { pk[i] = pk2(o0[2 * i], o0[2 * i + 1]); pk[8 + i] = pk2(o1[2 * i], o1[2 * i + 1]); }
                    SBAR;
#pragma unroll
                    for (int i = 0; i < 8; ++i) {
                        ow[(((2 * i) & 3) + 8 * ((2 * i) >> 2)) * 40] = (unsigned short)(pk[i] & 0xffffu); ow[(((2 * i + 1) & 3) + 8 * ((2 * i + 1) >> 2)) * 40] = (unsigned short)(pk[i] >> 16);
                        ow[(32 + ((2 * i) & 3) + 8 * ((2 * i) >> 2)) * 40] = (unsigned short)(pk[8 + i] & 0xffffu); ow[(32 + ((2 * i + 1) & 3) + 8 * ((2 * i + 1) >> 2)) * 40] = (unsigned short)(pk[8 + i] >> 16); }
                    asm volatile("" ::: "memory");
                    char* ob = (char*)O + (size_t)(((b * SEQ + n * 64) * DM + colbase + 32 * wave) * 2);
                    const int lrow = (r >> 2) + 8 * hh, lpart = r & 3;
                    const unsigned lo = (unsigned)(lrow * (DM * 2) + lpart * 16);
                    const LAS unsigned char* orp = og + lrow * 80 + lpart * 16;
#pragma unroll
                    for (int k = 0; k < 4; ++k) *(u32x4*)(ob + (lo + (unsigned)(k * 16 * DM * 2))) = *(const LAS u32x4*)(orp + 16 * k * 80);
                }
                SCAN_BAR();
            }
#undef SCAN_ULOAD
#undef FR
#undef LOAD_W
#undef LOAD_Q
#undef LOAD_T
#undef LOAD_K
#undef COMP_W
#undef SBF
#undef LOAD_WQ
#undef COMP_WQ
#undef COMP_Q
#undef COMP_T
#undef COMP_K
}
DI u32x4 ld_async(const unsigned char* p) { u32x4 v; asm volatile("global_load_dwordx4 %0, %1, off" : "=v"(v) : "v"(p) : "memory"); return v; }
template <int type>
DI void scan_loader(LAS unsigned char* lds, const unsigned char* rec0, size_t rstride, int o_w, int o_qg, int o_kd, int o_at, int wv) {
    int t2_ = wv * 64 + lane_id() - 256; asm volatile("" : "+v"(t2_));
    const int t2 = t2_;
    u32x4 sgA[14], sgB[14];
#define LD_LOAD(dst, nn) do { const unsigned char* rec = rec0 + (size_t)((nn) < 64 ? (nn) : 63) * rstride; \
        _Pragma("unroll") for (int i = 0; i < 4; ++i) { if constexpr (type != 0) dst[i] = ld_async(rec + o_w + (t2 + 256 * i) * 16); \
            dst[4 + i] = ld_async(rec + o_qg + (t2 + 256 * i) * 16); dst[8 + i] = ld_async(rec + o_kd + (t2 + 256 * i) * 16); } \
        dst[12] = ld_async(rec + o_at + t2 * 16); dst[13] = ld_async(rec + o_at + (t2 + 256) * 16); } while (0)
#define LD_STORE(src, st) do { LAS unsigned char* sb = lds + (st) * ST_BYTES; \
        _Pragma("unroll") for (int i = 0; i < 4; ++i) { const int p = t2 + 256 * i; \
            if constexpr (type != 0) *(LAS u32x4*)(sb + ST_W + (p >> 4) * 272 + (p & 15) * 16) = src[i]; \
            *(LAS u32x4*)(sb + ST_QG + (p >> 4) * 272 + (p & 15) * 16) = src[4 + i]; \
            *(LAS u32x4*)(sb + ST_KD + (p >> 3) * 144 + (p & 7) * 16) = src[8 + i]; } \
        *(LAS u32x4*)(sb + ST_AT + (t2 >> 3) * 144 + (t2 & 7) * 16) = src[12]; \
        *(LAS u32x4*)(sb + ST_AT + ((t2 + 256) >> 3) * 144 + (t2 & 7) * 16) = src[13]; } while (0)
#define LD_WAIT_OLDER() do { if constexpr (type != 0) asm volatile("s_waitcnt vmcnt(14)" ::: "memory"); else asm volatile("s_waitcnt vmcnt(10)" ::: "memory"); } while (0)
    LD_LOAD(sgA, 0); asm volatile("s_waitcnt vmcnt(0)" ::: "memory"); LD_STORE(sgA, 0); LD_LOAD(sgB, 1); LD_LOAD(sgA, 2);
    SCAN_BAR();
#define LD_ITER(nn, BUF) do { LD_WAIT_OLDER(); if ((nn) + 1 < 64) LD_STORE(BUF, ((nn) + 1) & 1); LD_LOAD(BUF, (nn) + 3); SCAN_BAR(); } while (0)
#pragma unroll 1
    for (int n = 0; n < 64; n += 2) { LD_ITER(n, sgB); LD_ITER(n + 1, sgA); }
    asm volatile("s_waitcnt vmcnt(0)" ::: "memory");
#undef LD_ITER
#undef LD_WAIT_OLDER
#undef LD_LOAD
#undef LD_STORE
}
DI void p_cvec(const Args& a, LAS unsigned char* lds, int wv, int part) {
    const int tid = wv * 64 + lane_id(), j = part * 512 + tid;
    LAS float* sh = (LAS float*)lds;
    const float* mod = (const float*)(a.ws + WS_MOD);
    for (int i = tid; i < 8192; i += 512) sh[i] = mod[(size_t)(i >> 10) * NMOD + 3072 + (i & 1023)];
    __syncthreads();
    float acc[8];
#pragma unroll
    for (int b = 0; b < 8; ++b) acc[b] = 0.f;
#pragma unroll 16
    for (int k = 0; k < 1024; ++k) { const float w = a.w_ff1[(size_t)k * DFF + j];
#pragma unroll
        for (int b = 0; b < 8; ++b) acc[b] += sh[b * 1024 + k] * w; }
#pragma unroll
    for (int b = 0; b < 8; ++b) ((float*)(a.ws + WS_CVEC))[b * DFF + j] = acc[b];
}
DI void scan_phase(const Args& a, LAS unsigned char* lds, int wv) {
    const int wave = wv;
    bf16_t* O = (bf16_t*)(a.ws + WS_ACT);
    const int item = blockIdx.x;
    if (item < 64) {
        const int type = item & 1, bh = item >> 1, b = bh >> 2, h = bh & 3;
        const unsigned char* rec0; size_t rstride; int o_w, o_qg, o_kd, o_at;
        if (type == 0) { rec0 = (const unsigned char*)a.out + (size_t)bh * 64 * RREC; rstride = RREC; o_w = 0; o_qg = 16384; o_kd = 32768; o_at = 49152; }
        else { rec0 = a.ws + WS_GREC + (size_t)bh * 64 * GREC; rstride = GREC; o_w = 16384; o_qg = 32768; o_kd = 49152; o_at = 65536; }
        if (wave >= 4) {
            if (type) scan_loader<1>(lds, rec0, rstride, o_w, o_qg, o_kd, o_at, wv); else scan_loader<0>(lds, rec0, rstride, o_w, o_qg, o_kd, o_at, wv);
        } else {
            __builtin_amdgcn_s_setprio(3);
            if (type) scan_compute<1>(a, lds, rec0, rstride, O, wave, bh, b, h); else scan_compute<0>(a, lds, rec0, rstride, O, wave, bh, b, h);
            __builtin_amdgcn_s_setprio(0);
        }
    } else if (item < 72) {
        p_cvec(a, lds, wv, item - 64);
    }
#undef SCAN_BAR
#undef SBAR
}

DI void p5_phase(const Args& a, int wv) {
    const int lane = lane_id(), wave = wv;
    bf16_t* O = (bf16_t*)(a.ws + WS_ACT); const bf16_t* proj = (const bf16_t*)(a.ws + WS_PROJ);
    const int gw = blockIdx.x * 8 + wave, NGW = gridDim.x * 8, col = lane * 16; const bool isret = lane < 32;
    const float* nwp = isret ? a.ret_norm_w + col : a.gdn_norm_w + (col & 127);
    float nw[16];
#pragma unroll
    for (int q = 0; q < 4; ++q) { const f32x4 t = *(const f32x4*)(nwp + 4 * q); nw[4 * q] = t.x; nw[4 * q + 1] = t.y; nw[4 * q + 2] = t.z; nw[4 * q + 3] = t.w; }
    const int gcol = isret ? 1536 + col : 3072 + col;
    for (int m = gw; m < MROWS; m += NGW) {
        bf16_t* op = O + (size_t)m * DM + col;
        const u32x4 o0 = *(const u32x4*)op, o1 = *(const u32x4*)(op + 8);
        const u32x4 g0 = *(const u32x4*)(proj + (size_t)m * NPROJ + gcol), g1 = *(const u32x4*)(proj + (size_t)m * NPROJ + gcol + 8);
        float v[16], g[16];
        v[0] = bflo(o0.x); v[1] = bfhi(o0.x); v[2] = bflo(o0.y); v[3] = bfhi(o0.y); v[4] = bflo(o0.z); v[5] = bfhi(o0.z); v[6] = bflo(o0.w); v[7] = bfhi(o0.w);
        v[8] = bflo(o1.x); v[9] = bfhi(o1.x); v[10] = bflo(o1.y); v[11] = bfhi(o1.y); v[12] = bflo(o1.z); v[13] = bfhi(o1.z); v[14] = bflo(o1.w); v[15] = bfhi(o1.w);
        g[0] = bflo(g0.x); g[1] = bfhi(g0.x); g[2] = bflo(g0.y); g[3] = bfhi(g0.y); g[4] = bflo(g0.z); g[5] = bfhi(g0.z); g[6] = bflo(g0.w); g[7] = bfhi(g0.w);
        g[8] = bflo(g1.x); g[9] = bfhi(g1.x); g[10] = bflo(g1.y); g[11] = bfhi(g1.y); g[12] = bflo(g1.z); g[13] = bfhi(g1.z); g[14] = bflo(g1.w); g[15] = bfhi(g1.w);
        float s = 0.f;
#pragma unroll
        for (int e = 0; e < 16; ++e) s += v[e];
        s = red8(s);
        const float mu = isret ? s * (1.f / 128.f) : 0.f;
        float ss = 0.f;
#pragma unroll
        for (int e = 0; e < 16; ++e) { v[e] -= mu; ss += v[e] * v[e]; }
        ss = red8(ss);
        const float rstd = 1.0f / sqrtf(ss * (1.f / 128.f) + EPS);
        float y[16];
#pragma unroll
        for (int e = 0; e < 16; ++e) y[e] = v[e] * rstd * nw[e] * silu_f(g[e]);
        u32x4 w0, w1; w0.x = pk2(y[0], y[1]); w0.y = pk2(y[2], y[3]); w0.z = pk2(y[4], y[5]); w0.w = pk2(y[6], y[7]);
        w1.x = pk2(y[8], y[9]); w1.y = pk2(y[10], y[11]); w1.z = pk2(y[12], y[13]); w1.w = pk2(y[14], y[15]);
        *(u32x4*)op = w0; *(u32x4*)(op + 8) = w1;
    }
}

DI void final_norm_phase(const Args& a, int wv) {
    const int lane = lane_id(), wave = wv;
    const int gw = blockIdx.x * 8 + wave, NGW = gridDim.x * 8, c0 = lane * 16;
    const bf16_t* X = (const bf16_t*)(a.ws + WS_X1);
    f32x4 nwv[4];
#pragma unroll
    for (int q = 0; q < 4; ++q) nwv[q] = *(const f32x4*)(a.norm_final_w + c0 + 4 * q);
    for (int m0 = gw; m0 < MROWS; m0 += 2 * NGW) {
        u32x4 raw[2][2];
#pragma unroll
        for (int rr = 0; rr < 2; ++rr) { const int m = m0 + rr * NGW < MROWS ? m0 + rr * NGW : m0;
            raw[rr][0] = *(const u32x4*)(X + (size_t)m * DM + c0); raw[rr][1] = *(const u32x4*)(X + (size_t)m * DM + c0 + 8); }
#pragma unroll
        for (int rr = 0; rr < 2; ++rr) {
            const int m = m0 + rr * NGW;
            if (m < MROWS) {
                f32x4 v[4];
                v[0] = (f32x4){bflo(raw[rr][0].x), bfhi(raw[rr][0].x), bflo(raw[rr][0].y), bfhi(raw[rr][0].y)};
                v[1] = (f32x4){bflo(raw[rr][0].z), bfhi(raw[rr][0].z), bflo(raw[rr][0].w), bfhi(raw[rr][0].w)};
                v[2] = (f32x4){bflo(raw[rr][1].x), bfhi(raw[rr][1].x), bflo(raw[rr][1].y), bfhi(raw[rr][1].y)};
                v[3] = (f32x4){bflo(raw[rr][1].z), bfhi(raw[rr][1].z), bflo(raw[rr][1].w), bfhi(raw[rr][1].w)};
                float ss = 0.f;
#pragma unroll
                for (int q = 0; q < 4; ++q) ss += (v[q].x * v[q].x + v[q].y * v[q].y) + (v[q].z * v[q].z + v[q].w * v[q].w);
                ss = wave_sum(ss);
                const float rstd = 1.0f / sqrtf(ss * (1.f / DM) + EPS);
                float* xr = a.out + (size_t)m * DM + c0;
#pragma unroll
                for (int q = 0; q < 4; ++q) *(f32x4*)(xr + 4 * q) = v[q] * rstd * nwv[q];
            }
        }
    }
}

#define XB_TMO      128
#define XB_XCNT(j)  (256  + 64 * (j))
#define XB_XSUB(j)  (1280 + 64 * (j))
#define XB_XGEN(j)  (2304 + 64 * (j))
#define XB_TOP      3328
#define XB_TOPGEN   3392
#define XCD_BAR_WORDS 3456
#define XB_SPIN_CAP (1u << 18)
DI unsigned xb_ld(unsigned* p)              { return __hip_atomic_load(p, __ATOMIC_RELAXED, __HIP_MEMORY_SCOPE_AGENT); }
DI unsigned xb_add(unsigned* p, unsigned v) { return __hip_atomic_fetch_add(p, v, __ATOMIC_RELAXED, __HIP_MEMORY_SCOPE_AGENT); }
DI unsigned xb_xcc_id() { return (unsigned)__builtin_amdgcn_s_getreg((3 << 11) | 20) & 0xFu; }
#define XB_SPIN(cond, bar) do { unsigned _sp = 0; while (cond) { __builtin_amdgcn_s_sleep(1); \
    if ((++_sp & 255u) == 0u) { if (xb_ld(&(bar)[XB_TMO])) break; if (_sp > XB_SPIN_CAP) { atomicAdd(&(bar)[XB_TMO], 1u); break; } } } } while (0)
struct XcdBarrier { unsigned* bar; unsigned x; volatile LAS unsigned* st; };
DI XcdBarrier xcd_barrier_post(unsigned* bar, volatile LAS unsigned* st, int wv) {
    XcdBarrier b; b.bar = bar; b.x = xb_xcc_id(); b.st = st;
    if (wv == 0 && lane_id() == 0) (void)xb_add(&bar[XB_XCNT(b.x)], 1u);
    return b;
}
DI void xcd_barrier_complete(unsigned* bar, unsigned x, unsigned& nloc, unsigned& nx) {
    const unsigned G = gridDim.x * gridDim.y * gridDim.z;
    unsigned sum, cnt, mine, sp = 0u;
    for (;;) {
        sum = 0u; cnt = 0u; mine = 0u;
#pragma unroll
        for (unsigned j = 0; j < 16; ++j) { const unsigned c = xb_ld(&bar[XB_XCNT(j)]); sum += c; cnt += (c > 0u) ? 1u : 0u; mine = (j == x) ? c : mine; }
        if (sum == G) break;
        __builtin_amdgcn_s_sleep(1);
        if ((++sp & 255u) == 0u) { if (xb_ld(&bar[XB_TMO])) break; if (sp > XB_SPIN_CAP) { atomicAdd(&bar[XB_TMO], 1u); break; } }
    }
    nloc = mine > 0u ? mine : 1u; nx = cnt > 0u ? cnt : 1u;
}
DI void xcd_barrier(const XcdBarrier& b, int wv) {
    asm volatile("s_waitcnt vmcnt(0)" ::: "memory");
    __syncthreads();
    if (wv == 0 && lane_id() == 0) {
        unsigned* bar = b.bar;
        __builtin_amdgcn_s_waitcnt(0);
        unsigned nloc = b.st[0], nx = b.st[1];
        if (nloc == 0u) { xcd_barrier_complete(bar, b.x, nloc, nx); b.st[0] = nloc; b.st[1] = nx; }
        const unsigned old = xb_add(&bar[XB_XSUB(b.x)], 1u);
        const unsigned gen = old / nloc;
        if (old + 1u == (gen + 1u) * nloc) {
            __builtin_amdgcn_fence(__ATOMIC_RELEASE, "agent");
            asm volatile("s_waitcnt vmcnt(0)" ::: "memory");
            const unsigned og = xb_add(&bar[XB_TOP], 1u);
            const unsigned tg = og / nx;
            if (og + 1u == (tg + 1u) * nx) xb_add(&bar[XB_TOPGEN], 1u);
            else XB_SPIN(xb_ld(&bar[XB_TOPGEN]) == tg, bar);
            __builtin_amdgcn_fence(__ATOMIC_ACQUIRE, "agent");
            xb_add(&bar[XB_XGEN(b.x)], 1u);
            asm volatile("s_waitcnt vmcnt(0)" ::: "memory");
        } else {
            XB_SPIN(xb_ld(&bar[XB_XGEN(b.x)]) == gen, bar);
            __builtin_amdgcn_fence(__ATOMIC_ACQUIRE, "agent");
            asm volatile("s_waitcnt vmcnt(0)" ::: "memory");
        }
    }
    __syncthreads();
}

constexpr int N_PHASES = 11;
__global__ void __launch_bounds__(512, 2) fwd_megakernel(Args a) {
    extern __shared__ __attribute__((aligned(16))) unsigned char lds_raw[];
    LAS unsigned char* lds = (LAS unsigned char*)lds_raw;
    cg::grid_group grid = cg::this_grid();
    volatile LAS unsigned* bst = (volatile LAS unsigned*)(lds + 147200);
    const int wv = __builtin_amdgcn_readfirstlane(threadIdx.x >> 6);
    if (wv == 0 && lane_id() < 2) bst[lane_id()] = 0u;
    __syncthreads();
    const XcdBarrier bar = xcd_barrier_post((unsigned*)(a.ws + WS_BAR), bst, wv);
    if (a.ph_lo < 0) grid.sync();
    const float* mod = (const float*)(a.ws + WS_MOD);
    bf16_t* act = (bf16_t*)(a.ws + WS_ACT);
    bf16_t* proj = (bf16_t*)(a.ws + WS_PROJ);
    const int G = gridDim.x;
#define IN(k) (a.ph_lo <= (k) && (k) < a.ph_hi)
#define SEAM(k) do { if (IN(k) && IN((k) + 1)) xcd_barrier(bar, wv); } while (0)
    if (IN(0)) { p0_phase(a, lds, wv); } SEAM(0);
    if (IN(1)) { norm_mod_phase<true>(a.x, a.norm_mix_w, mod, 0, 1024, act, a.w_in, (float*)(a.ws + WS_GAB), lds, wv); } SEAM(1);
    if (IN(2)) { pg8::Gemm g{act, (const bf16_t*)(a.ws + WS_WIN), MROWS, NPROJ, DM}; pg8::StaticOrder S; S.init(MROWS, NPROJ, G, (int)blockIdx.x);
        pg8::EpiBf16<0> E{proj, NPROJ}; pg8::gemm_phase<pg8::EpiBf16<0>, pg8::StaticOrder, true, true>(lds, g, S, E, wv); } SEAM(2);
    if (IN(3)) { p3_phase(a, lds, wv); } SEAM(3);
    if (IN(4)) { scan_phase(a, lds, wv); } SEAM(4);
    if (IN(5)) { p5_phase(a, wv); } SEAM(5);
    if (IN(6)) { pg8::Gemm g{act, (const bf16_t*)(a.ws + WS_WOUT), MROWS, DM, DM}; pg8::StaticOrder S; S.init(MROWS, DM, G, (int)blockIdx.x);
        pg8::EpiResGateNorm E{a.x, (bf16_t*)(a.ws + WS_X1), mod + 2048, a.norm_mlp_w, mod + 4096, (bf16_t*)(a.ws + WS_ACT2), (float*)(a.ws + WS_SUMSQ)}; pg8::gemm_phase<pg8::EpiResGateNorm, pg8::StaticOrder, true, true>(lds, g, S, E, wv); } SEAM(6);
    if (IN(8)) { pg8::Gemm g{(const bf16_t*)(a.ws + WS_ACT2), (const bf16_t*)(a.ws + WS_WFF1), MROWS, DFF, DM}; pg8::StaticOrder S; S.init(MROWS, DFF, G, (int)blockIdx.x);
        pg8::EpiFf1 E{proj, DFF, (const float*)(a.ws + WS_SUMSQ), (const float*)(a.ws + WS_CVEC)}; pg8::gemm_phase<pg8::EpiFf1, pg8::StaticOrder, true, true>(lds, g, S, E, wv); } SEAM(8);
    if (IN(9)) { pg8::Gemm g{proj, (const bf16_t*)(a.ws + WS_WFF2), MROWS, DM, DFF}; pg8::StaticOrder S; S.init(MROWS, DM, G, (int)blockIdx.x);
        pg8::EpiResGateBf E{(bf16_t*)(a.ws + WS_X1), mod + 5120}; pg8::gemm_phase<pg8::EpiResGateBf, pg8::StaticOrder, true, true>(lds, g, S, E, wv); } SEAM(9);
    if (IN(10)) { final_norm_phase(a, wv); }
#undef IN
#undef SEAM
}

extern "C" void kernel_launch(void* const* d_in, const int* in_sizes, int n_in, void* d_out, int out_size, void* d_ws, size_t ws_size, hipStream_t stream) {
    static int grid = 0;
    if (grid == 0) {
        if (n_in != 16 || out_size != MROWS * DM || ws_size < WS_END) { fprintf(stderr, "kernel_launch: unexpected shapes (n_in %d out %d ws %zu)\n", n_in, out_size, ws_size); grid = -1; return; }
        int dev = 0, cus = 0, per_cu = 0;
        hipGetDevice(&dev); hipDeviceGetAttribute(&cus, hipDeviceAttributeMultiprocessorCount, dev);
        if (hipFuncSetAttribute((const void*)fwd_megakernel, hipFuncAttributeMaxDynamicSharedMemorySize, LDS_BYTES) != hipSuccess) { fprintf(stderr, "kernel_launch: hipFuncSetAttribute failed\n"); grid = -1; return; }
        if (hipOccupancyMaxActiveBlocksPerMultiprocessor(&per_cu, (const void*)fwd_megakernel, 512, LDS_BYTES) != hipSuccess || per_cu < 1) { fprintf(stderr, "kernel_launch: occupancy query says %d\n", per_cu); per_cu = 1; }
        (void)hipGetLastError();
        grid = cus * per_cu;
        if (grid > 256) grid = 256;
        if (grid != 256) { fprintf(stderr, "kernel_launch: this build needs a 256-workgroup grid, got %d\n", grid); grid = -1; return; }
    }
    if (grid < 0) return;
    Args a{};
    a.x = (const float*)d_in[0]; a.c = (const float*)d_in[1]; a.ada_w = (const float*)d_in[2]; a.ada_b = (const float*)d_in[3]; a.norm_mix_w = (const float*)d_in[4]; a.w_in = (const float*)d_in[5];
    a.conv_w = (const float*)d_in[6]; a.a_log = (const float*)d_in[7]; a.dt_bias = (const float*)d_in[8]; a.ret_norm_w = (const float*)d_in[9]; a.gdn_norm_w = (const float*)d_in[10];
    a.w_out = (const float*)d_in[11]; a.norm_mlp_w = (const float*)d_in[12]; a.w_ff1 = (const float*)d_in[13]; a.w_ff2 = (const float*)d_in[14]; a.norm_final_w = (const float*)d_in[15];
    a.out = (float*)d_out; a.ws = (unsigned char*)d_ws;
    if (hipMemsetAsync((char*)d_ws + WS_BAR, 0, XCD_BAR_WORDS * 4, stream) != hipSuccess) { fprintf(stderr, "kernel_launch: memset of barrier words failed\n"); return; }
#if MK_N_LAUNCHES == 1
    a.ph_lo = 0; a.ph_hi = N_PHASES;
    void* args[] = {&a};
    hipError_t e = hipLaunchCooperativeKernel((const void*)fwd_megakernel, dim3(grid), dim3(512), args, LDS_BYTES, stream);
    if (e != hipSuccess) fprintf(stderr, "cooperative launch failed: %s (grid %d)\n", hipGetErrorString(e), grid);
#else
    for (int p = 0; p < N_PHASES; ++p) { a.ph_lo = p; a.ph_hi = p + 1; hipLaunchKernelGGL(fwd_megakernel, dim3(grid), dim3(512), LDS_BYTES, stream, a); }
#endif
}
```

```cpp
#include <hip/hip_runtime.h>
#include <hip/hip_cooperative_groups.h>
#include <cstdio>
#include <cstdint>
namespace cg = cooperative_groups;

#ifndef MK_N_LAUNCHES
#define MK_N_LAUNCHES 1
#endif

#define LAS __attribute__((address_space(3)))
typedef unsigned short bf16_t;
typedef short bf16x8 __attribute__((ext_vector_type(8)));
typedef float f32x4 __attribute__((ext_vector_type(4)));
typedef float f32x16 __attribute__((ext_vector_type(16)));
typedef unsigned u32x4 __attribute__((ext_vector_type(4)));
typedef unsigned u32x2 __attribute__((ext_vector_type(2)));
typedef float f32x2_t __attribute__((ext_vector_type(2)));
typedef __bf16 bf16x2_t __attribute__((ext_vector_type(2)));

#define DI __device__ __forceinline__

DI unsigned pk2(float lo, float hi) { f32x2_t v = {lo, hi}; bf16x2_t b = __builtin_convertvector(v, bf16x2_t); return __builtin_bit_cast(unsigned, b); }
DI unsigned short f2bf(float x) { return (unsigned short)(pk2(x, 0.f) & 0xffffu); }
DI float bf2f(unsigned short u) { return __builtin_bit_cast(float, ((unsigned)u) << 16); }
DI float bflo(unsigned u) { return __builtin_bit_cast(float, u << 16); }
DI float bfhi(unsigned u) { return __builtin_bit_cast(float, u & 0xffff0000u); }
DI float wave_sum(float v) {
#pragma unroll
    for (int o = 1; o < 64; o <<= 1) v += __shfl_xor(v, o);
    return v;
}
DI float silu_f(float v) { return v * __builtin_amdgcn_rcpf(1.f + __expf(-v)); }
DI int lane_id() { return (int)__builtin_amdgcn_mbcnt_hi(~0u, __builtin_amdgcn_mbcnt_lo(~0u, 0u)); }

constexpr int BATCH = 8, SEQ = 4096, DM = 1024, MROWS = BATCH * SEQ, DFF = 4096, NPROJ = 4096, DIN = 4104, NMOD = 6144;
constexpr float EPS = 1e-6f;
constexpr size_t MiB = 1u << 20;
constexpr size_t WS_WIN = 0, WS_WOUT = 8 * MiB, WS_WFF1 = 10 * MiB, WS_WFF2 = 18 * MiB, WS_MOD = 26 * MiB, WS_GLAST = 26 * MiB + 256 * 1024, WS_CVEC = 26 * MiB + 512 * 1024, WS_SUMSQ = 26 * MiB + 768 * 1024, WS_GAB = 27 * MiB,
                 WS_ACT = 28 * MiB, WS_PROJ = 92 * MiB, WS_GREC = 348 * MiB, WS_BAR = 492 * MiB, WS_END = 493 * MiB;
constexpr size_t WS_X1 = WS_GREC + 64 * MiB;
constexpr size_t WS_ACT2 = WS_GREC;
constexpr int GREC = 73728, RREC = 57344;
constexpr int LDS_BYTES = 147456;

struct Args {
    const float* x; const float* c; const float* ada_w; const float* ada_b; const float* norm_mix_w; const float* w_in;
    const float* conv_w; const float* a_log; const float* dt_bias; const float* ret_norm_w; const float* gdn_norm_w;
    const float* w_out; const float* norm_mlp_w; const float* w_ff1; const float* w_ff2; const float* norm_final_w;
    float* out; unsigned char* ws; int ph_lo, ph_hi;
};

namespace pg8 {
constexpr int BM = 256, BK = 64, HALF = 128, HTB = HALF * BK * 2, STAGE_BYTES = 8 * HTB, NXCD = 8, WGM = 8;
__host__ __device__ __forceinline__ int lds_byte(int r, int c) { const int st = (r >> 4) * 2 + (c >> 5), rr = r & 15, cc = c & 31, ob = rr * 64 + cc * 2; return st * 1024 + (ob ^ (((ob >> 9) & 1) << 5)); }
__host__ __device__ __forceinline__ void stage_rc(int b, int& R, int& C) { const int st = b / 1024, sb = b % 1024, swz = sb ^ (((sb >> 9) & 1) << 5); R = (st >> 1) * 16 + swz / 64; C = (st & 1) * 32 + (swz % 64) / 2; }
__host__ __device__ __forceinline__ int perm32(int rho) { const int n = rho >> 4, i = rho & 15; return 8 * (i >> 2) + 4 * n + (i & 3); }

struct Unit { int pm, pn; };
struct Gemm { const bf16_t* A; const bf16_t* Bt; int M, N, K; };

struct StaticOrder {
    int nM, nN, nwg, G, c;
    __host__ __device__ void init(int M, int N, int G_, int c_) { nM = M / BM; nN = N / BM; nwg = nM * nN; G = G_; c = c_; }
    __host__ __device__ bool next(int i, Unit& u) const {
        const long L = (long)i * G + c; if (L >= nwg) return false;
        int wgid = (int)L; { const int q = nwg / NXCD, r = nwg % NXCD, xcd = wgid % NXCD, off = wgid / NXCD; wgid = (xcd < r ? xcd * (q + 1) : r * (q + 1) + (xcd - r) * q) + off; }
        const int nig = WGM * nN, gid = wgid / nig, fm = gid * WGM, gsz = (nM - fm) < WGM ? (nM - fm) : WGM;
        u.pm = fm + ((wgid % nig) % gsz); u.pn = (wgid % nig) / gsz; return true;
    }
    __device__ __forceinline__ void a_ready(const Unit&) const {}
    __device__ __forceinline__ void done(const Unit&) const {}
};

template <int ACT  > struct EpiBf16 {
    static constexpr bool PERM = true, AFTER_DRAIN = false;
    bf16_t* O; int ldc;
    __device__ __forceinline__ void operator()(const f32x4 (&acc)[2][2][4][2], const Unit& u, int wr, int wc, int fr, int fq) const {
        const int row0 = u.pm * BM + wr * 64 + fr; const int col0 = u.pn * BM + wc * 32 + 8 * fq;
#pragma unroll
        for (int ai = 0; ai < 2; ++ai)
#pragma unroll
            for (int m = 0; m < 4; ++m) { bf16_t* rowp = O + (size_t)(row0 + ai * HALF + m * 16) * ldc + col0;
#pragma unroll
                for (int bj = 0; bj < 2; ++bj) { f32x4 v0 = acc[ai][bj][m][0], v1 = acc[ai][bj][m][1];
                    if (ACT == 1) {
#pragma unroll
                        for (int e = 0; e < 4; ++e) { float a0 = fmaxf(v0[e], 0.f), a1 = fmaxf(v1[e], 0.f); v0[e] = a0 * a0; v1[e] = a1 * a1; } }
                    u32x4 w; w.x = pk2(v0[0], v0[1]); w.y = pk2(v0[2], v0[3]); w.z = pk2(v1[0], v1[1]); w.w = pk2(v1[2], v1[3]);
                    *(u32x4*)(rowp + bj * HALF) = w; } }
    }
};
struct EpiResGate {
    static constexpr bool PERM = true, AFTER_DRAIN = false;
    const float* res; float* out; const float* gate;
    __device__ __forceinline__ void operator()(const f32x4 (&acc)[2][2][4][2], const Unit& u, int wr, int wc, int fr, int fq) const {
        const int row0 = u.pm * BM + wr * 64 + fr; const int col0 = u.pn * BM + wc * 32 + 8 * fq;
        const float* g = gate + (size_t)(u.pm >> 4) * NMOD + col0;
        f32x4 gv[2][2];
#pragma unroll
        for (int bj = 0; bj < 2; ++bj) { gv[bj][0] = *(const f32x4*)(g + bj * HALF); gv[bj][1] = *(const f32x4*)(g + bj * HALF + 4); }
#pragma unroll
        for (int ai = 0; ai < 2; ++ai)
#pragma unroll
            for (int m = 0; m < 4; ++m) { const size_t p = (size_t)(row0 + ai * HALF + m * 16) * DM + col0;
#pragma unroll
                for (int bj = 0; bj < 2; ++bj) {
                    const f32x4 r0 = *(const f32x4*)(res + p + bj * HALF), r1 = *(const f32x4*)(res + p + bj * HALF + 4);
                    *(f32x4*)(out + p + bj * HALF) = r0 + gv[bj][0] * acc[ai][bj][m][0];
                    *(f32x4*)(out + p + bj * HALF + 4) = r1 + gv[bj][1] * acc[ai][bj][m][1]; } }
    }
};

struct EpiResGateNorm {
    static constexpr bool PERM = true, AFTER_DRAIN = false;
    const float* res; bf16_t* out; const float* gate; const float* nw; const float* scale; bf16_t* A2; float* sumsq;
    __device__ __forceinline__ void operator()(const f32x4 (&acc)[2][2][4][2], const Unit& u, int wr, int wc, int fr, int fq) const {
        const int row0 = u.pm * BM + wr * 64 + fr; const int col0 = u.pn * BM + wc * 32 + 8 * fq;
        const float* g = gate + (size_t)(u.pm >> 4) * NMOD + col0; const float* sc = scale + (size_t)(u.pm >> 4) * NMOD + col0;
        f32x4 gv[2][2], gm[2][2];
#pragma unroll
        for (int bj = 0; bj < 2; ++bj)
#pragma unroll
            for (int q = 0; q < 2; ++q) { gv[bj][q] = *(const f32x4*)(g + bj * HALF + 4 * q);
                gm[bj][q] = *(const f32x4*)(nw + col0 + bj * HALF + 4 * q) * (*(const f32x4*)(sc + bj * HALF + 4 * q) + 1.0f); }
#pragma unroll
        for (int ai = 0; ai < 2; ++ai)
#pragma unroll
            for (int m = 0; m < 4; ++m) { const int row = row0 + ai * HALF + m * 16; const size_t p = (size_t)row * DM + col0; float ss = 0.f;
#pragma unroll
                for (int bj = 0; bj < 2; ++bj) {
                    const f32x4 x0 = *(const f32x4*)(res + p + bj * HALF) + gv[bj][0] * acc[ai][bj][m][0], x1 = *(const f32x4*)(res + p + bj * HALF + 4) + gv[bj][1] * acc[ai][bj][m][1];
                    { u32x4 xw; xw.x = pk2(x0.x, x0.y); xw.y = pk2(x0.z, x0.w); xw.z = pk2(x1.x, x1.y); xw.w = pk2(x1.z, x1.w); *(u32x4*)(out + p + bj * HALF) = xw; }
                    ss += (x0.x * x0.x + x0.y * x0.y) + (x0.z * x0.z + x0.w * x0.w) + (x1.x * x1.x + x1.y * x1.y) + (x1.z * x1.z + x1.w * x1.w);
                    const f32x4 a0 = x0 * gm[bj][0], a1 = x1 * gm[bj][1];
                    u32x4 w; w.x = pk2(a0.x, a0.y); w.y = pk2(a0.z, a0.w); w.z = pk2(a1.x, a1.y); w.w = pk2(a1.z, a1.w);
                    *(u32x4*)(A2 + p + bj * HALF) = w; }
                ss += __shfl_xor(ss, 16); ss += __shfl_xor(ss, 32);
                if (fq == 0) unsafeAtomicAdd(sumsq + row, ss); }
    }
};
struct EpiResGateBf {
    static constexpr bool PERM = true, AFTER_DRAIN = false;
    bf16_t* X; const float* gate;
    __device__ __forceinline__ void operator()(const f32x4 (&acc)[2][2][4][2], const Unit& u, int wr, int wc, int fr, int fq) const {
        const int row0 = u.pm * BM + wr * 64 + fr; const int col0 = u.pn * BM + wc * 32 + 8 * fq;
        const float* g = gate + (size_t)(u.pm >> 4) * NMOD + col0;
        f32x4 gv[2][2];
#pragma unroll
        for (int bj = 0; bj < 2; ++bj) { gv[bj][0] = *(const f32x4*)(g + bj * HALF); gv[bj][1] = *(const f32x4*)(g + bj * HALF + 4); }
#pragma unroll
        for (int ai = 0; ai < 2; ++ai)
#pragma unroll
            for (int m = 0; m < 4; ++m) { bf16_t* rp = X + (size_t)(row0 + ai * HALF + m * 16) * DM + col0;
#pragma unroll
                for (int bj = 0; bj < 2; ++bj) {
                    const u32x4 xr = *(const u32x4*)(rp + bj * HALF);
                    const f32x4 r0 = (f32x4){bflo(xr.x), bfhi(xr.x), bflo(xr.y), bfhi(xr.y)}, r1 = (f32x4){bflo(xr.z), bfhi(xr.z), bflo(xr.w), bfhi(xr.w)};
                    const f32x4 y0 = r0 + gv[bj][0] * acc[ai][bj][m][0], y1 = r1 + gv[bj][1] * acc[ai][bj][m][1];
                    u32x4 w; w.x = pk2(y0.x, y0.y); w.y = pk2(y0.z, y0.w); w.z = pk2(y1.x, y1.y); w.w = pk2(y1.z, y1.w);
                    *(u32x4*)(rp + bj * HALF) = w; } }
    }
};
struct EpiFf1 {
    static constexpr bool PERM = true, AFTER_DRAIN = false;
    bf16_t* O; int ldc; const float* sumsq; const float* cvec;
    __device__ __forceinline__ void operator()(const f32x4 (&acc)[2][2][4][2], const Unit& u, int wr, int wc, int fr, int fq) const {
        const int row0 = u.pm * BM + wr * 64 + fr; const int col0 = u.pn * BM + wc * 32 + 8 * fq;
        const float* cv = cvec + (size_t)(u.pm >> 4) * DFF + col0;
        f32x4 cq[2][2];
#pragma unroll
        for (int bj = 0; bj < 2; ++bj)
#pragma unroll
            for (int q = 0; q < 2; ++q) cq[bj][q] = *(const f32x4*)(cv + bj * HALF + 4 * q);
#pragma unroll
        for (int ai = 0; ai < 2; ++ai)
#pragma unroll
            for (int m = 0; m < 4; ++m) { const int row = row0 + ai * HALF + m * 16; bf16_t* rowp = O + (size_t)row * ldc + col0;
                const float rstd = 1.0f / sqrtf(sumsq[row] * (1.f / DM) + EPS);
#pragma unroll
                for (int bj = 0; bj < 2; ++bj) { f32x4 v0 = acc[ai][bj][m][0] * rstd + cq[bj][0], v1 = acc[ai][bj][m][1] * rstd + cq[bj][1];
#pragma unroll
                    for (int e = 0; e < 4; ++e) { const float a0 = fmaxf(v0[e], 0.f), a1 = fmaxf(v1[e], 0.f); v0[e] = a0 * a0; v1[e] = a1 * a1; }
                    u32x4 w; w.x = pk2(v0[0], v0[1]); w.y = pk2(v0[2], v0[3]); w.z = pk2(v1[0], v1[1]); w.w = pk2(v1[2], v1[3]);
                    *(u32x4*)(rowp + bj * HALF) = w; } }
    }
};

template <class Epi, class Sched, bool ALIGN_EPI = false, bool SP2 = false>
__device__ __forceinline__ void gemm_phase(LAS unsigned char* lds, const Gemm g, const Sched& S, const Epi& E, int wv) {
    const int wid = wv, lane = lane_id(), tid = wv * 64 + lane, wr = wid >> 2, wc = wid & 3, fr = lane & 15, fq = lane >> 4;
    const int K = g.K, nt = K / BK;
    unsigned voffA[2], voffB[2];
#pragma unroll
    for (int i = 0; i < 2; ++i) { int R, C; stage_rc(tid * 16 + i * 8192, R, C); const int Rb = Epi::PERM ? ((R & ~31) + perm32(R & 31)) : R;
        voffA[i] = (unsigned)(R * K + C) * 2u; voffB[i] = (unsigned)(Rb * K + C) * 2u; }
    const size_t kstep = (size_t)(BK * 2);
    const size_t hstep = (size_t)HALF * K * 2;
    const size_t tstep = 2 * hstep;
    const unsigned ldsw = (unsigned)wid * 1024u;
    const int aoff = lds_byte(wr * 64 + fr, fq * 8), boff = lds_byte(wc * 32 + fr, fq * 8);
#define PG8_SA(b, h) (((b) * 2 + (h)) * HTB)
#define PG8_SB(b, h) ((4 + (b) * 2 + (h)) * HTB)
#define PG8_STAGE(bufoff, gbase, voff) do { _Pragma("unroll") for (int _i = 0; _i < 2; ++_i) \
        __builtin_amdgcn_global_load_lds((const unsigned*)((const char*)(gbase) + (voff)[_i]), (LAS unsigned*)(lds + (bufoff) + ldsw + _i * 8192), 16, 0, 0); } while (0)
#define PG8_LDA(dst, b, h) do { _Pragma("unroll") for (int m = 0; m < 4; ++m) _Pragma("unroll") for (int k = 0; k < 2; ++k) dst[m][k] = *(const LAS bf16x8*)(lds + PG8_SA(b, h) + aoff + m * 2048 + k * 1024); } while (0)
#define PG8_LDB(dst, b, h) do { _Pragma("unroll") for (int n = 0; n < 2; ++n) _Pragma("unroll") for (int k = 0; k < 2; ++k) dst[n][k] = *(const LAS bf16x8*)(lds + PG8_SB(b, h) + boff + n * 2048 + k * 1024); } while (0)
#define PG8_MMA(ai, bj, At, Bt) do { __builtin_amdgcn_s_setprio(1); _Pragma("unroll") for (int m = 0; m < 4; ++m) _Pragma("unroll") for (int n = 0; n < 2; ++n) _Pragma("unroll") for (int k = 0; k < 2; ++k) \
        acc[ai][bj][m][n] = __builtin_amdgcn_mfma_f32_16x16x32_bf16(Bt[n][k], At[m][k], acc[ai][bj][m][n], 0, 0, 0); __builtin_amdgcn_s_setprio(0); } while (0)
#define PG8_WAIT_V(n) asm volatile("s_waitcnt vmcnt(" #n ")" ::: "memory")
#define PG8_WAIT_L(n) asm volatile("s_waitcnt lgkmcnt(" #n ")" ::: "memory")
#define PG8_BAR __builtin_amdgcn_s_barrier()
#define PG8_SCHED __builtin_amdgcn_sched_barrier(0)
    Unit cur, nxt; int ui = 0;
    if (!S.next(0, cur)) return;
    f32x4 acc[2][2][4][2];
#pragma unroll
    for (int a = 0; a < 2; ++a)
#pragma unroll
        for (int b = 0; b < 2; ++b)
#pragma unroll
            for (int m = 0; m < 4; ++m)
#pragma unroll
                for (int n = 0; n < 2; ++n) acc[a][b][m][n] = (f32x4){0.f, 0.f, 0.f, 0.f};
    bf16x8 At[4][2], B0[2][2], B1[2][2];
    const char* cA = (const char*)g.A + (size_t)cur.pm * tstep; const char* cB = (const char*)g.Bt + (size_t)cur.pn * tstep;
    S.a_ready(cur);
    if constexpr (SP2) {
        PG8_STAGE(PG8_SB(0, 0), cB, voffB); PG8_STAGE(PG8_SB(0, 1), cB + hstep, voffB); PG8_STAGE(PG8_SA(0, 0), cA, voffA); PG8_STAGE(PG8_SA(0, 1), cA + hstep, voffA);
        if (wr == 1) PG8_BAR;
        PG8_WAIT_V(2); PG8_BAR;
        PG8_STAGE(PG8_SB(1, 0), cB + kstep, voffB); PG8_STAGE(PG8_SA(1, 0), cA + kstep, voffA); PG8_STAGE(PG8_SB(1, 1), cB + hstep + kstep, voffB);
        PG8_WAIT_V(6); PG8_BAR;
    } else {
        PG8_STAGE(PG8_SB(0, 0), cB, voffB); PG8_STAGE(PG8_SA(0, 0), cA, voffA); PG8_STAGE(PG8_SB(0, 1), cB + hstep, voffB); PG8_STAGE(PG8_SA(0, 1), cA + hstep, voffA);
        if (wr == 1) PG8_BAR;
        PG8_WAIT_V(4); PG8_BAR;
        PG8_STAGE(PG8_SB(1, 0), cB + kstep, voffB); PG8_STAGE(PG8_SA(1, 0), cA + kstep, voffA); PG8_STAGE(PG8_SB(1, 1), cB + hstep + kstep, voffB);
        PG8_WAIT_V(6); PG8_BAR;
    }
    for (;;) {
        const bool has_next = S.next(ui + 1, nxt);
        const char* nA = has_next ? (const char*)g.A + (size_t)nxt.pm * tstep : cA; const char* nB = has_next ? (const char*)g.Bt + (size_t)nxt.pn * tstep : cB;
        for (int t = 0; t < nt; t += 2) {
            const bool last = (t == nt - 2);
            const char* a1 = cA + (size_t)(t + 1) * kstep;
            const char* a2 = last ? nA : cA + (size_t)(t + 2) * kstep; const char* b2 = last ? nB : cB + (size_t)(t + 2) * kstep;
            const char* a3 = a2 + kstep; const char* b3 = b2 + kstep;
            if (last && has_next) S.a_ready(nxt);
            if constexpr (SP2) {
            PG8_LDB(B0, 0, 0); PG8_LDB(B1, 0, 1); PG8_SCHED; PG8_LDA(At, 0, 0); PG8_STAGE(PG8_SA(1, 1), a1 + hstep, voffA);
            PG8_WAIT_V(8); PG8_WAIT_L(0); PG8_BAR; PG8_MMA(0, 0, At, B0); PG8_MMA(0, 1, At, B1); PG8_BAR; PG8_SCHED;
            PG8_LDA(At, 0, 1); PG8_STAGE(PG8_SB(0, 0), b2, voffB); PG8_STAGE(PG8_SB(0, 1), b2 + hstep, voffB); PG8_STAGE(PG8_SA(0, 0), a2, voffA);
            PG8_WAIT_V(8); PG8_WAIT_L(0); PG8_BAR; PG8_MMA(1, 0, At, B0); PG8_MMA(1, 1, At, B1); PG8_BAR; PG8_SCHED;
            PG8_LDB(B0, 1, 0); PG8_LDB(B1, 1, 1); PG8_SCHED; PG8_LDA(At, 1, 0); PG8_STAGE(PG8_SA(0, 1), a2 + hstep, voffA);
            PG8_WAIT_V(8); PG8_WAIT_L(0); PG8_BAR; PG8_MMA(0, 0, At, B0); PG8_MMA(0, 1, At, B1); PG8_BAR; PG8_SCHED;
            PG8_LDA(At, 1, 1); PG8_STAGE(PG8_SB(1, 0), b3, voffB); PG8_STAGE(PG8_SB(1, 1), b3 + hstep, voffB); PG8_STAGE(PG8_SA(1, 0), a3, voffA);
            PG8_WAIT_V(8); PG8_WAIT_L(0); PG8_BAR; PG8_MMA(1, 0, At, B0); PG8_MMA(1, 1, At, B1); PG8_BAR; PG8_SCHED;
            } else {
            PG8_LDB(B0, 0, 0); PG8_SCHED; PG8_LDA(At, 0, 0); PG8_STAGE(PG8_SA(1, 1), a1 + hstep, voffA);
            PG8_WAIT_L(8); PG8_BAR; PG8_WAIT_L(0); PG8_MMA(0, 0, At, B0); PG8_BAR; PG8_SCHED;
            PG8_LDB(B1, 0, 1); PG8_STAGE(PG8_SB(0, 0), b2, voffB);
            PG8_BAR; PG8_WAIT_L(0); PG8_MMA(0, 1, At, B1); PG8_BAR;
            PG8_LDA(At, 0, 1); PG8_STAGE(PG8_SA(0, 0), a2, voffA);
            PG8_BAR; PG8_WAIT_L(0); PG8_MMA(1, 0, At, B0); PG8_BAR; PG8_SCHED;
            PG8_STAGE(PG8_SB(0, 1), b2 + hstep, voffB);
            PG8_WAIT_V(6); PG8_BAR; PG8_MMA(1, 1, At, B1); PG8_BAR;
            PG8_LDB(B0, 1, 0); PG8_SCHED; PG8_LDA(At, 1, 0); PG8_STAGE(PG8_SA(0, 1), a2 + hstep, voffA);
            PG8_WAIT_L(8); PG8_BAR; PG8_WAIT_L(0); PG8_MMA(0, 0, At, B0); PG8_BAR; PG8_SCHED;
            PG8_LDB(B1, 1, 1); PG8_STAGE(PG8_SB(1, 0), b3, voffB);
            PG8_BAR; PG8_WAIT_L(0); PG8_MMA(0, 1, At, B1); PG8_BAR;
            PG8_LDA(At, 1, 1); PG8_STAGE(PG8_SA(1, 0), a3, voffA);
            PG8_BAR; PG8_WAIT_L(0); PG8_MMA(1, 0, At, B0); PG8_BAR; PG8_SCHED;
            PG8_STAGE(PG8_SB(1, 1), b3 + hstep, voffB);
            PG8_WAIT_V(6); PG8_BAR; PG8_MMA(1, 1, At, B1); PG8_BAR;
            }
        }
        if constexpr (ALIGN_EPI) { if (wr == 0) PG8_BAR; }
        if constexpr (!Epi::AFTER_DRAIN) { E(acc, cur, wr, wc, fr, fq); S.done(cur); }
        if (!has_next) break;
#pragma unroll
        for (int a = 0; a < 2; ++a)
#pragma unroll
            for (int b = 0; b < 2; ++b)
#pragma unroll
                for (int m = 0; m < 4; ++m)
#pragma unroll
                    for (int n = 0; n < 2; ++n) acc[a][b][m][n] = (f32x4){0.f, 0.f, 0.f, 0.f};
        cur = nxt; cA = nA; cB = nB; ++ui;
        if constexpr (ALIGN_EPI) { if (wr == 1) PG8_BAR; }
    }
    PG8_WAIT_V(0);
    if constexpr (!ALIGN_EPI) { if (wr == 0) PG8_BAR; }
    PG8_BAR;
#undef PG8_SA
#undef PG8_SB
#undef PG8_STAGE
#undef PG8_LDA
#undef PG8_LDB
#undef PG8_MMA
#undef PG8_WAIT_V
#undef PG8_WAIT_L
#undef PG8_BAR
#undef PG8_SCHED
}
}

DI void p0_transpose_job(const float* W, int ldn, int K, bf16_t* WT, int kb, int nb, LAS unsigned char* lds, int wv) {
    LAS float* tile = (LAS float*)lds;
    const int tid = wv * 64 + lane_id(), k0 = kb * 64, n0 = nb * 256;
    f32x4 v[8];
#pragma unroll
    for (int i = 0; i < 8; ++i) v[i] = *(const f32x4*)(W + (size_t)(k0 + (tid >> 6) + 8 * i) * ldn + n0 + (tid & 63) * 4);
#pragma unroll
    for (int i = 0; i < 8; ++i) { LAS float* t = tile + ((tid >> 6) + 8 * i) * 257 + (tid & 63) * 4; t[0] = v[i].x; t[1] = v[i].y; t[2] = v[i].z; t[3] = v[i].w; }
    __syncthreads();
#pragma unroll
    for (int j = 0; j < 4; ++j) { const int n = (tid >> 3) + 64 * j, k8 = (tid & 7) * 8; const LAS float* s = tile + k8 * 257 + n;
      u32x4 o; o.x = pk2(s[0], s[257]); o.y = pk2(s[2 * 257], s[3 * 257]); o.z = pk2(s[4 * 257], s[5 * 257]); o.w = pk2(s[6 * 257], s[7 * 257]);
      *(u32x4*)(WT + (size_t)(n0 + n) * K + k0 + k8) = o; }
    __syncthreads();
}
DI void p0_phase(const Args& a, LAS unsigned char* lds, int wv) {
    const int tid = wv * 64 + lane_id(), G = gridDim.x, blk = blockIdx.x;
    for (int i = blk * 512 + tid; i < MROWS; i += G * 512) ((float*)(a.ws + WS_SUMSQ))[i] = 0.f;
    for (int cg_ = blk; cg_ < NMOD / 32; cg_ += G) {
        LAS float* sc = (LAS float*)lds;
        LAS float* red = (LAS float*)(lds + 32768);
        for (int i = tid; i < 8192; i += 512) sc[i] = silu_f(a.c[i]);
        __syncthreads();
        const int ks = tid >> 5, col = tid & 31, j0 = cg_ * 32;
        float acc[8];
#pragma unroll
        for (int b = 0; b < 8; ++b) acc[b] = 0.f;
#pragma unroll 16
        for (int kk = 0; kk < 64; ++kk) { const int k = ks * 64 + kk; const float w = a.ada_w[(size_t)k * NMOD + j0 + col];
#pragma unroll
            for (int b = 0; b < 8; ++b) acc[b] += sc[b * 1024 + k] * w; }
#pragma unroll
        for (int b = 0; b < 8; ++b) red[(ks * 8 + b) * 32 + col] = acc[b];
        __syncthreads();
        if (tid < 256) { const int b = tid >> 5, cc = tid & 31; float s = a.ada_b[j0 + cc];
#pragma unroll
            for (int q = 0; q < 16; ++q) s += red[(q * 8 + b) * 32 + cc];
            ((float*)(a.ws + WS_MOD))[b * NMOD + j0 + cc] = s; }
        __syncthreads();
    }
    constexpr int J_IN = 16 * 16, J_OUT = 16 * 4, J_F1 = 16 * 16, J_F2 = 64 * 4, NJ = J_IN + J_OUT + J_F1 + J_F2;
    for (int j = (blk + 64) % G; j < NJ; j += G) {
        int r = j;
        if (r < J_IN) { p0_transpose_job(a.w_in, DIN, 1024, (bf16_t*)(a.ws + WS_WIN), r / 16, r % 16, lds, wv); continue; } r -= J_IN;
        if (r < J_OUT) { p0_transpose_job(a.w_out, 1024, 1024, (bf16_t*)(a.ws + WS_WOUT), r / 4, r % 4, lds, wv); continue; } r -= J_OUT;
        if (r < J_F1) { p0_transpose_job(a.w_ff1, 4096, 1024, (bf16_t*)(a.ws + WS_WFF1), r / 16, r % 16, lds, wv); continue; } r -= J_F1;
        p0_transpose_job(a.w_ff2, 1024, 4096, (bf16_t*)(a.ws + WS_WFF2), r / 4, r % 4, lds, wv);
    }
}

template <bool GAB>
DI void norm_mod_phase(const float* src, const float* nw, const float* mod, int shift_off, int scale_off, bf16_t* dst, const float* w_in, float* gab, LAS unsigned char* lds, int wv) {
    const int lane = lane_id(), wave = wv, tid = wv * 64 + lane;
    LAS float* W8 = (LAS float*)lds;
    if (GAB) { for (int i = tid; i < 8192; i += 512) { const int k = i >> 3, j = i & 7; W8[j * 1024 + k] = w_in[(size_t)k * DIN + 4096 + j]; } __syncthreads(); }
    const int gw = blockIdx.x * 8 + wave, NGW = gridDim.x * 8, c0 = lane * 8;
    f32x4 nwv[2][2];
#pragma unroll
    for (int i = 0; i < 2; ++i)
#pragma unroll
        for (int q = 0; q < 2; ++q) nwv[i][q] = *(const f32x4*)(nw + c0 + 512 * i + 4 * q);
    for (int m = gw; m < MROWS; m += NGW) {
        const float* xr = src + (size_t)m * DM;
        f32x4 v[2][2]; float ss = 0.f;
#pragma unroll
        for (int i = 0; i < 2; ++i)
#pragma unroll
            for (int q = 0; q < 2; ++q) { v[i][q] = *(const f32x4*)(xr + c0 + 512 * i + 4 * q); ss += (v[i][q].x * v[i][q].x + v[i][q].y * v[i][q].y) + (v[i][q].z * v[i][q].z + v[i][q].w * v[i][q].w); }
        ss = wave_sum(ss);
        const float rstd = 1.0f / sqrtf(ss * (1.f / DM) + EPS);
        const float* sh = mod + (size_t)(m >> 12) * NMOD + shift_off; const float* sc = mod + (size_t)(m >> 12) * NMOD + scale_off;
        float p[8];
#pragma unroll
        for (int j = 0; j < 8; ++j) p[j] = 0.f;
#pragma unroll
        for (int i = 0; i < 2; ++i) {
            f32x4 hq[2];
#pragma unroll
            for (int q = 0; q < 2; ++q) { const f32x4 shv = *(const f32x4*)(sh + c0 + 512 * i + 4 * q), scv = *(const f32x4*)(sc + c0 + 512 * i + 4 * q);
                hq[q] = v[i][q] * rstd * nwv[i][q] * (scv + 1.0f) + shv; }
            u32x4 w; w.x = pk2(hq[0].x, hq[0].y); w.y = pk2(hq[0].z, hq[0].w); w.z = pk2(hq[1].x, hq[1].y); w.w = pk2(hq[1].z, hq[1].w);
            *(u32x4*)(dst + (size_t)m * DM + c0 + 512 * i) = w;
            if (GAB) {
#pragma unroll
                for (int q = 0; q < 2; ++q)
#pragma unroll
                    for (int j = 0; j < 8; ++j) { const f32x4 wv = *(const LAS f32x4*)(W8 + j * 1024 + c0 + 512 * i + 4 * q);
                        p[j] += (hq[q].x * wv.x + hq[q].y * wv.y) + (hq[q].z * wv.z + hq[q].w * wv.w); } }
        }
        if (GAB) {
#pragma unroll
            for (int j = 0; j < 8; ++j) p[j] = wave_sum(p[j]);
            if (lane == 0) { *(f32x4*)(gab + (size_t)m * 8) = (f32x4){p[0], p[1], p[2], p[3]}; *(f32x4*)(gab + (size_t)m * 8 + 4) = (f32x4){p[4], p[5], p[6], p[7]}; }
        }
    }
    if (GAB) __syncthreads();
}

DI int pinv16(int d) { return ((d >> 2) & 1) * 8 + (d >> 3) * 4 + (d & 3); }
constexpr int P3_Q = 0, P3_K = 17408, P3_V = 34816, P3_L = 52224, P3_GC = 69632, P3_BETA = 69888, P3_BE = 70144;
DI u32x4 pack16lo(const float* v) { u32x4 o; o.x = pk2(v[0], v[1]); o.y = pk2(v[2], v[3]); o.z = pk2(v[8], v[9]); o.w = pk2(v[10], v[11]); return o; }
DI u32x4 pack16hi(const float* v) { u32x4 o; o.x = pk2(v[4], v[5]); o.y = pk2(v[6], v[7]); o.z = pk2(v[12], v[13]); o.w = pk2(v[14], v[15]); return o; }

constexpr int P3_CW = 126976;
DI void conv_silu16(const bf16_t* proj, const LAS float* cwl, int b, int tpos, int colbase, int chl, float* val) {
#pragma unroll
    for (int e = 0; e < 16; ++e) val[e] = 0.f;
#pragma unroll
    for (int w = 0; w < 4; ++w) {
        const int tt = tpos - 3 + w;
        if (tt >= 0) {
            const bf16_t* src = proj + (size_t)(b * SEQ + tt) * NPROJ + colbase;
            const u32x4 x0 = *(const u32x4*)src, x1 = *(const u32x4*)(src + 8);
            const LAS float* cw = cwl + w * 128 + chl;
            const f32x4 c0 = *(const LAS f32x4*)cw, c1 = *(const LAS f32x4*)(cw + 4), c2 = *(const LAS f32x4*)(cw + 8), c3 = *(const LAS f32x4*)(cw + 12);
            val[0] += c0.x * bflo(x0.x); val[1] += c0.y * bfhi(x0.x); val[2] += c0.z * bflo(x0.y); val[3] += c0.w * bfhi(x0.y);
            val[4] += c1.x * bflo(x0.z); val[5] += c1.y * bfhi(x0.z); val[6] += c1.z * bflo(x0.w); val[7] += c1.w * bfhi(x0.w);
            val[8] += c2.x * bflo(x1.x); val[9] += c2.y * bfhi(x1.x); val[10] += c2.z * bflo(x1.y); val[11] += c2.w * bfhi(x1.y);
            val[12] += c3.x * bflo(x1.z); val[13] += c3.y * bfhi(x1.z); val[14] += c3.z * bflo(x1.w); val[15] += c3.w * bfhi(x1.w);
        }
    }
#pragma unroll
    for (int e = 0; e < 16; ++e) val[e] = silu_f(val[e]);
}
DI void st16_lds(LAS unsigned char* p, const float* v) {
    u32x4 o0, o1; o0.x = pk2(v[0], v[1]); o0.y = pk2(v[2], v[3]); o0.z = pk2(v[4], v[5]); o0.w = pk2(v[6], v[7]);
    o1.x = pk2(v[8], v[9]); o1.y = pk2(v[10], v[11]); o1.z = pk2(v[12], v[13]); o1.w = pk2(v[14], v[15]);
    *(LAS u32x4*)p = o0; *(LAS u32x4*)(p + 16) = o1;
}
DI float red8(float v) { v += __shfl_xor(v, 1); v += __shfl_xor(v, 2); v += __shfl_xor(v, 4); return v; }

DI void p3_ret_half(const Args& a, LAS unsigned char* lds, int b, int n, int h, int t2in);
DI void p3_pair_item(const Args& a, LAS unsigned char* lds, int b, int n, int h, int rb, int rn, int rh, int wv) {
    int tid_ = wv * 64 + lane_id(); asm volatile("" : "+v"(tid_));
    const int tid = tid_, lane = tid & 63, wave = tid >> 6;
    const bf16_t* proj = (const bf16_t*)(a.ws + WS_PROJ);
    const float* gab = (const float*)(a.ws + WS_GAB);
    const int bh = b * 4 + h;
    unsigned char* rec = a.ws + WS_GREC + (size_t)(bh * 64 + n) * GREC;
    bf16_t* uT = (bf16_t*)rec; bf16_t* wG = (bf16_t*)(rec + 16384); bf16_t* qgG = (bf16_t*)(rec + 32768); bf16_t* kdT = (bf16_t*)(rec + 49152); bf16_t* atG = (bf16_t*)(rec + 65536);
    LAS float* gcs = (LAS float*)(lds + P3_GC); LAS float* betas = (LAS float*)(lds + P3_BETA); LAS float* bes = (LAS float*)(lds + P3_BE); LAS float* Ls = (LAS float*)(lds + P3_L);
    if (wave == 0) {
        const size_t m = (size_t)b * SEQ + n * 64 + lane;
        const float ga = gab[m * 8 + h], gb = gab[m * 8 + 4 + h];
        const float beta = 1.f / (1.f + __expf(-gb));
        const float xx = ga + a.dt_bias[h];
        const float sp = fmaxf(xx, 0.f) + log1pf(__expf(-fabsf(xx)));
        float g = -__expf(a.a_log[h]) * sp;
#pragma unroll
        for (int o = 1; o < 64; o <<= 1) { const float t = __shfl_up(g, o); if (lane >= o) g += t; }
        gcs[lane] = g; betas[lane] = beta; bes[lane] = beta * __expf(g);
    }
    const int r = tid >> 3, cb = tid & 7, c0 = cb * 16, tpos = n * 64 + r;
    float qv[16];
    {
        conv_silu16(proj, (const LAS float*)(lds + P3_CW), b, tpos, 2048 + h * 128 + c0, c0, qv);
        float ss = 0.f;
#pragma unroll
        for (int e = 0; e < 16; ++e) ss += qv[e] * qv[e];
        ss = red8(ss); const float rn = (1.0f / sqrtf(ss + EPS)) * 0.08838834764831845f;
#pragma unroll
        for (int e = 0; e < 16; ++e) qv[e] *= rn;
        st16_lds(lds + P3_Q + r * 272 + c0 * 2, qv);
    }
    {
        float kv[16];
        conv_silu16(proj, (const LAS float*)(lds + P3_CW) + 512, b, tpos, 2560 + h * 128 + c0, c0, kv);
        float ss = 0.f;
#pragma unroll
        for (int e = 0; e < 16; ++e) ss += kv[e] * kv[e];
        ss = red8(ss); const float rn = 1.0f / sqrtf(ss + EPS);
#pragma unroll
        for (int e = 0; e < 16; ++e) kv[e] *= rn;
        st16_lds(lds + P3_K + r * 272 + c0 * 2, kv);
    }
    {
        float vv[16];
        conv_silu16(proj, (const LAS float*)(lds + P3_CW) + 1024, b, tpos, 3072 + h * 128 + c0, c0, vv);
        st16_lds(lds + P3_V + r * 272 + c0 * 2, vv);
    }
    __syncthreads();
    {
        const float eg = __expf(gcs[r]);
#pragma unroll
        for (int e = 0; e < 16; ++e) qv[e] *= eg;
        *(u32x4*)(qgG + r * 128 + c0) = pack16lo(qv); *(u32x4*)(qgG + r * 128 + c0 + 8) = pack16hi(qv);
    }
#pragma unroll
    for (int i = 0; i < 4; ++i) {
        const int ti = wave * 4 + i, mat = ti >> 4, mt = (ti >> 2) & 3, nt = ti & 3;
        const LAS unsigned char* Ab = lds + (mat ? P3_Q : P3_K) + (16 * mt + (lane & 15)) * 272 + (lane >> 4) * 16;
        const LAS unsigned char* Bb = lds + P3_K + (16 * nt + (lane & 15)) * 272 + (lane >> 4) * 16;
        f32x4 acc = {0.f, 0.f, 0.f, 0.f};
#pragma unroll
        for (int s = 0; s < 4; ++s) acc = __builtin_amdgcn_mfma_f32_16x16x32_bf16(*(const LAS bf16x8*)(Ab + s * 64), *(const LAS bf16x8*)(Bb + s * 64), acc, 0, 0, 0);
        const int jj = 16 * nt + (lane & 15); const float gj = gcs[jj];
#pragma unroll
        for (int j = 0; j < 4; ++j) {
            const int ii = 16 * mt + (lane >> 4) * 4 + j; const float gi = gcs[ii];
            if (mat == 0) { Ls[ii * 68 + jj] = (ii > jj) ? betas[ii] * acc[j] * __expf(gi - gj) : 0.f; }
            else { const float v = (ii >= jj) ? acc[j] * __expf(gi - gj) : 0.f; atG[ii * 64 + (jj & ~15) + pinv16(jj & 15)] = f2bf(v); }
        }
    }
    __syncthreads();
    if (tid < 256) {
        const int col = tid; const bool isu = col < 128;
        int xoff = (isu ? P3_V : P3_K) + 2 * (isu ? col : col - 128), coff = isu ? P3_BETA : P3_BE;
        asm volatile("" : "+v"(xoff), "+v"(coff));
        const LAS unsigned short* Xp = (const LAS unsigned short*)(lds + xoff);
        const LAS float* cf = (const LAS float*)(lds + coff);
        float xs[64];
#pragma unroll
        for (int i = 0; i < 64; ++i) xs[i] = cf[i] * bf2f(Xp[i * 136]);
        f32x4 LB0[12], LB1[12];
        int zlane; asm volatile("v_mov_b32 %0, 0" : "=v"(zlane));
        const LAS float* Lv = Ls + zlane;
#define SOL_L(b, k, off) LB##b[k] = *(const LAS f32x4*)(Lv + (off))
#define SOL_F(i, j, b, k, c) xs[i] = fmaf(-LB##b[k].c, xs[j], xs[i])
        SOL_L(0, 0, 68); SOL_L(0, 1, 136); SOL_L(0, 2, 204); SOL_L(0, 3, 272); SOL_L(0, 4, 340); SOL_L(0, 5, 344); SOL_L(0, 6, 408); SOL_L(0, 7, 412); SOL_L(0, 8, 476); SOL_L(0, 9, 480); SOL_L(0, 10, 544); SOL_L(0, 11, 548);
        SOL_L(1, 0, 612); SOL_L(1, 1, 616); SOL_L(1, 2, 620); SOL_L(1, 3, 680); SOL_L(1, 4, 684); SOL_L(1, 5, 688); SOL_L(1, 6, 748); SOL_L(1, 7, 752); SOL_L(1, 8, 756); SOL_L(1, 9, 816); SOL_L(1, 10, 820); SOL_L(1, 11, 824);
        __builtin_amdgcn_sched_barrier(0);
        SOL_F(1, 0, 0, 0, x);
        SOL_F(2, 0, 0, 1, x); SOL_F(2, 1, 0, 1, y);
        SOL_F(3, 0, 0, 2, x); SOL_F(3, 1, 0, 2, y); SOL_F(3, 2, 0, 2, z);
        SOL_F(4, 0, 0, 3, x); SOL_F(4, 1, 0, 3, y); SOL_F(4, 2, 0, 3, z); SOL_F(4, 3, 0, 3, w);
        SOL_F(5, 0, 0, 4, x); SOL_F(5, 1, 0, 4, y); SOL_F(5, 2, 0, 4, z); SOL_F(5, 3, 0, 4, w);
        SOL_F(5, 4, 0, 5, x);
        SOL_F(6, 0, 0, 6, x); SOL_F(6, 1, 0, 6, y); SOL_F(6, 2, 0, 6, z); SOL_F(6, 3, 0, 6, w);
        SOL_F(6, 4, 0, 7, x); SOL_F(6, 5, 0, 7, y);
        SOL_F(7, 0, 0, 8, x); SOL_F(7, 1, 0, 8, y); SOL_F(7, 2, 0, 8, z); SOL_F(7, 3, 0, 8, w);
        SOL_F(7, 4, 0, 9, x); SOL_F(7, 5, 0, 9, y); SOL_F(7, 6, 0, 9, z);
        SOL_F(8, 0, 0, 10, x); SOL_F(8, 1, 0, 10, y); SOL_F(8, 2, 0, 10, z); SOL_F(8, 3, 0, 10, w);
        SOL_F(8, 4, 0, 11, x); SOL_F(8, 5, 0, 11, y); SOL_F(8, 6, 0, 11, z); SOL_F(8, 7, 0, 11, w);
        __builtin_amdgcn_sched_barrier(0);
        SOL_L(0, 0, 884); SOL_L(0, 1, 888); SOL_L(0, 2, 892); SOL_L(0, 3, 896); SOL_L(0, 4, 952); SOL_L(0, 5, 956); SOL_L(0, 6, 960); SOL_L(0, 7, 964); SOL_L(0, 8, 1020); SOL_L(0, 9, 1024); SOL_L(0, 10, 1028); SOL_L(0, 11, 1032);
        __builtin_amdgcn_sched_barrier(0);
        SOL_F(9, 0, 1, 0, x); SOL_F(9, 1, 1, 0, y); SOL_F(9, 2, 1, 0, z); SOL_F(9, 3, 1, 0, w);
        SOL_F(9, 4, 1, 1, x); SOL_F(9, 5, 1, 1, y); SOL_F(9, 6, 1, 1, z); SOL_F(9, 7, 1, 1, w);
        SOL_F(9, 8, 1, 2, x);
        SOL_F(10, 0, 1, 3, x); SOL_F(10, 1, 1, 3, y); SOL_F(10, 2, 1, 3, z); SOL_F(10, 3, 1, 3, w);
        SOL_F(10, 4, 1, 4, x); SOL_F(10, 5, 1, 4, y); SOL_F(10, 6, 1, 4, z); SOL_F(10, 7, 1, 4, w);
        SOL_F(10, 8, 1, 5, x); SOL_F(10, 9, 1, 5, y);
        SOL_F(11, 0, 1, 6, x); SOL_F(11, 1, 1, 6, y); SOL_F(11, 2, 1, 6, z); SOL_F(11, 3, 1, 6, w);
        SOL_F(11, 4, 1, 7, x); SOL_F(11, 5, 1, 7, y); SOL_F(11, 6, 1, 7, z); SOL_F(11, 7, 1, 7, w);
        SOL_F(11, 8, 1, 8, x); SOL_F(11, 9, 1, 8, y); SOL_F(11, 10, 1, 8, z);
        SOL_F(12, 0, 1, 9, x); SOL_F(12, 1, 1, 9, y); SOL_F(12, 2, 1, 9, z); SOL_F(12, 3, 1, 9, w);
        SOL_F(12, 4, 1, 10, x); SOL_F(12, 5, 1, 10, y); SOL_F(12, 6, 1, 10, z); SOL_F(12, 7, 1, 10, w);
        SOL_F(12, 8, 1, 11, x); SOL_F(12, 9, 1, 11, y); SOL_F(12, 10, 1, 11, z); SOL_F(12, 11, 1, 11, w);
        __builtin_amdgcn_sched_barrier(0);
        SOL_L(1, 0, 1088); SOL_L(1, 1, 1092); SOL_L(1, 2, 1096); SOL_L(1, 3, 1100); SOL_L(1, 4, 1156); SOL_L(1, 5, 1160); SOL_L(1, 6, 1164); SOL_L(1, 7, 1168); SOL_L(1, 8, 1172); SOL_L(1, 9, 1224); SOL_L(1, 10, 1228); SOL_L(1, 11, 1232);
        __builtin_amdgcn_sched_barrier(0);
        SOL_F(13, 0, 0, 0, x); SOL_F(13, 1, 0, 0, y); SOL_F(13, 2, 0, 0, z); SOL_F(13, 3, 0, 0, w);
        SOL_F(13, 4, 0, 1, x); SOL_F(13, 5, 0, 1, y); SOL_F(13, 6, 0, 1, z); SOL_F(13, 7, 0, 1, w);
        SOL_F(13, 8, 0, 2, x); SOL_F(13, 9, 0, 2, y); SOL_F(13, 10, 0, 2, z); SOL_F(13, 11, 0, 2, w);
        SOL_F(13, 12, 0, 3, x);
        SOL_F(14, 0, 0, 4, x); SOL_F(14, 1, 0, 4, y); SOL_F(14, 2, 0, 4, z); SOL_F(14, 3, 0, 4, w);
        SOL_F(14, 4, 0, 5, x); SOL_F(14, 5, 0, 5, y); SOL_F(14, 6, 0, 5, z); SOL_F(14, 7, 0, 5, w);
        SOL_F(14, 8, 0, 6, x); SOL_F(14, 9, 0, 6, y); SOL_F(14, 10, 0, 6, z); SOL_F(14, 11, 0, 6, w);
        SOL_F(14, 12, 0, 7, x); SOL_F(14, 13, 0, 7, y);
        SOL_F(15, 0, 0, 8, x); SOL_F(15, 1, 0, 8, y); SOL_F(15, 2, 0, 8, z); SOL_F(15, 3, 0, 8, w);
        SOL_F(15, 4, 0, 9, x); SOL_F(15, 5, 0, 9, y); SOL_F(15, 6, 0, 9, z); SOL_F(15, 7, 0, 9, w);
        SOL_F(15, 8, 0, 10, x); SOL_F(15, 9, 0, 10, y); SOL_F(15, 10, 0, 10, z); SOL_F(15, 11, 0, 10, w);
        SOL_F(15, 12, 0, 11, x); SOL_F(15, 13, 0, 11, y); SOL_F(15, 14, 0, 11, z);
        __builtin_amdgcn_sched_barrier(0);
        SOL_L(0, 0, 1236); SOL_L(0, 1, 1240); SOL_L(0, 2, 1292); SOL_L(0, 3, 1296); SOL_L(0, 4, 1300); SOL_L(0, 5, 1304); SOL_L(0, 6, 1308); SOL_L(0, 7, 1360); SOL_L(0, 8, 1364); SOL_L(0, 9, 1368); SOL_L(0, 10, 1372); SOL_L(0, 11, 1376);
        __builtin_amdgcn_sched_barrier(0);
        SOL_F(16, 0, 1, 0, x); SOL_F(16, 1, 1, 0, y); SOL_F(16, 2, 1, 0, z); SOL_F(16, 3, 1, 0, w);
        SOL_F(16, 4, 1, 1, x); SOL_F(16, 5, 1, 1, y); SOL_F(16, 6, 1, 1, z); SOL_F(16, 7, 1, 1, w);
        SOL_F(16, 8, 1, 2, x); SOL_F(16, 9, 1, 2, y); SOL_F(16, 10, 1, 2, z); SOL_F(16, 11, 1, 2, w);
        SOL_F(16, 12, 1, 3, x); SOL_F(16, 13, 1, 3, y); SOL_F(16, 14, 1, 3, z); SOL_F(16, 15, 1, 3, w);
        SOL_F(17, 0, 1, 4, x); SOL_F(17, 1, 1, 4, y); SOL_F(17, 2, 1, 4, z); SOL_F(17, 3, 1, 4, w);
        SOL_F(17, 4, 1, 5, x); SOL_F(17, 5, 1, 5, y); SOL_F(17, 6, 1, 5, z); SOL_F(17, 7, 1, 5, w);
        SOL_F(17, 8, 1, 6, x); SOL_F(17, 9, 1, 6, y); SOL_F(17, 10, 1, 6, z); SOL_F(17, 11, 1, 6, w);
        SOL_F(17, 12, 1, 7, x); SOL_F(17, 13, 1, 7, y); SOL_F(17, 14, 1, 7, z); SOL_F(17, 15, 1, 7, w);
        SOL_F(17, 16, 1, 8, x);
        SOL_F(18, 0, 1, 9, x); SOL_F(18, 1, 1, 9, y); SOL_F(18, 2, 1, 9, z); SOL_F(18, 3, 1, 9, w);
        SOL_F(18, 4, 1, 10, x); SOL_F(18, 5, 1, 10, y); SOL_F(18, 6, 1, 10, z); SOL_F(18, 7, 1, 10, w);
        SOL_F(18, 8, 1, 11, x); SOL_F(18, 9, 1, 11, y); SOL_F(18, 10, 1, 11, z); SOL_F(18, 11, 1, 11, w);
        __builtin_amdgcn_sched_barrier(0);
        SOL_L(1, 0, 1428); SOL_L(1, 1, 1432); SOL_L(1, 2, 1436); SOL_L(1, 3, 1440); SOL_L(1, 4, 1444); SOL_L(1, 5, 1448); SOL_L(1, 6, 1496); SOL_L(1, 7, 1500); SOL_L(1, 8, 1504); SOL_L(1, 9, 1508); SOL_L(1, 10, 1512); SOL_L(1, 11, 1516);
        __builtin_amdgcn_sched_barrier(0);
        SOL_F(18, 12, 0, 0, x); SOL_F(18, 13, 0, 0, y); SOL_F(18, 14, 0, 0, z); SOL_F(18, 15, 0, 0, w);
        SOL_F(18, 16, 0, 1, x); SOL_F(18, 17, 0, 1, y);
        SOL_F(19, 0, 0, 2, x); SOL_F(19, 1, 0, 2, y); SOL_F(19, 2, 0, 2, z); SOL_F(19, 3, 0, 2, w);
        SOL_F(19, 4, 0, 3, x); SOL_F(19, 5, 0, 3, y); SOL_F(19, 6, 0, 3, z); SOL_F(19, 7, 0, 3, w);
        SOL_F(19, 8, 0, 4, x); SOL_F(19, 9, 0, 4, y); SOL_F(19, 10, 0, 4, z); SOL_F(19, 11, 0, 4, w);
        SOL_F(19, 12, 0, 5, x); SOL_F(19, 13, 0, 5, y); SOL_F(19, 14, 0, 5, z); SOL_F(19, 15, 0, 5, w);
        SOL_F(19, 16, 0, 6, x); SOL_F(19, 17, 0, 6, y); SOL_F(19, 18, 0, 6, z);
        SOL_F(20, 0, 0, 7, x); SOL_F(20, 1, 0, 7, y); SOL_F(20, 2, 0, 7, z); SOL_F(20, 3, 0, 7, w);
        SOL_F(20, 4, 0, 8, x); SOL_F(20, 5, 0, 8, y); SOL_F(20, 6, 0, 8, z); SOL_F(20, 7, 0, 8, w);
        SOL_F(20, 8, 0, 9, x); SOL_F(20, 9, 0, 9, y); SOL_F(20, 10, 0, 9, z); SOL_F(20, 11, 0, 9, w);
        SOL_F(20, 12, 0, 10, x); SOL_F(20, 13, 0, 10, y); SOL_F(20, 14, 0, 10, z); SOL_F(20, 15, 0, 10, w);
        SOL_F(20, 16, 0, 11, x); SOL_F(20, 17, 0, 11, y); SOL_F(20, 18, 0, 11, z); SOL_F(20, 19, 0, 11, w);
        __builtin_amdgcn_sched_barrier(0);
        SOL_L(0, 0, 1564); SOL_L(0, 1, 1568); SOL_L(0, 2, 1572); SOL_L(0, 3, 1576); SOL_L(0, 4, 1580); SOL_L(0, 5, 1584); SOL_L(0, 6, 1632); SOL_L(0, 7, 1636); SOL_L(0, 8, 1640); SOL_L(0, 9, 1644); SOL_L(0, 10, 1648); SOL_L(0, 11, 1652);
        __builtin_amdgcn_sched_barrier(0);
        SOL_F(21, 0, 1, 0, x); SOL_F(21, 1, 1, 0, y); SOL_F(21, 2, 1, 0, z); SOL_F(21, 3, 1, 0, w);
        SOL_F(21, 4, 1, 1, x); SOL_F(21, 5, 1, 1, y); SOL_F(21, 6, 1, 1, z); SOL_F(21, 7, 1, 1, w);
        SOL_F(21, 8, 1, 2, x); SOL_F(21, 9, 1, 2, y); SOL_F(21, 10, 1, 2, z); SOL_F(21, 11, 1, 2, w);
        SOL_F(21, 12, 1, 3, x); SOL_F(21, 13, 1, 3, y); SOL_F(21, 14, 1, 3, z); SOL_F(21, 15, 1, 3, w);
        SOL_F(21, 16, 1, 4, x); SOL_F(21, 17, 1, 4, y); SOL_F(21, 18, 1, 4, z); SOL_F(21, 19, 1, 4, w);
        SOL_F(21, 20, 1, 5, x);
        SOL_F(22, 0, 1, 6, x); SOL_F(22, 1, 1, 6, y); SOL_F(22, 2, 1, 6, z); SOL_F(22, 3, 1, 6, w);
        SOL_F(22, 4, 1, 7, x); SOL_F(22, 5, 1, 7, y); SOL_F(22, 6, 1, 7, z); SOL_F(22, 7, 1, 7, w);
        SOL_F(22, 8, 1, 8, x); SOL_F(22, 9, 1, 8, y); SOL_F(22, 10, 1, 8, z); SOL_F(22, 11, 1, 8, w);
        SOL_F(22, 12, 1, 9, x); SOL_F(22, 13, 1, 9, y); SOL_F(22, 14, 1, 9, z); SOL_F(22, 15, 1, 9, w);
        SOL_F(22, 16, 1, 10, x); SOL_F(22, 17, 1, 10, y); SOL_F(22, 18, 1, 10, z); SOL_F(22, 19, 1, 10, w);
        SOL_F(22, 20, 1, 11, x); SOL_F(22, 21, 1, 11, y);
        __builtin_amdgcn_sched_barrier(0);
        SOL_L(1, 0, 1700); SOL_L(1, 1, 1704); SOL_L(1, 2, 1708); SOL_L(1, 3, 1712); SOL_L(1, 4, 1716); SOL_L(1, 5, 1720); SOL_L(1, 6, 1724); SOL_L(1, 7, 1768); SOL_L(1, 8, 1772); SOL_L(1, 9, 1776); SOL_L(1, 10, 1780); SOL_L(1, 11, 1784);
        __builtin_amdgcn_sched_barrier(0);
        SOL_F(23, 0, 0, 0, x); SOL_F(23, 1, 0, 0, y); SOL_F(23, 2, 0, 0, z); SOL_F(23, 3, 0, 0, w);
        SOL_F(23, 4, 0, 1, x); SOL_F(23, 5, 0, 1, y); SOL_F(23, 6, 0, 1, z); SOL_F(23, 7, 0, 1, w);
        SOL_F(23, 8, 0, 2, x); SOL_F(23, 9, 0, 2, y); SOL_F(23, 10, 0, 2, z); SOL_F(23, 11, 0, 2, w);
        SOL_F(23, 12, 0, 3, x); SOL_F(23, 13, 0, 3, y); SOL_F(23, 14, 0, 3, z); SOL_F(23, 15, 0, 3, w);
        SOL_F(23, 16, 0, 4, x); SOL_F(23, 17, 0, 4, y); SOL_F(23, 18, 0, 4, z); SOL_F(23, 19, 0, 4, w);
        SOL_F(23, 20, 0, 5, x); SOL_F(23, 21, 0, 5, y); SOL_F(23, 22, 0, 5, z);
        SOL_F(24, 0, 0, 6, x); SOL_F(24, 1, 0, 6, y); SOL_F(24, 2, 0, 6, z); SOL_F(24, 3, 0, 6, w);
        SOL_F(24, 4, 0, 7, x); SOL_F(24, 5, 0, 7, y); SOL_F(24, 6, 0, 7, z); SOL_F(24, 7, 0, 7, w);
        SOL_F(24, 8, 0, 8, x); SOL_F(24, 9, 0, 8, y); SOL_F(24, 10, 0, 8, z); SOL_F(24, 11, 0, 8, w);
        SOL_F(24, 12, 0, 9, x); SOL_F(24, 13, 0, 9, y); SOL_F(24, 14, 0, 9, z); SOL_F(24, 15, 0, 9, w);
        SOL_F(24, 16, 0, 10, x); SOL_F(24, 17, 0, 10, y); SOL_F(24, 18, 0, 10, z); SOL_F(24, 19, 0, 10, w);
        SOL_F(24, 20, 0, 11, x); SOL_F(24, 21, 0, 11, y); SOL_F(24, 22, 0, 11, z); SOL_F(24, 23, 0, 11, w);
        __builtin_amdgcn_sched_barrier(0);
        SOL_L(0, 0, 1788); SOL_L(0, 1, 1792); SOL_L(0, 2, 1836); SOL_L(0, 3, 1840); SOL_L(0, 4, 1844); SOL_L(0, 5, 1848); SOL_L(0, 6, 1852); SOL_L(0, 7, 1856); SOL_L(0, 8, 1860); SOL_L(0, 9, 1904); SOL_L(0, 10, 1908); SOL_L(0, 11, 1912);
        __builtin_amdgcn_sched_barrier(0);
        SOL_F(25, 0, 1, 0, x); SOL_F(25, 1, 1, 0, y); SOL_F(25, 2, 1, 0, z); SOL_F(25, 3, 1, 0, w);
        SOL_F(25, 4, 1, 1, x); SOL_F(25, 5, 1, 1, y); SOL_F(25, 6, 1, 1, z); SOL_F(25, 7, 1, 1, w);
        SOL_F(25, 8, 1, 2, x); SOL_F(25, 9, 1, 2, y); SOL_F(25, 10, 1, 2, z); SOL_F(25, 11, 1, 2, w);
        SOL_F(25, 12, 1, 3, x); SOL_F(25, 13, 1, 3, y); SOL_F(25, 14, 1, 3, z); SOL_F(25, 15, 1, 3, w);
        SOL_F(25, 16, 1, 4, x); SOL_F(25, 17, 1, 4, y); SOL_F(25, 18, 1, 4, z); SOL_F(25, 19, 1, 4, w);
        SOL_F(25, 20, 1, 5, x); SOL_F(25, 21, 1, 5, y); SOL_F(25, 22, 1, 5, z); SOL_F(25, 23, 1, 5, w);
        SOL_F(25, 24, 1, 6, x);
        SOL_F(26, 0, 1, 7, x); SOL_F(26, 1, 1, 7, y); SOL_F(26, 2, 1, 7, z); SOL_F(26, 3, 1, 7, w);
        SOL_F(26, 4, 1, 8, x); SOL_F(26, 5, 1, 8, y); SOL_F(26, 6, 1, 8, z); SOL_F(26, 7, 1, 8, w);
        SOL_F(26, 8, 1, 9, x); SOL_F(26, 9, 1, 9, y); SOL_F(26, 10, 1, 9, z); SOL_F(26, 11, 1, 9, w);
        SOL_F(26, 12, 1, 10, x); SOL_F(26, 13, 1, 10, y); SOL_F(26, 14, 1, 10, z); SOL_F(26, 15, 1, 10, w);
        SOL_F(26, 16, 1, 11, x); SOL_F(26, 17, 1, 11, y); SOL_F(26, 18, 1, 11, z); SOL_F(26, 19, 1, 11, w);
        __builtin_amdgcn_sched_barrier(0);
        SOL_L(1, 0, 1916); SOL_L(1, 1, 1920); SOL_L(1, 2, 1924); SOL_L(1, 3, 1928); SOL_L(1, 4, 1972); SOL_L(1, 5, 1976); SOL_L(1, 6, 1980); SOL_L(1, 7, 1984); SOL_L(1, 8, 1988); SOL_L(1, 9, 1992); SOL_L(1, 10, 1996); SOL_L(1, 11, 2000);
        __builtin_amdgcn_sched_barrier(0);
        SOL_F(26, 20, 0, 0, x); SOL_F(26, 21, 0, 0, y); SOL_F(26, 22, 0, 0, z); SOL_F(26, 23, 0, 0, w);
        SOL_F(26, 24, 0, 1, x); SOL_F(26, 25, 0, 1, y);
        SOL_F(27, 0, 0, 2, x); SOL_F(27, 1, 0, 2, y); SOL_F(27, 2, 0, 2, z); SOL_F(27, 3, 0, 2, w);
        SOL_F(27, 4, 0, 3, x); SOL_F(27, 5, 0, 3, y); SOL_F(27, 6, 0, 3, z); SOL_F(27, 7, 0, 3, w);
        SOL_F(27, 8, 0, 4, x); SOL_F(27, 9, 0, 4, y); SOL_F(27, 10, 0, 4, z); SOL_F(27, 11, 0, 4, w);
        SOL_F(27, 12, 0, 5, x); SOL_F(27, 13, 0, 5, y); SOL_F(27, 14, 0, 5, z); SOL_F(27, 15, 0, 5, w);
        SOL_F(27, 16, 0, 6, x); SOL_F(27, 17, 0, 6, y); SOL_F(27, 18, 0, 6, z); SOL_F(27, 19, 0, 6, w);
        SOL_F(27, 20, 0, 7, x); SOL_F(27, 21, 0, 7, y); SOL_F(27, 22, 0, 7, z); SOL_F(27, 23, 0, 7, w);
        SOL_F(27, 24, 0, 8, x); SOL_F(27, 25, 0, 8, y); SOL_F(27, 26, 0, 8, z);
        SOL_F(28, 0, 0, 9, x); SOL_F(28, 1, 0, 9, y); SOL_F(28, 2, 0, 9, z); SOL_F(28, 3, 0, 9, w);
        SOL_F(28, 4, 0, 10, x); SOL_F(28, 5, 0, 10, y); SOL_F(28, 6, 0, 10, z); SOL_F(28, 7, 0, 10, w);
        SOL_F(28, 8, 0, 11, x); SOL_F(28, 9, 0, 11, y); SOL_F(28, 10, 0, 11, z); SOL_F(28, 11, 0, 11, w);
        __builtin_amdgcn_sched_barrier(0);
        SOL_L(0, 0, 2040); SOL_L(0, 1, 2044); SOL_L(0, 2, 2048); SOL_L(0, 3, 2052); SOL_L(0, 4, 2056); SOL_L(0, 5, 2060); SOL_L(0, 6, 2064); SOL_L(0, 7, 2068); SOL_L(0, 8, 2108); SOL_L(0, 9, 2112); SOL_L(0, 10, 2116); SOL_L(0, 11, 2120);
        __builtin_amdgcn_sched_barrier(0);
        SOL_F(28, 12, 1, 0, x); SOL_F(28, 13, 1, 0, y); SOL_F(28, 14, 1, 0, z); SOL_F(28, 15, 1, 0, w);
        SOL_F(28, 16, 1, 1, x); SOL_F(28, 17, 1, 1, y); SOL_F(28, 18, 1, 1, z); SOL_F(28, 19, 1, 1, w);
        SOL_F(28, 20, 1, 2, x); SOL_F(28, 21, 1, 2, y); SOL_F(28, 22, 1, 2, z); SOL_F(28, 23, 1, 2, w);
        SOL_F(28, 24, 1, 3, x); SOL_F(28, 25, 1, 3, y); SOL_F(28, 26, 1, 3, z); SOL_F(28, 27, 1, 3, w);
        SOL_F(29, 0, 1, 4, x); SOL_F(29, 1, 1, 4, y); SOL_F(29, 2, 1, 4, z); SOL_F(29, 3, 1, 4, w);
        SOL_F(29, 4, 1, 5, x); SOL_F(29, 5, 1, 5, y); SOL_F(29, 6, 1, 5, z); SOL_F(29, 7, 1, 5, w);
        SOL_F(29, 8, 1, 6, x); SOL_F(29, 9, 1, 6, y); SOL_F(29, 10, 1, 6, z); SOL_F(29, 11, 1, 6, w);
        SOL_F(29, 12, 1, 7, x); SOL_F(29, 13, 1, 7, y); SOL_F(29, 14, 1, 7, z); SOL_F(29, 15, 1, 7, w);
        SOL_F(29, 16, 1, 8, x); SOL_F(29, 17, 1, 8, y); SOL_F(29, 18, 1, 8, z); SOL_F(29, 19, 1, 8, w);
        SOL_F(29, 20, 1, 9, x); SOL_F(29, 21, 1, 9, y); SOL_F(29, 22, 1, 9, z); SOL_F(29, 23, 1, 9, w);
        SOL_F(29, 24, 1, 10, x); SOL_F(29, 25, 1, 10, y); SOL_F(29, 26, 1, 10, z); SOL_F(29, 27, 1, 10, w);
        SOL_F(29, 28, 1, 11, x);
        __builtin_amdgcn_sched_barrier(0);
        SOL_L(1, 0, 2124); SOL_L(1, 1, 2128); SOL_L(1, 2, 2132); SOL_L(1, 3, 2136); SOL_L(1, 4, 2176); SOL_L(1, 5, 2180); SOL_L(1, 6, 2184); SOL_L(1, 7, 2188); SOL_L(1, 8, 2192); SOL_L(1, 9, 2196); SOL_L(1, 10, 2200); SOL_L(1, 11, 2204);
        __builtin_amdgcn_sched_barrier(0);
        SOL_F(30, 0, 0, 0, x); SOL_F(30, 1, 0, 0, y); SOL_F(30, 2, 0, 0, z); SOL_F(30, 3, 0, 0, w);
        SOL_F(30, 4, 0, 1, x); SOL_F(30, 5, 0, 1, y); SOL_F(30, 6, 0, 1, z); SOL_F(30, 7, 0, 1, w);
        SOL_F(30, 8, 0, 2, x); SOL_F(30, 9, 0, 2, y); SOL_F(30, 10, 0, 2, z); SOL_F(30, 11, 0, 2, w);
        SOL_F(30, 12, 0, 3, x); SOL_F(30, 13, 0, 3, y); SOL_F(30, 14, 0, 3, z); SOL_F(30, 15, 0, 3, w);
        SOL_F(30, 16, 0, 4, x); SOL_F(30, 17, 0, 4, y); SOL_F(30, 18, 0, 4, z); SOL_F(30, 19, 0, 4, w);
        SOL_F(30, 20, 0, 5, x); SOL_F(30, 21, 0, 5, y); SOL_F(30, 22, 0, 5, z); SOL_F(30, 23, 0, 5, w);
        SOL_F(30, 24, 0, 6, x); SOL_F(30, 25, 0, 6, y); SOL_F(30, 26, 0, 6, z); SOL_F(30, 27, 0, 6, w);
        SOL_F(30, 28, 0, 7, x); SOL_F(30, 29, 0, 7, y);
        SOL_F(31, 0, 0, 8, x); SOL_F(31, 1, 0, 8, y); SOL_F(31, 2, 0, 8, z); SOL_F(31, 3, 0, 8, w);
        SOL_F(31, 4, 0, 9, x); SOL_F(31, 5, 0, 9, y); SOL_F(31, 6, 0, 9, z); SOL_F(31, 7, 0, 9, w);
        SOL_F(31, 8, 0, 10, x); SOL_F(31, 9, 0, 10, y); SOL_F(31, 10, 0, 10, z); SOL_F(31, 11, 0, 10, w);
        SOL_F(31, 12, 0, 11, x); SOL_F(31, 13, 0, 11, y); SOL_F(31, 14, 0, 11, z); SOL_F(31, 15, 0, 11, w);
        __builtin_amdgcn_sched_barrier(0);
        SOL_L(0, 0, 2244); SOL_L(0, 1, 2248); SOL_L(0, 2, 2252); SOL_L(0, 3, 2256); SOL_L(0, 4, 2260); SOL_L(0, 5, 2264); SOL_L(0, 6, 2268); SOL_L(0, 7, 2272); SOL_L(0, 8, 2276); SOL_L(0, 9, 2312); SOL_L(0, 10, 2316); SOL_L(0, 11, 2320);
        __builtin_amdgcn_sched_barrier(0);
        SOL_F(31, 16, 1, 0, x); SOL_F(31, 17, 1, 0, y); SOL_F(31, 18, 1, 0, z); SOL_F(31, 19, 1, 0, w);
        SOL_F(31, 20, 1, 1, x); SOL_F(31, 21, 1, 1, y); SOL_F(31, 22, 1, 1, z); SOL_F(31, 23, 1, 1, w);
        SOL_F(31, 24, 1, 2, x); SOL_F(31, 25, 1, 2, y); SOL_F(31, 26, 1, 2, z); SOL_F(31, 27, 1, 2, w);
        SOL_F(31, 28, 1, 3, x); SOL_F(31, 29, 1, 3, y); SOL_F(31, 30, 1, 3, z);
        SOL_F(32, 0, 1, 4, x); SOL_F(32, 1, 1, 4, y); SOL_F(32, 2, 1, 4, z); SOL_F(32, 3, 1, 4, w);
        SOL_F(32, 4, 1, 5, x); SOL_F(32, 5, 1, 5, y); SOL_F(32, 6, 1, 5, z); SOL_F(32, 7, 1, 5, w);
        SOL_F(32, 8, 1, 6, x); SOL_F(32, 9, 1, 6, y); SOL_F(32, 10, 1, 6, z); SOL_F(32, 11, 1, 6, w);
        SOL_F(32, 12, 1, 7, x); SOL_F(32, 13, 1, 7, y); SOL_F(32, 14, 1, 7, z); SOL_F(32, 15, 1, 7, w);
        SOL_F(32, 16, 1, 8, x); SOL_F(32, 17, 1, 8, y); SOL_F(32, 18, 1, 8, z); SOL_F(32, 19, 1, 8, w);
        SOL_F(32, 20, 1, 9, x); SOL_F(32, 21, 1, 9, y); SOL_F(32, 22, 1, 9, z); SOL_F(32, 23, 1, 9, w);
        SOL_F(32, 24, 1, 10, x); SOL_F(32, 25, 1, 10, y); SOL_F(32, 26, 1, 10, z); SOL_F(32, 27, 1, 10, w);
        SOL_F(32, 28, 1, 11, x); SOL_F(32, 29, 1, 11, y); SOL_F(32, 30, 1, 11, z); SOL_F(32, 31, 1, 11, w);
        __builtin_amdgcn_sched_barrier(0);
        __syncthreads();
        SOL_L(1, 0, 2324); SOL_L(1, 1, 2328); SOL_L(1, 2, 2332); SOL_L(1, 3, 2336); SOL_L(1, 4, 2340); SOL_L(1, 5, 2344); SOL_L(1, 6, 2380); SOL_L(1, 7, 2384); SOL_L(1, 8, 2388); SOL_L(1, 9, 2392); SOL_L(1, 10, 2396); SOL_L(1, 11, 2400);
        __builtin_amdgcn_sched_barrier(0);
        SOL_F(33, 0, 0, 0, x); SOL_F(33, 1, 0, 0, y); SOL_F(33, 2, 0, 0, z); SOL_F(33, 3, 0, 0, w);
        SOL_F(33, 4, 0, 1, x); SOL_F(33, 5, 0, 1, y); SOL_F(33, 6, 0, 1, z); SOL_F(33, 7, 0, 1, w);
        SOL_F(33, 8, 0, 2, x); SOL_F(33, 9, 0, 2, y); SOL_F(33, 10, 0, 2, z); SOL_F(33, 11, 0, 2, w);
        SOL_F(33, 12, 0, 3, x); SOL_F(33, 13, 0, 3, y); SOL_F(33, 14, 0, 3, z); SOL_F(33, 15, 0, 3, w);
        SOL_F(33, 16, 0, 4, x); SOL_F(33, 17, 0, 4, y); SOL_F(33, 18, 0, 4, z); SOL_F(33, 19, 0, 4, w);
        SOL_F(33, 20, 0, 5, x); SOL_F(33, 21, 0, 5, y); SOL_F(33, 22, 0, 5, z); SOL_F(33, 23, 0, 5, w);
        SOL_F(33, 24, 0, 6, x); SOL_F(33, 25, 0, 6, y); SOL_F(33, 26, 0, 6, z); SOL_F(33, 27, 0, 6, w);
        SOL_F(33, 28, 0, 7, x); SOL_F(33, 29, 0, 7, y); SOL_F(33, 30, 0, 7, z); SOL_F(33, 31, 0, 7, w);
        SOL_F(33, 32, 0, 8, x);
        SOL_F(34, 0, 0, 9, x); SOL_F(34, 1, 0, 9, y); SOL_F(34, 2, 0, 9, z); SOL_F(34, 3, 0, 9, w);
        SOL_F(34, 4, 0, 10, x); SOL_F(34, 5, 0, 10, y); SOL_F(34, 6, 0, 10, z); SOL_F(34, 7, 0, 10, w);
        SOL_F(34, 8, 0, 11, x); SOL_F(34, 9, 0, 11, y); SOL_F(34, 10, 0, 11, z); SOL_F(34, 11, 0, 11, w);
        __builtin_amdgcn_sched_barrier(0);
        SOL_L(0, 0, 2404); SOL_L(0, 1, 2408); SOL_L(0, 2, 2412); SOL_L(0, 3, 2448); SOL_L(0, 4, 2452); SOL_L(0, 5, 2456); SOL_L(0, 6, 2460); SOL_L(0, 7, 2464); SOL_L(0, 8, 2468); SOL_L(0, 9, 2472); SOL_L(0, 10, 2476); SOL_L(0, 11, 2480);
        __builtin_amdgcn_sched_barrier(0);
        SOL_F(34, 12, 1, 0, x); SOL_F(34, 13, 1, 0, y); SOL_F(34, 14, 1, 0, z); SOL_F(34, 15, 1, 0, w);
        SOL_F(34, 16, 1, 1, x); SOL_F(34, 17, 1, 1, y); SOL_F(34, 18, 1, 1, z); SOL_F(34, 19, 1, 1, w);
        SOL_F(34, 20, 1, 2, x); SOL_F(34, 21, 1, 2, y); SOL_F(34, 22, 1, 2, z); SOL_F(34, 23, 1, 2, w);
        SOL_F(34, 24, 1, 3, x); SOL_F(34, 25, 1, 3, y); SOL_F(34, 26, 1, 3, z); SOL_F(34, 27, 1, 3, w);
        SOL_F(34, 28, 1, 4, x); SOL_F(34, 29, 1, 4, y); SOL_F(34, 30, 1, 4, z); SOL_F(34, 31, 1, 4, w);
        SOL_F(34, 32, 1, 5, x); SOL_F(34, 33, 1, 5, y);
        SOL_F(35, 0, 1, 6, x); SOL_F(35, 1, 1, 6, y); SOL_F(35, 2, 1, 6, z); SOL_F(35, 3, 1, 6, w);
        SOL_F(35, 4, 1, 7, x); SOL_F(35, 5, 1, 7, y); SOL_F(35, 6, 1, 7, z); SOL_F(35, 7, 1, 7, w);
        SOL_F(35, 8, 1, 8, x); SOL_F(35, 9, 1, 8, y); SOL_F(35, 10, 1, 8, z); SOL_F(35, 11, 1, 8, w);
        SOL_F(35, 12, 1, 9, x); SOL_F(35, 13, 1, 9, y); SOL_F(35, 14, 1, 9, z); SOL_F(35, 15, 1, 9, w);
        SOL_F(35, 16, 1, 10, x); SOL_F(35, 17, 1, 10, y); SOL_F(35, 18, 1, 10, z); SOL_F(35, 19, 1, 10, w);
        SOL_F(35, 20, 1, 11, x); SOL_F(35, 21, 1, 11, y); SOL_F(35, 22, 1, 11, z); SOL_F(35, 23, 1, 11, w);
        __builtin_amdgcn_sched_barrier(0);
        SOL_L(1, 0, 2516); SOL_L(1, 1, 2520); SOL_L(1, 2, 2524); SOL_L(1, 3, 2528); SOL_L(1, 4, 2532); SOL_L(1, 5, 2536); SOL_L(1, 6, 2540); SOL_L(1, 7, 2544); SOL_L(1, 8, 2548); SOL_L(1, 9, 2552); SOL_L(1, 10, 2584); SOL_L(1, 11, 2588);
        __builtin_amdgcn_sched_barrier(0);
        SOL_F(35, 24, 0, 0, x); SOL_F(35, 25, 0, 0, y); SOL_F(35, 26, 0, 0, z); SOL_F(35, 27, 0, 0, w);
        SOL_F(35, 28, 0, 1, x); SOL_F(35, 29, 0, 1, y); SOL_F(35, 30, 0, 1, z); SOL_F(35, 31, 0, 1, w);
        SOL_F(35, 32, 0, 2, x); SOL_F(35, 33, 0, 2, y); SOL_F(35, 34, 0, 2, z);
        SOL_F(36, 0, 0, 3, x); SOL_F(36, 1, 0, 3, y); SOL_F(36, 2, 0, 3, z); SOL_F(36, 3, 0, 3, w);
        SOL_F(36, 4, 0, 4, x); SOL_F(36, 5, 0, 4, y); SOL_F(36, 6, 0, 4, z); SOL_F(36, 7, 0, 4, w);
        SOL_F(36, 8, 0, 5, x); SOL_F(36, 9, 0, 5, y); SOL_F(36, 10, 0, 5, z); SOL_F(36, 11, 0, 5, w);
        SOL_F(36, 12, 0, 6, x); SOL_F(36, 13, 0, 6, y); SOL_F(36, 14, 0, 6, z); SOL_F(36, 15, 0, 6, w);
        SOL_F(36, 16, 0, 7, x); SOL_F(36, 17, 0, 7, y); SOL_F(36, 18, 0, 7, z); SOL_F(36, 19, 0, 7, w);
        SOL_F(36, 20, 0, 8, x); SOL_F(36, 21, 0, 8, y); SOL_F(36, 22, 0, 8, z); SOL_F(36, 23, 0, 8, w);
        SOL_F(36, 24, 0, 9, x); SOL_F(36, 25, 0, 9, y); SOL_F(36, 26, 0, 9, z); SOL_F(36, 27, 0, 9, w);
        SOL_F(36, 28, 0, 10, x); SOL_F(36, 29, 0, 10, y); SOL_F(36, 30, 0, 10, z); SOL_F(36, 31, 0, 10, w);
        SOL_F(36, 32, 0, 11, x); SOL_F(36, 33, 0, 11, y); SOL_F(36, 34, 0, 11, z); SOL_F(36, 35, 0, 11, w);
        __builtin_amdgcn_sched_barrier(0);
        SOL_L(0, 0, 2592); SOL_L(0, 1, 2596); SOL_L(0, 2, 2600); SOL_L(0, 3, 2604); SOL_L(0, 4, 2608); SOL_L(0, 5, 2612); SOL_L(0, 6, 2616); SOL_L(0, 7, 2620); SOL_L(0, 8, 2652); SOL_L(0, 9, 2656); SOL_L(0, 10, 2660); SOL_L(0, 11, 2664);
        __builtin_amdgcn_sched_barrier(0);
        SOL_F(37, 0, 1, 0, x); SOL_F(37, 1, 1, 0, y); SOL_F(37, 2, 1, 0, z); SOL_F(37, 3, 1, 0, w);
        SOL_F(37, 4, 1, 1, x); SOL_F(37, 5, 1, 1, y); SOL_F(37, 6, 1, 1, z); SOL_F(37, 7, 1, 1, w);
        SOL_F(37, 8, 1, 2, x); SOL_F(37, 9, 1, 2, y); SOL_F(37, 10, 1, 2, z); SOL_F(37, 11, 1, 2, w);
        SOL_F(37, 12, 1, 3, x); SOL_F(37, 13, 1, 3, y); SOL_F(37, 14, 1, 3, z); SOL_F(37, 15, 1, 3, w);
        SOL_F(37, 16, 1, 4, x); SOL_F(37, 17, 1, 4, y); SOL_F(37, 18, 1, 4, z); SOL_F(37, 19, 1, 4, w);
        SOL_F(37, 20, 1, 5, x); SOL_F(37, 21, 1, 5, y); SOL_F(37, 22, 1, 5, z); SOL_F(37, 23, 1, 5, w);
        SOL_F(37, 24, 1, 6, x); SOL_F(37, 25, 1, 6, y); SOL_F(37, 26, 1, 6, z); SOL_F(37, 27, 1, 6, w);
        SOL_F(37, 28, 1, 7, x); SOL_F(37, 29, 1, 7, y); SOL_F(37, 30, 1, 7, z); SOL_F(37, 31, 1, 7, w);
        SOL_F(37, 32, 1, 8, x); SOL_F(37, 33, 1, 8, y); SOL_F(37, 34, 1, 8, z); SOL_F(37, 35, 1, 8, w);
        SOL_F(37, 36, 1, 9, x);
        SOL_F(38, 0, 1, 10, x); SOL_F(38, 1, 1, 10, y); SOL_F(38, 2, 1, 10, z); SOL_F(38, 3, 1, 10, w);
        SOL_F(38, 4, 1, 11, x); SOL_F(38, 5, 1, 11, y); SOL_F(38, 6, 1, 11, z); SOL_F(38, 7, 1, 11, w);
        __builtin_amdgcn_sched_barrier(0);
        SOL_L(1, 0, 2668); SOL_L(1, 1, 2672); SOL_L(1, 2, 2676); SOL_L(1, 3, 2680); SOL_L(1, 4, 2684); SOL_L(1, 5, 2688); SOL_L(1, 6, 2720); SOL_L(1, 7, 2724); SOL_L(1, 8, 2728); SOL_L(1, 9, 2732); SOL_L(1, 10, 2736); SOL_L(1, 11, 2740);
        __builtin_amdgcn_sched_barrier(0);
        SOL_F(38, 8, 0, 0, x); SOL_F(38, 9, 0, 0, y); SOL_F(38, 10, 0, 0, z); SOL_F(38, 11, 0, 0, w);
        SOL_F(38, 12, 0, 1, x); SOL_F(38, 13, 0, 1, y); SOL_F(38, 14, 0, 1, z); SOL_F(38, 15, 0, 1, w);
        SOL_F(38, 16, 0, 2, x); SOL_F(38, 17, 0, 2, y); SOL_F(38, 18, 0, 2, z); SOL_F(38, 19, 0, 2, w);
        SOL_F(38, 20, 0, 3, x); SOL_F(38, 21, 0, 3, y); SOL_F(38, 22, 0, 3, z); SOL_F(38, 23, 0, 3, w);
        SOL_F(38, 24, 0, 4, x); SOL_F(38, 25, 0, 4, y); SOL_F(38, 26, 0, 4, z); SOL_F(38, 27, 0, 4, w);
        SOL_F(38, 28, 0, 5, x); SOL_F(38, 29, 0, 5, y); SOL_F(38, 30, 0, 5, z); SOL_F(38, 31, 0, 5, w);
        SOL_F(38, 32, 0, 6, x); SOL_F(38, 33, 0, 6, y); SOL_F(38, 34, 0, 6, z); SOL_F(38, 35, 0, 6, w);
        SOL_F(38, 36, 0, 7, x); SOL_F(38, 37, 0, 7, y);
        SOL_F(39, 0, 0, 8, x); SOL_F(39, 1, 0, 8, y); SOL_F(39, 2, 0, 8, z); SOL_F(39, 3, 0, 8, w);
        SOL_F(39, 4, 0, 9, x); SOL_F(39, 5, 0, 9, y); SOL_F(39, 6, 0, 9, z); SOL_F(39, 7, 0, 9, w);
        SOL_F(39, 8, 0, 10, x); SOL_F(39, 9, 0, 10, y); SOL_F(39, 10, 0, 10, z); SOL_F(39, 11, 0, 10, w);
        SOL_F(39, 12, 0, 11, x); SOL_F(39, 13, 0, 11, y); SOL_F(39, 14, 0, 11, z); SOL_F(39, 15, 0, 11, w);
        __builtin_amdgcn_sched_barrier(0);
        SOL_L(0, 0, 2744); SOL_L(0, 1, 2748); SOL_L(0, 2, 2752); SOL_L(0, 3, 2756); SOL_L(0, 4, 2788); SOL_L(0, 5, 2792); SOL_L(0, 6, 2796); SOL_L(0, 7, 2800); SOL_L(0, 8, 2804); SOL_L(0, 9, 2808); SOL_L(0, 10, 2812); SOL_L(0, 11, 2816);
        __builtin_amdgcn_sched_barrier(0);
        SOL_F(39, 16, 1, 0, x); SOL_F(39, 17, 1, 0, y); SOL_F(39, 18, 1, 0, z); SOL_F(39, 19, 1, 0, w);
        SOL_F(39, 20, 1, 1, x); SOL_F(39, 21, 1, 1, y); SOL_F(39, 22, 1, 1, z); SOL_F(39, 23, 1, 1, w);
        SOL_F(39, 24, 1, 2, x); SOL_F(39, 25, 1, 2, y); SOL_F(39, 26, 1, 2, z); SOL_F(39, 27, 1, 2, w);
        SOL_F(39, 28, 1, 3, x); SOL_F(39, 29, 1, 3, y); SOL_F(39, 30, 1, 3, z); SOL_F(39, 31, 1, 3, w);
        SOL_F(39, 32, 1, 4, x); SOL_F(39, 33, 1, 4, y); SOL_F(39, 34, 1, 4, z); SOL_F(39, 35, 1, 4, w);
        SOL_F(39, 36, 1, 5, x); SOL_F(39, 37, 1, 5, y); SOL_F(39, 38, 1, 5, z);
        SOL_F(40, 0, 1, 6, x); SOL_F(40, 1, 1, 6, y); SOL_F(40, 2, 1, 6, z); SOL_F(40, 3, 1, 6, w);
        SOL_F(40, 4, 1, 7, x); SOL_F(40, 5, 1, 7, y); SOL_F(40, 6, 1, 7, z); SOL_F(40, 7, 1, 7, w);
        SOL_F(40, 8, 1, 8, x); SOL_F(40, 9, 1, 8, y); SOL_F(40, 10, 1, 8, z); SOL_F(40, 11, 1, 8, w);
        SOL_F(40, 12, 1, 9, x); SOL_F(40, 13, 1, 9, y); SOL_F(40, 14, 1, 9, z); SOL_F(40, 15, 1, 9, w);
        SOL_F(40, 16, 1, 10, x); SOL_F(40, 17, 1, 10, y); SOL_F(40, 18, 1, 10, z); SOL_F(40, 19, 1, 10, w);
        SOL_F(40, 20, 1, 11, x); SOL_F(40, 21, 1, 11, y); SOL_F(40, 22, 1, 11, z); SOL_F(40, 23, 1, 11, w);
        __builtin_amdgcn_sched_barrier(0);
        SOL_L(1, 0, 2820); SOL_L(1, 1, 2824); SOL_L(1, 2, 2828); SOL_L(1, 3, 2856); SOL_L(1, 4, 2860); SOL_L(1, 5, 2864); SOL_L(1, 6, 2868); SOL_L(1, 7, 2872); SOL_L(1, 8, 2876); SOL_L(1, 9, 2880); SOL_L(1, 10, 2884); SOL_L(1, 11, 2888);
        __builtin_amdgcn_sched_barrier(0);
        SOL_F(40, 24, 0, 0, x); SOL_F(40, 25, 0, 0, y); SOL_F(40, 26, 0, 0, z); SOL_F(40, 27, 0, 0, w);
        SOL_F(40, 28, 0, 1, x); SOL_F(40, 29, 0, 1, y); SOL_F(40, 30, 0, 1, z); SOL_F(40, 31, 0, 1, w);
        SOL_F(40, 32, 0, 2, x); SOL_F(40, 33, 0, 2, y); SOL_F(40, 34, 0, 2, z); SOL_F(40, 35, 0, 2, w);
        SOL_F(40, 36, 0, 3, x); SOL_F(40, 37, 0, 3, y); SOL_F(40, 38, 0, 3, z); SOL_F(40, 39, 0, 3, w);
        SOL_F(41, 0, 0, 4, x); SOL_F(41, 1, 0, 4, y); SOL_F(41, 2, 0, 4, z); SOL_F(41, 3, 0, 4, w);
        SOL_F(41, 4, 0, 5, x); SOL_F(41, 5, 0, 5, y); SOL_F(41, 6, 0, 5, z); SOL_F(41, 7, 0, 5, w);
        SOL_F(41, 8, 0, 6, x); SOL_F(41, 9, 0, 6, y); SOL_F(41, 10, 0, 6, z); SOL_F(41, 11, 0, 6, w);
        SOL_F(41, 12, 0, 7, x); SOL_F(41, 13, 0, 7, y); SOL_F(41, 14, 0, 7, z); SOL_F(41, 15, 0, 7, w);
        SOL_F(41, 16, 0, 8, x); SOL_F(41, 17, 0, 8, y); SOL_F(41, 18, 0, 8, z); SOL_F(41, 19, 0, 8, w);
        SOL_F(41, 20, 0, 9, x); SOL_F(41, 21, 0, 9, y); SOL_F(41, 22, 0, 9, z); SOL_F(41, 23, 0, 9, w);
        SOL_F(41, 24, 0, 10, x); SOL_F(41, 25, 0, 10, y); SOL_F(41, 26, 0, 10, z); SOL_F(41, 27, 0, 10, w);
        SOL_F(41, 28, 0, 11, x); SOL_F(41, 29, 0, 11, y); SOL_F(41, 30, 0, 11, z); SOL_F(41, 31, 0, 11, w);
        __builtin_amdgcn_sched_barrier(0);
        SOL_L(0, 0, 2892); SOL_L(0, 1, 2896); SOL_L(0, 2, 2924); SOL_L(0, 3, 2928); SOL_L(0, 4, 2932); SOL_L(0, 5, 2936); SOL_L(0, 6, 2940); SOL_L(0, 7, 2944); SOL_L(0, 8, 2948); SOL_L(0, 9, 2952); SOL_L(0, 10, 2956); SOL_L(0, 11, 2960);
        __builtin_amdgcn_sched_barrier(0);
        SOL_F(41, 32, 1, 0, x); SOL_F(41, 33, 1, 0, y); SOL_F(41, 34, 1, 0, z); SOL_F(41, 35, 1, 0, w);
        SOL_F(41, 36, 1, 1, x); SOL_F(41, 37, 1, 1, y); SOL_F(41, 38, 1, 1, z); SOL_F(41, 39, 1, 1, w);
        SOL_F(41, 40, 1, 2, x);
        SOL_F(42, 0, 1, 3, x); SOL_F(42, 1, 1, 3, y); SOL_F(42, 2, 1, 3, z); SOL_F(42, 3, 1, 3, w);
        SOL_F(42, 4, 1, 4, x); SOL_F(42, 5, 1, 4, y); SOL_F(42, 6, 1, 4, z); SOL_F(42, 7, 1, 4, w);
        SOL_F(42, 8, 1, 5, x); SOL_F(42, 9, 1, 5, y); SOL_F(42, 10, 1, 5, z); SOL_F(42, 11, 1, 5, w);
        SOL_F(42, 12, 1, 6, x); SOL_F(42, 13, 1, 6, y); SOL_F(42, 14, 1, 6, z); SOL_F(42, 15, 1, 6, w);
        SOL_F(42, 16, 1, 7, x); SOL_F(42, 17, 1, 7, y); SOL_F(42, 18, 1, 7, z); SOL_F(42, 19, 1, 7, w);
        SOL_F(42, 20, 1, 8, x); SOL_F(42, 21, 1, 8, y); SOL_F(42, 22, 1, 8, z); SOL_F(42, 23, 1, 8, w);
        SOL_F(42, 24, 1, 9, x); SOL_F(42, 25, 1, 9, y); SOL_F(42, 26, 1, 9, z); SOL_F(42, 27, 1, 9, w);
        SOL_F(42, 28, 1, 10, x); SOL_F(42, 29, 1, 10, y); SOL_F(42, 30, 1, 10, z); SOL_F(42, 31, 1, 10, w);
        SOL_F(42, 32, 1, 11, x); SOL_F(42, 33, 1, 11, y); SOL_F(42, 34, 1, 11, z); SOL_F(42, 35, 1, 11, w);
        __builtin_amdgcn_sched_barrier(0);
        SOL_L(1, 0, 2964); SOL_L(1, 1, 2992); SOL_L(1, 2, 2996); SOL_L(1, 3, 3000); SOL_L(1, 4, 3004); SOL_L(1, 5, 3008); SOL_L(1, 6, 3012); SOL_L(1, 7, 3016); SOL_L(1, 8, 3020); SOL_L(1, 9, 3024); SOL_L(1, 10, 3028); SOL_L(1, 11, 3032);
        __builtin_amdgcn_sched_barrier(0);
        SOL_F(42, 36, 0, 0, x); SOL_F(42, 37, 0, 0, y); SOL_F(42, 38, 0, 0, z); SOL_F(42, 39, 0, 0, w);
        SOL_F(42, 40, 0, 1, x); SOL_F(42, 41, 0, 1, y);
        SOL_F(43, 0, 0, 2, x); SOL_F(43, 1, 0, 2, y); SOL_F(43, 2, 0, 2, z); SOL_F(43, 3, 0, 2, w);
        SOL_F(43, 4, 0, 3, x); SOL_F(43, 5, 0, 3, y); SOL_F(43, 6, 0, 3, z); SOL_F(43, 7, 0, 3, w);
        SOL_F(43, 8, 0, 4, x); SOL_F(43, 9, 0, 4, y); SOL_F(43, 10, 0, 4, z); SOL_F(43, 11, 0, 4, w);
        SOL_F(43, 12, 0, 5, x); SOL_F(43, 13, 0, 5, y); SOL_F(43, 14, 0, 5, z); SOL_F(43, 15, 0, 5, w);
        SOL_F(43, 16, 0, 6, x); SOL_F(43, 17, 0, 6, y); SOL_F(43, 18, 0, 6, z); SOL_F(43, 19, 0, 6, w);
        SOL_F(43, 20, 0, 7, x); SOL_F(43, 21, 0, 7, y); SOL_F(43, 22, 0, 7, z); SOL_F(43, 23, 0, 7, w);
        SOL_F(43, 24, 0, 8, x); SOL_F(43, 25, 0, 8, y); SOL_F(43, 26, 0, 8, z); SOL_F(43, 27, 0, 8, w);
        SOL_F(43, 28, 0, 9, x); SOL_F(43, 29, 0, 9, y); SOL_F(43, 30, 0, 9, z); SOL_F(43, 31, 0, 9, w);
        SOL_F(43, 32, 0, 10, x); SOL_F(43, 33, 0, 10, y); SOL_F(43, 34, 0, 10, z); SOL_F(43, 35, 0, 10, w);
        SOL_F(43, 36, 0, 11, x); SOL_F(43, 37, 0, 11, y); SOL_F(43, 38, 0, 11, z); SOL_F(43, 39, 0, 11, w);
        __builtin_amdgcn_sched_barrier(0);
        SOL_L(0, 0, 3060); SOL_L(0, 1, 3064); SOL_L(0, 2, 3068); SOL_L(0, 3, 3072); SOL_L(0, 4, 3076); SOL_L(0, 5, 3080); SOL_L(0, 6, 3084); SOL_L(0, 7, 3088); SOL_L(0, 8, 3092); SOL_L(0, 9, 3096); SOL_L(0, 10, 3100); SOL_L(0, 11, 3104);
        __builtin_amdgcn_sched_barrier(0);
        SOL_F(43, 40, 1, 0, x); SOL_F(43, 41, 1, 0, y); SOL_F(43, 42, 1, 0, z);
        SOL_F(44, 0, 1, 1, x); SOL_F(44, 1, 1, 1, y); SOL_F(44, 2, 1, 1, z); SOL_F(44, 3, 1, 1, w);
        SOL_F(44, 4, 1, 2, x); SOL_F(44, 5, 1, 2, y); SOL_F(44, 6, 1, 2, z); SOL_F(44, 7, 1, 2, w);
        SOL_F(44, 8, 1, 3, x); SOL_F(44, 9, 1, 3, y); SOL_F(44, 10, 1, 3, z); SOL_F(44, 11, 1, 3, w);
        SOL_F(44, 12, 1, 4, x); SOL_F(44, 13, 1, 4, y); SOL_F(44, 14, 1, 4, z); SOL_F(44, 15, 1, 4, w);
        SOL_F(44, 16, 1, 5, x); SOL_F(44, 17, 1, 5, y); SOL_F(44, 18, 1, 5, z); SOL_F(44, 19, 1, 5, w);
        SOL_F(44, 20, 1, 6, x); SOL_F(44, 21, 1, 6, y); SOL_F(44, 22, 1, 6, z); SOL_F(44, 23, 1, 6, w);
        SOL_F(44, 24, 1, 7, x); SOL_F(44, 25, 1, 7, y); SOL_F(44, 26, 1, 7, z); SOL_F(44, 27, 1, 7, w);
        SOL_F(44, 28, 1, 8, x); SOL_F(44, 29, 1, 8, y); SOL_F(44, 30, 1, 8, z); SOL_F(44, 31, 1, 8, w);
        SOL_F(44, 32, 1, 9, x); SOL_F(44, 33, 1, 9, y); SOL_F(44, 34, 1, 9, z); SOL_F(44, 35, 1, 9, w);
        SOL_F(44, 36, 1, 10, x); SOL_F(44, 37, 1, 10, y); SOL_F(44, 38, 1, 10, z); SOL_F(44, 39, 1, 10, w);
        SOL_F(44, 40, 1, 11, x); SOL_F(44, 41, 1, 11, y); SOL_F(44, 42, 1, 11, z); SOL_F(44, 43, 1, 11, w);
        __builtin_amdgcn_sched_barrier(0);
        SOL_L(1, 0, 3128); SOL_L(1, 1, 3132); SOL_L(1, 2, 3136); SOL_L(1, 3, 3140); SOL_L(1, 4, 3144); SOL_L(1, 5, 3148); SOL_L(1, 6, 3152); SOL_L(1, 7, 3156); SOL_L(1, 8, 3160); SOL_L(1, 9, 3164); SOL_L(1, 10, 3168); SOL_L(1, 11, 3172);
        __builtin_amdgcn_sched_barrier(0);
        SOL_F(45, 0, 0, 0, x); SOL_F(45, 1, 0, 0, y); SOL_F(45, 2, 0, 0, z); SOL_F(45, 3, 0, 0, w);
        SOL_F(45, 4, 0, 1, x); SOL_F(45, 5, 0, 1, y); SOL_F(45, 6, 0, 1, z); SOL_F(45, 7, 0, 1, w);
        SOL_F(45, 8, 0, 2, x); SOL_F(45, 9, 0, 2, y); SOL_F(45, 10, 0, 2, z); SOL_F(45, 11, 0, 2, w);
        SOL_F(45, 12, 0, 3, x); SOL_F(45, 13, 0, 3, y); SOL_F(45, 14, 0, 3, z); SOL_F(45, 15, 0, 3, w);
        SOL_F(45, 16, 0, 4, x); SOL_F(45, 17, 0, 4, y); SOL_F(45, 18, 0, 4, z); SOL_F(45, 19, 0, 4, w);
        SOL_F(45, 20, 0, 5, x); SOL_F(45, 21, 0, 5, y); SOL_F(45, 22, 0, 5, z); SOL_F(45, 23, 0, 5, w);
        SOL_F(45, 24, 0, 6, x); SOL_F(45, 25, 0, 6, y); SOL_F(45, 26, 0, 6, z); SOL_F(45, 27, 0, 6, w);
        SOL_F(45, 28, 0, 7, x); SOL_F(45, 29, 0, 7, y); SOL_F(45, 30, 0, 7, z); SOL_F(45, 31, 0, 7, w);
        SOL_F(45, 32, 0, 8, x); SOL_F(45, 33, 0, 8, y); SOL_F(45, 34, 0, 8, z); SOL_F(45, 35, 0, 8, w);
        SOL_F(45, 36, 0, 9, x); SOL_F(45, 37, 0, 9, y); SOL_F(45, 38, 0, 9, z); SOL_F(45, 39, 0, 9, w);
        SOL_F(45, 40, 0, 10, x); SOL_F(45, 41, 0, 10, y); SOL_F(45, 42, 0, 10, z); SOL_F(45, 43, 0, 10, w);
        SOL_F(45, 44, 0, 11, x);
        __builtin_amdgcn_sched_barrier(0);
        SOL_L(0, 0, 3196); SOL_L(0, 1, 3200); SOL_L(0, 2, 3204); SOL_L(0, 3, 3208); SOL_L(0, 4, 3212); SOL_L(0, 5, 3216); SOL_L(0, 6, 3220); SOL_L(0, 7, 3224); SOL_L(0, 8, 3228); SOL_L(0, 9, 3232); SOL_L(0, 10, 3236); SOL_L(0, 11, 3240);
        __builtin_amdgcn_sched_barrier(0);
        SOL_F(46, 0, 1, 0, x); SOL_F(46, 1, 1, 0, y); SOL_F(46, 2, 1, 0, z); SOL_F(46, 3, 1, 0, w);
        SOL_F(46, 4, 1, 1, x); SOL_F(46, 5, 1, 1, y); SOL_F(46, 6, 1, 1, z); SOL_F(46, 7, 1, 1, w);
        SOL_F(46, 8, 1, 2, x); SOL_F(46, 9, 1, 2, y); SOL_F(46, 10, 1, 2, z); SOL_F(46, 11, 1, 2, w);
        SOL_F(46, 12, 1, 3, x); SOL_F(46, 13, 1, 3, y); SOL_F(46, 14, 1, 3, z); SOL_F(46, 15, 1, 3, w);
        SOL_F(46, 16, 1, 4, x); SOL_F(46, 17, 1, 4, y); SOL_F(46, 18, 1, 4, z); SOL_F(46, 19, 1, 4, w);
        SOL_F(46, 20, 1, 5, x); SOL_F(46, 21, 1, 5, y); SOL_F(46, 22, 1, 5, z); SOL_F(46, 23, 1, 5, w);
        SOL_F(46, 24, 1, 6, x); SOL_F(46, 25, 1, 6, y); SOL_F(46, 26, 1, 6, z); SOL_F(46, 27, 1, 6, w);
        SOL_F(46, 28, 1, 7, x); SOL_F(46, 29, 1, 7, y); SOL_F(46, 30, 1, 7, z); SOL_F(46, 31, 1, 7, w);
        SOL_F(46, 32, 1, 8, x); SOL_F(46, 33, 1, 8, y); SOL_F(46, 34, 1, 8, z); SOL_F(46, 35, 1, 8, w);
        SOL_F(46, 36, 1, 9, x); SOL_F(46, 37, 1, 9, y); SOL_F(46, 38, 1, 9, z); SOL_F(46, 39, 1, 9, w);
        SOL_F(46, 40, 1, 10, x); SOL_F(46, 41, 1, 10, y); SOL_F(46, 42, 1, 10, z); SOL_F(46, 43, 1, 10, w);
        SOL_F(46, 44, 1, 11, x); SOL_F(46, 45, 1, 11, y);
        __builtin_amdgcn_sched_barrier(0);
        SOL_L(1, 0, 3264); SOL_L(1, 1, 3268); SOL_L(1, 2, 3272); SOL_L(1, 3, 3276); SOL_L(1, 4, 3280); SOL_L(1, 5, 3284); SOL_L(1, 6, 3288); SOL_L(1, 7, 3292); SOL_L(1, 8, 3296); SOL_L(1, 9, 3300); SOL_L(1, 10, 3304); SOL_L(1, 11, 3308);
        __builtin_amdgcn_sched_barrier(0);
        SOL_F(47, 0, 0, 0, x); SOL_F(47, 1, 0, 0, y); SOL_F(47, 2, 0, 0, z); SOL_F(47, 3, 0, 0, w);
        SOL_F(47, 4, 0, 1, x); SOL_F(47, 5, 0, 1, y); SOL_F(47, 6, 0, 1, z); SOL_F(47, 7, 0, 1, w);
        SOL_F(47, 8, 0, 2, x); SOL_F(47, 9, 0, 2, y); SOL_F(47, 10, 0, 2, z); SOL_F(47, 11, 0, 2, w);
        SOL_F(47, 12, 0, 3, x); SOL_F(47, 13, 0, 3, y); SOL_F(47, 14, 0, 3, z); SOL_F(47, 15, 0, 3, w);
        SOL_F(47, 16, 0, 4, x); SOL_F(47, 17, 0, 4, y); SOL_F(47, 18, 0, 4, z); SOL_F(47, 19, 0, 4, w);
        SOL_F(47, 20, 0, 5, x); SOL_F(47, 21, 0, 5, y); SOL_F(47, 22, 0, 5, z); SOL_F(47, 23, 0, 5, w);
        SOL_F(47, 24, 0, 6, x); SOL_F(47, 25, 0, 6, y); SOL_F(47, 26, 0, 6, z); SOL_F(47, 27, 0, 6, w);
        SOL_F(47, 28, 0, 7, x); SOL_F(47, 29, 0, 7, y); SOL_F(47, 30, 0, 7, z); SOL_F(47, 31, 0, 7, w);
        SOL_F(47, 32, 0, 8, x); SOL_F(47, 33, 0, 8, y); SOL_F(47, 34, 0, 8, z); SOL_F(47, 35, 0, 8, w);
        SOL_F(47, 36, 0, 9, x); SOL_F(47, 37, 0, 9, y); SOL_F(47, 38, 0, 9, z); SOL_F(47, 39, 0, 9, w);
        SOL_F(47, 40, 0, 10, x); SOL_F(47, 41, 0, 10, y); SOL_F(47, 42, 0, 10, z); SOL_F(47, 43, 0, 10, w);
        SOL_F(47, 44, 0, 11, x); SOL_F(47, 45, 0, 11, y); SOL_F(47, 46, 0, 11, z);
        __builtin_amdgcn_sched_barrier(0);
        SOL_L(0, 0, 3332); SOL_L(0, 1, 3336); SOL_L(0, 2, 3340); SOL_L(0, 3, 3344); SOL_L(0, 4, 3348); SOL_L(0, 5, 3352); SOL_L(0, 6, 3356); SOL_L(0, 7, 3360); SOL_L(0, 8, 3364); SOL_L(0, 9, 3368); SOL_L(0, 10, 3372); SOL_L(0, 11, 3376);
        __builtin_amdgcn_sched_barrier(0);
        SOL_F(48, 0, 1, 0, x); SOL_F(48, 1, 1, 0, y); SOL_F(48, 2, 1, 0, z); SOL_F(48, 3, 1, 0, w);
        SOL_F(48, 4, 1, 1, x); SOL_F(48, 5, 1, 1, y); SOL_F(48, 6, 1, 1, z); SOL_F(48, 7, 1, 1, w);
        SOL_F(48, 8, 1, 2, x); SOL_F(48, 9, 1, 2, y); SOL_F(48, 10, 1, 2, z); SOL_F(48, 11, 1, 2, w);
        SOL_F(48, 12, 1, 3, x); SOL_F(48, 13, 1, 3, y); SOL_F(48, 14, 1, 3, z); SOL_F(48, 15, 1, 3, w);
        SOL_F(48, 16, 1, 4, x); SOL_F(48, 17, 1, 4, y); SOL_F(48, 18, 1, 4, z); SOL_F(48, 19, 1, 4, w);
        SOL_F(48, 20, 1, 5, x); SOL_F(48, 21, 1, 5, y); SOL_F(48, 22, 1, 5, z); SOL_F(48, 23, 1, 5, w);
        SOL_F(48, 24, 1, 6, x); SOL_F(48, 25, 1, 6, y); SOL_F(48, 26, 1, 6, z); SOL_F(48, 27, 1, 6, w);
        SOL_F(48, 28, 1, 7, x); SOL_F(48, 29, 1, 7, y); SOL_F(48, 30, 1, 7, z); SOL_F(48, 31, 1, 7, w);
        SOL_F(48, 32, 1, 8, x); SOL_F(48, 33, 1, 8, y); SOL_F(48, 34, 1, 8, z); SOL_F(48, 35, 1, 8, w);
        SOL_F(48, 36, 1, 9, x); SOL_F(48, 37, 1, 9, y); SOL_F(48, 38, 1, 9, z); SOL_F(48, 39, 1, 9, w);
        SOL_F(48, 40, 1, 10, x); SOL_F(48, 41, 1, 10, y); SOL_F(48, 42, 1, 10, z); SOL_F(48, 43, 1, 10, w);
        SOL_F(48, 44, 1, 11, x); SOL_F(48, 45, 1, 11, y); SOL_F(48, 46, 1, 11, z); SOL_F(48, 47, 1, 11, w);
        __builtin_amdgcn_sched_barrier(0);
        SOL_L(1, 0, 3380); SOL_L(1, 1, 3400); SOL_L(1, 2, 3404); SOL_L(1, 3, 3408); SOL_L(1, 4, 3412); SOL_L(1, 5, 3416); SOL_L(1, 6, 3420); SOL_L(1, 7, 3424); SOL_L(1, 8, 3428); SOL_L(1, 9, 3432); SOL_L(1, 10, 3436); SOL_L(1, 11, 3440);
        __builtin_amdgcn_sched_barrier(0);
        SOL_F(49, 0, 0, 0, x); SOL_F(49, 1, 0, 0, y); SOL_F(49, 2, 0, 0, z); SOL_F(49, 3, 0, 0, w);
        SOL_F(49, 4, 0, 1, x); SOL_F(49, 5, 0, 1, y); SOL_F(49, 6, 0, 1, z); SOL_F(49, 7, 0, 1, w);
        SOL_F(49, 8, 0, 2, x); SOL_F(49, 9, 0, 2, y); SOL_F(49, 10, 0, 2, z); SOL_F(49, 11, 0, 2, w);
        SOL_F(49, 12, 0, 3, x); SOL_F(49, 13, 0, 3, y); SOL_F(49, 14, 0, 3, z); SOL_F(49, 15, 0, 3, w);
        SOL_F(49, 16, 0, 4, x); SOL_F(49, 17, 0, 4, y); SOL_F(49, 18, 0, 4, z); SOL_F(49, 19, 0, 4, w);
        SOL_F(49, 20, 0, 5, x); SOL_F(49, 21, 0, 5, y); SOL_F(49, 22, 0, 5, z); SOL_F(49, 23, 0, 5, w);
        SOL_F(49, 24, 0, 6, x); SOL_F(49, 25, 0, 6, y); SOL_F(49, 26, 0, 6, z); SOL_F(49, 27, 0, 6, w);
        SOL_F(49, 28, 0, 7, x); SOL_F(49, 29, 0, 7, y); SOL_F(49, 30, 0, 7, z); SOL_F(49, 31, 0, 7, w);
        SOL_F(49, 32, 0, 8, x); SOL_F(49, 33, 0, 8, y); SOL_F(49, 34, 0, 8, z); SOL_F(49, 35, 0, 8, w);
        SOL_F(49, 36, 0, 9, x); SOL_F(49, 37, 0, 9, y); SOL_F(49, 38, 0, 9, z); SOL_F(49, 39, 0, 9, w);
        SOL_F(49, 40, 0, 10, x); SOL_F(49, 41, 0, 10, y); SOL_F(49, 42, 0, 10, z); SOL_F(49, 43, 0, 10, w);
        SOL_F(49, 44, 0, 11, x); SOL_F(49, 45, 0, 11, y); SOL_F(49, 46, 0, 11, z); SOL_F(49, 47, 0, 11, w);
        __builtin_amdgcn_sched_barrier(0);
        SOL_L(0, 0, 3444); SOL_L(0, 1, 3448); SOL_L(0, 2, 3468); SOL_L(0, 3, 3472); SOL_L(0, 4, 3476); SOL_L(0, 5, 3480); SOL_L(0, 6, 3484); SOL_L(0, 7, 3488); SOL_L(0, 8, 3492); SOL_L(0, 9, 3496); SOL_L(0, 10, 3500); SOL_L(0, 11, 3504);
        __builtin_amdgcn_sched_barrier(0);
        SOL_F(49, 48, 1, 0, x);
        SOL_F(50, 0, 1, 1, x); SOL_F(50, 1, 1, 1, y); SOL_F(50, 2, 1, 1, z); SOL_F(50, 3, 1, 1, w);
        SOL_F(50, 4, 1, 2, x); SOL_F(50, 5, 1, 2, y); SOL_F(50, 6, 1, 2, z); SOL_F(50, 7, 1, 2, w);
        SOL_F(50, 8, 1, 3, x); SOL_F(50, 9, 1, 3, y); SOL_F(50, 10, 1, 3, z); SOL_F(50, 11, 1, 3, w);
        SOL_F(50, 12, 1, 4, x); SOL_F(50, 13, 1, 4, y); SOL_F(50, 14, 1, 4, z); SOL_F(50, 15, 1, 4, w);
        SOL_F(50, 16, 1, 5, x); SOL_F(50, 17, 1, 5, y); SOL_F(50, 18, 1, 5, z); SOL_F(50, 19, 1, 5, w);
        SOL_F(50, 20, 1, 6, x); SOL_F(50, 21, 1, 6, y); SOL_F(50, 22, 1, 6, z); SOL_F(50, 23, 1, 6, w);
        SOL_F(50, 24, 1, 7, x); SOL_F(50, 25, 1, 7, y); SOL_F(50, 26, 1, 7, z); SOL_F(50, 27, 1, 7, w);
        SOL_F(50, 28, 1, 8, x); SOL_F(50, 29, 1, 8, y); SOL_F(50, 30, 1, 8, z); SOL_F(50, 31, 1, 8, w);
        SOL_F(50, 32, 1, 9, x); SOL_F(50, 33, 1, 9, y); SOL_F(50, 34, 1, 9, z); SOL_F(50, 35, 1, 9, w);
        SOL_F(50, 36, 1, 10, x); SOL_F(50, 37, 1, 10, y); SOL_F(50, 38, 1, 10, z); SOL_F(50, 39, 1, 10, w);
        SOL_F(50, 40, 1, 11, x); SOL_F(50, 41, 1, 11, y); SOL_F(50, 42, 1, 11, z); SOL_F(50, 43, 1, 11, w);
        __builtin_amdgcn_sched_barrier(0);
        SOL_L(1, 0, 3508); SOL_L(1, 1, 3512); SOL_L(1, 2, 3516); SOL_L(1, 3, 3536); SOL_L(1, 4, 3540); SOL_L(1, 5, 3544); SOL_L(1, 6, 3548); SOL_L(1, 7, 3552); SOL_L(1, 8, 3556); SOL_L(1, 9, 3560); SOL_L(1, 10, 3564); SOL_L(1, 11, 3568);
        __builtin_amdgcn_sched_barrier(0);
        SOL_F(50, 44, 0, 0, x); SOL_F(50, 45, 0, 0, y); SOL_F(50, 46, 0, 0, z); SOL_F(50, 47, 0, 0, w);
        SOL_F(50, 48, 0, 1, x); SOL_F(50, 49, 0, 1, y);
        SOL_F(51, 0, 0, 2, x); SOL_F(51, 1, 0, 2, y); SOL_F(51, 2, 0, 2, z); SOL_F(51, 3, 0, 2, w);
        SOL_F(51, 4, 0, 3, x); SOL_F(51, 5, 0, 3, y); SOL_F(51, 6, 0, 3, z); SOL_F(51, 7, 0, 3, w);
        SOL_F(51, 8, 0, 4, x); SOL_F(51, 9, 0, 4, y); SOL_F(51, 10, 0, 4, z); SOL_F(51, 11, 0, 4, w);
        SOL_F(51, 12, 0, 5, x); SOL_F(51, 13, 0, 5, y); SOL_F(51, 14, 0, 5, z); SOL_F(51, 15, 0, 5, w);
        SOL_F(51, 16, 0, 6, x); SOL_F(51, 17, 0, 6, y); SOL_F(51, 18, 0, 6, z); SOL_F(51, 19, 0, 6, w);
        SOL_F(51, 20, 0, 7, x); SOL_F(51, 21, 0, 7, y); SOL_F(51, 22, 0, 7, z); SOL_F(51, 23, 0, 7, w);
        SOL_F(51, 24, 0, 8, x); SOL_F(51, 25, 0, 8, y); SOL_F(51, 26, 0, 8, z); SOL_F(51, 27, 0, 8, w);
        SOL_F(51, 28, 0, 9, x); SOL_F(51, 29, 0, 9, y); SOL_F(51, 30, 0, 9, z); SOL_F(51, 31, 0, 9, w);
        SOL_F(51, 32, 0, 10, x); SOL_F(51, 33, 0, 10, y); SOL_F(51, 34, 0, 10, z); SOL_F(51, 35, 0, 10, w);
        SOL_F(51, 36, 0, 11, x); SOL_F(51, 37, 0, 11, y); SOL_F(51, 38, 0, 11, z); SOL_F(51, 39, 0, 11, w);
        __builtin_amdgcn_sched_barrier(0);
        SOL_L(0, 0, 3572); SOL_L(0, 1, 3576); SOL_L(0, 2, 3580); SOL_L(0, 3, 3584); SOL_L(0, 4, 3604); SOL_L(0, 5, 3608); SOL_L(0, 6, 3612); SOL_L(0, 7, 3616); SOL_L(0, 8, 3620); SOL_L(0, 9, 3624); SOL_L(0, 10, 3628); SOL_L(0, 11, 3632);
        __builtin_amdgcn_sched_barrier(0);
        SOL_F(51, 40, 1, 0, x); SOL_F(51, 41, 1, 0, y); SOL_F(51, 42, 1, 0, z); SOL_F(51, 43, 1, 0, w);
        SOL_F(51, 44, 1, 1, x); SOL_F(51, 45, 1, 1, y); SOL_F(51, 46, 1, 1, z); SOL_F(51, 47, 1, 1, w);
        SOL_F(51, 48, 1, 2, x); SOL_F(51, 49, 1, 2, y); SOL_F(51, 50, 1, 2, z);
        SOL_F(52, 0, 1, 3, x); SOL_F(52, 1, 1, 3, y); SOL_F(52, 2, 1, 3, z); SOL_F(52, 3, 1, 3, w);
        SOL_F(52, 4, 1, 4, x); SOL_F(52, 5, 1, 4, y); SOL_F(52, 6, 1, 4, z); SOL_F(52, 7, 1, 4, w);
        SOL_F(52, 8, 1, 5, x); SOL_F(52, 9, 1, 5, y); SOL_F(52, 10, 1, 5, z); SOL_F(52, 11, 1, 5, w);
        SOL_F(52, 12, 1, 6, x); SOL_F(52, 13, 1, 6, y); SOL_F(52, 14, 1, 6, z); SOL_F(52, 15, 1, 6, w);
        SOL_F(52, 16, 1, 7, x); SOL_F(52, 17, 1, 7, y); SOL_F(52, 18, 1, 7, z); SOL_F(52, 19, 1, 7, w);
        SOL_F(52, 20, 1, 8, x); SOL_F(52, 21, 1, 8, y); SOL_F(52, 22, 1, 8, z); SOL_F(52, 23, 1, 8, w);
        SOL_F(52, 24, 1, 9, x); SOL_F(52, 25, 1, 9, y); SOL_F(52, 26, 1, 9, z); SOL_F(52, 27, 1, 9, w);
        SOL_F(52, 28, 1, 10, x); SOL_F(52, 29, 1, 10, y); SOL_F(52, 30, 1, 10, z); SOL_F(52, 31, 1, 10, w);
        SOL_F(52, 32, 1, 11, x); SOL_F(52, 33, 1, 11, y); SOL_F(52, 34, 1, 11, z); SOL_F(52, 35, 1, 11, w);
        __builtin_amdgcn_sched_barrier(0);
        SOL_L(1, 0, 3636); SOL_L(1, 1, 3640); SOL_L(1, 2, 3644); SOL_L(1, 3, 3648); SOL_L(1, 4, 3652); SOL_L(1, 5, 3656); SOL_L(1, 6, 3672); SOL_L(1, 7, 3676); SOL_L(1, 8, 3680); SOL_L(1, 9, 3684); SOL_L(1, 10, 3688); SOL_L(1, 11, 3692);
        __builtin_amdgcn_sched_barrier(0);
        SOL_F(52, 36, 0, 0, x); SOL_F(52, 37, 0, 0, y); SOL_F(52, 38, 0, 0, z); SOL_F(52, 39, 0, 0, w);
        SOL_F(52, 40, 0, 1, x); SOL_F(52, 41, 0, 1, y); SOL_F(52, 42, 0, 1, z); SOL_F(52, 43, 0, 1, w);
        SOL_F(52, 44, 0, 2, x); SOL_F(52, 45, 0, 2, y); SOL_F(52, 46, 0, 2, z); SOL_F(52, 47, 0, 2, w);
        SOL_F(52, 48, 0, 3, x); SOL_F(52, 49, 0, 3, y); SOL_F(52, 50, 0, 3, z); SOL_F(52, 51, 0, 3, w);
        SOL_F(53, 0, 0, 4, x); SOL_F(53, 1, 0, 4, y); SOL_F(53, 2, 0, 4, z); SOL_F(53, 3, 0, 4, w);
        SOL_F(53, 4, 0, 5, x); SOL_F(53, 5, 0, 5, y); SOL_F(53, 6, 0, 5, z); SOL_F(53, 7, 0, 5, w);
        SOL_F(53, 8, 0, 6, x); SOL_F(53, 9, 0, 6, y); SOL_F(53, 10, 0, 6, z); SOL_F(53, 11, 0, 6, w);
        SOL_F(53, 12, 0, 7, x); SOL_F(53, 13, 0, 7, y); SOL_F(53, 14, 0, 7, z); SOL_F(53, 15, 0, 7, w);
        SOL_F(53, 16, 0, 8, x); SOL_F(53, 17, 0, 8, y); SOL_F(53, 18, 0, 8, z); SOL_F(53, 19, 0, 8, w);
        SOL_F(53, 20, 0, 9, x); SOL_F(53, 21, 0, 9, y); SOL_F(53, 22, 0, 9, z); SOL_F(53, 23, 0, 9, w);
        SOL_F(53, 24, 0, 10, x); SOL_F(53, 25, 0, 10, y); SOL_F(53, 26, 0, 10, z); SOL_F(53, 27, 0, 10, w);
        SOL_F(53, 28, 0, 11, x); SOL_F(53, 29, 0, 11, y); SOL_F(53, 30, 0, 11, z); SOL_F(53, 31, 0, 11, w);
        __builtin_amdgcn_sched_barrier(0);
        SOL_L(0, 0, 3696); SOL_L(0, 1, 3700); SOL_L(0, 2, 3704); SOL_L(0, 3, 3708); SOL_L(0, 4, 3712); SOL_L(0, 5, 3716); SOL_L(0, 6, 3720); SOL_L(0, 7, 3724); SOL_L(0, 8, 3740); SOL_L(0, 9, 3744); SOL_L(0, 10, 3748); SOL_L(0, 11, 3752);
        __builtin_amdgcn_sched_barrier(0);
        SOL_F(53, 32, 1, 0, x); SOL_F(53, 33, 1, 0, y); SOL_F(53, 34, 1, 0, z); SOL_F(53, 35, 1, 0, w);
        SOL_F(53, 36, 1, 1, x); SOL_F(53, 37, 1, 1, y); SOL_F(53, 38, 1, 1, z); SOL_F(53, 39, 1, 1, w);
        SOL_F(53, 40, 1, 2, x); SOL_F(53, 41, 1, 2, y); SOL_F(53, 42, 1, 2, z); SOL_F(53, 43, 1, 2, w);
        SOL_F(53, 44, 1, 3, x); SOL_F(53, 45, 1, 3, y); SOL_F(53, 46, 1, 3, z); SOL_F(53, 47, 1, 3, w);
        SOL_F(53, 48, 1, 4, x); SOL_F(53, 49, 1, 4, y); SOL_F(53, 50, 1, 4, z); SOL_F(53, 51, 1, 4, w);
        SOL_F(53, 52, 1, 5, x);
        SOL_F(54, 0, 1, 6, x); SOL_F(54, 1, 1, 6, y); SOL_F(54, 2, 1, 6, z); SOL_F(54, 3, 1, 6, w);
        SOL_F(54, 4, 1, 7, x); SOL_F(54, 5, 1, 7, y); SOL_F(54, 6, 1, 7, z); SOL_F(54, 7, 1, 7, w);
        SOL_F(54, 8, 1, 8, x); SOL_F(54, 9, 1, 8, y); SOL_F(54, 10, 1, 8, z); SOL_F(54, 11, 1, 8, w);
        SOL_F(54, 12, 1, 9, x); SOL_F(54, 13, 1, 9, y); SOL_F(54, 14, 1, 9, z); SOL_F(54, 15, 1, 9, w);
        SOL_F(54, 16, 1, 10, x); SOL_F(54, 17, 1, 10, y); SOL_F(54, 18, 1, 10, z); SOL_F(54, 19, 1, 10, w);
        SOL_F(54, 20, 1, 11, x); SOL_F(54, 21, 1, 11, y); SOL_F(54, 22, 1, 11, z); SOL_F(54, 23, 1, 11, w);
        __builtin_amdgcn_sched_barrier(0);
        SOL_L(1, 0, 3756); SOL_L(1, 1, 3760); SOL_L(1, 2, 3764); SOL_L(1, 3, 3768); SOL_L(1, 4, 3772); SOL_L(1, 5, 3776); SOL_L(1, 6, 3780); SOL_L(1, 7, 3784); SOL_L(1, 8, 3788); SOL_L(1, 9, 3792); SOL_L(1, 10, 3808); SOL_L(1, 11, 3812);
        __builtin_amdgcn_sched_barrier(0);
        SOL_F(54, 24, 0, 0, x); SOL_F(54, 25, 0, 0, y); SOL_F(54, 26, 0, 0, z); SOL_F(54, 27, 0, 0, w);
        SOL_F(54, 28, 0, 1, x); SOL_F(54, 29, 0, 1, y); SOL_F(54, 30, 0, 1, z); SOL_F(54, 31, 0, 1, w);
        SOL_F(54, 32, 0, 2, x); SOL_F(54, 33, 0, 2, y); SOL_F(54, 34, 0, 2, z); SOL_F(54, 35, 0, 2, w);
        SOL_F(54, 36, 0, 3, x); SOL_F(54, 37, 0, 3, y); SOL_F(54, 38, 0, 3, z); SOL_F(54, 39, 0, 3, w);
        SOL_F(54, 40, 0, 4, x); SOL_F(54, 41, 0, 4, y); SOL_F(54, 42, 0, 4, z); SOL_F(54, 43, 0, 4, w);
        SOL_F(54, 44, 0, 5, x); SOL_F(54, 45, 0, 5, y); SOL_F(54, 46, 0, 5, z); SOL_F(54, 47, 0, 5, w);
        SOL_F(54, 48, 0, 6, x); SOL_F(54, 49, 0, 6, y); SOL_F(54, 50, 0, 6, z); SOL_F(54, 51, 0, 6, w);
        SOL_F(54, 52, 0, 7, x); SOL_F(54, 53, 0, 7, y);
        SOL_F(55, 0, 0, 8, x); SOL_F(55, 1, 0, 8, y); SOL_F(55, 2, 0, 8, z); SOL_F(55, 3, 0, 8, w);
        SOL_F(55, 4, 0, 9, x); SOL_F(55, 5, 0, 9, y); SOL_F(55, 6, 0, 9, z); SOL_F(55, 7, 0, 9, w);
        SOL_F(55, 8, 0, 10, x); SOL_F(55, 9, 0, 10, y); SOL_F(55, 10, 0, 10, z); SOL_F(55, 11, 0, 10, w);
        SOL_F(55, 12, 0, 11, x); SOL_F(55, 13, 0, 11, y); SOL_F(55, 14, 0, 11, z); SOL_F(55, 15, 0, 11, w);
        __builtin_amdgcn_sched_barrier(0);
        SOL_L(0, 0, 3816); SOL_L(0, 1, 3820); SOL_L(0, 2, 3824); SOL_L(0, 3, 3828); SOL_L(0, 4, 3832); SOL_L(0, 5, 3836); SOL_L(0, 6, 3840); SOL_L(0, 7, 3844); SOL_L(0, 8, 3848); SOL_L(0, 9, 3852); SOL_L(0, 10, 3856); SOL_L(0, 11, 3860);
        __builtin_amdgcn_sched_barrier(0);
        SOL_F(55, 16, 1, 0, x); SOL_F(55, 17, 1, 0, y); SOL_F(55, 18, 1, 0, z); SOL_F(55, 19, 1, 0, w);
        SOL_F(55, 20, 1, 1, x); SOL_F(55, 21, 1, 1, y); SOL_F(55, 22, 1, 1, z); SOL_F(55, 23, 1, 1, w);
        SOL_F(55, 24, 1, 2, x); SOL_F(55, 25, 1, 2, y); SOL_F(55, 26, 1, 2, z); SOL_F(55, 27, 1, 2, w);
        SOL_F(55, 28, 1, 3, x); SOL_F(55, 29, 1, 3, y); SOL_F(55, 30, 1, 3, z); SOL_F(55, 31, 1, 3, w);
        SOL_F(55, 32, 1, 4, x); SOL_F(55, 33, 1, 4, y); SOL_F(55, 34, 1, 4, z); SOL_F(55, 35, 1, 4, w);
        SOL_F(55, 36, 1, 5, x); SOL_F(55, 37, 1, 5, y); SOL_F(55, 38, 1, 5, z); SOL_F(55, 39, 1, 5, w);
        SOL_F(55, 40, 1, 6, x); SOL_F(55, 41, 1, 6, y); SOL_F(55, 42, 1, 6, z); SOL_F(55, 43, 1, 6, w);
        SOL_F(55, 44, 1, 7, x); SOL_F(55, 45, 1, 7, y); SOL_F(55, 46, 1, 7, z); SOL_F(55, 47, 1, 7, w);
        SOL_F(55, 48, 1, 8, x); SOL_F(55, 49, 1, 8, y); SOL_F(55, 50, 1, 8, z); SOL_F(55, 51, 1, 8, w);
        SOL_F(55, 52, 1, 9, x); SOL_F(55, 53, 1, 9, y); SOL_F(55, 54, 1, 9, z);
        SOL_F(56, 0, 1, 10, x); SOL_F(56, 1, 1, 10, y); SOL_F(56, 2, 1, 10, z); SOL_F(56, 3, 1, 10, w);
        SOL_F(56, 4, 1, 11, x); SOL_F(56, 5, 1, 11, y); SOL_F(56, 6, 1, 11, z); SOL_F(56, 7, 1, 11, w);
        __builtin_amdgcn_sched_barrier(0);
        SOL_L(1, 0, 3876); SOL_L(1, 1, 3880); SOL_L(1, 2, 3884); SOL_L(1, 3, 3888); SOL_L(1, 4, 3892); SOL_L(1, 5, 3896); SOL_L(1, 6, 3900); SOL_L(1, 7, 3904); SOL_L(1, 8, 3908); SOL_L(1, 9, 3912); SOL_L(1, 10, 3916); SOL_L(1, 11, 3920);
        __builtin_amdgcn_sched_barrier(0);
        SOL_F(56, 8, 0, 0, x); SOL_F(56, 9, 0, 0, y); SOL_F(56, 10, 0, 0, z); SOL_F(56, 11, 0, 0, w);
        SOL_F(56, 12, 0, 1, x); SOL_F(56, 13, 0, 1, y); SOL_F(56, 14, 0, 1, z); SOL_F(56, 15, 0, 1, w);
        SOL_F(56, 16, 0, 2, x); SOL_F(56, 17, 0, 2, y); SOL_F(56, 18, 0, 2, z); SOL_F(56, 19, 0, 2, w);
        SOL_F(56, 20, 0, 3, x); SOL_F(56, 21, 0, 3, y); SOL_F(56, 22, 0, 3, z); SOL_F(56, 23, 0, 3, w);
        SOL_F(56, 24, 0, 4, x); SOL_F(56, 25, 0, 4, y); SOL_F(56, 26, 0, 4, z); SOL_F(56, 27, 0, 4, w);
        SOL_F(56, 28, 0, 5, x); SOL_F(56, 29, 0, 5, y); SOL_F(56, 30, 0, 5, z); SOL_F(56, 31, 0, 5, w);
        SOL_F(56, 32, 0, 6, x); SOL_F(56, 33, 0, 6, y); SOL_F(56, 34, 0, 6, z); SOL_F(56, 35, 0, 6, w);
        SOL_F(56, 36, 0, 7, x); SOL_F(56, 37, 0, 7, y); SOL_F(56, 38, 0, 7, z); SOL_F(56, 39, 0, 7, w);
        SOL_F(56, 40, 0, 8, x); SOL_F(56, 41, 0, 8, y); SOL_F(56, 42, 0, 8, z); SOL_F(56, 43, 0, 8, w);
        SOL_F(56, 44, 0, 9, x); SOL_F(56, 45, 0, 9, y); SOL_F(56, 46, 0, 9, z); SOL_F(56, 47, 0, 9, w);
        SOL_F(56, 48, 0, 10, x); SOL_F(56, 49, 0, 10, y); SOL_F(56, 50, 0, 10, z); SOL_F(56, 51, 0, 10, w);
        SOL_F(56, 52, 0, 11, x); SOL_F(56, 53, 0, 11, y); SOL_F(56, 54, 0, 11, z); SOL_F(56, 55, 0, 11, w);
        __builtin_amdgcn_sched_barrier(0);
        SOL_L(0, 0, 3924); SOL_L(0, 1, 3928); SOL_L(0, 2, 3932); SOL_L(0, 3, 3944); SOL_L(0, 4, 3948); SOL_L(0, 5, 3952); SOL_L(0, 6, 3956); SOL_L(0, 7, 3960); SOL_L(0, 8, 3964); SOL_L(0, 9, 3968); SOL_L(0, 10, 3972); SOL_L(0, 11, 3976);
        __builtin_amdgcn_sched_barrier(0);
        SOL_F(57, 0, 1, 0, x); SOL_F(57, 1, 1, 0, y); SOL_F(57, 2, 1, 0, z); SOL_F(57, 3, 1, 0, w);
        SOL_F(57, 4, 1, 1, x); SOL_F(57, 5, 1, 1, y); SOL_F(57, 6, 1, 1, z); SOL_F(57, 7, 1, 1, w);
        SOL_F(57, 8, 1, 2, x); SOL_F(57, 9, 1, 2, y); SOL_F(57, 10, 1, 2, z); SOL_F(57, 11, 1, 2, w);
        SOL_F(57, 12, 1, 3, x); SOL_F(57, 13, 1, 3, y); SOL_F(57, 14, 1, 3, z); SOL_F(57, 15, 1, 3, w);
        SOL_F(57, 16, 1, 4, x); SOL_F(57, 17, 1, 4, y); SOL_F(57, 18, 1, 4, z); SOL_F(57, 19, 1, 4, w);
        SOL_F(57, 20, 1, 5, x); SOL_F(57, 21, 1, 5, y); SOL_F(57, 22, 1, 5, z); SOL_F(57, 23, 1, 5, w);
        SOL_F(57, 24, 1, 6, x); SOL_F(57, 25, 1, 6, y); SOL_F(57, 26, 1, 6, z); SOL_F(57, 27, 1, 6, w);
        SOL_F(57, 28, 1, 7, x); SOL_F(57, 29, 1, 7, y); SOL_F(57, 30, 1, 7, z); SOL_F(57, 31, 1, 7, w);
        SOL_F(57, 32, 1, 8, x); SOL_F(57, 33, 1, 8, y); SOL_F(57, 34, 1, 8, z); SOL_F(57, 35, 1, 8, w);
        SOL_F(57, 36, 1, 9, x); SOL_F(57, 37, 1, 9, y); SOL_F(57, 38, 1, 9, z); SOL_F(57, 39, 1, 9, w);
        SOL_F(57, 40, 1, 10, x); SOL_F(57, 41, 1, 10, y); SOL_F(57, 42, 1, 10, z); SOL_F(57, 43, 1, 10, w);
        SOL_F(57, 44, 1, 11, x); SOL_F(57, 45, 1, 11, y); SOL_F(57, 46, 1, 11, z); SOL_F(57, 47, 1, 11, w);
        __builtin_amdgcn_sched_barrier(0);
        SOL_L(1, 0, 3980); SOL_L(1, 1, 3984); SOL_L(1, 2, 3988); SOL_L(1, 3, 3992); SOL_L(1, 4, 3996); SOL_L(1, 5, 4000); SOL_L(1, 6, 4012); SOL_L(1, 7, 4016); SOL_L(1, 8, 4020); SOL_L(1, 9, 4024); SOL_L(1, 10, 4028); SOL_L(1, 11, 4032);
        __builtin_amdgcn_sched_barrier(0);
        SOL_F(57, 48, 0, 0, x); SOL_F(57, 49, 0, 0, y); SOL_F(57, 50, 0, 0, z); SOL_F(57, 51, 0, 0, w);
        SOL_F(57, 52, 0, 1, x); SOL_F(57, 53, 0, 1, y); SOL_F(57, 54, 0, 1, z); SOL_F(57, 55, 0, 1, w);
        SOL_F(57, 56, 0, 2, x);
        SOL_F(58, 0, 0, 3, x); SOL_F(58, 1, 0, 3, y); SOL_F(58, 2, 0, 3, z); SOL_F(58, 3, 0, 3, w);
        SOL_F(58, 4, 0, 4, x); SOL_F(58, 5, 0, 4, y); SOL_F(58, 6, 0, 4, z); SOL_F(58, 7, 0, 4, w);
        SOL_F(58, 8, 0, 5, x); SOL_F(58, 9, 0, 5, y); SOL_F(58, 10, 0, 5, z); SOL_F(58, 11, 0, 5, w);
        SOL_F(58, 12, 0, 6, x); SOL_F(58, 13, 0, 6, y); SOL_F(58, 14, 0, 6, z); SOL_F(58, 15, 0, 6, w);
        SOL_F(58, 16, 0, 7, x); SOL_F(58, 17, 0, 7, y); SOL_F(58, 18, 0, 7, z); SOL_F(58, 19, 0, 7, w);
        SOL_F(58, 20, 0, 8, x); SOL_F(58, 21, 0, 8, y); SOL_F(58, 22, 0, 8, z); SOL_F(58, 23, 0, 8, w);
        SOL_F(58, 24, 0, 9, x); SOL_F(58, 25, 0, 9, y); SOL_F(58, 26, 0, 9, z); SOL_F(58, 27, 0, 9, w);
        SOL_F(58, 28, 0, 10, x); SOL_F(58, 29, 0, 10, y); SOL_F(58, 30, 0, 10, z); SOL_F(58, 31, 0, 10, w);
        SOL_F(58, 32, 0, 11, x); SOL_F(58, 33, 0, 11, y); SOL_F(58, 34, 0, 11, z); SOL_F(58, 35, 0, 11, w);
        __builtin_amdgcn_sched_barrier(0);
        SOL_L(0, 0, 4036); SOL_L(0, 1, 4040); SOL_L(0, 2, 4044); SOL_L(0, 3, 4048); SOL_L(0, 4, 4052); SOL_L(0, 5, 4056); SOL_L(0, 6, 4060); SOL_L(0, 7, 4064); SOL_L(0, 8, 4068); SOL_L(0, 9, 4080); SOL_L(0, 10, 4084); SOL_L(0, 11, 4088);
        __builtin_amdgcn_sched_barrier(0);
        SOL_F(58, 36, 1, 0, x); SOL_F(58, 37, 1, 0, y); SOL_F(58, 38, 1, 0, z); SOL_F(58, 39, 1, 0, w);
        SOL_F(58, 40, 1, 1, x); SOL_F(58, 41, 1, 1, y); SOL_F(58, 42, 1, 1, z); SOL_F(58, 43, 1, 1, w);
        SOL_F(58, 44, 1, 2, x); SOL_F(58, 45, 1, 2, y); SOL_F(58, 46, 1, 2, z); SOL_F(58, 47, 1, 2, w);
        SOL_F(58, 48, 1, 3, x); SOL_F(58, 49, 1, 3, y); SOL_F(58, 50, 1, 3, z); SOL_F(58, 51, 1, 3, w);
        SOL_F(58, 52, 1, 4, x); SOL_F(58, 53, 1, 4, y); SOL_F(58, 54, 1, 4, z); SOL_F(58, 55, 1, 4, w);
        SOL_F(58, 56, 1, 5, x); SOL_F(58, 57, 1, 5, y);
        SOL_F(59, 0, 1, 6, x); SOL_F(59, 1, 1, 6, y); SOL_F(59, 2, 1, 6, z); SOL_F(59, 3, 1, 6, w);
        SOL_F(59, 4, 1, 7, x); SOL_F(59, 5, 1, 7, y); SOL_F(59, 6, 1, 7, z); SOL_F(59, 7, 1, 7, w);
        SOL_F(59, 8, 1, 8, x); SOL_F(59, 9, 1, 8, y); SOL_F(59, 10, 1, 8, z); SOL_F(59, 11, 1, 8, w);
        SOL_F(59, 12, 1, 9, x); SOL_F(59, 13, 1, 9, y); SOL_F(59, 14, 1, 9, z); SOL_F(59, 15, 1, 9, w);
        SOL_F(59, 16, 1, 10, x); SOL_F(59, 17, 1, 10, y); SOL_F(59, 18, 1, 10, z); SOL_F(59, 19, 1, 10, w);
        SOL_F(59, 20, 1, 11, x); SOL_F(59, 21, 1, 11, y); SOL_F(59, 22, 1, 11, z); SOL_F(59, 23, 1, 11, w);
        __builtin_amdgcn_sched_barrier(0);
        SOL_L(1, 0, 4092); SOL_L(1, 1, 4096); SOL_L(1, 2, 4100); SOL_L(1, 3, 4104); SOL_L(1, 4, 4108); SOL_L(1, 5, 4112); SOL_L(1, 6, 4116); SOL_L(1, 7, 4120); SOL_L(1, 8, 4124); SOL_L(1, 9, 4128); SOL_L(1, 10, 4132); SOL_L(1, 11, 4136);
        __builtin_amdgcn_sched_barrier(0);
        SOL_F(59, 24, 0, 0, x); SOL_F(59, 25, 0, 0, y); SOL_F(59, 26, 0, 0, z); SOL_F(59, 27, 0, 0, w);
        SOL_F(59, 28, 0, 1, x); SOL_F(59, 29, 0, 1, y); SOL_F(59, 30, 0, 1, z); SOL_F(59, 31, 0, 1, w);
        SOL_F(59, 32, 0, 2, x); SOL_F(59, 33, 0, 2, y); SOL_F(59, 34, 0, 2, z); SOL_F(59, 35, 0, 2, w);
        SOL_F(59, 36, 0, 3, x); SOL_F(59, 37, 0, 3, y); SOL_F(59, 38, 0, 3, z); SOL_F(59, 39, 0, 3, w);
        SOL_F(59, 40, 0, 4, x); SOL_F(59, 41, 0, 4, y); SOL_F(59, 42, 0, 4, z); SOL_F(59, 43, 0, 4, w);
        SOL_F(59, 44, 0, 5, x); SOL_F(59, 45, 0, 5, y); SOL_F(59, 46, 0, 5, z); SOL_F(59, 47, 0, 5, w);
        SOL_F(59, 48, 0, 6, x); SOL_F(59, 49, 0, 6, y); SOL_F(59, 50, 0, 6, z); SOL_F(59, 51, 0, 6, w);
        SOL_F(59, 52, 0, 7, x); SOL_F(59, 53, 0, 7, y); SOL_F(59, 54, 0, 7, z); SOL_F(59, 55, 0, 7, w);
        SOL_F(59, 56, 0, 8, x); SOL_F(59, 57, 0, 8, y); SOL_F(59, 58, 0, 8, z);
        SOL_F(60, 0, 0, 9, x); SOL_F(60, 1, 0, 9, y); SOL_F(60, 2, 0, 9, z); SOL_F(60, 3, 0, 9, w);
        SOL_F(60, 4, 0, 10, x); SOL_F(60, 5, 0, 10, y); SOL_F(60, 6, 0, 10, z); SOL_F(60, 7, 0, 10, w);
        SOL_F(60, 8, 0, 11, x); SOL_F(60, 9, 0, 11, y); SOL_F(60, 10, 0, 11, z); SOL_F(60, 11, 0, 11, w);
        __builtin_amdgcn_sched_barrier(0);
        SOL_L(0, 0, 4148); SOL_L(0, 1, 4152); SOL_L(0, 2, 4156); SOL_L(0, 3, 4160); SOL_L(0, 4, 4164); SOL_L(0, 5, 4168); SOL_L(0, 6, 4172); SOL_L(0, 7, 4176); SOL_L(0, 8, 4180); SOL_L(0, 9, 4184); SOL_L(0, 10, 4188); SOL_L(0, 11, 4192);
        __builtin_amdgcn_sched_barrier(0);
        SOL_F(60, 12, 1, 0, x); SOL_F(60, 13, 1, 0, y); SOL_F(60, 14, 1, 0, z); SOL_F(60, 15, 1, 0, w);
        SOL_F(60, 16, 1, 1, x); SOL_F(60, 17, 1, 1, y); SOL_F(60, 18, 1, 1, z); SOL_F(60, 19, 1, 1, w);
        SOL_F(60, 20, 1, 2, x); SOL_F(60, 21, 1, 2, y); SOL_F(60, 22, 1, 2, z); SOL_F(60, 23, 1, 2, w);
        SOL_F(60, 24, 1, 3, x); SOL_F(60, 25, 1, 3, y); SOL_F(60, 26, 1, 3, z); SOL_F(60, 27, 1, 3, w);
        SOL_F(60, 28, 1, 4, x); SOL_F(60, 29, 1, 4, y); SOL_F(60, 30, 1, 4, z); SOL_F(60, 31, 1, 4, w);
        SOL_F(60, 32, 1, 5, x); SOL_F(60, 33, 1, 5, y); SOL_F(60, 34, 1, 5, z); SOL_F(60, 35, 1, 5, w);
        SOL_F(60, 36, 1, 6, x); SOL_F(60, 37, 1, 6, y); SOL_F(60, 38, 1, 6, z); SOL_F(60, 39, 1, 6, w);
        SOL_F(60, 40, 1, 7, x); SOL_F(60, 41, 1, 7, y); SOL_F(60, 42, 1, 7, z); SOL_F(60, 43, 1, 7, w);
        SOL_F(60, 44, 1, 8, x); SOL_F(60, 45, 1, 8, y); SOL_F(60, 46, 1, 8, z); SOL_F(60, 47, 1, 8, w);
        SOL_F(60, 48, 1, 9, x); SOL_F(60, 49, 1, 9, y); SOL_F(60, 50, 1, 9, z); SOL_F(60, 51, 1, 9, w);
        SOL_F(60, 52, 1, 10, x); SOL_F(60, 53, 1, 10, y); SOL_F(60, 54, 1, 10, z); SOL_F(60, 55, 1, 10, w);
        SOL_F(60, 56, 1, 11, x); SOL_F(60, 57, 1, 11, y); SOL_F(60, 58, 1, 11, z); SOL_F(60, 59, 1, 11, w);
        __builtin_amdgcn_sched_barrier(0);
        SOL_L(1, 0, 4196); SOL_L(1, 1, 4200); SOL_L(1, 2, 4204); SOL_L(1, 3, 4208); SOL_L(1, 4, 4216); SOL_L(1, 5, 4220); SOL_L(1, 6, 4224); SOL_L(1, 7, 4228); SOL_L(1, 8, 4232); SOL_L(1, 9, 4236); SOL_L(1, 10, 4240); SOL_L(1, 11, 4244);
        __builtin_amdgcn_sched_barrier(0);
        SOL_F(61, 0, 0, 0, x); SOL_F(61, 1, 0, 0, y); SOL_F(61, 2, 0, 0, z); SOL_F(61, 3, 0, 0, w);
        SOL_F(61, 4, 0, 1, x); SOL_F(61, 5, 0, 1, y); SOL_F(61, 6, 0, 1, z); SOL_F(61, 7, 0, 1, w);
        SOL_F(61, 8, 0, 2, x); SOL_F(61, 9, 0, 2, y); SOL_F(61, 10, 0, 2, z); SOL_F(61, 11, 0, 2, w);
        SOL_F(61, 12, 0, 3, x); SOL_F(61, 13, 0, 3, y); SOL_F(61, 14, 0, 3, z); SOL_F(61, 15, 0, 3, w);
        SOL_F(61, 16, 0, 4, x); SOL_F(61, 17, 0, 4, y); SOL_F(61, 18, 0, 4, z); SOL_F(61, 19, 0, 4, w);
        SOL_F(61, 20, 0, 5, x); SOL_F(61, 21, 0, 5, y); SOL_F(61, 22, 0, 5, z); SOL_F(61, 23, 0, 5, w);
        SOL_F(61, 24, 0, 6, x); SOL_F(61, 25, 0, 6, y); SOL_F(61, 26, 0, 6, z); SOL_F(61, 27, 0, 6, w);
        SOL_F(61, 28, 0, 7, x); SOL_F(61, 29, 0, 7, y); SOL_F(61, 30, 0, 7, z); SOL_F(61, 31, 0, 7, w);
        SOL_F(61, 32, 0, 8, x); SOL_F(61, 33, 0, 8, y); SOL_F(61, 34, 0, 8, z); SOL_F(61, 35, 0, 8, w);
        SOL_F(61, 36, 0, 9, x); SOL_F(61, 37, 0, 9, y); SOL_F(61, 38, 0, 9, z); SOL_F(61, 39, 0, 9, w);
        SOL_F(61, 40, 0, 10, x); SOL_F(61, 41, 0, 10, y); SOL_F(61, 42, 0, 10, z); SOL_F(61, 43, 0, 10, w);
        SOL_F(61, 44, 0, 11, x); SOL_F(61, 45, 0, 11, y); SOL_F(61, 46, 0, 11, z); SOL_F(61, 47, 0, 11, w);
        __builtin_amdgcn_sched_barrier(0);
        SOL_L(0, 0, 4248); SOL_L(0, 1, 4252); SOL_L(0, 2, 4256); SOL_L(0, 3, 4260); SOL_L(0, 4, 4264); SOL_L(0, 5, 4268); SOL_L(0, 6, 4272); SOL_L(0, 7, 4276); SOL_L(0, 8, 4284); SOL_L(0, 9, 4288); SOL_L(0, 10, 4292); SOL_L(0, 11, 4296);
        __builtin_amdgcn_sched_barrier(0);
        SOL_F(61, 48, 1, 0, x); SOL_F(61, 49, 1, 0, y); SOL_F(61, 50, 1, 0, z); SOL_F(61, 51, 1, 0, w);
        SOL_F(61, 52, 1, 1, x); SOL_F(61, 53, 1, 1, y); SOL_F(61, 54, 1, 1, z); SOL_F(61, 55, 1, 1, w);
        SOL_F(61, 56, 1, 2, x); SOL_F(61, 57, 1, 2, y); SOL_F(61, 58, 1, 2, z); SOL_F(61, 59, 1, 2, w);
        SOL_F(61, 60, 1, 3, x);
        SOL_F(62, 0, 1, 4, x); SOL_F(62, 1, 1, 4, y); SOL_F(62, 2, 1, 4, z); SOL_F(62, 3, 1, 4, w);
        SOL_F(62, 4, 1, 5, x); SOL_F(62, 5, 1, 5, y); SOL_F(62, 6, 1, 5, z); SOL_F(62, 7, 1, 5, w);
        SOL_F(62, 8, 1, 6, x); SOL_F(62, 9, 1, 6, y); SOL_F(62, 10, 1, 6, z); SOL_F(62, 11, 1, 6, w);
        SOL_F(62, 12, 1, 7, x); SOL_F(62, 13, 1, 7, y); SOL_F(62, 14, 1, 7, z); SOL_F(62, 15, 1, 7, w);
        SOL_F(62, 16, 1, 8, x); SOL_F(62, 17, 1, 8, y); SOL_F(62, 18, 1, 8, z); SOL_F(62, 19, 1, 8, w);
        SOL_F(62, 20, 1, 9, x); SOL_F(62, 21, 1, 9, y); SOL_F(62, 22, 1, 9, z); SOL_F(62, 23, 1, 9, w);
        SOL_F(62, 24, 1, 10, x); SOL_F(62, 25, 1, 10, y); SOL_F(62, 26, 1, 10, z); SOL_F(62, 27, 1, 10, w);
        SOL_F(62, 28, 1, 11, x); SOL_F(62, 29, 1, 11, y); SOL_F(62, 30, 1, 11, z); SOL_F(62, 31, 1, 11, w);
        __builtin_amdgcn_sched_barrier(0);
        SOL_L(1, 0, 4300); SOL_L(1, 1, 4304); SOL_L(1, 2, 4308); SOL_L(1, 3, 4312); SOL_L(1, 4, 4316); SOL_L(1, 5, 4320); SOL_L(1, 6, 4324); SOL_L(1, 7, 4328); SOL_L(1, 8, 4332); SOL_L(1, 9, 4336); SOL_L(1, 10, 4340); SOL_L(1, 11, 4344);
        __builtin_amdgcn_sched_barrier(0);
        SOL_F(62, 32, 0, 0, x); SOL_F(62, 33, 0, 0, y); SOL_F(62, 34, 0, 0, z); SOL_F(62, 35, 0, 0, w);
        SOL_F(62, 36, 0, 1, x); SOL_F(62, 37, 0, 1, y); SOL_F(62, 38, 0, 1, z); SOL_F(62, 39, 0, 1, w);
        SOL_F(62, 40, 0, 2, x); SOL_F(62, 41, 0, 2, y); SOL_F(62, 42, 0, 2, z); SOL_F(62, 43, 0, 2, w);
        SOL_F(62, 44, 0, 3, x); SOL_F(62, 45, 0, 3, y); SOL_F(62, 46, 0, 3, z); SOL_F(62, 47, 0, 3, w);
        SOL_F(62, 48, 0, 4, x); SOL_F(62, 49, 0, 4, y); SOL_F(62, 50, 0, 4, z); SOL_F(62, 51, 0, 4, w);
        SOL_F(62, 52, 0, 5, x); SOL_F(62, 53, 0, 5, y); SOL_F(62, 54, 0, 5, z); SOL_F(62, 55, 0, 5, w);
        SOL_F(62, 56, 0, 6, x); SOL_F(62, 57, 0, 6, y); SOL_F(62, 58, 0, 6, z); SOL_F(62, 59, 0, 6, w);
        SOL_F(62, 60, 0, 7, x); SOL_F(62, 61, 0, 7, y);
        SOL_F(63, 0, 0, 8, x); SOL_F(63, 1, 0, 8, y); SOL_F(63, 2, 0, 8, z); SOL_F(63, 3, 0, 8, w);
        SOL_F(63, 4, 0, 9, x); SOL_F(63, 5, 0, 9, y); SOL_F(63, 6, 0, 9, z); SOL_F(63, 7, 0, 9, w);
        SOL_F(63, 8, 0, 10, x); SOL_F(63, 9, 0, 10, y); SOL_F(63, 10, 0, 10, z); SOL_F(63, 11, 0, 10, w);
        SOL_F(63, 12, 0, 11, x); SOL_F(63, 13, 0, 11, y); SOL_F(63, 14, 0, 11, z); SOL_F(63, 15, 0, 11, w);
        __builtin_amdgcn_sched_barrier(0);
        __builtin_amdgcn_sched_barrier(0);
        SOL_F(63, 16, 1, 0, x); SOL_F(63, 17, 1, 0, y); SOL_F(63, 18, 1, 0, z); SOL_F(63, 19, 1, 0, w);
        SOL_F(63, 20, 1, 1, x); SOL_F(63, 21, 1, 1, y); SOL_F(63, 22, 1, 1, z); SOL_F(63, 23, 1, 1, w);
        SOL_F(63, 24, 1, 2, x); SOL_F(63, 25, 1, 2, y); SOL_F(63, 26, 1, 2, z); SOL_F(63, 27, 1, 2, w);
        SOL_F(63, 28, 1, 3, x); SOL_F(63, 29, 1, 3, y); SOL_F(63, 30, 1, 3, z); SOL_F(63, 31, 1, 3, w);
        SOL_F(63, 32, 1, 4, x); SOL_F(63, 33, 1, 4, y); SOL_F(63, 34, 1, 4, z); SOL_F(63, 35, 1, 4, w);
        SOL_F(63, 36, 1, 5, x); SOL_F(63, 37, 1, 5, y); SOL_F(63, 38, 1, 5, z); SOL_F(63, 39, 1, 5, w);
        SOL_F(63, 40, 1, 6, x); SOL_F(63, 41, 1, 6, y); SOL_F(63, 42, 1, 6, z); SOL_F(63, 43, 1, 6, w);
        SOL_F(63, 44, 1, 7, x); SOL_F(63, 45, 1, 7, y); SOL_F(63, 46, 1, 7, z); SOL_F(63, 47, 1, 7, w);
        SOL_F(63, 48, 1, 8, x); SOL_F(63, 49, 1, 8, y); SOL_F(63, 50, 1, 8, z); SOL_F(63, 51, 1, 8, w);
        SOL_F(63, 52, 1, 9, x); SOL_F(63, 53, 1, 9, y); SOL_F(63, 54, 1, 9, z); SOL_F(63, 55, 1, 9, w);
        SOL_F(63, 56, 1, 10, x); SOL_F(63, 57, 1, 10, y); SOL_F(63, 58, 1, 10, z); SOL_F(63, 59, 1, 10, w);
        SOL_F(63, 60, 1, 11, x); SOL_F(63, 61, 1, 11, y); SOL_F(63, 62, 1, 11, z);
        __builtin_amdgcn_sched_barrier(0);
#undef SOL_L
#undef SOL_F
        if (isu) {
#pragma unroll
            for (int q = 0; q < 8; ++q) { u32x4 o; o.x = pk2(xs[8 * q], xs[8 * q + 1]); o.y = pk2(xs[8 * q + 2], xs[8 * q + 3]); o.z = pk2(xs[8 * q + 4], xs[8 * q + 5]); o.w = pk2(xs[8 * q + 6], xs[8 * q + 7]);
                bf16_t* up = uT + ((col >> 5) * 8 + q) * 256 + (col & 31) * 4;
                *(u32x2*)up = (u32x2){o.x, o.y}; *(u32x2*)(up + 128) = (u32x2){o.z, o.w}; }
        } else {
            const int dk = col - 128, pos = (dk & ~15) + pinv16(dk & 15);
            LAS unsigned short* Wp = (LAS unsigned short*)(lds + P3_Q) + pos;
            unsigned wpk[32];
#pragma unroll
            for (int i = 0; i < 32; ++i) wpk[i] = pk2(xs[2 * i], xs[2 * i + 1]);
            __builtin_amdgcn_sched_barrier(0);
#pragma unroll
            for (int i = 0; i < 32; ++i) { Wp[(2 * i) * 136] = (unsigned short)(wpk[i] & 0xffffu); Wp[(2 * i + 1) * 136] = (unsigned short)(wpk[i] >> 16); }
        }
    } else {
        const int t2 = tid - 256; const float gl = gcs[63];
        const LAS unsigned short* Kb = (const LAS unsigned short*)(lds + P3_K);
#pragma unroll
        for (int i = 0; i < 4; ++i) {
            const int idx = t2 + 256 * i, dk = idx >> 3, ch = idx & 7, cb0 = (ch >> 1) * 16 + (ch & 1) * 4;
            float v[8];
#pragma unroll
            for (int e = 0; e < 8; ++e) { const int c = cb0 + (e & 3) + (e >> 2) * 8; v[e] = bf2f(Kb[c * 136 + dk]) * __expf(gl - gcs[c]); }
            u32x4 o; o.x = pk2(v[0], v[1]); o.y = pk2(v[2], v[3]); o.z = pk2(v[4], v[5]); o.w = pk2(v[6], v[7]);
            *(u32x4*)(kdT + dk * 64 + ch * 8) = o;
        }
        if (tid == 256) ((float*)(a.ws + WS_GLAST))[bh * 64 + n] = gl;
        p3_ret_half(a, lds + 73728, rb, rn, rh, t2);
    }
    __syncthreads();
#pragma unroll
    for (int i = 0; i < 2; ++i) { const int p = tid + 512 * i, row = p >> 4, pc = p & 15; *(u32x4*)(wG + row * 128 + pc * 8) = *(const LAS u32x4*)(lds + P3_Q + row * 272 + pc * 16); }
    __syncthreads();
}

DI void p3_ret_half(const Args& a, LAS unsigned char* lds, int b, int n, int h, int t2in) {
    int tid_ = t2in; asm volatile("" : "+v"(tid_));
    const int tid = tid_, lane = tid & 63, wave = tid >> 6;
    const bf16_t* proj = (const bf16_t*)(a.ws + WS_PROJ);
    const int bh = b * 4 + h;
    unsigned char* rec = (unsigned char*)a.out + (size_t)(bh * 64 + n) * RREC;
    bf16_t* vT = (bf16_t*)rec; bf16_t* qgG = (bf16_t*)(rec + 16384); bf16_t* kdT = (bf16_t*)(rec + 32768); bf16_t* atG = (bf16_t*)(rec + 49152);
    const float lg = log1pf(-exp2f(-5.f - (float)h));
#pragma unroll 1
    for (int ps = 0; ps < 2; ++ps) {
    const int r = (tid >> 3) + 32 * ps, cb = tid & 7;
    const bf16_t* prow = proj + (size_t)(b * SEQ + n * 64 + r) * NPROJ;
    {
        const u32x4 q1 = *(const u32x4*)(prow + h * 128 + cb * 8), q2 = *(const u32x4*)(prow + h * 128 + 64 + cb * 8);
        const u32x4 k1 = *(const u32x4*)(prow + 512 + h * 128 + cb * 8), k2 = *(const u32x4*)(prow + 512 + h * 128 + 64 + cb * 8);
        const u32x4 v0 = *(const u32x4*)(prow + 1024 + h * 128 + cb * 16), v1 = *(const u32x4*)(prow + 1024 + h * 128 + cb * 16 + 8);
        *(LAS u32x4*)(lds + P3_V + r * 272 + cb * 32) = v0; *(LAS u32x4*)(lds + P3_V + r * 272 + cb * 32 + 16) = v1;
        const float pos = (float)(n * 64 + r);
        float qa[8], qb[8], ka[8], kb[8];
        const unsigned qw1[4] = {q1.x, q1.y, q1.z, q1.w}, qw2[4] = {q2.x, q2.y, q2.z, q2.w}, kw1[4] = {k1.x, k1.y, k1.z, k1.w}, kw2[4] = {k2.x, k2.y, k2.z, k2.w};
#pragma unroll
        for (int e = 0; e < 8; ++e) {
            const int d = cb * 8 + e;
            const float inv = exp2f(-(float)d * (13.287712379549449f / 64.f));
            const float ang = pos * inv;
            const float kq = rintf(ang * 0.15915494309189535f);
            float rr = fmaf(-kq, 6.2831854820251465f, ang); rr = fmaf(-kq, -1.7484555e-7f, rr);
            const float cs = __cosf(rr), sn = __sinf(rr);
            const float x1 = (e & 1) ? bfhi(qw1[e >> 1]) : bflo(qw1[e >> 1]), x2 = (e & 1) ? bfhi(qw2[e >> 1]) : bflo(qw2[e >> 1]);
            const float y1 = (e & 1) ? bfhi(kw1[e >> 1]) : bflo(kw1[e >> 1]), y2 = (e & 1) ? bfhi(kw2[e >> 1]) : bflo(kw2[e >> 1]);
            qa[e] = x1 * cs - x2 * sn; qb[e] = x1 * sn + x2 * cs;
            ka[e] = (y1 * cs - y2 * sn) * 0.08838834764831845f; kb[e] = (y1 * sn + y2 * cs) * 0.08838834764831845f;
        }
        u32x4 o;
        o.x = pk2(qa[0], qa[1]); o.y = pk2(qa[2], qa[3]); o.z = pk2(qa[4], qa[5]); o.w = pk2(qa[6], qa[7]); *(LAS u32x4*)(lds + P3_Q + r * 272 + cb * 16) = o;
        o.x = pk2(qb[0], qb[1]); o.y = pk2(qb[2], qb[3]); o.z = pk2(qb[4], qb[5]); o.w = pk2(qb[6], qb[7]); *(LAS u32x4*)(lds + P3_Q + r * 272 + 128 + cb * 16) = o;
        o.x = pk2(ka[0], ka[1]); o.y = pk2(ka[2], ka[3]); o.z = pk2(ka[4], ka[5]); o.w = pk2(ka[6], ka[7]); *(LAS u32x4*)(lds + P3_K + r * 272 + cb * 16) = o;
        o.x = pk2(kb[0], kb[1]); o.y = pk2(kb[2], kb[3]); o.z = pk2(kb[4], kb[5]); o.w = pk2(kb[6], kb[7]); *(LAS u32x4*)(lds + P3_K + r * 272 + 128 + cb * 16) = o;
        const float qd = __expf(lg * (float)(r + 1));
        bf16_t* q0 = qgG + r * 128 + (cb >> 1) * 16 + 4 * (cb & 1);
        u32x2 w2;
        w2.x = pk2(qa[0] * qd, qa[1] * qd); w2.y = pk2(qa[2] * qd, qa[3] * qd); *(u32x2*)(q0) = w2;
        w2.x = pk2(qa[4] * qd, qa[5] * qd); w2.y = pk2(qa[6] * qd, qa[7] * qd); *(u32x2*)(q0 + 8) = w2;
        w2.x = pk2(qb[0] * qd, qb[1] * qd); w2.y = pk2(qb[2] * qd, qb[3] * qd); *(u32x2*)(q0 + 64) = w2;
        w2.x = pk2(qb[4] * qd, qb[5] * qd); w2.y = pk2(qb[6] * qd, qb[7] * qd); *(u32x2*)(q0 + 64 + 8) = w2;
    }
    }
    __syncthreads();
#pragma unroll
    for (int i = 0; i < 4; ++i) {
        const int ti = wave * 4 + i, mt = ti >> 2, nt = ti & 3;
        const LAS unsigned char* Ab = lds + P3_Q + (16 * mt + (lane & 15)) * 272 + (lane >> 4) * 16;
        const LAS unsigned char* Bb = lds + P3_K + (16 * nt + (lane & 15)) * 272 + (lane >> 4) * 16;
        f32x4 acc = {0.f, 0.f, 0.f, 0.f};
#pragma unroll
        for (int s = 0; s < 4; ++s) acc = __builtin_amdgcn_mfma_f32_16x16x32_bf16(*(const LAS bf16x8*)(Ab + s * 64), *(const LAS bf16x8*)(Bb + s * 64), acc, 0, 0, 0);
        const int jj = 16 * nt + (lane & 15);
#pragma unroll
        for (int j = 0; j < 4; ++j) { const int ii = 16 * mt + (lane >> 4) * 4 + j; const int dd = ii > jj ? ii - jj : jj - ii;
            atG[ii * 64 + (jj & ~15) + pinv16(jj & 15)] = f2bf(acc[j] * __expf(lg * (float)dd)); }
    }
    {
        const LAS unsigned short* Kb = (const LAS unsigned short*)(lds + P3_K);
#pragma unroll
        for (int i = 0; i < 4; ++i) {
            const int idx = tid + 256 * i, dk = idx >> 3, ch = idx & 7, cb0 = (ch >> 1) * 16 + (ch & 1) * 4;
            float v[8];
#pragma unroll
            for (int e = 0; e < 8; ++e) { const int c = cb0 + (e & 3) + (e >> 2) * 8; v[e] = bf2f(Kb[c * 136 + dk]) * __expf(lg * (float)(63 - c)); }
            u32x4 o; o.x = pk2(v[0], v[1]); o.y = pk2(v[2], v[3]); o.z = pk2(v[4], v[5]); o.w = pk2(v[6], v[7]);
            *(u32x4*)(kdT + dk * 64 + ch * 8) = o;
        }
    }
#pragma unroll 1
    for (int ps = 0; ps < 2; ++ps) {
        const int dk = tid & 127, cblk = (tid >> 7) + 2 * ps;
        const LAS unsigned short* Vp = (const LAS unsigned short*)(lds + P3_V) + dk;
        unsigned short vv[16];
#pragma unroll
        for (int d = 0; d < 16; ++d) vv[d] = Vp[(cblk * 16 + d) * 136];
        u32x4 o0, o1;
        o0.x = vv[0] | ((unsigned)vv[1] << 16); o0.y = vv[2] | ((unsigned)vv[3] << 16); o0.z = vv[4] | ((unsigned)vv[5] << 16); o0.w = vv[6] | ((unsigned)vv[7] << 16);
        o1.x = vv[8] | ((unsigned)vv[9] << 16); o1.y = vv[10] | ((unsigned)vv[11] << 16); o1.z = vv[12] | ((unsigned)vv[13] << 16); o1.w = vv[14] | ((unsigned)vv[15] << 16);
        { bf16_t* up = vT + ((dk >> 5) * 8 + cblk * 2) * 256 + (dk & 31) * 4;
          *(u32x2*)up = (u32x2){o0.x, o0.y}; *(u32x2*)(up + 128) = (u32x2){o0.z, o0.w}; *(u32x2*)(up + 256) = (u32x2){o1.x, o1.y}; *(u32x2*)(up + 256 + 128) = (u32x2){o1.z, o1.w}; }
    }
}

DI void p3_phase(const Args& a, LAS unsigned char* lds, int wv) {
    { const int hh = (blockIdx.x >> 1) & 3, tid = wv * 64 + lane_id();
      LAS float* cwl = (LAS float*)(lds + P3_CW);
      for (int i = tid; i < 1536; i += 512) { const int mtx = i >> 9, w = (i >> 7) & 3, ch = i & 127; cwl[i] = a.conv_w[(size_t)w * 1536 + mtx * 512 + hh * 128 + ch]; }
      __syncthreads(); }
    for (int it = blockIdx.x; it < 4096; it += 2 * gridDim.x) {
        const int it2 = it + gridDim.x;
        const int typeA = (it & 1) ^ ((it >> 8) & 1);
        const int itg = typeA ? it : it2, itr = typeA ? it2 : it;
        const int chg = itg >> 1, chr = itr >> 1;
        p3_pair_item(a, lds, chg >> 8, (chg >> 2) & 63, chg & 3, chr >> 8, (chr >> 2) & 63, chr & 3, wv);
    }
}

constexpr int ST_BYTES = 62464, ST_W = 0, ST_QG = 17408, ST_KD = 34816, ST_AT = 53248;
DI void decay16(f32x16& x, float d) {
#pragma unroll
    for (int i = 0; i < 16; ++i) { float r; asm("v_mul_f32_e32 %0, %1, %2" : "=v"(r) : "v"(x[i]), "v"(d)); x[i] = r; }
}
DI bf16x8 pack8(const f32x16& x, int base) {
    u32x4 p; p.x = pk2(x[base + 0], x[base + 1]); p.y = pk2(x[base + 2], x[base + 3]); p.z = pk2(x[base + 4], x[base + 5]); p.w = pk2(x[base + 6], x[base + 7]);
    return __builtin_bit_cast(bf16x8, p);
}
#define MFMA32(a, b, c) __builtin_amdgcn_mfma_f32_32x32x16_bf16((a), (b), (c), 0, 0, 0)
#define SCAN_BAR() do { asm volatile("s_waitcnt lgkmcnt(0)" ::: "memory"); __builtin_amdgcn_s_barrier(); asm volatile("" ::: "memory"); } while (0)
#define SBAR __builtin_amdgcn_sched_barrier(0)
template <int type>
DI void scan_compute(const Args& a, LAS unsigned char* lds, const unsigned char* rec0, size_t rstride, bf16_t* O, int wave, int bh, int b, int h) {
            int lane_ = lane_id(); asm volatile("" : "+v"(lane_));
            const int r = lane_ & 31, hh = lane_ >> 5;
            const float* glast = (const float*)(a.ws + WS_GLAST) + bh * 64;
            const float rdec = __expf(64.f * log1pf(-exp2f(-5.f - (float)h)));
            const float edec = type ? __expf(glast[lane_]) : 1.f;
            const int ncol = 32 * wave + r;
            const int colbase = (type == 0 ? 0 : 512) + h * 128;
            u32x2 uc[2][4];
            f32x16 S[4];
#pragma unroll
            for (int mt = 0; mt < 4; ++mt)
#pragma unroll
                for (int i = 0; i < 16; ++i) S[mt][i] = 0.f;
#define SCAN_ULOAD(nn) do { const bf16_t* up = (const bf16_t*)(rec0 + (size_t)(nn) * rstride) + wave * 2048 + hh * 128 + r * 4;        \
                _Pragma("unroll") for (int mt = 0; mt < 2; ++mt) _Pragma("unroll") for (int g = 0; g < 4; ++g) uc[mt][g] = *(const u32x2*)(up + (mt * 4 + g) * 256); } while (0)
            SCAN_ULOAD(0);
            SCAN_BAR();
#define FR(p) (*(const LAS bf16x8*)(p))
#define LOAD_W(F, s)  do { F[0] = FR(pW + (s) * 32); F[1] = FR(pW + 32 * 272 + (s) * 32); F[2] = FR(pW + ((s) + 1) * 32); F[3] = FR(pW + 32 * 272 + ((s) + 1) * 32); } while (0)
#define LOAD_Q(F, s)  do { F[0] = FR(pQ + (s) * 32); F[1] = FR(pQ + 32 * 272 + (s) * 32); F[2] = FR(pQ + ((s) + 1) * 32); F[3] = FR(pQ + 32 * 272 + ((s) + 1) * 32); } while (0)
#define LOAD_T(F, s)  do { F[0] = FR(pT + (s) * 32); F[1] = FR(pT + 32 * 144 + (s) * 32); F[2] = FR(pT + ((s) + 1) * 32); F[3] = FR(pT + 32 * 144 + ((s) + 1) * 32); } while (0)
#define LOAD_K(F, s)  do { F[0] = FR(pK + (s) * 32); F[1] = FR(pK + 32 * 144 + (s) * 32); F[2] = FR(pK + 64 * 144 + (s) * 32); F[3] = FR(pK + 96 * 144 + (s) * 32); } while (0)
#define COMP_W(F, s)  do { acc0 = MFMA32(F[0], Sb[s], acc0); acc1 = MFMA32(F[1], Sb[s], acc1); acc0 = MFMA32(F[2], Sb[(s) + 1], acc0); acc1 = MFMA32(F[3], Sb[(s) + 1], acc1); } while (0)
#define COMP_Q(F, s)  do { o0 = MFMA32(F[0], Sb[s], o0); o1 = MFMA32(F[1], Sb[s], o1); o0 = MFMA32(F[2], Sb[(s) + 1], o0); o1 = MFMA32(F[3], Sb[(s) + 1], o1); } while (0)
#define COMP_T(F, s)  do { o0 = MFMA32(F[0], vb[s], o0); o1 = MFMA32(F[1], vb[s], o1); o0 = MFMA32(F[2], vb[(s) + 1], o0); o1 = MFMA32(F[3], vb[(s) + 1], o1); } while (0)
#define COMP_K(F, s)  do { S[0] = MFMA32(F[0], vb[s], S[0]); S[1] = MFMA32(F[1], vb[s], S[1]); S[2] = MFMA32(F[2], vb[s], S[2]); S[3] = MFMA32(F[3], vb[s], S[3]); } while (0)
#pragma unroll 1
            for (int n = 0; n < 64; ++n) {
                const LAS unsigned char* sb = lds + (n & 1) * ST_BYTES;
                const LAS unsigned char* pW = sb + ST_W + r * 272 + hh * 16;
                const LAS unsigned char* pQ = sb + ST_QG + r * 272 + hh * 16;
                const LAS unsigned char* pT = sb + ST_AT + r * 144 + hh * 16;
                const LAS unsigned char* pK = sb + ST_KD + r * 144 + hh * 16;
                const float dec = type ? __builtin_bit_cast(float, __builtin_amdgcn_readlane(__builtin_bit_cast(int, edec), n)) : rdec;
                bf16x8 vb[4], fa[4], fb[4];
                f32x16 acc0, acc1, o0, o1;
#pragma unroll
                for (int i = 0; i < 16; ++i) { acc0[i] = 0.f; acc1[i] = 0.f; o0[i] = 0.f; o1[i] = 0.f; }
#define SBF(s) pack8(S[(s) >> 1], ((s) & 1) * 8)
#define LOAD_WQ(F, s) do { if constexpr (type != 0) { F[0] = FR(pW + (s) * 32); F[1] = FR(pW + 32 * 272 + (s) * 32); } F[2] = FR(pQ + (s) * 32); F[3] = FR(pQ + 32 * 272 + (s) * 32); } while (0)
#define COMP_WQ(F, s) do { const bf16x8 sbs = SBF(s); if constexpr (type != 0) { acc0 = MFMA32(F[0], sbs, acc0); acc1 = MFMA32(F[1], sbs, acc1); } o0 = MFMA32(F[2], sbs, o0); o1 = MFMA32(F[3], sbs, o1); } while (0)
                LOAD_WQ(fa, 0);
                LOAD_WQ(fb, 1); SBAR; COMP_WQ(fa, 0); SBAR;
                LOAD_WQ(fa, 2); SBAR; COMP_WQ(fb, 1); SBAR;
                LOAD_WQ(fb, 3); SBAR; COMP_WQ(fa, 2); SBAR;
                LOAD_WQ(fa, 4); SBAR; COMP_WQ(fb, 3); SBAR;
                LOAD_WQ(fb, 5); SBAR; COMP_WQ(fa, 4); SBAR;
                LOAD_WQ(fa, 6); SBAR; COMP_WQ(fb, 5); SBAR;
                LOAD_WQ(fb, 7); SBAR; COMP_WQ(fa, 6); SBAR;
                LOAD_T(fa, 0); SBAR; COMP_WQ(fb, 7); SBAR;
                {
#pragma unroll
                    for (int g = 0; g < 4; ++g) {
                        acc0[4 * g + 0] = bflo(uc[0][g].x) - acc0[4 * g + 0]; acc0[4 * g + 1] = bfhi(uc[0][g].x) - acc0[4 * g + 1];
                        acc0[4 * g + 2] = bflo(uc[0][g].y) - acc0[4 * g + 2]; acc0[4 * g + 3] = bfhi(uc[0][g].y) - acc0[4 * g + 3];
                        acc1[4 * g + 0] = bflo(uc[1][g].x) - acc1[4 * g + 0]; acc1[4 * g + 1] = bfhi(uc[1][g].x) - acc1[4 * g + 1];
                        acc1[4 * g + 2] = bflo(uc[1][g].y) - acc1[4 * g + 2]; acc1[4 * g + 3] = bfhi(uc[1][g].y) - acc1[4 * g + 3]; }
                    vb[0] = pack8(acc0, 0); vb[1] = pack8(acc0, 8); vb[2] = pack8(acc1, 0); vb[3] = pack8(acc1, 8);
                }
                SBAR;
                SCAN_ULOAD(n + 1 < 64 ? n + 1 : 63);
                LOAD_T(fb, 2); SBAR; COMP_T(fa, 0); decay16(S[0], dec); decay16(S[1], dec); SBAR;
                LOAD_K(fa, 0); SBAR; COMP_T(fb, 2); decay16(S[2], dec); decay16(S[3], dec); SBAR;
                LOAD_K(fb, 1); SBAR; COMP_K(fa, 0); SBAR;
                LOAD_K(fa, 2); SBAR; COMP_K(fb, 1); SBAR;
                LOAD_K(fb, 3); SBAR; COMP_K(fa, 2); SBAR;
                COMP_K(fb, 3);
                SBAR;
                {
                    LAS unsigned char* og = lds + 2 * ST_BYTES + wave * 5120;
                    LAS unsigned short* ow = (LAS unsigned short*)(og + (4 * hh) * 80) + r;
                    unsigned pk[16];
#pragma unroll
                    for (int i = 0; i < 8; ++i) { pk[i] = pk2(o0[2 * i], o0[2 * i + 1]); pk[8 + i] = pk2(o1[2 * i], o1[2 * i + 1]); }
                    SBAR;
#pragma unroll
                    for (int i = 0; i < 8; ++i) {
                        ow[(((2 * i) & 3) + 8 * ((2 * i) >> 2)) * 40] = (unsigned short)(pk[i] & 0xffffu); ow[(((2 * i + 1) & 3) + 8 * ((2 * i + 1) >> 2)) * 40] = (unsigned short)(pk[i] >> 16);
                        ow[(32 + ((2 * i) & 3) + 8 * ((2 * i) >> 2)) * 40] = (unsigned short)(pk[8 + i] & 0xffffu); ow[(32 + ((2 * i + 1) & 3) + 8 * ((2 * i + 1) >> 2)) * 40] = (unsigned short)(pk[8 + i] >> 16); }
                    asm volatile("" ::: "memory");
                    char* ob = (char*)O + (size_t)(((b * SEQ + n * 64) * DM + colbase + 32 * wave) * 2);
                    const int lrow = (r >> 2) + 8 * hh, lpart = r & 3;
                    const unsigned lo = (unsigned)(lrow * (DM * 2) + lpart * 16);
                    const LAS unsigned char* orp = og + lrow * 80 + lpart * 16;
#pragma unroll
                    for (int k = 0; k < 4; ++k) *(u32x4*)(ob + (lo + (unsigned)(k * 16 * DM * 2))) = *(const LAS u32x4*)(orp + 16 * k * 80);
                }
                SCAN_BAR();
            }
#undef SCAN_ULOAD
#undef FR
#undef LOAD_W
#undef LOAD_Q
#undef LOAD_T
#undef LOAD_K
#undef COMP_W
#undef SBF
#undef LOAD_WQ
#undef COMP_WQ
#undef COMP_Q
#undef COMP_T
#undef COMP_K
}
DI u32x4 ld_async(const unsigned char* p) { u32x4 v; asm volatile("global_load_dwordx4 %0, %1, off" : "=v"(v) : "v"(p) : "memory"); return v; }
template <int type>
DI void scan_loader(LAS unsigned char* lds, const unsigned char* rec0, size_t rstride, int o_w, int o_qg, int o_kd, int o_at, int wv) {
    int t2_ = wv * 64 + lane_id() - 256; asm volatile("" : "+v"(t2_));
    const int t2 = t2_;
    u32x4 sgA[14], sgB[14];
#define LD_LOAD(dst, nn) do { const unsigned char* rec = rec0 + (size_t)((nn) < 64 ? (nn) : 63) * rstride; \
        _Pragma("unroll") for (int i = 0; i < 4; ++i) { if constexpr (type != 0) dst[i] = ld_async(rec + o_w + (t2 + 256 * i) * 16); \
            dst[4 + i] = ld_async(rec + o_qg + (t2 + 256 * i) * 16); dst[8 + i] = ld_async(rec + o_kd + (t2 + 256 * i) * 16); } \
        dst[12] = ld_async(rec + o_at + t2 * 16); dst[13] = ld_async(rec + o_at + (t2 + 256) * 16); } while (0)
#define LD_STORE(src, st) do { LAS unsigned char* sb = lds + (st) * ST_BYTES; \
        _Pragma("unroll") for (int i = 0; i < 4; ++i) { const int p = t2 + 256 * i; \
            if constexpr (type != 0) *(LAS u32x4*)(sb + ST_W + (p >> 4) * 272 + (p & 15) * 16) = src[i]; \
            *(LAS u32x4*)(sb + ST_QG + (p >> 4) * 272 + (p & 15) * 16) = src[4 + i]; \
            *(LAS u32x4*)(sb + ST_KD + (p >> 3) * 144 + (p & 7) * 16) = src[8 + i]; } \
        *(LAS u32x4*)(sb + ST_AT + (t2 >> 3) * 144 + (t2 & 7) * 16) = src[12]; \
        *(LAS u32x4*)(sb + ST_AT + ((t2 + 256) >> 3) * 144 + (t2 & 7) * 16) = src[13]; } while (0)
#define LD_WAIT_OLDER() do { if constexpr (type != 0) asm volatile("s_waitcnt vmcnt(14)" ::: "memory"); else asm volatile("s_waitcnt vmcnt(10)" ::: "memory"); } while (0)
    LD_LOAD(sgA, 0); asm volatile("s_waitcnt vmcnt(0)" ::: "memory"); LD_STORE(sgA, 0); LD_LOAD(sgB, 1); LD_LOAD(sgA, 2);
    SCAN_BAR();
#define LD_ITER(nn, BUF) do { LD_WAIT_OLDER(); if ((nn) + 1 < 64) LD_STORE(BUF, ((nn) + 1) & 1); LD_LOAD(BUF, (nn) + 3); SCAN_BAR(); } while (0)
#pragma unroll 1
    for (int n = 0; n < 64; n += 2) { LD_ITER(n, sgB); LD_ITER(n + 1, sgA); }
    asm volatile("s_waitcnt vmcnt(0)" ::: "memory");
#undef LD_ITER
#undef LD_WAIT_OLDER
#undef LD_LOAD
#undef LD_STORE
}
DI void p_cvec(const Args& a, LAS unsigned char* lds, int wv, int part) {
    const int tid = wv * 64 + lane_id(), j = part * 512 + tid;
    LAS float* sh = (LAS float*)lds;
    const float* mod = (const float*)(a.ws + WS_MOD);
    for (int i = tid; i < 8192; i += 512) sh[i] = mod[(size_t)(i >> 10) * NMOD + 3072 + (i & 1023)];
    __syncthreads();
    float acc[8];
#pragma unroll
    for (int b = 0; b < 8; ++b) acc[b] = 0.f;
#pragma unroll 16
    for (int k = 0; k < 1024; ++k) { const float w = a.w_ff1[(size_t)k * DFF + j];
#pragma unroll
        for (int b = 0; b < 8; ++b) acc[b] += sh[b * 1024 + k] * w; }
#pragma unroll
    for (int b = 0; b < 8; ++b) ((float*)(a.ws + WS_CVEC))[b * DFF + j] = acc[b];
}
DI void scan_phase(const Args& a, LAS unsigned char* lds, int wv) {
    const int wave = wv;
    bf16_t* O = (bf16_t*)(a.ws + WS_ACT);
    const int item = blockIdx.x;
    if (item < 64) {
        const int type = item & 1, bh = item >> 1, b = bh >> 2, h = bh & 3;
        const unsigned char* rec0; size_t rstride; int o_w, o_qg, o_kd, o_at;
        if (type == 0) { rec0 = (const unsigned char*)a.out + (size_t)bh * 64 * RREC; rstride = RREC; o_w = 0; o_qg = 16384; o_kd = 32768; o_at = 49152; }
        else { rec0 = a.ws + WS_GREC + (size_t)bh * 64 * GREC; rstride = GREC; o_w = 16384; o_qg = 32768; o_kd = 49152; o_at = 65536; }
        if (wave >= 4) {
            if (type) scan_loader<1>(lds, rec0, rstride, o_w, o_qg, o_kd, o_at, wv); else scan_loader<0>(lds, rec0, rstride, o_w, o_qg, o_kd, o_at, wv);
        } else {
            __builtin_amdgcn_s_setprio(3);
            if (type) scan_compute<1>(a, lds, rec0, rstride, O, wave, bh, b, h); else scan_compute<0>(a, lds, rec0, rstride, O, wave, bh, b, h);
            __builtin_amdgcn_s_setprio(0);
        }
    } else if (item < 72) {
        p_cvec(a, lds, wv, item - 64);
    }
#undef SCAN_BAR
#undef SBAR
}

DI void p5_phase(const Args& a, int wv) {
    const int lane = lane_id(), wave = wv;
    bf16_t* O = (bf16_t*)(a.ws + WS_ACT); const bf16_t* proj = (const bf16_t*)(a.ws + WS_PROJ);
    const int gw = blockIdx.x * 8 + wave, NGW = gridDim.x * 8, col = lane * 16; const bool isret = lane < 32;
    const float* nwp = isret ? a.ret_norm_w + col : a.gdn_norm_w + (col & 127);
    float nw[16];
#pragma unroll
    for (int q = 0; q < 4; ++q) { const f32x4 t = *(const f32x4*)(nwp + 4 * q); nw[4 * q] = t.x; nw[4 * q + 1] = t.y; nw[4 * q + 2] = t.z; nw[4 * q + 3] = t.w; }
    const int gcol = isret ? 1536 + col : 3072 + col;
    for (int m = gw; m < MROWS; m += NGW) {
        bf16_t* op = O + (size_t)m * DM + col;
        const u32x4 o0 = *(const u32x4*)op, o1 = *(const u32x4*)(op + 8);
        const u32x4 g0 = *(const u32x4*)(proj + (size_t)m * NPROJ + gcol), g1 = *(const u32x4*)(proj + (size_t)m * NPROJ + gcol + 8);
        float v[16], g[16];
        v[0] = bflo(o0.x); v[1] = bfhi(o0.x); v[2] = bflo(o0.y); v[3] = bfhi(o0.y); v[4] = bflo(o0.z); v[5] = bfhi(o0.z); v[6] = bflo(o0.w); v[7] = bfhi(o0.w);
        v[8] = bflo(o1.x); v[9] = bfhi(o1.x); v[10] = bflo(o1.y); v[11] = bfhi(o1.y); v[12] = bflo(o1.z); v[13] = bfhi(o1.z); v[14] = bflo(o1.w); v[15] = bfhi(o1.w);
        g[0] = bflo(g0.x); g[1] = bfhi(g0.x); g[2] = bflo(g0.y); g[3] = bfhi(g0.y); g[4] = bflo(g0.z); g[5] = bfhi(g0.z); g[6] = bflo(g0.w); g[7] = bfhi(g0.w);
        g[8] = bflo(g1.x); g[9] = bfhi(g1.x); g[10] = bflo(g1.y); g[11] = bfhi(g1.y); g[12] = bflo(g1.z); g[13] = bfhi(g1.z); g[14] = bflo(g1.w); g[15] = bfhi(g1.w);
        float s = 0.f;
#pragma unroll
        for (int e = 0; e < 16; ++e) s += v[e];
        s = red8(s);
        const float mu = isret ? s * (1.f / 128.f) : 0.f;
        float ss = 0.f;
#pragma unroll
        for (int e = 0; e < 16; ++e) { v[e] -= mu; ss += v[e] * v[e]; }
        ss = red8(ss);
        const float rstd = 1.0f / sqrtf(ss * (1.f / 128.f) + EPS);
        float y[16];
#pragma unroll
        for (int e = 0; e < 16; ++e) y[e] = v[e] * rstd * nw[e] * silu_f(g[e]);
        u32x4 w0, w1; w0.x = pk2(y[0], y[1]); w0.y = pk2(y[2], y[3]); w0.z = pk2(y[4], y[5]); w0.w = pk2(y[6], y[7]);
        w1.x = pk2(y[8], y[9]); w1.y = pk2(y[10], y[11]); w1.z = pk2(y[12], y[13]); w1.w = pk2(y[14], y[15]);
        *(u32x4*)op = w0; *(u32x4*)(op + 8) = w1;
    }
}

DI void final_norm_phase(const Args& a, int wv) {
    const int lane = lane_id(), wave = wv;
    const int gw = blockIdx.x * 8 + wave, NGW = gridDim.x * 8, c0 = lane * 16;
    const bf16_t* X = (const bf16_t*)(a.ws + WS_X1);
    f32x4 nwv[4];
#pragma unroll
    for (int q = 0; q < 4; ++q) nwv[q] = *(const f32x4*)(a.norm_final_w + c0 + 4 * q);
    for (int m0 = gw; m0 < MROWS; m0 += 2 * NGW) {
        u32x4 raw[2][2];
#pragma unroll
        for (int rr = 0; rr < 2; ++rr) { const int m = m0 + rr * NGW < MROWS ? m0 + rr * NGW : m0;
            raw[rr][0] = *(const u32x4*)(X + (size_t)m * DM + c0); raw[rr][1] = *(const u32x4*)(X + (size_t)m * DM + c0 + 8); }
#pragma unroll
        for (int rr = 0; rr < 2; ++rr) {
            const int m = m0 + rr * NGW;
            if (m < MROWS) {
                f32x4 v[4];
                v[0] = (f32x4){bflo(raw[rr][0].x), bfhi(raw[rr][0].x), bflo(raw[rr][0].y), bfhi(raw[rr][0].y)};
                v[1] = (f32x4){bflo(raw[rr][0].z), bfhi(raw[rr][0].z), bflo(raw[rr][0].w), bfhi(raw[rr][0].w)};
                v[2] = (f32x4){bflo(raw[rr][1].x), bfhi(raw[rr][1].x), bflo(raw[rr][1].y), bfhi(raw[rr][1].y)};
                v[3] = (f32x4){bflo(raw[rr][1].z), bfhi(raw[rr][1].z), bflo(raw[rr][1].w), bfhi(raw[rr][1].w)};
                float ss = 0.f;
#pragma unroll
                for (int q = 0; q < 4; ++q) ss += (v[q].x * v[q].x + v[q].y * v[q].y) + (v[q].z * v[q].z + v[q].w * v[q].w);
                ss = wave_sum(ss);
                const float rstd = 1.0f / sqrtf(ss * (1.f / DM) + EPS);
                float* xr = a.out + (size_t)m * DM + c0;
#pragma unroll
                for (int q = 0; q < 4; ++q) *(f32x4*)(xr + 4 * q) = v[q] * rstd * nwv[q];
            }
        }
    }
}

#define XB_TMO      128
#define XB_XCNT(j)  (256  + 64 * (j))
#define XB_XSUB(j)  (1280 + 64 * (j))
#define XB_XGEN(j)  (2304 + 64 * (j))
#define XB_TOP      3328
#define XB_TOPGEN   3392
#define XCD_BAR_WORDS 3456
#define XB_SPIN_CAP (1u << 18)
DI unsigned xb_ld(unsigned* p)              { return __hip_atomic_load(p, __ATOMIC_RELAXED, __HIP_MEMORY_SCOPE_AGENT); }
DI unsigned xb_add(unsigned* p, unsigned v) { return __hip_atomic_fetch_add(p, v, __ATOMIC_RELAXED, __HIP_MEMORY_SCOPE_AGENT); }
DI unsigned xb_xcc_id() { return (unsigned)__builtin_amdgcn_s_getreg((3 << 11) | 20) & 0xFu; }
#define XB_SPIN(cond, bar) do { unsigned _sp = 0; while (cond) { __builtin_amdgcn_s_sleep(1); \
    if ((++_sp & 255u) == 0u) { if (xb_ld(&(bar)[XB_TMO])) break; if (_sp > XB_SPIN_CAP) { atomicAdd(&(bar)[XB_TMO], 1u); break; } } } } while (0)
struct XcdBarrier { unsigned* bar; unsigned x; volatile LAS unsigned* st; };
DI XcdBarrier xcd_barrier_post(unsigned* bar, volatile LAS unsigned* st, int wv) {
    XcdBarrier b; b.bar = bar; b.x = xb_xcc_id(); b.st = st;
    if (wv == 0 && lane_id() == 0) (void)xb_add(&bar[XB_XCNT(b.x)], 1u);
    return b;
}
DI void xcd_barrier_complete(unsigned* bar, unsigned x, unsigned& nloc, unsigned& nx) {
    const unsigned G = gridDim.x * gridDim.y * gridDim.z;
    unsigned sum, cnt, mine, sp = 0u;
    for (;;) {
        sum = 0u; cnt = 0u; mine = 0u;
#pragma unroll
        for (unsigned j = 0; j < 16; ++j) { const unsigned c = xb_ld(&bar[XB_XCNT(j)]); sum += c; cnt += (c > 0u) ? 1u : 0u; mine = (j == x) ? c : mine; }
        if (sum == G) break;
        __builtin_amdgcn_s_sleep(1);
        if ((++sp & 255u) == 0u) { if (xb_ld(&bar[XB_TMO])) break; if (sp > XB_SPIN_CAP) { atomicAdd(&bar[XB_TMO], 1u); break; } }
    }
    nloc = mine > 0u ? mine : 1u; nx = cnt > 0u ? cnt : 1u;
}
DI void xcd_barrier(const XcdBarrier& b, int wv) {
    asm volatile("s_waitcnt vmcnt(0)" ::: "memory");
    __syncthreads();
    if (wv == 0 && lane_id() == 0) {
        unsigned* bar = b.bar;
        __builtin_amdgcn_s_waitcnt(0);
        unsigned nloc = b.st[0], nx = b.st[1];
        if (nloc == 0u) { xcd_barrier_complete(bar, b.x, nloc, nx); b.st[0] = nloc; b.st[1] = nx; }
        const unsigned old = xb_add(&bar[XB_XSUB(b.x)], 1u);
        const unsigned gen = old / nloc;
        if (old + 1u == (gen + 1u) * nloc) {
            __builtin_amdgcn_fence(__ATOMIC_RELEASE, "agent");
            asm volatile("s_waitcnt vmcnt(0)" ::: "memory");
            const unsigned og = xb_add(&bar[XB_TOP], 1u);
            const unsigned tg = og / nx;
            if (og + 1u == (tg + 1u) * nx) xb_add(&bar[XB_TOPGEN], 1u);
            else XB_SPIN(xb_ld(&bar[XB_TOPGEN]) == tg, bar);
            __builtin_amdgcn_fence(__ATOMIC_ACQUIRE, "agent");
            xb_add(&bar[XB_XGEN(b.x)], 1u);
            asm volatile("s_waitcnt vmcnt(0)" ::: "memory");
        } else {
            XB_SPIN(xb_ld(&bar[XB_XGEN(b.x)]) == gen, bar);
            __builtin_amdgcn_fence(__ATOMIC_ACQUIRE, "agent");
            asm volatile("s_waitcnt vmcnt(0)" ::: "memory");
        }
    }
    __syncthreads();
}

constexpr int N_PHASES = 11;
__global__ void __launch_bounds__(512, 2) fwd_megakernel(Args a) {
    extern __shared__ __attribute__((aligned(16))) unsigned char lds_raw[];
    LAS unsigned char* lds = (LAS unsigned char*)lds_raw;
    cg::grid_group grid = cg::this_grid();
    volatile LAS unsigned* bst = (volatile LAS unsigned*)(lds + 147200);
    const int wv = __builtin_amdgcn_readfirstlane(threadIdx.x >> 6);
    if (wv == 0 && lane_id() < 2) bst[lane_id()] = 0u;
    __syncthreads();
    const XcdBarrier bar = xcd_barrier_post((unsigned*)(a.ws + WS_BAR), bst, wv);
    if (a.ph_lo < 0) grid.sync();
    const float* mod = (const float*)(a.ws + WS_MOD);
    bf16_t* act = (bf16_t*)(a.ws + WS_ACT);
    bf16_t* proj = (bf16_t*)(a.ws + WS_PROJ);
    const int G = gridDim.x;
#define IN(k) (a.ph_lo <= (k) && (k) < a.ph_hi)
#define SEAM(k) do { if (IN(k) && IN((k) + 1)) xcd_barrier(bar, wv); } while (0)
    if (IN(0)) { p0_phase(a, lds, wv); } SEAM(0);
    if (IN(1)) { norm_mod_phase<true>(a.x, a.norm_mix_w, mod, 0, 1024, act, a.w_in, (float*)(a.ws + WS_GAB), lds, wv); } SEAM(1);
    if (IN(2)) { pg8::Gemm g{act, (const bf16_t*)(a.ws + WS_WIN), MROWS, NPROJ, DM}; pg8::StaticOrder S; S.init(MROWS, NPROJ, G, (int)blockIdx.x);
        pg8::EpiBf16<0> E{proj, NPROJ}; pg8::gemm_phase<pg8::EpiBf16<0>, pg8::StaticOrder, true, true>(lds, g, S, E, wv); } SEAM(2);
    if (IN(3)) { p3_phase(a, lds, wv); } SEAM(3);
    if (IN(4)) { scan_phase(a, lds, wv); } SEAM(4);
    if (IN(5)) { p5_phase(a, wv); } SEAM(5);
    if (IN(6)) { pg8::Gemm g{act, (const bf16_t*)(a.ws + WS_WOUT), MROWS, DM, DM}; pg8::StaticOrder S; S.init(MROWS, DM, G, (int)blockIdx.x);
        pg8::EpiResGateNorm E{a.x, (bf16_t*)(a.ws + WS_X1), mod + 2048, a.norm_mlp_w, mod + 4096, (bf16_t*)(a.ws + WS_ACT2), (float*)(a.ws + WS_SUMSQ)}; pg8::gemm_phase<pg8::EpiResGateNorm, pg8::StaticOrder, true, true>(lds, g, S, E, wv); } SEAM(6);
    if (IN(8)) { pg8::Gemm g{(const bf16_t*)(a.ws + WS_ACT2), (const bf16_t*)(a.ws + WS_WFF1), MROWS, DFF, DM}; pg8::StaticOrder S; S.init(MROWS, DFF, G, (int)blockIdx.x);
        pg8::EpiFf1 E{proj, DFF, (const float*)(a.ws + WS_SUMSQ), (const float*)(a.ws + WS_CVEC)}; pg8::gemm_phase<pg8::EpiFf1, pg8::StaticOrder, true, true>(lds, g, S, E, wv); } SEAM(8);
    if (IN(9)) { pg8::Gemm g{proj, (const bf16_t*)(a.ws + WS_WFF2), MROWS, DM, DFF}; pg8::StaticOrder S; S.init(MROWS, DM, G, (int)blockIdx.x);
        pg8::EpiResGateBf E{(bf16_t*)(a.ws + WS_X1), mod + 5120}; pg8::gemm_phase<pg8::EpiResGateBf, pg8::StaticOrder, true, true>(lds, g, S, E, wv); } SEAM(9);
    if (IN(10)) { final_norm_phase(a, wv); }
#undef IN
#undef SEAM
}

extern "C" void kernel_launch(void* const* d_in, const int* in_sizes, int n_in, void* d_out, int out_size, void* d_ws, size_t ws_size, hipStream_t stream) {
    static int grid = 0;
    if (grid == 0) {
        if (n_in != 16 || out_size != MROWS * DM || ws_size < WS_END) { fprintf(stderr, "kernel_launch: unexpected shapes (n_in %d out %d ws %zu)\n", n_in, out_size, ws_size); grid = -1; return; }
        int dev = 0, cus = 0, per_cu = 0;
        hipGetDevice(&dev); hipDeviceGetAttribute(&cus, hipDeviceAttributeMultiprocessorCount, dev);
        if (hipFuncSetAttribute((const void*)fwd_megakernel, hipFuncAttributeMaxDynamicSharedMemorySize, LDS_BYTES) != hipSuccess) { fprintf(stderr, "kernel_launch: hipFuncSetAttribute failed\n"); grid = -1; return; }
        if (hipOccupancyMaxActiveBlocksPerMultiprocessor(&per_cu, (const void*)fwd_megakernel, 512, LDS_BYTES) != hipSuccess || per_cu < 1) { fprintf(stderr, "kernel_launch: occupancy query says %d\n", per_cu); per_cu = 1; }
        (void)hipGetLastError();
        grid = cus * per_cu;
        if (grid > 256) grid = 256;
        if (grid != 256) { fprintf(stderr, "kernel_launch: this build needs a 256-workgroup grid, got %d\n", grid); grid = -1; return; }
    }
    if (grid < 0) return;
    Args a{};
    a.x = (const float*)d_in[0]; a.c = (const float*)d_in[1]; a.ada_w = (const float*)d_in[2]; a.ada_b = (const float*)d_in[3]; a.norm_mix_w = (const float*)d_in[4]; a.w_in = (const float*)d_in[5];
    a.conv_w = (const float*)d_in[6]; a.a_log = (const float*)d_in[7]; a.dt_bias = (const float*)d_in[8]; a.ret_norm_w = (const float*)d_in[9]; a.gdn_norm_w = (const float*)d_in[10];
    a.w_out = (const float*)d_in[11]; a.norm_mlp_w = (const float*)d_in[12]; a.w_ff1 = (const float*)d_in[13]; a.w_ff2 = (const float*)d_in[14]; a.norm_final_w = (const float*)d_in[15];
    a.out = (float*)d_out; a.ws = (unsigned char*)d_ws;
    if (hipMemsetAsync((char*)d_ws + WS_BAR, 0, XCD_BAR_WORDS * 4, stream) != hipSuccess) { fprintf(stderr, "kernel_launch: memset of barrier words failed\n"); return; }
#if MK_N_LAUNCHES == 1
    a.ph_lo = 0; a.ph_hi = N_PHASES;
    void* args[] = {&a};
    hipError_t e = hipLaunchCooperativeKernel((const void*)fwd_megakernel, dim3(grid), dim3(512), args, LDS_BYTES, stream);
    if (e != hipSuccess) fprintf(stderr, "cooperative launch failed: %s (grid %d)\n", hipGetErrorString(e), grid);
#else
    for (int p = 0; p < N_PHASES; ++p) { a.ph_lo = p; a.ph_hi = p + 1; hipLaunchKernelGGL(fwd_megakernel, dim3(grid), dim3(512), LDS_BYTES, stream, a); }
#endif
}
```
